# Optimizing an MI355X kernel written in HIP

```python
import math
import jax, jax.numpy as jnp
from jax import lax
import numpy as np

D_MODEL = 1024
BATCH = 2
SEQ = 8192
DEPTH = 2
DEC_BATCH = 32
DEC_SEQ = 64
PAST_LEN = 2048

CHUNK = 64
Q_BLOCK = 128
EPS = 1e-6
N_BRANCH = 4

SSD_HEADS = 8
SSD_HEAD_DIM = 64
SSD_INNER = SSD_HEADS * SSD_HEAD_DIM
SSD_GROUPS = 2
SSD_STATE = 128
SSD_CONV = 4
SSD_CONV_DIM = SSD_INNER + 2 * SSD_GROUPS * SSD_STATE

MLA_HEADS = 8
MLA_Q_RANK = 384
MLA_KV_RANK = 256
MLA_NOPE = 64
MLA_ROPE = 32
MLA_V = 64
MLA_WIDTH = MLA_HEADS * MLA_V
ROPE_THETA = 10000.0

SCONV_WIDTH = 512
SCONV_K = 3

BAND_HEADS = 8
BAND_HEAD_DIM = 64
BAND_WIDTH = BAND_HEADS * BAND_HEAD_DIM
BAND_PAST_CHUNKS = 8
BAND_CHUNKS = BAND_PAST_CHUNKS + 1
REL_CLIP = 128

FF_HIDDEN = ((8 * D_MODEL // 3 + 255) // 256) * 256

IN_SPLITS = (SSD_INNER, SSD_INNER, SSD_GROUPS * SSD_STATE, SSD_GROUPS * SSD_STATE, SSD_HEADS,
             MLA_Q_RANK, MLA_KV_RANK, MLA_ROPE,
             SCONV_WIDTH, SCONV_WIDTH, SCONV_WIDTH,
             BAND_WIDTH, BAND_WIDTH, BAND_WIDTH,
             N_BRANCH * D_MODEL)
IN_COLS = sum(IN_SPLITS)

kernel_name = 'hybrid_streaming_encoder_step'


def rms_norm(x, g):
    xf = x.astype(jnp.float32)
    y = xf * lax.rsqrt(jnp.mean(xf * xf, axis=-1, keepdims=True) + EPS)
    return (y * g.astype(jnp.float32)).astype(x.dtype)


def causal_dwconv(x, prev, w):
    width = w.shape[0]
    t = x.shape[1]
    xp = jnp.concatenate([prev.astype(x.dtype), x], axis=1)
    y = xp[:, 0:t] * w[0]
    for i in range(1, width):
        y = y + xp[:, i:i + t] * w[i]
    return y, xp[:, xp.shape[1] - (width - 1):]


def rope_tables(pos):
    inv = ROPE_THETA ** (-jnp.arange(0, MLA_ROPE, 2, dtype=jnp.float32) / MLA_ROPE)
    ang = pos.astype(jnp.float32)[:, None] * inv[None, :]
    return jnp.cos(ang), jnp.sin(ang)


def apply_rope(x, cos, sin):
    half = x.shape[-1] // 2
    x1, x2 = x[..., :half], x[..., half:]
    cos = cos.astype(x.dtype)
    sin = sin.astype(x.dtype)
    return jnp.concatenate([x1 * cos - x2 * sin, x1 * sin + x2 * cos], axis=-1)


def ssd_scan(x, da, bm, cm, h0, chunk):
    f32 = jnp.float32
    bsz, t, nh, hp = x.shape
    ng, ns = bm.shape[-2:]
    nr = nh // ng
    nc = t // chunk
    xc = x.astype(f32).reshape(bsz, nc, chunk, ng, nr, hp)
    bc = bm.astype(f32).reshape(bsz, nc, chunk, ng, ns)
    cc = cm.astype(f32).reshape(bsz, nc, chunk, ng, ns)
    a_cs = jnp.cumsum(da.astype(f32).reshape(bsz, nc, chunk, ng, nr).transpose(0, 3, 4, 1, 2), axis=-1)
    tril = jnp.tril(jnp.ones((chunk, chunk), bool))
    seg = a_cs[..., :, None] - a_cs[..., None, :]
    decay_in = jnp.where(tril, jnp.exp(jnp.where(tril, seg, 0.0)), 0.0)
    cb = jnp.einsum('bclgn,bcsgn->bgcls', cc, bc)
    y_diag = jnp.einsum('bgrcls,bcsgrp->bclgrp', cb[:, :, None] * decay_in, xc)
    decay_to_end = jnp.exp(a_cs[..., -1:] - a_cs)
    chunk_states = jnp.einsum('bclgn,bgrcl,bclgrp->cbgrpn', bc, decay_to_end, xc)
    chunk_decay = jnp.exp(a_cs[..., -1]).transpose(3, 0, 1, 2)

    def step(h, inp):
        dec, st = inp
        return dec[..., None, None] * h + st, h

    h_fin, h_in = lax.scan(step, h0.astype(f32).reshape(bsz, ng, nr, hp, ns), (chunk_decay, chunk_states))
    y_off = jnp.einsum('bclgn,cbgrpn,bgrcl->bclgrp', cc, h_in, jnp.exp(a_cs))
    y = (y_diag + y_off).reshape(bsz, t, nh, hp)
    return y, h_fin.reshape(bsz, nh, hp, ns).astype(h0.dtype)


def ssd_branch(a_z, a_x, a_b, a_c, a_dt, ssm_prev, conv_prev, prm):
    bsz, t, _ = a_x.shape
    gn = SSD_GROUPS * SSD_STATE
    xbc, conv_new = causal_dwconv(jnp.concatenate([a_x, a_b, a_c], axis=-1), conv_prev, prm['ssd_conv_w'])
    xbc = jax.nn.silu(xbc + prm['ssd_conv_b'])
    xs = xbc[..., :SSD_INNER].reshape(bsz, t, SSD_HEADS, SSD_HEAD_DIM)
    bm = xbc[..., SSD_INNER:SSD_INNER + gn].reshape(bsz, t, SSD_GROUPS, SSD_STATE)
    cm = xbc[..., SSD_INNER + gn:].reshape(bsz, t, SSD_GROUPS, SSD_STATE)
    dt = jax.nn.softplus(a_dt.astype(jnp.float32) + prm['ssd_dt_bias'].astype(jnp.float32))
    a = -jnp.exp(prm['ssd_a_log'].astype(jnp.float32))
    y, ssm_new = ssd_scan(xs.astype(jnp.float32) * dt[..., None], dt * a, bm, cm, ssm_prev, min(CHUNK, t))
    y = y.astype(a_x.dtype) + prm['ssd_d'][:, None] * xs
    y = rms_norm(y.reshape(bsz, t, SSD_INNER) * jax.nn.silu(a_z), prm['ssd_norm_g'])
    return y @ prm['w_a_out'], ssm_new, conv_new


def mla_attend(q_nope, q_pe, k_nope, k_pe, v, q_pos, k_pos):
    bsz, t, nh, _ = q_nope.shape
    scale = (MLA_NOPE + MLA_ROPE) ** -0.5
    k_chunk = k_pos // CHUNK

    def block(args):
        qn, qp, qpos = args
        s = jnp.einsum('bqhd,bkhd->bhqk', qn, k_nope) + jnp.einsum('bqhr,bkr->bhqk', qp, k_pe)
        s = s.astype(jnp.float32) * scale
        mask = k_chunk[None, :] <= (qpos // CHUNK)[:, None]
        p = jax.nn.softmax(jnp.where(mask, s, -jnp.inf), axis=-1).astype(v.dtype)
        return jnp.einsum('bhqk,bkhd->bqhd', p, v)

    if t <= Q_BLOCK:
        return block((q_nope, q_pe, q_pos))
    nb = t // Q_BLOCK

    def to_blocks(a):
        return a.reshape(bsz, nb, Q_BLOCK, *a.shape[2:]).swapaxes(0, 1)

    out = lax.map(block, (to_blocks(q_nope), to_blocks(q_pe), q_pos.reshape(nb, Q_BLOCK)))
    return out.swapaxes(0, 1).reshape(bsz, t, nh, MLA_V)


def mla_branch(b_ql, b_kvl, b_kpe, pos, ckv_prev, kpe_prev, prm):
    bsz, t, _ = b_ql.shape
    cos, sin = rope_tables(pos)
    q = (rms_norm(b_ql, prm['mla_q_norm_g']) @ prm['mla_w_q_up']).reshape(bsz, t, MLA_HEADS, MLA_NOPE + MLA_ROPE)
    q_nope = rms_norm(q[..., :MLA_NOPE], prm['mla_qn_g'])
    q_pe = apply_rope(rms_norm(q[..., MLA_NOPE:], prm['mla_qr_g']), cos[:, None], sin[:, None])
    ckv = rms_norm(b_kvl, prm['mla_kv_norm_g'])
    kpe = apply_rope(rms_norm(b_kpe, prm['mla_kr_g']), cos, sin)
    if ckv_prev is None:
        ckv_all, kpe_all, k_pos = ckv, kpe, pos
    else:
        ckv_all = jnp.concatenate([ckv_prev, ckv], axis=1)
        kpe_all = jnp.concatenate([kpe_prev, kpe], axis=1)
        k_pos = jnp.arange(ckv_all.shape[1], dtype=jnp.int32)
    kv = (ckv_all @ prm['mla_w_kv_up']).reshape(bsz, ckv_all.shape[1], MLA_HEADS, MLA_NOPE + MLA_V)
    k_nope = rms_norm(kv[..., :MLA_NOPE], prm['mla_kn_g'])
    v = kv[..., MLA_NOPE:]
    o = mla_attend(q_nope, q_pe, k_nope, kpe_all, v, pos, k_pos)
    return o.reshape(bsz, t, MLA_WIDTH) @ prm['w_b_out'], ckv, kpe


def sconv_branch(c_b, c_c, c_x, prev, prm):
    u = c_c * c_x
    uc, new = causal_dwconv(u, prev, prm['sconv_w'])
    return (c_b * uc) @ prm['w_c_out'], new


def band_attend(q, k, v, rel, valid, rel_bias):
    idx = jnp.clip(rel, -REL_CLIP, REL_CLIP) + REL_CLIP
    bias = rel_bias[:, idx].astype(jnp.float32)
    s = jnp.einsum('bclhd,bcshd->bchls', q, k).astype(jnp.float32) * (BAND_HEAD_DIM ** -0.5) + bias[None, None]
    s = jnp.where(valid[None, :, None, None, :], s, -jnp.inf)
    p = jax.nn.softmax(s, axis=-1).astype(v.dtype)
    return jnp.einsum('bchls,bcshd->bclhd', p, v)


def band_branch(d_q, d_k, d_v, pos, k_prev, v_prev, prm):
    bsz, t, _ = d_q.shape
    shp = (bsz, t, BAND_HEADS, BAND_HEAD_DIM)
    q = rms_norm(d_q.reshape(shp), prm['band_qn_g'])
    k = rms_norm(d_k.reshape(shp), prm['band_kn_g'])
    v = d_v.reshape(shp)
    span = BAND_CHUNKS * CHUNK
    if k_prev is None:
        nc = t // CHUNK
        cshp = (bsz, nc, CHUNK, BAND_HEADS, BAND_HEAD_DIM)
        pad = jnp.zeros((bsz, BAND_PAST_CHUNKS, CHUNK, BAND_HEADS, BAND_HEAD_DIM), k.dtype)
        idx = jnp.arange(nc)[:, None] + jnp.arange(BAND_CHUNKS)[None, :]
        bshp = (bsz, nc, span, BAND_HEADS, BAND_HEAD_DIM)
        k_band = jnp.concatenate([pad, k.reshape(cshp)], axis=1)[:, idx].reshape(bshp)
        v_band = jnp.concatenate([pad, v.reshape(cshp)], axis=1)[:, idx].reshape(bshp)
        rel = jnp.arange(CHUNK)[:, None] - jnp.arange(span)[None, :] + BAND_PAST_CHUNKS * CHUNK
        valid = ((jnp.arange(nc)[:, None] - BAND_PAST_CHUNKS) * CHUNK + jnp.arange(span)[None, :]) >= 0
        o = band_attend(q.reshape(cshp), k_band, v_band, rel, valid, prm['band_rel_bias']).reshape(bsz, t, BAND_WIDTH)
        rows = min(BAND_PAST_CHUNKS * CHUNK, t)
        k_new, v_new = k[:, t - rows:], v[:, t - rows:]
    else:
        rows = k_prev.shape[1]
        k_all = jnp.concatenate([k_prev, k], axis=1)
        v_all = jnp.concatenate([v_prev, v], axis=1)
        k_pos = jnp.concatenate([pos[0] - rows + jnp.arange(rows, dtype=jnp.int32), pos])
        rel = pos[:, None] - k_pos[None, :]
        valid = jnp.ones((1, rows + t), bool)
        o = band_attend(q[:, None], k_all[:, None], v_all[:, None], rel, valid, prm['band_rel_bias'])[:, 0]
        o = o.reshape(bsz, t, BAND_WIDTH)
        k_new, v_new = k_all[:, t:], v_all[:, t:]
    return o @ prm['w_d_out'], k_new, v_new


def hybrid_layer(x, pos, past, prm):
    bsz, t, _ = x.shape
    h = rms_norm(x, prm['norm_mix_g'])
    proj = h @ prm['w_in']
    (a_z, a_x, a_b, a_c, a_dt, b_ql, b_kvl, b_kpe, c_b, c_c, c_x, d_q, d_k, d_v, g_logit) = jnp.split(
        proj, np.cumsum(IN_SPLITS)[:-1].tolist(), axis=-1)
    out_a, ssm_new, ssd_conv_new = ssd_branch(a_z, a_x, a_b, a_c, a_dt, past['ssm'], past['ssd_conv'], prm)
    out_b, ckv_new, kpe_new = mla_branch(b_ql, b_kvl, b_kpe, pos, past['mla_ckv'], past['mla_kpe'], prm)
    out_c, sconv_new = sconv_branch(c_b, c_c, c_x, past['sconv'], prm)
    out_d, bk_new, bv_new = band_branch(d_q, d_k, d_v, pos, past['band_k'], past['band_v'], prm)
    gates = jax.nn.sigmoid((g_logit + prm['b_gate']).astype(jnp.float32)).astype(x.dtype)
    gates = gates.reshape(bsz, t, N_BRANCH, D_MODEL)
    merged = gates[:, :, 0] * out_a + gates[:, :, 1] * out_b + gates[:, :, 2] * out_c + gates[:, :, 3] * out_d
    x = x + merged @ prm['w_o']
    gu = rms_norm(x, prm['norm_ffn_g']) @ prm['w_ffn_up']
    x = x + (jax.nn.silu(gu[..., :FF_HIDDEN]) * gu[..., FF_HIDDEN:]) @ prm['w_ffn_down']
    new = {'ssm': ssm_new, 'ssd_conv': ssd_conv_new, 'mla_ckv': ckv_new, 'mla_kpe': kpe_new,
           'sconv': sconv_new, 'band_k': bk_new, 'band_v': bv_new}
    return x, new


def setup_inputs(seed: int = 0) -> dict:
    key = jax.random.key(seed)
    keys = jax.random.split(key, 48)
    ctr = iter(range(48))
    L = DEPTH

    def nrm(shape, scale):
        return scale * jax.random.normal(keys[next(ctr)], shape, jnp.float32)

    def gain(shape):
        return 1.0 + nrm(shape, 0.05)

    band_rows = min(BAND_PAST_CHUNKS * CHUNK, PAST_LEN)
    dt0 = jnp.exp(jax.random.uniform(keys[next(ctr)], (L, SSD_HEADS), jnp.float32,
                                     minval=math.log(1e-3), maxval=math.log(1e-1)))
    dt_bias = dt0 + jnp.log(-jnp.expm1(-dt0))
    a_log = jnp.log(jax.random.uniform(keys[next(ctr)], (L, SSD_HEADS), jnp.float32, minval=1.0, maxval=16.0))
    return {
        'x_prompt': nrm((BATCH, SEQ, D_MODEL), 1.0),
        'x_sample': nrm((DEC_BATCH, DEC_SEQ, D_MODEL), 1.0),
        'state_ssm': nrm((L, DEC_BATCH, SSD_HEADS, SSD_HEAD_DIM, SSD_STATE), 0.5),
        'state_ssd_conv': nrm((L, DEC_BATCH, SSD_CONV - 1, SSD_CONV_DIM), 1.0),
        'cache_mla_ckv': nrm((L, DEC_BATCH, PAST_LEN, MLA_KV_RANK), 1.0),
        'cache_mla_kpe': nrm((L, DEC_BATCH, PAST_LEN, MLA_ROPE), 1.0),
        'state_sconv': nrm((L, DEC_BATCH, SCONV_K - 1, SCONV_WIDTH), 1.0),
        'cache_band_k': nrm((L, DEC_BATCH, band_rows, BAND_HEADS, BAND_HEAD_DIM), 1.0),
        'cache_band_v': nrm((L, DEC_BATCH, band_rows, BAND_HEADS, BAND_HEAD_DIM), 1.0),
        'norm_mix_g': gain((L, D_MODEL)),
        'w_in': nrm((L, D_MODEL, IN_COLS), D_MODEL ** -0.5),
        'b_gate': nrm((L, N_BRANCH * D_MODEL), 0.1),
        'ssd_conv_w': nrm((L, SSD_CONV, SSD_CONV_DIM), SSD_CONV ** -0.5),
        'ssd_conv_b': nrm((L, SSD_CONV_DIM), 0.02),
        'ssd_dt_bias': dt_bias,
        'ssd_a_log': a_log,
        'ssd_d': 1.0 + nrm((L, SSD_HEADS), 0.1),
        'ssd_norm_g': gain((L, SSD_INNER)),
        'w_a_out': nrm((L, SSD_INNER, D_MODEL), SSD_INNER ** -0.5),
        'mla_q_norm_g': gain((L, MLA_Q_RANK)),
        'mla_w_q_up': nrm((L, MLA_Q_RANK, MLA_HEADS * (MLA_NOPE + MLA_ROPE)), MLA_Q_RANK ** -0.5),
        'mla_kv_norm_g': gain((L, MLA_KV_RANK)),
        'mla_w_kv_up': nrm((L, MLA_KV_RANK, MLA_HEADS * (MLA_NOPE + MLA_V)), MLA_KV_RANK ** -0.5),
        'mla_qn_g': gain((L, MLA_NOPE)),
        'mla_kn_g': gain((L, MLA_NOPE)),
        'mla_qr_g': gain((L, MLA_ROPE)),
        'mla_kr_g': gain((L, MLA_ROPE)),
        'w_b_out': nrm((L, MLA_WIDTH, D_MODEL), MLA_WIDTH ** -0.5),
        'sconv_w': nrm((L, SCONV_K, SCONV_WIDTH), SCONV_K ** -0.5),
        'w_c_out': nrm((L, SCONV_WIDTH, D_MODEL), SCONV_WIDTH ** -0.5),
        'band_qn_g': gain((L, BAND_HEAD_DIM)),
        'band_kn_g': gain((L, BAND_HEAD_DIM)),
        'band_rel_bias': nrm((L, BAND_HEADS, 2 * REL_CLIP + 1), 0.1),
        'w_d_out': nrm((L, BAND_WIDTH, D_MODEL), BAND_WIDTH ** -0.5),
        'w_o': nrm((L, D_MODEL, D_MODEL), D_MODEL ** -0.5),
        'norm_ffn_g': gain((L, D_MODEL)),
        'w_ffn_up': nrm((L, D_MODEL, 2 * FF_HIDDEN), D_MODEL ** -0.5),
        'w_ffn_down': nrm((L, FF_HIDDEN, D_MODEL), FF_HIDDEN ** -0.5),
    }


def reference(x_prompt, x_sample, state_ssm, state_ssd_conv, cache_mla_ckv, cache_mla_kpe, state_sconv,
              cache_band_k, cache_band_v,
              norm_mix_g, w_in, b_gate,
              ssd_conv_w, ssd_conv_b, ssd_dt_bias, ssd_a_log, ssd_d, ssd_norm_g, w_a_out,
              mla_q_norm_g, mla_w_q_up, mla_kv_norm_g, mla_w_kv_up, mla_qn_g, mla_kn_g, mla_qr_g, mla_kr_g, w_b_out,
              sconv_w, w_c_out,
              band_qn_g, band_kn_g, band_rel_bias, w_d_out,
              w_o, norm_ffn_g, w_ffn_up, w_ffn_down):
    b_p, t_p, _ = x_prompt.shape
    past_len = cache_mla_ckv.shape[2]
    pos_p = jnp.arange(t_p, dtype=jnp.int32)
    pos_s = past_len + jnp.arange(x_sample.shape[1], dtype=jnp.int32)
    y_p, y_s = x_prompt, x_sample
    new_p, new_s = [], []
    for l in range(DEPTH):
        prm = {
            'norm_mix_g': norm_mix_g[l], 'w_in': w_in[l], 'b_gate': b_gate[l],
            'ssd_conv_w': ssd_conv_w[l], 'ssd_conv_b': ssd_conv_b[l], 'ssd_dt_bias': ssd_dt_bias[l],
            'ssd_a_log': ssd_a_log[l], 'ssd_d': ssd_d[l], 'ssd_norm_g': ssd_norm_g[l], 'w_a_out': w_a_out[l],
            'mla_q_norm_g': mla_q_norm_g[l], 'mla_w_q_up': mla_w_q_up[l], 'mla_kv_norm_g': mla_kv_norm_g[l],
            'mla_w_kv_up': mla_w_kv_up[l], 'mla_qn_g': mla_qn_g[l], 'mla_kn_g': mla_kn_g[l],
            'mla_qr_g': mla_qr_g[l], 'mla_kr_g': mla_kr_g[l], 'w_b_out': w_b_out[l],
            'sconv_w': sconv_w[l], 'w_c_out': w_c_out[l],
            'band_qn_g': band_qn_g[l], 'band_kn_g': band_kn_g[l], 'band_rel_bias': band_rel_bias[l],
            'w_d_out': w_d_out[l],
            'w_o': w_o[l], 'norm_ffn_g': norm_ffn_g[l], 'w_ffn_up': w_ffn_up[l], 'w_ffn_down': w_ffn_down[l],
        }
        init_p = {
            'ssm': jnp.zeros((b_p, SSD_HEADS, SSD_HEAD_DIM, SSD_STATE), x_prompt.dtype),
            'ssd_conv': jnp.zeros((b_p, SSD_CONV - 1, SSD_CONV_DIM), x_prompt.dtype),
            'sconv': jnp.zeros((b_p, SCONV_K - 1, SCONV_WIDTH), x_prompt.dtype),
            'mla_ckv': None, 'mla_kpe': None, 'band_k': None, 'band_v': None,
        }
        y_p, st_p = hybrid_layer(y_p, pos_p, init_p, prm)
        new_p.append(st_p)
        past_s = {
            'ssm': state_ssm[l], 'ssd_conv': state_ssd_conv[l], 'sconv': state_sconv[l],
            'mla_ckv': cache_mla_ckv[l], 'mla_kpe': cache_mla_kpe[l],
            'band_k': cache_band_k[l], 'band_v': cache_band_v[l],
        }
        y_s, st_s = hybrid_layer(y_s, pos_s, past_s, prm)
        new_s.append(st_s)

    def stack(states, name):
        return jnp.stack([s[name] for s in states], axis=0)

    ssm_p, ssm_s = stack(new_p, 'ssm'), stack(new_s, 'ssm')
    ssd_conv_p, ssd_conv_s = stack(new_p, 'ssd_conv'), stack(new_s, 'ssd_conv')
    mla_ckv_p, mla_ckv_s = stack(new_p, 'mla_ckv'), stack(new_s, 'mla_ckv')
    mla_kpe_p, mla_kpe_s = stack(new_p, 'mla_kpe'), stack(new_s, 'mla_kpe')
    sconv_p, sconv_s = stack(new_p, 'sconv'), stack(new_s, 'sconv')
    band_k_p, band_k_s = stack(new_p, 'band_k'), stack(new_s, 'band_k')
    band_v_p, band_v_s = stack(new_p, 'band_v'), stack(new_s, 'band_v')
    return (y_p, y_s, ssm_p, ssm_s, ssd_conv_p, ssd_conv_s, mla_ckv_p, mla_ckv_s, mla_kpe_p, mla_kpe_s,
            sconv_p, sconv_s, band_k_p, band_k_s, band_v_p, band_v_s)
```

```cpp
#include <hip/hip_runtime.h>
#include <hip/hip_cooperative_groups.h>
#include <cstdio>
#include <cstdint>
namespace cg = cooperative_groups;

#define LAS __attribute__((address_space(3)))
#define GAS __attribute__((address_space(1)))
typedef unsigned short bf16_t;
typedef short bf16x8 __attribute__((ext_vector_type(8)));
typedef float f32x4 __attribute__((ext_vector_type(4)));
typedef unsigned u32x4 __attribute__((ext_vector_type(4)));
typedef unsigned u32x2 __attribute__((ext_vector_type(2)));

constexpr int NTHREADS = 512, NWAVES = 8;
constexpr int LDS_BYTES = 155648;
constexpr int NP = 16384, NS = 2048, R = NP + NS;
constexpr int TP = 8192, TS = 64, BP = 2, BS = 32, PAST = 2048, KS_ALL = PAST + TS;
constexpr int DM = 1024, FF = 2816;
constexpr int IN_COLS = 9384;
constexpr float EPS = 1e-6f;
constexpr float LOG2E = 1.4426950408889634f;

constexpr size_t O_Y = 0;
constexpr size_t O_SSM_P = (size_t)R * DM;
constexpr size_t O_SSM_S = O_SSM_P + 262144;
constexpr size_t O_CONV_P = O_SSM_S + 4194304;
constexpr size_t O_CONV_S = O_CONV_P + 12288;
constexpr size_t O_CKV_P = O_CONV_S + 196608;
constexpr size_t O_CKV_S = O_CKV_P + 8388608;
constexpr size_t O_KPE_P = O_CKV_S + 1048576;
constexpr size_t O_KPE_S = O_KPE_P + 1048576;
constexpr size_t O_SC_P = O_KPE_S + 131072;
constexpr size_t O_SC_S = O_SC_P + 4096;
constexpr size_t O_BK_P = O_SC_S + 65536;
constexpr size_t O_BK_S = O_BK_P + 1048576;
constexpr size_t O_BV_P = O_BK_S + 16777216;
constexpr size_t O_BV_S = O_BV_P + 1048576;
constexpr size_t O_END = O_BV_S + 16777216;

constexpr size_t al256(size_t x) { return (x + 255) & ~(size_t)255; }
constexpr size_t WS_CTL = 0;
constexpr size_t WS_DECAY = 4096;
constexpr size_t WS_WT_IN = 65536;
constexpr size_t WS_WT_G = WS_WT_IN + (size_t)5376 * 1024 * 2;
constexpr size_t WS_WT_QUP = WS_WT_G + (size_t)4096 * 1024 * 2;
constexpr size_t WS_WT_KVUP = WS_WT_QUP + (size_t)768 * 384 * 2;
constexpr size_t WS_WT_OUT = WS_WT_KVUP + (size_t)1024 * 256 * 2;
constexpr size_t WS_WT_O = WS_WT_OUT + (size_t)4 * 1024 * 1024 * 2;
constexpr size_t WS_WT_UP = WS_WT_O + (size_t)1024 * 1024 * 2;
constexpr size_t WS_WT_DOWN = WS_WT_UP + (size_t)5632 * 1024 * 2;
constexpr size_t WS_HB = al256(WS_WT_DOWN + (size_t)1024 * 2816 * 2);
constexpr size_t WS_PA = WS_HB + (size_t)R * 1024 * 2;
constexpr size_t WS_PD = WS_PA + (size_t)R * 1536 * 2;
constexpr size_t WS_ZB = WS_PD + (size_t)R * 1536 * 2;
constexpr size_t WS_CKVP = WS_ZB + (size_t)R * 768 * 2;
constexpr size_t WS_XR = WS_ZB + (size_t)R * 1024 * 2;
constexpr size_t WS_Q = WS_XR + (size_t)67584 * 1024 * 2;
constexpr size_t WS_KPEP = WS_Q + (size_t)R * 768 * 2;
constexpr size_t WS_KPES = WS_KPEP + (size_t)16384 * 32 * 2;
constexpr size_t WS_KVP = WS_KPES + (size_t)67584 * 32 * 2;
constexpr size_t WS_STATES = WS_KVP + (size_t)16384 * 1024 * 2;
constexpr size_t WS_YBC = WS_STATES + (size_t)2048 * 64 * 128 * 2;
constexpr size_t WS_END = WS_YBC + (size_t)R * 1024 * 2;
static_assert(WS_END < (size_t)550000000, "ws map too large");
static_assert((size_t)R * 768 * 2 + (size_t)16384 * 256 * 2 <= (size_t)R * 1024 * 2, "ZB");
static_assert((size_t)67584 * 256 * 2 <= (size_t)R * 1024 * 2, "ckvS in HB");

__device__ __forceinline__ unsigned f2bf(float f) { unsigned u = __builtin_bit_cast(unsigned, f); return (u + 0x7fffu + ((u >> 16) & 1u)) >> 16; }
__device__ __forceinline__ unsigned pk2(float lo, float hi) { return f2bf(lo) | (f2bf(hi) << 16); }
__device__ __forceinline__ float bflo(unsigned u) { return __builtin_bit_cast(float, u << 16); }
__device__ __forceinline__ float bfhi(unsigned u) { return __builtin_bit_cast(float, u & 0xffff0000u); }
__device__ __forceinline__ float bf1(bf16_t h) { return __builtin_bit_cast(float, (unsigned)h << 16); }
__device__ __forceinline__ float fexp2(float x) { return __builtin_amdgcn_exp2f(x); }
__device__ __forceinline__ float fexp(float x) { return __builtin_amdgcn_exp2f(x * LOG2E); }
__device__ __forceinline__ float frcp(float x) { return __builtin_amdgcn_rcpf(x); }
__device__ __forceinline__ float sigmoidf_(float x) { return frcp(1.f + fexp(-x)); }
__device__ __forceinline__ float siluf_(float x) { return x * sigmoidf_(x); }
__device__ __forceinline__ float wave_sum(float v) {
#pragma unroll
    for (int o = 1; o < 64; o <<= 1) v += __shfl_xor(v, o);
    return v;
}
#define LDS_WAIT() asm volatile("s_waitcnt lgkmcnt(0)" ::: "memory")
__device__ __forceinline__ void unpack8(u32x4 v, float* f) {
    f[0] = bflo(v.x); f[1] = bfhi(v.x); f[2] = bflo(v.y); f[3] = bfhi(v.y); f[4] = bflo(v.z); f[5] = bfhi(v.z); f[6] = bflo(v.w); f[7] = bfhi(v.w);
}
__device__ __forceinline__ u32x4 pack8(const float* f) { u32x4 o; o.x = pk2(f[0], f[1]); o.y = pk2(f[2], f[3]); o.z = pk2(f[4], f[5]); o.w = pk2(f[6], f[7]); return o; }
__device__ __forceinline__ u32x4 load8(const void* base, size_t idx, bool is_f32) {
    if (is_f32) { const f32x4* p = (const f32x4*)((const float*)base + idx); f32x4 a = p[0], b = p[1];
        u32x4 o; o.x = pk2(a.x, a.y); o.y = pk2(a.z, a.w); o.z = pk2(b.x, b.y); o.w = pk2(b.z, b.w); return o; }
    return *(const u32x4*)((const bf16_t*)base + idx);
}

namespace pg8 {
constexpr int BM = 256, BK = 64, HALF = 128, HTB = HALF * BK * 2, STAGE_BYTES = 8 * HTB, NXCD = 8, WGM = 8;
__device__ __forceinline__ int lds_byte(int r, int c) { const int st = (r >> 4) * 2 + (c >> 5), rr = r & 15, cc = c & 31, ob = rr * 64 + cc * 2; return st * 1024 + (ob ^ (((ob >> 9) & 1) << 5)); }
__device__ __forceinline__ void stage_rc(int b, int& Rr, int& C) { const int st = b / 1024, sb = b % 1024, swz = sb ^ (((sb >> 9) & 1) << 5); Rr = (st >> 1) * 16 + swz / 64; C = (st & 1) * 32 + (swz % 64) / 2; }
__device__ __forceinline__ int perm32(int rho) { const int n = rho >> 4, i = rho & 15; return 8 * (i >> 2) + 4 * n + (i & 3); }

struct GUnit { const bf16_t* A; const bf16_t* B; int lda, ldb, nt; int pm, pn, sub; bf16_t* C; int ldc; };

__device__ __forceinline__ void tile_map(int L, int nM, int nN, int& pm, int& pn) {
    const int nwg = nM * nN; int wgid = L;
    { const int q = nwg / NXCD, r = nwg % NXCD, xcd = wgid % NXCD, off = wgid / NXCD; wgid = (xcd < r ? xcd * (q + 1) : r * (q + 1) + (xcd - r) * q) + off; }
    const int nig = WGM * nN, gid = wgid / nig, fm = gid * WGM, gsz = (nM - fm) < WGM ? (nM - fm) : WGM;
    pm = fm + ((wgid % nig) % gsz); pn = (wgid % nig) / gsz;
}
typedef float f32x2_t __attribute__((ext_vector_type(2)));
typedef __bf16 bf16x2_t __attribute__((ext_vector_type(2)));
__device__ __forceinline__ unsigned cvt_pk_bf16(float lo, float hi) { f32x2_t v = {lo, hi}; bf16x2_t b = __builtin_convertvector(v, bf16x2_t); return __builtin_bit_cast(unsigned, b); }

template <class Epi, class Sched>
__device__ __forceinline__ void gemm_phase(LAS unsigned char* lds, const Sched& S, Epi& E, int tid) {
    const int wid = __builtin_amdgcn_readfirstlane(tid >> 6), lane = tid & 63, wr = wid >> 2, wc = wid & 3, fr = lane & 15, fq = lane >> 4;
    int RA[2], RB[2], CC[2];
#pragma unroll
    for (int i = 0; i < 2; ++i) { int Rr, C; stage_rc(tid * 16 + i * 8192, Rr, C); RA[i] = Rr; RB[i] = (Rr & ~31) + perm32(Rr & 31); CC[i] = C; }
    const size_t kstep = (size_t)(BK * 2);
    const unsigned ldsw = (unsigned)wid * 1024u;
    const int aoff = lds_byte(wr * 64 + fr, fq * 8), boff = lds_byte(wc * 32 + fr, fq * 8);
#define PG8_SA(b, h) (((b) * 2 + (h)) * HTB)
#define PG8_SB(b, h) ((4 + (b) * 2 + (h)) * HTB)
#define PG8_STAGE(bufoff, gbase, v0, v1) do { \
        __builtin_amdgcn_global_load_lds((const unsigned*)((const char*)(gbase) + (v0)), (LAS unsigned*)(lds + (bufoff) + ldsw), 16, 0, 0); \
        __builtin_amdgcn_global_load_lds((const unsigned*)((const char*)(gbase) + (v1)), (LAS unsigned*)(lds + (bufoff) + ldsw + 8192), 16, 0, 0); } while (0)
#define PG8_LDA(dst, b, h) do { _Pragma("unroll") for (int m = 0; m < 4; ++m) _Pragma("unroll") for (int k = 0; k < 2; ++k) dst[m][k] = *(const LAS bf16x8*)(lds + PG8_SA(b, h) + aoff + m * 2048 + k * 1024); } while (0)
#define PG8_LDB(dst, b, h) do { _Pragma("unroll") for (int n = 0; n < 2; ++n) _Pragma("unroll") for (int k = 0; k < 2; ++k) dst[n][k] = *(const LAS bf16x8*)(lds + PG8_SB(b, h) + boff + n * 2048 + k * 1024); } while (0)
#define PG8_MMA(ai, bj, At, Bt) do { __builtin_amdgcn_s_setprio(1); _Pragma("unroll") for (int m = 0; m < 4; ++m) _Pragma("unroll") for (int n = 0; n < 2; ++n) _Pragma("unroll") for (int k = 0; k < 2; ++k) \
        acc[ai][bj][m][n] = __builtin_amdgcn_mfma_f32_16x16x32_bf16(Bt[n][k], At[m][k], acc[ai][bj][m][n], 0, 0, 0); __builtin_amdgcn_s_setprio(0); } while (0)
#define PG8_WAIT_V(n) asm volatile("s_waitcnt vmcnt(" #n ")" ::: "memory")
#define PG8_WAIT_L(n) asm volatile("s_waitcnt lgkmcnt(" #n ")" ::: "memory")
#define PG8_BAR __builtin_amdgcn_s_barrier()
#define PG8_SCHED __builtin_amdgcn_sched_barrier(0)
    GUnit cur, nxt; int ui = 0;
    if (!S.next(0, cur)) return;
    f32x4 acc[2][2][4][2];
#pragma unroll
    for (int a = 0; a < 2; ++a)
#pragma unroll
        for (int b = 0; b < 2; ++b)
#pragma unroll
            for (int m = 0; m < 4; ++m)
#pragma unroll
                for (int n = 0; n < 2; ++n) acc[a][b][m][n] = (f32x4){0.f, 0.f, 0.f, 0.f};
    bf16x8 At[4][2], B0[2][2], B1[2][2];
    const char* cA = (const char*)cur.A; const char* cB = (const char*)cur.B;
    int clda = cur.lda, cldb = cur.ldb;
#define VA0(ld) ((unsigned)(RA[0] * (ld) + CC[0]) * 2u)
#define VA1(ld) ((unsigned)(RA[1] * (ld) + CC[1]) * 2u)
#define VB0(ld) ((unsigned)(RB[0] * (ld) + CC[0]) * 2u)
#define VB1(ld) ((unsigned)(RB[1] * (ld) + CC[1]) * 2u)
    unsigned vAc0 = VA0(clda), vAc1 = VA1(clda), vBc0 = VB0(cldb), vBc1 = VB1(cldb);
    size_t hsAc = (size_t)HALF * clda * 2, hsBc = (size_t)HALF * cldb * 2;
    PG8_STAGE(PG8_SB(0, 0), cB, vBc0, vBc1); PG8_STAGE(PG8_SB(0, 1), cB + hsBc, vBc0, vBc1); PG8_STAGE(PG8_SA(0, 0), cA, vAc0, vAc1); PG8_STAGE(PG8_SA(0, 1), cA + hsAc, vAc0, vAc1);
    if (wr == 1) PG8_BAR;
    PG8_WAIT_V(2); PG8_BAR;
    PG8_STAGE(PG8_SB(1, 0), cB + kstep, vBc0, vBc1); PG8_STAGE(PG8_SA(1, 0), cA + kstep, vAc0, vAc1); PG8_STAGE(PG8_SB(1, 1), cB + hsBc + kstep, vBc0, vBc1);
    PG8_WAIT_V(6); PG8_BAR;
    for (;;) {
        const bool has_next = S.next(ui + 1, nxt);
        const char* nA = has_next ? (const char*)nxt.A : cA; const char* nB = has_next ? (const char*)nxt.B : cB;
        const int nlda = has_next ? nxt.lda : cur.lda, nldb = has_next ? nxt.ldb : cur.ldb;
        const size_t hsAn = (size_t)HALF * nlda * 2, hsBn = (size_t)HALF * nldb * 2;
        const int nt = cur.nt;
        for (int t = 0; t < nt; t += 2) {
            const bool last = (t == nt - 2);
            const char* a1 = cA + (size_t)(t + 1) * kstep;
            const char* a2 = last ? nA : cA + (size_t)(t + 2) * kstep; const char* b2 = last ? nB : cB + (size_t)(t + 2) * kstep;
            const char* a3 = a2 + kstep; const char* b3 = b2 + kstep;
            const int lda2 = last ? nlda : clda, ldb2 = last ? nldb : cldb;
            const unsigned vA0 = VA0(lda2), vA1 = VA1(lda2), vB0 = VB0(ldb2), vB1 = VB1(ldb2);
            vAc0 = VA0(clda); vAc1 = VA1(clda);
            const size_t hsA2 = last ? hsAn : hsAc, hsB2 = last ? hsBn : hsBc;
            PG8_LDB(B0, 0, 0); PG8_LDB(B1, 0, 1); PG8_SCHED; PG8_LDA(At, 0, 0); PG8_STAGE(PG8_SA(1, 1), a1 + hsAc, vAc0, vAc1);
            PG8_WAIT_V(8); PG8_WAIT_L(0); PG8_BAR; PG8_MMA(0, 0, At, B0); PG8_MMA(0, 1, At, B1); PG8_BAR; PG8_SCHED;
            PG8_LDA(At, 0, 1); PG8_STAGE(PG8_SB(0, 0), b2, vB0, vB1); PG8_STAGE(PG8_SB(0, 1), b2 + hsB2, vB0, vB1); PG8_STAGE(PG8_SA(0, 0), a2, vA0, vA1);
            PG8_WAIT_V(8); PG8_WAIT_L(0); PG8_BAR; PG8_MMA(1, 0, At, B0); PG8_MMA(1, 1, At, B1); PG8_BAR; PG8_SCHED;
            PG8_LDB(B0, 1, 0); PG8_LDB(B1, 1, 1); PG8_SCHED; PG8_LDA(At, 1, 0); PG8_STAGE(PG8_SA(0, 1), a2 + hsA2, vA0, vA1);
            PG8_WAIT_V(8); PG8_WAIT_L(0); PG8_BAR; PG8_MMA(0, 0, At, B0); PG8_MMA(0, 1, At, B1); PG8_BAR; PG8_SCHED;
            PG8_LDA(At, 1, 1); PG8_STAGE(PG8_SB(1, 0), b3, vB0, vB1); PG8_STAGE(PG8_SB(1, 1), b3 + hsB2, vB0, vB1); PG8_STAGE(PG8_SA(1, 0), a3, vA0, vA1);
            PG8_WAIT_V(8); PG8_WAIT_L(0); PG8_BAR; PG8_MMA(1, 0, At, B0); PG8_MMA(1, 1, At, B1); PG8_BAR; PG8_SCHED;
        }
        if (wr == 0) PG8_BAR;
        const bool clear = E(acc, cur, wr, wc, fr, fq);
        if (!has_next) break;
        if (clear) {
#pragma unroll
        for (int a = 0; a < 2; ++a)
#pragma unroll
            for (int b = 0; b < 2; ++b)
#pragma unroll
                for (int m = 0; m < 4; ++m)
#pragma unroll
                    for (int n = 0; n < 2; ++n) acc[a][b][m][n] = (f32x4){0.f, 0.f, 0.f, 0.f};
        }
        cur = nxt; cA = nA; cB = nB; ++ui;
        clda = nlda; cldb = nldb; vAc0 = VA0(clda); vAc1 = VA1(clda); hsAc = hsAn; hsBc = hsBn;
        if (wr == 1) PG8_BAR;
    }
    PG8_WAIT_V(0);
    PG8_BAR;
#undef VA0
#undef VA1
#undef VB0
#undef VB1
#undef PG8_SA
#undef PG8_SB
#undef PG8_STAGE
#undef PG8_LDA
#undef PG8_LDB
#undef PG8_MMA
#undef PG8_WAIT_V
#undef PG8_WAIT_L
#undef PG8_BAR
#undef PG8_SCHED
}

struct EpiStore {
    __device__ __forceinline__ bool operator()(const f32x4 (&acc)[2][2][4][2], const GUnit& u, int wr, int wc, int fr, int fq) {
#pragma unroll
        for (int ai = 0; ai < 2; ++ai)
#pragma unroll
            for (int m = 0; m < 4; ++m) { bf16_t* rowp = u.C + (size_t)(ai * HALF + wr * 64 + m * 16 + fr) * u.ldc + wc * 32 + 8 * fq;
#pragma unroll
                for (int bj = 0; bj < 2; ++bj) { const f32x4 v0 = acc[ai][bj][m][0], v1 = acc[ai][bj][m][1];
                    u32x4 w; w.x = cvt_pk_bf16(v0[0], v0[1]); w.y = cvt_pk_bf16(v0[2], v0[3]); w.z = cvt_pk_bf16(v1[0], v1[1]); w.w = cvt_pk_bf16(v1[2], v1[3]);
                    *(GAS u32x4*)(rowp + bj * HALF) = w; } }
        return true;
    }
};
struct EpiResid {
    const float* xp; const float* xs; float* out;
    __device__ __forceinline__ bool operator()(const f32x4 (&acc)[2][2][4][2], const GUnit& u, int wr, int wc, int fr, int fq) {
        const unsigned off0 = (unsigned)(wr * 64 + fr) * DM + u.pn * 256 + wc * 32 + 8 * fq;
        const float* xin = ((u.pm < 64) ? xp + (size_t)u.pm * 256 * DM : xs + (size_t)(u.pm - 64) * 256 * DM) + off0;
        float* o = out + (size_t)u.pm * 256 * DM + off0;
#pragma unroll
        for (int ai = 0; ai < 2; ++ai)
#pragma unroll
            for (int m = 0; m < 4; ++m)
#pragma unroll
                for (int bj = 0; bj < 2; ++bj) { const unsigned ro = (unsigned)(ai * HALF + m * 16) * DM + bj * HALF;
                    const f32x4 x0 = *(const GAS f32x4*)(xin + ro), x1 = *(const GAS f32x4*)(xin + ro + 4);
                    *(GAS f32x4*)(o + ro) = x0 + acc[ai][bj][m][0]; *(GAS f32x4*)(o + ro + 4) = x1 + acc[ai][bj][m][1]; }
        return true;
    }
};
struct EpiSwiglu {
    bf16_t* act;
    __device__ __forceinline__ bool operator()(const f32x4 (&acc)[2][2][4][2], const GUnit& u, int wr, int wc, int fr, int fq) {
#pragma unroll
        for (int ai = 0; ai < 2; ++ai)
#pragma unroll
            for (int m = 0; m < 4; ++m) { bf16_t* rowp = act + (size_t)(u.pm * 256 + ai * HALF + wr * 64 + m * 16 + fr) * FF + u.pn * 128 + wc * 32 + 8 * fq;
                float o[8];
#pragma unroll
                for (int n = 0; n < 2; ++n)
#pragma unroll
                    for (int i = 0; i < 4; ++i) o[4 * n + i] = siluf_(acc[ai][0][m][n][i]) * acc[ai][1][m][n][i];
                u32x4 w; w.x = cvt_pk_bf16(o[0], o[1]); w.y = cvt_pk_bf16(o[2], o[3]); w.z = cvt_pk_bf16(o[4], o[5]); w.w = cvt_pk_bf16(o[6], o[7]);
                *(GAS u32x4*)rowp = w; }
        return true;
    }
};
struct EpiMerge {
    const float* bgate; bf16_t* merged; bf16_t* gtmp;
    __device__ __forceinline__ bool operator()(const f32x4 (&acc)[2][2][4][2], const GUnit& u, int wr, int wc, int fr, int fq) {
        const int br = u.sub >> 1;
        const unsigned off0 = (unsigned)(u.pm * 256 + wr * 64 + fr) * DM + u.pn * 256 + wc * 32 + 8 * fq;
        if ((u.sub & 1) == 0) {
#pragma unroll
            for (int bj = 0; bj < 2; ++bj) { const float* bp = bgate + br * 1024 + u.pn * 256 + bj * HALF + wc * 32 + 8 * fq;
                const f32x4 b0 = *(const GAS f32x4*)bp, b1 = *(const GAS f32x4*)(bp + 4);
#pragma unroll
                for (int ai = 0; ai < 2; ++ai)
#pragma unroll
                    for (int m = 0; m < 4; ++m) { const f32x4 v0 = acc[ai][bj][m][0] + b0, v1 = acc[ai][bj][m][1] + b1; u32x4 w;
                        w.x = cvt_pk_bf16(sigmoidf_(v0[0]), sigmoidf_(v0[1])); w.y = cvt_pk_bf16(sigmoidf_(v0[2]), sigmoidf_(v0[3]));
                        w.z = cvt_pk_bf16(sigmoidf_(v1[0]), sigmoidf_(v1[1])); w.w = cvt_pk_bf16(sigmoidf_(v1[2]), sigmoidf_(v1[3]));
                        *(GAS u32x4*)(gtmp + off0 + (unsigned)(ai * HALF + m * 16) * DM + bj * HALF) = w; } }
        } else {
#pragma unroll
            for (int ai = 0; ai < 2; ++ai)
#pragma unroll
                for (int m = 0; m < 4; ++m)
#pragma unroll
                    for (int bj = 0; bj < 2; ++bj) { const unsigned off = off0 + (unsigned)(ai * HALF + m * 16) * DM + bj * HALF;
                        const u32x4 gg = *(const GAS u32x4*)(gtmp + off); u32x4 mm = (u32x4){0u, 0u, 0u, 0u}; if (br > 0) mm = *(const GAS u32x4*)(merged + off);
                        const f32x4 a0 = acc[ai][bj][m][0], a1 = acc[ai][bj][m][1]; u32x4 w;
                        w.x = cvt_pk_bf16(bflo(mm.x) + bflo(gg.x) * a0[0], bfhi(mm.x) + bfhi(gg.x) * a0[1]); w.y = cvt_pk_bf16(bflo(mm.y) + bflo(gg.y) * a0[2], bfhi(mm.y) + bfhi(gg.y) * a0[3]);
                        w.z = cvt_pk_bf16(bflo(mm.z) + bflo(gg.z) * a1[0], bfhi(mm.z) + bfhi(gg.z) * a1[1]); w.w = cvt_pk_bf16(bflo(mm.w) + bflo(gg.w) * a1[2], bfhi(mm.w) + bfhi(gg.w) * a1[3]);
                        *(GAS u32x4*)(merged + off) = w; }
        }
        return true;
    }
};
}

struct Args { const float* in[38]; float* out; unsigned char* ws; int ph_lo, ph_hi; };
struct Ctx {
    const Args* A; float* out; unsigned char* ws; LAS unsigned char* lds;
    int tid, lane, wave, gw, NGW, l, G, bid;
};
#define WSB(off) ((bf16_t*)(C.ws + (off)))
#define INL(i, sz) (C.A->in[i] + (size_t)C.l * (size_t)(sz))
#define IN0(i) (C.A->in[i])

using pg8::GUnit;
struct SchedOne {
    const bf16_t* A; const bf16_t* B; bf16_t* Cp; int lda, ldb, ldc, nM, nN, nt, G, c;
    __device__ __forceinline__ bool next(int i, GUnit& u) const {
        const long L = (long)i * G + c; if (L >= (long)nM * nN) return false;
        int pm, pn; pg8::tile_map((int)L, nM, nN, pm, pn);
        u.A = A + (size_t)pm * 256 * lda; u.B = B + (size_t)pn * 256 * ldb; u.lda = lda; u.ldb = ldb; u.nt = nt; u.pm = pm; u.pn = pn; u.sub = 0;
        u.C = Cp ? Cp + (size_t)pm * 256 * ldc + (size_t)pn * 256 : nullptr; u.ldc = ldc; return true;
    }
};
struct SchedInproj {
    const bf16_t* A; const bf16_t* B; bf16_t *pA, *pB, *pC, *pD; int G, c;
    __device__ __forceinline__ bool next(int i, GUnit& u) const {
        const long L = (long)i * G + c; if (L >= 72 * 21) return false;
        int pm, pn; pg8::tile_map((int)L, 72, 21, pm, pn);
        u.A = A + (size_t)pm * 256 * 1024; u.B = B + (size_t)pn * 256 * 1024; u.lda = 1024; u.ldb = 1024; u.nt = 16; u.pm = pm; u.pn = pn; u.sub = 0;
        if (pn < 6) { u.C = pA + (size_t)pm * 256 * 1536 + pn * 256; u.ldc = 1536; }
        else if (pn < 9) { u.C = pB + (size_t)pm * 256 * 768 + (pn - 6) * 256; u.ldc = 768; }
        else if (pn < 15) { u.C = pC + (size_t)pm * 256 * 1536 + (pn - 9) * 256; u.ldc = 1536; }
        else { u.C = pD + (size_t)pm * 256 * 1536 + (pn - 15) * 256; u.ldc = 1536; }
        return true;
    }
};
struct SchedP3 {
    const bf16_t *pB, *wq, *ckvP, *ckvS, *wkv; bf16_t *Q, *KVP, *KVS; int G, c;
    __device__ __forceinline__ bool next(int i, GUnit& u) const {
        long L = (long)i * G + c; int pm, pn; u.sub = 0;
        if (L < 264 * 4) { pg8::tile_map((int)L, 264, 4, pm, pn); u.A = ckvS + (size_t)pm * 256 * 256; u.B = wkv + (size_t)pn * 256 * 256; u.lda = 256; u.ldb = 256; u.nt = 4;
            u.C = KVS + (size_t)pm * 256 * 1024 + pn * 256; u.ldc = 1024; u.pm = pm; u.pn = pn; return true; }
        L -= 264 * 4;
        if (L < 64 * 4) { pg8::tile_map((int)L, 64, 4, pm, pn); u.A = ckvP + (size_t)pm * 256 * 256; u.B = wkv + (size_t)pn * 256 * 256; u.lda = 256; u.ldb = 256; u.nt = 4;
            u.C = KVP + (size_t)pm * 256 * 1024 + pn * 256; u.ldc = 1024; u.pm = pm; u.pn = pn; return true; }
        L -= 64 * 4;
        if (L < 72 * 3) { pg8::tile_map((int)L, 72, 3, pm, pn); u.A = pB + (size_t)pm * 256 * 768; u.B = wq + (size_t)pn * 256 * 384; u.lda = 768; u.ldb = 384; u.nt = 6;
            u.C = Q + (size_t)pm * 256 * 768 + pn * 256; u.ldc = 768; u.pm = pm; u.pn = pn; return true; }
        return false;
    }
};
struct SchedMerge {
    const bf16_t *hb, *wg, *wout, *pA, *ybc, *pD; int G, c;
    __device__ __forceinline__ bool next(int i, GUnit& u) const {
        const long L = (long)(i >> 3) * G + c; if (L >= 72 * 4) return false;
        int pm, pn; pg8::tile_map((int)L, 72, 4, pm, pn); const int sub = i & 7, br = sub >> 1;
        u.pm = pm; u.pn = pn; u.sub = sub; u.C = nullptr; u.ldc = 0; u.ldb = 1024;
        if ((sub & 1) == 0) { u.A = hb + (size_t)pm * 256 * 1024; u.lda = 1024; u.nt = 16; u.B = wg + (size_t)(br * 1024 + pn * 256) * 1024; }
        else { u.nt = 8; u.B = wout + (size_t)(br * 1024 + pn * 256) * 1024;
            if (br == 0) { u.A = pA + (size_t)pm * 256 * 1536; u.lda = 1536; }
            else if (br == 1) { u.A = ybc + (size_t)pm * 256 * 1024; u.lda = 1024; }
            else if (br == 2) { u.A = ybc + (size_t)pm * 256 * 1024 + 512; u.lda = 1024; }
            else { u.A = pD + (size_t)pm * 256 * 1536; u.lda = 1536; } }
        return true;
    }
};

template <class Map>
__device__ __forceinline__ void transpose_w(const Ctx& C, const float* W, int ldw, int K, int Nout, bf16_t* WT, int ldt, Map map) {
    LAS float* scr = (LAS float*)(C.lds + C.wave * 8704);
    const int lane = C.lane, nblk = Nout / 32, items = (K / 64) * nblk;
    for (int it = C.gw; it < items; it += C.NGW) {
        const int kb = it / nblk, nb = it % nblk, k0 = 64 * kb, n0 = 32 * nb;
        const int col = map(n0 + (lane & 31));
#pragma unroll 8
        for (int i = 0; i < 32; ++i) { const int kk = 2 * i + (lane >> 5); scr[kk * 33 + (lane & 31)] = (col >= 0) ? W[(size_t)(k0 + kk) * ldw + col] : 0.f; }
        LDS_WAIT();
        const int c = lane & 7;
#pragma unroll
        for (int j = 0; j < 4; ++j) { const int n = (lane >> 3) + 8 * j; const LAS float* s = scr + (8 * c) * 33 + n;
            u32x4 o; o.x = pk2(s[0 * 33], s[1 * 33]); o.y = pk2(s[2 * 33], s[3 * 33]); o.z = pk2(s[4 * 33], s[5 * 33]); o.w = pk2(s[6 * 33], s[7 * 33]);
            *(u32x4*)(WT + (size_t)(n0 + n) * ldt + k0 + 8 * c) = o; }
        LDS_WAIT();
    }
}
struct MapId { __device__ __forceinline__ int operator()(int n) const { return n; } };
struct MapOff { int off; __device__ __forceinline__ int operator()(int n) const { return n + off; } };
struct MapIn { __device__ __forceinline__ int operator()(int n) const { return n < 1536 ? n : (n < 2208 ? n + 8 : (n < 2216 ? n - 2208 + 1536 : (n < 2304 ? -1 : n - 88))); } };
struct MapKv { __device__ __forceinline__ int operator()(int n) const { return n < 512 ? ((n >> 6) * 128 + (n & 63)) : (((n - 512) >> 6) * 128 + 64 + (n & 63)); } };
struct MapUp { __device__ __forceinline__ int operator()(int n) const { const int t = n >> 8, w = n & 255; return w < 128 ? 128 * t + w : 2816 + 128 * t + (w - 128); } };

__device__ __forceinline__ void phase_wprep(const Ctx& C) {
    transpose_w(C, INL(10, 1024 * IN_COLS), IN_COLS, 1024, 5376, WSB(WS_WT_IN), 1024, MapIn());
    transpose_w(C, INL(10, 1024 * IN_COLS), IN_COLS, 1024, 4096, WSB(WS_WT_G), 1024, MapOff{5288});
    transpose_w(C, INL(20, 384 * 768), 768, 384, 768, WSB(WS_WT_QUP), 384, MapId());
    transpose_w(C, INL(22, 256 * 1024), 1024, 256, 1024, WSB(WS_WT_KVUP), 256, MapKv());
    transpose_w(C, INL(18, 512 * 1024), 1024, 512, 1024, WSB(WS_WT_OUT), 1024, MapId());
    transpose_w(C, INL(27, 512 * 1024), 1024, 512, 1024, WSB(WS_WT_OUT) + (size_t)1 * 1024 * 1024, 1024, MapId());
    transpose_w(C, INL(29, 512 * 1024), 1024, 512, 1024, WSB(WS_WT_OUT) + (size_t)2 * 1024 * 1024, 1024, MapId());
    transpose_w(C, INL(33, 512 * 1024), 1024, 512, 1024, WSB(WS_WT_OUT) + (size_t)3 * 1024 * 1024, 1024, MapId());
    transpose_w(C, INL(34, 1024 * 1024), 1024, 1024, 1024, WSB(WS_WT_O), 1024, MapId());
    transpose_w(C, INL(36, 1024 * 5632), 5632, 1024, 5632, WSB(WS_WT_UP), 1024, MapUp());
    transpose_w(C, INL(37, 2816 * 1024), 1024, 2816, 1024, WSB(WS_WT_DOWN), 2816, MapId());
}

__device__ __forceinline__ const float* xrow(const Ctx& C, int row, bool from_out) {
    if (from_out) return C.out + (size_t)row * DM;
    return row < NP ? IN0(0) + (size_t)row * DM : IN0(1) + (size_t)(row - NP) * DM;
}
__device__ __forceinline__ void phase_norm(const Ctx& C, const float* g, bool from_out) {
    const int lane = C.lane;
    f32x4 gv[4];
#pragma unroll
    for (int j = 0; j < 4; ++j) gv[j] = ((const f32x4*)g)[64 * j + lane];
    for (int row = C.gw; row < R; row += C.NGW) {
        const f32x4* xr = (const f32x4*)xrow(C, row, from_out) + lane;
        f32x4 v[4]; float s = 0.f;
#pragma unroll
        for (int j = 0; j < 4; ++j) { v[j] = xr[64 * j]; s += (v[j].x * v[j].x + v[j].y * v[j].y) + (v[j].z * v[j].z + v[j].w * v[j].w); }
        const float rstd = 1.f / sqrtf(wave_sum(s) * (1.f / DM) + EPS);
        u32x2* o = (u32x2*)(WSB(WS_HB) + (size_t)row * DM) + lane;
#pragma unroll
        for (int j = 0; j < 4; ++j) { u32x2 w; w.x = pk2(v[j].x * rstd * gv[j].x, v[j].y * rstd * gv[j].y); w.y = pk2(v[j].z * rstd * gv[j].z, v[j].w * rstd * gv[j].w); o[64 * j] = w; }
    }
}
__device__ __forceinline__ void rope_cs(int pos, int i, float& c, float& s) {
    const float chi = ((i & 8) ? ((i & 4) ? ((i & 2) ? ((i & 1) ? 2.831220627e-05f : 5.030632019e-05f) : ((i & 1) ? 8.952617645e-05f : 1.592636108e-04f)) : ((i & 2) ? ((i & 1) ? 2.832412720e-04f : 5.035400391e-04f) : ((i & 1) ? 8.945465088e-04f : 1.590728760e-03f))) : ((i & 4) ? ((i & 2) ? ((i & 1) ? 2.830505371e-03f : 5.035400391e-03f) : ((i & 1) ? 8.956909180e-03f : 1.593017578e-02f)) : ((i & 2) ? ((i & 1) ? 2.828979492e-02f : 5.035400391e-02f) : ((i & 1) ? 8.947753906e-02f : 1.591796875e-01f))));
    const float clo = ((i & 8) ? ((i & 4) ? ((i & 2) ? ((i & 1) ? -1.001043781e-08f : 2.289191414e-08f) : ((i & 1) ? -2.677484368e-08f : -1.086677486e-07f)) : ((i & 2) ? ((i & 1) ? -2.193136623e-07f : -2.479180239e-07f) : ((i & 1) ? 4.475072899e-07f : 8.206711755e-07f))) : ((i & 4) ? ((i & 2) ? ((i & 1) ? -2.857880190e-07f : -2.479180239e-06f) : ((i & 1) ? -6.969018614e-06f : -1.468147184e-05f)) : ((i & 2) ? ((i & 1) ? 1.240090842e-05f : -2.479180148e-05f) : ((i & 1) ? 2.186254642e-05f : -2.474440771e-05f))));
    const float pf = (float)pos, rh = pf * chi, f1 = rh - __builtin_rintf(rh), fr = f1 + pf * clo;
    c = __builtin_amdgcn_cosf(fr); s = __builtin_amdgcn_sinf(fr);
}
__device__ __forceinline__ int row_pos(int row) { return row < NP ? (row & (TP - 1)) : PAST + ((row - NP) & 63); }

__device__ __forceinline__ void phase_mla_prep(const Ctx& C) {
    const int lane = C.lane; const int l = C.l;
    const float* gq = INL(19, 384); const float* gkv = INL(21, 256); const float* gkr = INL(26, 32);
    for (int row = C.gw; row < R; row += C.NGW) {
        bf16_t* pb = WSB(WS_ZB) + (size_t)row * 768;
        unsigned q[3]; float ss = 0.f;
#pragma unroll
        for (int j = 0; j < 3; ++j) { q[j] = *(const unsigned*)(pb + 2 * lane + 128 * j); const float a = bflo(q[j]), b = bfhi(q[j]); ss += a * a + b * b; }
        float rstd = 1.f / sqrtf(wave_sum(ss) * (1.f / 384.f) + EPS);
#pragma unroll
        for (int j = 0; j < 3; ++j) { const int c = 2 * lane + 128 * j; *(unsigned*)(pb + c) = pk2(bflo(q[j]) * rstd * gq[c], bfhi(q[j]) * rstd * gq[c + 1]); }
        const u32x2 kv = *(const u32x2*)(pb + 384 + 4 * lane);
        float k0 = bflo(kv.x), k1 = bfhi(kv.x), k2 = bflo(kv.y), k3 = bfhi(kv.y);
        rstd = 1.f / sqrtf(wave_sum(k0 * k0 + k1 * k1 + k2 * k2 + k3 * k3) * (1.f / 256.f) + EPS);
        const f32x4 g4 = *(const f32x4*)(gkv + 4 * lane);
        f32x4 ck; ck.x = k0 * rstd * g4.x; ck.y = k1 * rstd * g4.y; ck.z = k2 * rstd * g4.z; ck.w = k3 * rstd * g4.w;
        u32x2 ckb; ckb.x = pk2(ck.x, ck.y); ckb.y = pk2(ck.z, ck.w);
        const int pos = row_pos(row);
        size_t srow = 0;
        if (row < NP) { *(f32x4*)(C.out + O_CKV_P + ((size_t)l * NP + row) * 256 + 4 * lane) = ck; *(u32x2*)(WSB(WS_CKVP) + (size_t)row * 256 + 4 * lane) = ckb; }
        else { const int rs = row - NP; srow = (size_t)(rs >> 6) * KS_ALL + PAST + (rs & 63);
            *(f32x4*)(C.out + O_CKV_S + ((size_t)l * NS + rs) * 256 + 4 * lane) = ck; *(u32x2*)(WSB(WS_HB) + srow * 256 + 4 * lane) = ckb; }
        const float x = (lane < 32) ? bf1(pb[640 + lane]) : 0.f;
        rstd = 1.f / sqrtf(wave_sum(x * x) * (1.f / 32.f) + EPS);
        const float y = x * rstd * gkr[lane & 31];
        const float part = __shfl_xor(y, 16);
        float cs, sn; rope_cs(pos, lane & 15, cs, sn);
        const float o = (lane < 16) ? (y * cs - part * sn) : (part * sn + y * cs);
        if (lane < 32) {
            if (row < NP) { C.out[O_KPE_P + ((size_t)l * NP + row) * 32 + lane] = o; WSB(WS_KPEP)[(size_t)row * 32 + lane] = (bf16_t)f2bf(o); }
            else { C.out[O_KPE_S + ((size_t)l * NS + (row - NP)) * 32 + lane] = o; WSB(WS_KPES)[srow * 32 + lane] = (bf16_t)f2bf(o); }
        }
    }
    const size_t gt = (size_t)C.bid * NTHREADS + C.tid, GT = (size_t)C.G * NTHREADS;
    { const float* src = INL(4, (size_t)BS * PAST * 256);
      for (size_t i = gt; i < (size_t)BS * PAST * 256 / 8; i += GT) { const size_t e = i * 8, b = e / ((size_t)PAST * 256), rem = e % ((size_t)PAST * 256);
          *(u32x4*)(WSB(WS_HB) + b * KS_ALL * 256 + rem) = load8(src, e, true); } }
    { const float* src = INL(5, (size_t)BS * PAST * 32);
      for (size_t i = gt; i < (size_t)BS * PAST * 32 / 8; i += GT) { const size_t e = i * 8, b = e / ((size_t)PAST * 32), rem = e % ((size_t)PAST * 32);
          *(u32x4*)(WSB(WS_KPES) + b * KS_ALL * 32 + rem) = load8(src, e, true); } }
}

__device__ __forceinline__ float red8(float v) { v += __shfl_xor(v, 1); v += __shfl_xor(v, 2); v += __shfl_xor(v, 4); return v; }

__device__ __forceinline__ void phase_band_prep(const Ctx& C) {
    const int lane = C.lane, l = C.l, d0 = (lane & 7) * 8;
    float gq[8], gk[8];
#pragma unroll
    for (int e = 0; e < 8; ++e) { gq[e] = INL(30, 64)[d0 + e] * (0.125f * LOG2E); gk[e] = INL(31, 64)[d0 + e]; }
    for (int row = C.gw; row < R; row += C.NGW) {
        bf16_t* pd = WSB(WS_PD) + (size_t)row * 1536 + 8 * lane;
        float f[8], kf[8], vf[8];
        unpack8(*(const u32x4*)pd, f); float ss = 0.f;
#pragma unroll
        for (int e = 0; e < 8; ++e) ss += f[e] * f[e];
        float rstd = 1.f / sqrtf(red8(ss) * (1.f / 64.f) + EPS);
#pragma unroll
        for (int e = 0; e < 8; ++e) f[e] *= rstd * gq[e];
        *(u32x4*)pd = pack8(f);
        unpack8(*(const u32x4*)(pd + 512), kf); ss = 0.f;
#pragma unroll
        for (int e = 0; e < 8; ++e) ss += kf[e] * kf[e];
        rstd = 1.f / sqrtf(red8(ss) * (1.f / 64.f) + EPS);
#pragma unroll
        for (int e = 0; e < 8; ++e) kf[e] *= rstd * gk[e];
        *(u32x4*)(pd + 512) = pack8(kf);
        unpack8(*(const u32x4*)(pd + 1024), vf);
        long dst = -1;
        if (row < NP) { const int t = row & (TP - 1), b = row >> 13; if (t >= TP - 512) dst = (long)(((size_t)(l * BP + b) * 512 + (t - (TP - 512))) * 512 + 8 * lane); }
        else { const int rs = row - NP, b = rs >> 6, t = rs & 63; dst = (long)(((size_t)(l * BS + b) * 512 + 448 + t) * 512 + 8 * lane); }
        if (dst >= 0) { float* ko = C.out + (row < NP ? O_BK_P : O_BK_S) + dst; float* vo = C.out + (row < NP ? O_BV_P : O_BV_S) + dst;
            *(f32x4*)ko = (f32x4){kf[0], kf[1], kf[2], kf[3]}; *(f32x4*)(ko + 4) = (f32x4){kf[4], kf[5], kf[6], kf[7]};
            *(f32x4*)vo = (f32x4){vf[0], vf[1], vf[2], vf[3]}; *(f32x4*)(vo + 4) = (f32x4){vf[4], vf[5], vf[6], vf[7]}; }
    }
    const size_t gt = (size_t)C.bid * NTHREADS + C.tid, GT = (size_t)C.G * NTHREADS;
    const f32x4* sk = (const f32x4*)INL(7, (size_t)BS * 512 * 512); const f32x4* sv = (const f32x4*)INL(8, (size_t)BS * 512 * 512);
    f32x4* dk = (f32x4*)(C.out + O_BK_S + (size_t)l * BS * 512 * 512); f32x4* dv = (f32x4*)(C.out + O_BV_S + (size_t)l * BS * 512 * 512);
    for (size_t i = gt; i < (size_t)BS * 448 * 128; i += GT) { const size_t b = i / (448 * 128), rem = i % (448 * 128);
        dk[b * 512 * 128 + rem] = sk[b * 512 * 128 + 64 * 128 + rem]; dv[b * 512 * 128 + rem] = sv[b * 512 * 128 + 64 * 128 + rem]; }
}

__device__ __forceinline__ void phase_sconv(const Ctx& C) {
    const int lane = C.lane, l = C.l, ch = 8 * lane;
    const float* w = INL(28, 3 * 512);
    float w0[8], w1[8], w2[8];
#pragma unroll
    for (int e = 0; e < 8; ++e) { w0[e] = w[ch + e]; w1[e] = w[512 + ch + e]; w2[e] = w[1024 + ch + e]; }
    for (int row = C.gw; row < R; row += C.NGW) {
        const bf16_t* pc = WSB(WS_XR) + (size_t)row * 1536 + ch;
        const bool pr = row < NP; const int t = pr ? (row & (TP - 1)) : ((row - NP) & 63); const int b = pr ? (row >> 13) : ((row - NP) >> 6);
        float cb[8], a[8], x[8], u0[8], u1[8], u2[8];
        unpack8(*(const u32x4*)pc, cb); unpack8(*(const u32x4*)(pc + 512), a); unpack8(*(const u32x4*)(pc + 1024), x);
#pragma unroll
        for (int e = 0; e < 8; ++e) u0[e] = a[e] * x[e];
        const float* st = INL(6, BS * 2 * 512) + (size_t)b * 2 * 512 + ch;
        if (t >= 1) { unpack8(*(const u32x4*)(pc - 1536 + 512), a); unpack8(*(const u32x4*)(pc - 1536 + 1024), x);
#pragma unroll
            for (int e = 0; e < 8; ++e) u1[e] = a[e] * x[e]; }
        else {
#pragma unroll
            for (int e = 0; e < 8; ++e) u1[e] = pr ? 0.f : st[512 + e]; }
        if (t >= 2) { unpack8(*(const u32x4*)(pc - 3072 + 512), a); unpack8(*(const u32x4*)(pc - 3072 + 1024), x);
#pragma unroll
            for (int e = 0; e < 8; ++e) u2[e] = a[e] * x[e]; }
        else {
#pragma unroll
            for (int e = 0; e < 8; ++e) u2[e] = pr ? 0.f : st[(t == 1 ? 512 : 0) + e]; }
        float y[8];
#pragma unroll
        for (int e = 0; e < 8; ++e) y[e] = cb[e] * (w0[e] * u2[e] + w1[e] * u1[e] + w2[e] * u0[e]);
        *(u32x4*)(WSB(WS_YBC) + (size_t)row * 1024 + 512 + ch) = pack8(y);
        const int T = pr ? TP : TS;
        if (t >= T - 2) { float* o = C.out + (pr ? O_SC_P + ((size_t)(l * BP + b) * 2 + (t - (T - 2))) * 512 : O_SC_S + ((size_t)(l * BS + b) * 2 + (t - (T - 2))) * 512) + ch;
            *(f32x4*)o = (f32x4){u0[0], u0[1], u0[2], u0[3]}; *(f32x4*)(o + 4) = (f32x4){u0[4], u0[5], u0[6], u0[7]}; }
    }
}

__device__ __forceinline__ void phase_qk_post(const Ctx& C) {
    const int lane = C.lane, head = lane >> 3, sub = lane & 7;
    const float SC = 0.10206207261596577f * LOG2E;
    float gn[8], gr[8], gk[8];
#pragma unroll
    for (int e = 0; e < 8; ++e) { gn[e] = INL(23, 64)[8 * sub + e] * SC; gr[e] = INL(25, 32)[8 * (sub & 3) + e]; gk[e] = INL(24, 64)[8 * sub + e]; }
    for (int row = C.gw; row < R; row += C.NGW) {
        bf16_t* qp = WSB(WS_Q) + (size_t)row * 768 + 96 * head;
        float f[8]; unpack8(*(const u32x4*)(qp + 8 * sub), f); float ss = 0.f;
#pragma unroll
        for (int e = 0; e < 8; ++e) ss += f[e] * f[e];
        float rstd = 1.f / sqrtf(red8(ss) * (1.f / 64.f) + EPS);
#pragma unroll
        for (int e = 0; e < 8; ++e) f[e] *= rstd * gn[e];
        *(u32x4*)(qp + 8 * sub) = pack8(f);
        float r[8];
        if (sub < 4) unpack8(*(const u32x4*)(qp + 64 + 8 * sub), r);
        else {
#pragma unroll
            for (int e = 0; e < 8; ++e) r[e] = 0.f; }
        ss = 0.f;
#pragma unroll
        for (int e = 0; e < 8; ++e) ss += r[e] * r[e];
        ss += __shfl_xor(ss, 1); ss += __shfl_xor(ss, 2);
        rstd = 1.f / sqrtf(ss * (1.f / 32.f) + EPS);
        const int pos = row_pos(row);
        float o[8];
#pragma unroll
        for (int e = 0; e < 8; ++e) { const float y = r[e] * rstd * gr[e]; const float part = __shfl_xor(y, 2);
            float cs, sn; rope_cs(pos, 8 * (sub & 1) + e, cs, sn);
            o[e] = ((sub < 2) ? (y * cs - part * sn) : (part * sn + y * cs)) * SC; }
        if (sub < 4) *(u32x4*)(qp + 64 + 8 * sub) = pack8(o);
    }
    for (int row = C.gw; row < NP + BS * KS_ALL; row += C.NGW) {
        bf16_t* kp = (row < NP ? WSB(WS_KVP) + (size_t)row * 1024 : WSB(WS_XR) + (size_t)(row - NP) * 1024) + 8 * lane;
        float f[8]; unpack8(*(const u32x4*)kp, f); float ss = 0.f;
#pragma unroll
        for (int e = 0; e < 8; ++e) ss += f[e] * f[e];
        const float rstd = 1.f / sqrtf(red8(ss) * (1.f / 64.f) + EPS);
#pragma unroll
        for (int e = 0; e < 8; ++e) f[e] *= rstd * gk[e];
        *(u32x4*)kp = pack8(f);
    }
}

__device__ __forceinline__ bf16x8 mk_frag(u32x2 lo, u32x2 hi) { u32x4 v; v.x = lo.x; v.y = lo.y; v.z = hi.x; v.w = hi.y; return __builtin_bit_cast(bf16x8, v); }
__device__ __forceinline__ bf16x8 as_frag(u32x4 v) { return __builtin_bit_cast(bf16x8, v); }
#define MFMA16(a, b, c) __builtin_amdgcn_mfma_f32_16x16x32_bf16((a), (b), (c), 0, 0, 0)

__device__ __forceinline__ int ssd_row0(int seq, int c) { return seq < 2 ? seq * TP + c * 64 : NP + (seq - 2) * 64; }
__device__ __forceinline__ void ssd_dt(const Ctx& C, int row0, LAS float* sDT, LAS float* sACS) {
    const int h = C.wave, lane = C.lane;
    const float adt = bf1(WSB(WS_ZB)[(size_t)(row0 + lane) * 768 + 672 + h]) + INL(14, 8)[h];
    float dt; { const float e_ = fexp(adt), u_ = 1.f + e_; dt = (adt > 20.f) ? adt : ((u_ == 1.f) ? e_ : (__builtin_amdgcn_logf(u_) * 0.6931471805599453f) * e_ * frcp(u_ - 1.f)); }
    const float A = -fexp(INL(15, 8)[h]);
    float cs = dt * A;
#pragma unroll
    for (int o = 1; o < 64; o <<= 1) { const float t = __shfl_up(cs, o); if (lane >= o) cs += t; }
    sDT[h * 64 + lane] = dt; sACS[h * 64 + lane] = cs;
}
template <class F>
__device__ __forceinline__ void ssd_load_chunk(const Ctx& C, int seq, int c, int row0, F store) {
    const int lane = C.lane, w = C.wave;
    const bf16_t* base = WSB(WS_PA) + (size_t)(row0 + lane) * 1536 + 512;
    const float* cw = INL(12, 4 * 1024); const float* cbias = INL(13, 1024);
    for (int j = 0; j < 16; ++j) {
        const int ch0 = 128 * w + 8 * j;
        const u32x4 v0 = *(const u32x4*)(base + ch0);
        u32x4 ex = (u32x4){0u, 0u, 0u, 0u};
        if (lane < 3) {
            if (seq < 2) { if (c > 0) ex = *(const u32x4*)(base - (size_t)3 * 1536 + ch0); }
            else ex = load8(INL(3, BS * 3 * 1024) + ((size_t)(seq - 2) * 3 + lane) * 1024 + ch0, 0, true);
        }
        float x0[8], xk[3][8];
        unpack8(v0, x0);
#pragma unroll
        for (int k = 1; k <= 3; ++k) {
            u32x4 a, b;
            a.x = __shfl(v0.x, (lane - k) & 63); a.y = __shfl(v0.y, (lane - k) & 63); a.z = __shfl(v0.z, (lane - k) & 63); a.w = __shfl(v0.w, (lane - k) & 63);
            b.x = __shfl(ex.x, (lane - k + 3) & 63); b.y = __shfl(ex.y, (lane - k + 3) & 63); b.z = __shfl(ex.z, (lane - k + 3) & 63); b.w = __shfl(ex.w, (lane - k + 3) & 63);
            unpack8(lane >= k ? a : b, xk[k - 1]);
        }
        float y[8];
#pragma unroll
        for (int e = 0; e < 8; ++e) {
            const float a = cbias[ch0 + e] + cw[3 * 1024 + ch0 + e] * x0[e] + cw[2 * 1024 + ch0 + e] * xk[0][e] + cw[1 * 1024 + ch0 + e] * xk[1][e] + cw[ch0 + e] * xk[2][e];
            y[e] = siluf_(a);
        }
        store(ch0, y, x0);
    }
}

constexpr int XT_ST = 72;
__device__ __forceinline__ void ssd_s1_item(const Ctx& C, int item) {
    const int seq = item < 256 ? (item >> 7) : 2 + (item - 256), c = item < 256 ? (item & 127) : 0, row0 = ssd_row0(seq, c);
    const int lane = C.lane, h = C.wave, fr = lane & 15, fq = lane >> 4, l = C.l;
    LAS bf16_t* XT = (LAS bf16_t*)C.lds; LAS bf16_t* BT = (LAS bf16_t*)(C.lds + 73728);
    LAS float* sDT = (LAS float*)(C.lds + 110592); LAS float* sACS = (LAS float*)(C.lds + 112640);
    ssd_dt(C, row0, sDT, sACS);
    __syncthreads();
    const bool lastc = (seq >= 2) || (c == 127);
    float* convo = C.out + (seq < 2 ? O_CONV_P + (size_t)(l * BP + seq) * 3 * 1024 : O_CONV_S + (size_t)(l * BS + seq - 2) * 3 * 1024);
    ssd_load_chunk(C, seq, c, row0, [&](int ch0, const float* y, const float* raw) {
        if (ch0 < 512) { const int hh = ch0 >> 6, p0 = ch0 & 63; const float wgt = sDT[hh * 64 + lane] * fexp(sACS[hh * 64 + 63] - sACS[hh * 64 + lane]);
#pragma unroll
            for (int e = 0; e < 8; ++e) XT[(hh * 64 + p0 + e) * XT_ST + lane] = (bf16_t)f2bf(y[e] * wgt); }
        else if (ch0 < 768) { const int g = (ch0 - 512) >> 7, n0 = (ch0 - 512) & 127;
#pragma unroll
            for (int e = 0; e < 8; ++e) BT[(g * 128 + n0 + e) * XT_ST + lane] = (bf16_t)f2bf(y[e]); }
        if (lastc && lane >= 61) {
#pragma unroll
            for (int e = 0; e < 8; ++e) convo[(size_t)(lane - 61) * 1024 + ch0 + e] = raw[e]; }
    });
    __syncthreads();
    const int g = h >> 2;
    bf16x8 bx[4][2];
#pragma unroll
    for (int pt = 0; pt < 4; ++pt)
#pragma unroll
        for (int ks = 0; ks < 2; ++ks) bx[pt][ks] = *(const LAS bf16x8*)(XT + (h * 64 + 16 * pt + fr) * XT_ST + 32 * ks + 8 * fq);
    const float dall = fexp(sACS[h * 64 + 63]);
    for (int nt = 0; nt < 8; ++nt) {
        bf16x8 a[2];
#pragma unroll
        for (int ks = 0; ks < 2; ++ks) a[ks] = *(const LAS bf16x8*)(BT + (g * 128 + 16 * nt + fr) * XT_ST + 32 * ks + 8 * fq);
#pragma unroll
        for (int pt = 0; pt < 4; ++pt) {
            f32x4 acc = (f32x4){0.f, 0.f, 0.f, 0.f};
#pragma unroll
            for (int ks = 0; ks < 2; ++ks) acc = MFMA16(a[ks], bx[pt][ks], acc);
            const int p = 16 * pt + fr, n = 16 * nt + 4 * fq;
            if (seq < 2) { u32x2 w; w.x = pk2(acc[0], acc[1]); w.y = pk2(acc[2], acc[3]);
                *(u32x2*)(WSB(WS_STATES) + ((size_t)((seq * 128 + c) * 8 + h) * 64 + p) * 128 + n) = w; }
            else { const size_t o = ((size_t)((l * BS + seq - 2) * 8 + h) * 64 + p) * 128 + n;
                const f32x4 h0 = *(const f32x4*)(IN0(2) + o);
                *(f32x4*)(C.out + O_SSM_S + o) = h0 * dall + acc; }
        }
    }
    if (seq < 2 && lane == 0) ((float*)(C.ws + WS_DECAY))[(seq * 128 + c) * 8 + h] = dall;
    __syncthreads();
}
__device__ __forceinline__ void ssd_scan(const Ctx& C) {
    const size_t gt = (size_t)C.bid * NTHREADS + C.tid;
    if (gt >= (size_t)2 * 8 * 64 * 128) return;
    const int b = (int)(gt >> 16), h = (int)(gt >> 13) & 7, pn = (int)(gt & 8191);
    bf16_t* st = WSB(WS_STATES) + ((size_t)(b * 128) * 8 + h) * 8192 + pn;
    const float* dec = (const float*)(C.ws + WS_DECAY) + (b * 128) * 8 + h;
    float hst = 0.f;
#pragma unroll 8
    for (int c = 0; c < 128; ++c) { const float s = bf1(st[(size_t)c * 8 * 8192]); st[(size_t)c * 8 * 8192] = (bf16_t)f2bf(hst); hst = dec[c * 8] * hst + s; }
    C.out[O_SSM_P + ((size_t)(C.l * BP + b) * 8 + h) * 8192 + pn] = hst;
}
constexpr int CN_ST = 136;
__device__ __forceinline__ void ssd_s3_item(const Ctx& C, int item) {
    const int seq = item < 256 ? (item >> 7) : 2 + (item - 256), c = item < 256 ? (item & 127) : 0, row0 = ssd_row0(seq, c);
    const int lane = C.lane, h = C.wave, fr = lane & 15, fq = lane >> 4, l = C.l, g = h >> 2;
    LAS bf16_t* Cn = (LAS bf16_t*)C.lds; LAS bf16_t* Bn = (LAS bf16_t*)(C.lds + 34816); LAS bf16_t* XT = (LAS bf16_t*)(C.lds + 69632);
    LAS float* sDT = (LAS float*)(C.lds + 143360); LAS float* sACS = (LAS float*)(C.lds + 145408); LAS float* sRed = (LAS float*)(C.lds + 147456);
    ssd_dt(C, row0, sDT, sACS);
    ssd_load_chunk(C, seq, c, row0, [&](int ch0, const float* y, const float*) {
        if (ch0 < 512) { const int hh = ch0 >> 6, p0 = ch0 & 63;
#pragma unroll
            for (int e = 0; e < 8; ++e) XT[(hh * 64 + p0 + e) * XT_ST + lane] = (bf16_t)f2bf(y[e]); }
        else if (ch0 < 768) { const int gg = (ch0 - 512) >> 7, n0 = (ch0 - 512) & 127; *(LAS u32x4*)(Bn + (gg * 64 + lane) * CN_ST + n0) = pack8(y); }
        else { const int gg = (ch0 - 768) >> 7, n0 = (ch0 - 768) & 127; *(LAS u32x4*)(Cn + (gg * 64 + lane) * CN_ST + n0) = pack8(y); }
    });
    __syncthreads();
#define CF(lt, ks) (*(const LAS bf16x8*)(Cn + (g * 64 + 16 * (lt) + fr) * CN_ST + 32 * (ks) + 8 * fq))
    f32x4 yacc[4][4];
    const void* hin; bool hin_f32;
    if (seq < 2) { hin = WSB(WS_STATES) + (size_t)((seq * 128 + c) * 8 + h) * 8192; hin_f32 = false; }
    else { hin = IN0(2) + (size_t)((l * BS + seq - 2) * 8 + h) * 8192; hin_f32 = true; }
#pragma unroll
    for (int pt = 0; pt < 4; ++pt) {
#pragma unroll
        for (int lt = 0; lt < 4; ++lt) yacc[pt][lt] = (f32x4){0.f, 0.f, 0.f, 0.f};
        bf16x8 af[4];
        if (hin_f32) {
#pragma unroll
            for (int ks = 0; ks < 4; ++ks) af[ks] = as_frag(load8(hin, (size_t)(16 * pt + fr) * 128 + 32 * ks + 8 * fq, true));
        } else {
#pragma unroll
            for (int ks = 0; ks < 4; ++ks) af[ks] = as_frag(load8(hin, (size_t)(16 * pt + fr) * 128 + 32 * ks + 8 * fq, false));
        }
#pragma unroll
        for (int ks = 0; ks < 4; ++ks)
#pragma unroll
            for (int lt = 0; lt < 4; ++lt) yacc[pt][lt] = MFMA16(af[ks], CF(lt, ks), yacc[pt][lt]);
        __builtin_amdgcn_sched_barrier(0);
    }
    float acl[4];
#pragma unroll
    for (int lt = 0; lt < 4; ++lt) { acl[lt] = sACS[h * 64 + 16 * lt + fr]; const float el = fexp(acl[lt]);
#pragma unroll
        for (int pt = 0; pt < 4; ++pt) yacc[pt][lt] = yacc[pt][lt] * el; }
    const float Dh = INL(16, 8)[h];
#pragma unroll
    for (int lt = 0; lt < 4; ++lt) {
        bf16x8 pf[2], cfl[4];
#pragma unroll
        for (int ks = 0; ks < 4; ++ks) cfl[ks] = CF(lt, ks);
        unsigned pw[4][2];
#pragma unroll
        for (int st = 0; st < 4; ++st) {
            f32x4 cb = (f32x4){0.f, 0.f, 0.f, 0.f};
#pragma unroll
            for (int ks = 0; ks < 4; ++ks) { const bf16x8 a = *(const LAS bf16x8*)(Bn + (g * 64 + 16 * st + fr) * CN_ST + 32 * ks + 8 * fq); cb = MFMA16(a, cfl[ks], cb); }
            const f32x4 as4 = *(const LAS f32x4*)(sACS + h * 64 + 16 * st + 4 * fq), dt4 = *(const LAS f32x4*)(sDT + h * 64 + 16 * st + 4 * fq);
            float m[4];
#pragma unroll
            for (int i = 0; i < 4; ++i) { const int s = 16 * st + 4 * fq + i, ll = 16 * lt + fr;
                float v = (s <= ll) ? cb[i] * fexp(acl[lt] - as4[i]) * dt4[i] : 0.f; if (s == ll) v += Dh; m[i] = v; }
            pw[st][0] = pk2(m[0], m[1]); pw[st][1] = pk2(m[2], m[3]);
        }
        { u32x4 v; v.x = pw[0][0]; v.y = pw[0][1]; v.z = pw[1][0]; v.w = pw[1][1]; pf[0] = as_frag(v); v.x = pw[2][0]; v.y = pw[2][1]; v.z = pw[3][0]; v.w = pw[3][1]; pf[1] = as_frag(v); }
#pragma unroll
        for (int pt = 0; pt < 4; ++pt)
#pragma unroll
            for (int kk = 0; kk < 2; ++kk) { const LAS bf16_t* xp = XT + (h * 64 + 16 * pt + fr) * XT_ST + 32 * kk + 4 * fq;
                const bf16x8 a = mk_frag(*(const LAS u32x2*)xp, *(const LAS u32x2*)(xp + 16)); yacc[pt][lt] = MFMA16(a, pf[kk], yacc[pt][lt]); }
    }
    float ss[4] = {0.f, 0.f, 0.f, 0.f};
#pragma unroll
    for (int lt = 0; lt < 4; ++lt)
#pragma unroll
        for (int pt = 0; pt < 4; ++pt) { const u32x2 z = *(const u32x2*)(WSB(WS_PA) + (size_t)(row0 + 16 * lt + fr) * 1536 + h * 64 + 16 * pt + 4 * fq);
            f32x4 v = yacc[pt][lt]; v[0] *= siluf_(bflo(z.x)); v[1] *= siluf_(bfhi(z.x)); v[2] *= siluf_(bflo(z.y)); v[3] *= siluf_(bfhi(z.y));
            yacc[pt][lt] = v; ss[lt] += v[0] * v[0] + v[1] * v[1] + v[2] * v[2] + v[3] * v[3]; }
#pragma unroll
    for (int lt = 0; lt < 4; ++lt) { ss[lt] += __shfl_xor(ss[lt], 16); ss[lt] += __shfl_xor(ss[lt], 32); if (fq == 0) sRed[h * 64 + 16 * lt + fr] = ss[lt]; }
    __syncthreads();
    const float* ng = INL(17, 512);
#pragma unroll
    for (int lt = 0; lt < 4; ++lt) { float tot = 0.f;
#pragma unroll
        for (int hh = 0; hh < 8; ++hh) tot += sRed[hh * 64 + 16 * lt + fr];
        const float rstd = 1.f / sqrtf(tot * (1.f / 512.f) + EPS);
#pragma unroll
        for (int pt = 0; pt < 4; ++pt) { const f32x4 gg = *(const f32x4*)(ng + h * 64 + 16 * pt + 4 * fq); const f32x4 v = yacc[pt][lt];
            u32x2 w; w.x = pk2(v[0] * rstd * gg[0], v[1] * rstd * gg[1]); w.y = pk2(v[2] * rstd * gg[2], v[3] * rstd * gg[3]);
            *(u32x2*)(WSB(WS_PA) + (size_t)(row0 + 16 * lt + fr) * 1536 + h * 64 + 16 * pt + 4 * fq) = w; } }
    __syncthreads();
}

struct AH {
    const bf16_t* q; int qld; bf16_t* o; int old_;
    const void* kn; size_t knld; bool kn_f32; const bf16_t* kn2; size_t kn2ld; int split;
    const bf16_t* kp; size_t kpld;
    const void* v; size_t vld; bool v_f32; const bf16_t* v2; size_t v2ld;
    int count, cdiff0;
};
template <int DK, bool BIAS>
__device__ __forceinline__ void attn_core(const Ctx& C, const AH& H, int n_iter) {
    constexpr int KST = DK + 8, VST = 72, KBYTES = 64 * KST * 2, VBYTES = 64 * VST * 2, HBY = KBYTES + VBYTES;
    const int lane = C.lane, hf = C.wave >> 2, wq = C.wave & 3, tid_h = C.tid & 255, fr = lane & 15, fq = lane >> 4;
    LAS float* tab = (LAS float*)(C.lds + 4 * HBY) + hf * 260;
    bf16x8 qf[DK / 32];
#pragma unroll
    for (int ks = 0; ks < DK / 32; ++ks) qf[ks] = *(const bf16x8*)(H.q + (size_t)(16 * wq + fr) * H.qld + 32 * ks + 8 * fq);
    f32x4 oacc[4];
#pragma unroll
    for (int d = 0; d < 4; ++d) oacc[d] = (f32x4){0.f, 0.f, 0.f, 0.f};
    float m_run = -1e30f, l_run = 0.f;
    u32x4 rk[2], rp = (u32x4){0u, 0u, 0u, 0u}, rv[2];
#define ATT_GLOAD(t) do { if ((t) < H.count) { const bool sec = (t) >= H.split; const int tk = sec ? (t) - H.split : (t); \
        _Pragma("unroll") for (int i = 0; i < 2; ++i) { const int p = tid_h + 256 * i; \
            { const int key = p >> 3, ch = p & 7; rk[i] = sec ? load8(H.kn2, (size_t)(tk * 64 + key) * H.kn2ld + 8 * ch, false) : load8(H.kn, (size_t)(tk * 64 + key) * H.knld + 8 * ch, H.kn_f32); } \
            { const int key = p & 63, dc = p >> 6; rv[i] = sec ? load8(H.v2, (size_t)(tk * 64 + key) * H.v2ld + 8 * dc, false) : load8(H.v, (size_t)(tk * 64 + key) * H.vld + 8 * dc, H.v_f32); } } \
        if (DK == 96) { const int key = tid_h >> 2, ch = tid_h & 3; rp = *(const u32x4*)(H.kp + (size_t)((t) * 64 + key) * H.kpld + 8 * ch); } } } while (0)
#define ATT_SSTORE(t, buf) do { if ((t) < H.count) { LAS unsigned char* base = C.lds + ((buf) * 2 + hf) * HBY; \
        _Pragma("unroll") for (int i = 0; i < 2; ++i) { const int p = tid_h + 256 * i; \
            { const int key = p >> 3, ch = p & 7; *(LAS u32x4*)(base + (key * KST + 8 * ch) * 2) = rk[i]; } \
            { const int key = p & 63, dc = p >> 6; LAS bf16_t* vt = (LAS bf16_t*)(base + KBYTES) + (8 * dc) * VST + key; const u32x4 vv = rv[i]; \
              vt[0] = (bf16_t)(vv.x & 0xffffu); vt[VST] = (bf16_t)(vv.x >> 16); vt[2 * VST] = (bf16_t)(vv.y & 0xffffu); vt[3 * VST] = (bf16_t)(vv.y >> 16); \
              vt[4 * VST] = (bf16_t)(vv.z & 0xffffu); vt[5 * VST] = (bf16_t)(vv.z >> 16); vt[6 * VST] = (bf16_t)(vv.w & 0xffffu); vt[7 * VST] = (bf16_t)(vv.w >> 16); } } \
        if (DK == 96) { const int key = tid_h >> 2, ch = tid_h & 3; *(LAS u32x4*)(base + (key * KST + 64 + 8 * ch) * 2) = rp; } } } while (0)
    ATT_GLOAD(0); ATT_SSTORE(0, 0);
    __syncthreads();
    for (int t = 0; t < n_iter; ++t) {
        ATT_GLOAD(t + 1);
        if (t < H.count) {
            const LAS unsigned char* base = C.lds + ((t & 1) * 2 + hf) * HBY;
            f32x4 s[4];
#pragma unroll
            for (int mt = 0; mt < 4; ++mt) { s[mt] = (f32x4){0.f, 0.f, 0.f, 0.f};
#pragma unroll
                for (int ks = 0; ks < DK / 32; ++ks) { const bf16x8 a = *(const LAS bf16x8*)(base + ((16 * mt + fr) * KST + 32 * ks + 8 * fq) * 2); s[mt] = MFMA16(a, qf[ks], s[mt]); } }
            if (BIAS) { const int cd = H.cdiff0 - t, ql = 16 * wq + fr;
                if (cd >= 3) { const float bb = tab[256];
#pragma unroll
                    for (int mt = 0; mt < 4; ++mt) s[mt] = s[mt] + bb; }
                else {
#pragma unroll
                    for (int mt = 0; mt < 4; ++mt)
#pragma unroll
                        for (int i = 0; i < 4; ++i) { int rel = cd * 64 + ql - (16 * mt + 4 * fq + i); rel = rel > 128 ? 128 : rel; s[mt][i] += tab[rel + 128]; } } }
            float mx = s[0][0];
#pragma unroll
            for (int mt = 0; mt < 4; ++mt)
#pragma unroll
                for (int i = 0; i < 4; ++i) mx = fmaxf(mx, s[mt][i]);
            mx = fmaxf(mx, __shfl_xor(mx, 16)); mx = fmaxf(mx, __shfl_xor(mx, 32));
            const float mnew = fmaxf(m_run, mx), alpha = fexp2(m_run - mnew); m_run = mnew;
            float psum = 0.f;
#pragma unroll
            for (int mt = 0; mt < 4; ++mt)
#pragma unroll
                for (int i = 0; i < 4; ++i) { const float p = fexp2(s[mt][i] - mnew); s[mt][i] = p; psum += p; }
            l_run = l_run * alpha + psum;
#pragma unroll
            for (int d = 0; d < 4; ++d) oacc[d] = oacc[d] * alpha;
            bf16x8 pf[2];
#pragma unroll
            for (int kk = 0; kk < 2; ++kk) { u32x4 v; v.x = pk2(s[2 * kk][0], s[2 * kk][1]); v.y = pk2(s[2 * kk][2], s[2 * kk][3]); v.z = pk2(s[2 * kk + 1][0], s[2 * kk + 1][1]); v.w = pk2(s[2 * kk + 1][2], s[2 * kk + 1][3]); pf[kk] = as_frag(v); }
            const LAS bf16_t* vt = (const LAS bf16_t*)(base + KBYTES);
#pragma unroll
            for (int d = 0; d < 4; ++d)
#pragma unroll
                for (int kk = 0; kk < 2; ++kk) { const LAS bf16_t* vp = vt + (16 * d + fr) * VST + 32 * kk + 4 * fq;
                    const bf16x8 a = mk_frag(*(const LAS u32x2*)vp, *(const LAS u32x2*)(vp + 16)); oacc[d] = MFMA16(a, pf[kk], oacc[d]); }
        }
        ATT_SSTORE(t + 1, (t + 1) & 1);
        __syncthreads();
    }
#undef ATT_GLOAD
#undef ATT_SSTORE
    l_run += __shfl_xor(l_run, 16); l_run += __shfl_xor(l_run, 32);
    const float inv = 1.f / l_run;
#pragma unroll
    for (int d = 0; d < 4; ++d) { u32x2 w; w.x = pk2(oacc[d][0] * inv, oacc[d][1] * inv); w.y = pk2(oacc[d][2] * inv, oacc[d][3] * inv);
        *(u32x2*)(H.o + (size_t)(16 * wq + fr) * H.old_ + 16 * d + 4 * fq) = w; }
}

constexpr int N_MLAP = 1024, N_S3 = 288, N_MLAS = 128, N_BANDP = 1024, N_BANDS = 128, N_P5 = N_MLAP + N_S3 + N_MLAS + N_BANDP + N_BANDS;
#ifndef P5SEL
#define P5SEL 7
#endif
__device__ __forceinline__ void p5_unit(const Ctx& C, int idx) {
    const int hf = C.wave >> 2, l = C.l;
    AH H; H.split = 1 << 30; H.kn2 = nullptr; H.kn2ld = 0; H.v2 = nullptr; H.v2ld = 0; H.kn_f32 = false; H.v_f32 = false; H.kp = nullptr; H.kpld = 0; H.cdiff0 = 0;
    if (idx < N_MLAP) {
        const int cp = 63 - (idx >> 4), b = (idx >> 3) & 1, h = idx & 7, c = 2 * cp + hf; const size_t row0 = (size_t)b * TP + c * 64;
        H.q = WSB(WS_Q) + row0 * 768 + h * 96; H.qld = 768; H.o = WSB(WS_YBC) + row0 * 1024 + h * 64; H.old_ = 1024;
        H.kn = WSB(WS_KVP) + (size_t)b * TP * 1024 + h * 64; H.knld = 1024; H.kp = WSB(WS_KPEP) + (size_t)b * TP * 32; H.kpld = 32;
        H.v = WSB(WS_KVP) + (size_t)b * TP * 1024 + 512 + h * 64; H.vld = 1024; H.count = c + 1;
        if (P5SEL & 1) attn_core<96, false>(C, H, 2 * cp + 2); return;
    }
    idx -= N_MLAP;
    if (idx < N_S3) { if (P5SEL & 2) ssd_s3_item(C, idx); return; }
    idx -= N_S3;
    if (idx < N_MLAS) {
        const int b = idx >> 2, h = (idx & 3) * 2 + hf; const size_t row0 = (size_t)NP + b * 64;
        H.q = WSB(WS_Q) + row0 * 768 + h * 96; H.qld = 768; H.o = WSB(WS_YBC) + row0 * 1024 + h * 64; H.old_ = 1024;
        H.kn = WSB(WS_XR) + (size_t)b * KS_ALL * 1024 + h * 64; H.knld = 1024; H.kp = WSB(WS_KPES) + (size_t)b * KS_ALL * 32; H.kpld = 32;
        H.v = WSB(WS_XR) + (size_t)b * KS_ALL * 1024 + 512 + h * 64; H.vld = 1024; H.count = 33;
        if (P5SEL & 1) attn_core<96, false>(C, H, 33); return;
    }
    idx -= N_MLAS;
    constexpr int HBY64 = 64 * 72 * 2 * 2;
    if (idx < N_BANDP) {
        const int cp = idx >> 4, b = (idx >> 3) & 1, h = idx & 7, c = 2 * cp + hf, kt0 = c > 8 ? c - 8 : 0; const size_t row0 = (size_t)b * TP + c * 64;
        LAS float* tab = (LAS float*)(C.lds + 4 * HBY64) + hf * 260; const float* rb = INL(32, 8 * 257) + h * 257;
        for (int i = C.tid & 255; i < 257; i += 256) tab[i] = rb[i] * LOG2E;
        H.q = WSB(WS_PD) + row0 * 1536 + h * 64; H.qld = 1536; H.o = WSB(WS_PD) + row0 * 1536 + h * 64; H.old_ = 1536;
        H.kn = WSB(WS_PD) + ((size_t)b * TP + kt0 * 64) * 1536 + 512 + h * 64; H.knld = 1536;
        H.v = WSB(WS_PD) + ((size_t)b * TP + kt0 * 64) * 1536 + 1024 + h * 64; H.vld = 1536; H.count = c - kt0 + 1; H.cdiff0 = c - kt0;
        const int c1 = 2 * cp + 1;
        if (P5SEL & 4) attn_core<64, true>(C, H, (c1 > 8 ? 8 : c1) + 1); return;
    }
    idx -= N_BANDP;
    {
        const int b = idx >> 2, h = (idx & 3) * 2 + hf; const size_t row0 = (size_t)NP + b * 64;
        LAS float* tab = (LAS float*)(C.lds + 4 * HBY64) + hf * 260; const float* rb = INL(32, 8 * 257) + h * 257;
        for (int i = C.tid & 255; i < 257; i += 256) tab[i] = rb[i] * LOG2E;
        H.q = WSB(WS_PD) + row0 * 1536 + h * 64; H.qld = 1536; H.o = WSB(WS_PD) + row0 * 1536 + h * 64; H.old_ = 1536;
        H.kn = INL(7, (size_t)BS * 512 * 512) + (size_t)b * 512 * 512 + h * 64; H.knld = 512; H.kn_f32 = true;
        H.v = INL(8, (size_t)BS * 512 * 512) + (size_t)b * 512 * 512 + h * 64; H.vld = 512; H.v_f32 = true;
        H.split = 8; H.kn2 = WSB(WS_PD) + row0 * 1536 + 512 + h * 64; H.kn2ld = 1536; H.v2 = WSB(WS_PD) + row0 * 1536 + 1024 + h * 64; H.v2ld = 1536;
        H.count = 9; H.cdiff0 = 8;
        if (P5SEL & 4) attn_core<64, true>(C, H, 9);
    }
}

__global__ void __launch_bounds__(NTHREADS) mk_fwd(Args args) {
    extern __shared__ __attribute__((aligned(16))) unsigned char lds_raw[];
    cg::grid_group grid = cg::this_grid();
    Ctx C;
    C.A = &args;
    C.out = args.out; C.ws = args.ws; C.lds = (LAS unsigned char*)lds_raw;
    C.tid = threadIdx.x; C.lane = C.tid & 63; C.wave = __builtin_amdgcn_readfirstlane(C.tid >> 6);
    C.G = gridDim.x; C.bid = blockIdx.x; C.gw = C.bid * NWAVES + C.wave; C.NGW = C.G * NWAVES;
    unsigned* ctl = (unsigned*)(C.ws + WS_CTL);
    LAS int* sIdx = (LAS int*)(C.lds + LDS_BYTES - 16);
#ifndef PMASK
#define PMASK 0xFFF
#endif
#define REFRESH() do { int t_ = threadIdx.x; asm volatile("" : "+v"(t_)); C.tid = t_; C.lane = t_ & 63; C.wave = __builtin_amdgcn_readfirstlane(t_ >> 6); C.gw = C.bid * NWAVES + C.wave; GAS unsigned char* w_ = (GAS unsigned char*)args.ws; asm volatile("" : "+s"(w_)); C.ws = (unsigned char*)w_; GAS float* o_ = (GAS float*)args.out; asm volatile("" : "+s"(o_)); C.out = (float*)o_; } while (0)
#define PH_BEGIN(n) if ((PMASK >> (n)) & 1) { REFRESH();
#define PH_END } grid.sync();
#pragma unroll 1
    for (int l = 0; l < 2; ++l) {
        C.l = l;
        PH_BEGIN(0)
            if (C.bid == 0 && C.tid == 0) ctl[l] = 0u;
            phase_wprep(C);
            phase_norm(C, INL(9, 1024), l > 0);
        PH_END
        PH_BEGIN(1)
            SchedInproj S{WSB(WS_HB), WSB(WS_WT_IN), WSB(WS_PA), WSB(WS_ZB), WSB(WS_XR), WSB(WS_PD), C.G, C.bid};
            pg8::EpiStore E; pg8::gemm_phase(C.lds, S, E, C.tid);
        PH_END
        PH_BEGIN(2)
            for (int it = C.bid; it < N_S3; it += C.G) { REFRESH(); ssd_s1_item(C, it); }
            REFRESH();
            phase_mla_prep(C); phase_band_prep(C); phase_sconv(C);
        PH_END
        PH_BEGIN(3)
            ssd_scan(C);
            SchedP3 S{WSB(WS_ZB), WSB(WS_WT_QUP), WSB(WS_CKVP), WSB(WS_HB), WSB(WS_WT_KVUP), WSB(WS_Q), WSB(WS_KVP), WSB(WS_XR), C.G, C.bid};
            pg8::EpiStore E; pg8::gemm_phase(C.lds, S, E, C.tid);
        PH_END
        PH_BEGIN(4)
            phase_qk_post(C);
        PH_END
        PH_BEGIN(5)
            for (;;) {
                if (C.tid == 0) *sIdx = (int)atomicAdd(&ctl[l], 1u);
                __syncthreads();
                const int idx = *sIdx;
                __syncthreads();
                if (idx >= N_P5) break;
                REFRESH();
                p5_unit(C, idx);
            }
        PH_END
        PH_BEGIN(6)
            phase_norm(C, INL(9, 1024), l > 0);
        PH_END
        PH_BEGIN(7)
            SchedMerge S{WSB(WS_HB), WSB(WS_WT_G), WSB(WS_WT_OUT), WSB(WS_PA), WSB(WS_YBC), WSB(WS_PD), C.G, C.bid};
            pg8::EpiMerge E{INL(11, 4096), WSB(WS_ZB), WSB(WS_XR)}; pg8::gemm_phase(C.lds, S, E, C.tid);
        PH_END
        PH_BEGIN(8)
            SchedOne S{WSB(WS_ZB), WSB(WS_WT_O), nullptr, 1024, 1024, 0, 72, 4, 16, C.G, C.bid};
            pg8::EpiResid E{l > 0 ? C.out : IN0(0), l > 0 ? C.out + (size_t)NP * DM : IN0(1), C.out}; pg8::gemm_phase(C.lds, S, E, C.tid);
        PH_END
        PH_BEGIN(9)
            phase_norm(C, INL(35, 1024), true);
        PH_END
        PH_BEGIN(10)
            SchedOne S{WSB(WS_HB), WSB(WS_WT_UP), nullptr, 1024, 1024, 0, 72, 22, 16, C.G, C.bid};
            pg8::EpiSwiglu E{WSB(WS_XR)}; pg8::gemm_phase(C.lds, S, E, C.tid);
        PH_END
        PH_BEGIN(11)
            SchedOne S{WSB(WS_XR), WSB(WS_WT_DOWN), nullptr, 2816, 2816, 0, 72, 4, 44, C.G, C.bid};
            pg8::EpiResid E{C.out, C.out + (size_t)NP * DM, C.out}; pg8::gemm_phase(C.lds, S, E, C.tid);
        PH_END
    }
}

extern "C" void kernel_launch(void* const* d_in, const int* in_sizes, int n_in, void* d_out, int out_size, void* d_ws, size_t ws_size, hipStream_t stream) {
    static int grid = 0;
    if (grid == 0) {
        int dev = 0, cus = 0, per_cu = 0;
        (void)hipGetDevice(&dev);
        (void)hipDeviceGetAttribute(&cus, hipDeviceAttributeMultiprocessorCount, dev);
        (void)hipFuncSetAttribute((const void*)mk_fwd, hipFuncAttributeMaxDynamicSharedMemorySize, LDS_BYTES);
        (void)hipOccupancyMaxActiveBlocksPerMultiprocessor(&per_cu, (const void*)mk_fwd, NTHREADS, LDS_BYTES);
        if (per_cu < 1) per_cu = 1;
        grid = cus * per_cu;
        if (ws_size < WS_END || n_in != 38 || (size_t)out_size != O_END) { fprintf(stderr, "kernel_launch: bad sizes ws %zu n_in %d out %d\n", ws_size, n_in, out_size); grid = -1; }
    }
    if (grid < 0) return;
    Args a{};
    for (int i = 0; i < 38; ++i) a.in[i] = (const float*)d_in[i];
    a.out = (float*)d_out; a.ws = (unsigned char*)d_ws; a.ph_lo = 0; a.ph_hi = 1000;
    void* kargs[] = {&a};
    hipError_t e = hipLaunchCooperativeKernel((const void*)mk_fwd, dim3(grid), dim3(NTHREADS), kargs, LDS_BYTES, stream);
    if (e != hipSuccess) fprintf(stderr, "cooperative launch failed: %s (grid %d)\n", hipGetErrorString(e), grid);
}
```

```cpp
#include <hip/hip_runtime.h>
#include <hip/hip_cooperative_groups.h>
#include <cstdio>
#include <cstdint>
namespace cg = cooperative_groups;

#define LAS __attribute__((address_space(3)))
#define GAS __attribute__((address_space(1)))
typedef unsigned short bf16_t;
typedef short bf16x8 __attribute__((ext_vector_type(8)));
typedef float f32x4 __attribute__((ext_vector_type(4)));
typedef unsigned u32x4 __attribute__((ext_vector_type(4)));
typedef unsigned u32x2 __attribute__((ext_vector_type(2)));

constexpr int NTHREADS = 512, NWAVES = 8;
constexpr int LDS_BYTES = 155648;
constexpr int NP = 16384, NS = 2048, R = NP + NS;
constexpr int TP = 8192, TS = 64, BP = 2, BS = 32, PAST = 2048, KS_ALL = PAST + TS;
constexpr int DM = 1024, FF = 2816;
constexpr int IN_COLS = 9384;
constexpr float EPS = 1e-6f;
constexpr float LOG2E = 1.4426950408889634f;

constexpr size_t O_Y = 0;
constexpr size_t O_SSM_P = (size_t)R * DM;
constexpr size_t O_SSM_S = O_SSM_P + 262144;
constexpr size_t O_CONV_P = O_SSM_S + 4194304;
constexpr size_t O_CONV_S = O_CONV_P + 12288;
constexpr size_t O_CKV_P = O_CONV_S + 196608;
constexpr size_t O_CKV_S = O_CKV_P + 8388608;
constexpr size_t O_KPE_P = O_CKV_S + 1048576;
constexpr size_t O_KPE_S = O_KPE_P + 1048576;
constexpr size_t O_SC_P = O_KPE_S + 131072;
constexpr size_t O_SC_S = O_SC_P + 4096;
constexpr size_t O_BK_P = O_SC_S + 65536;
constexpr size_t O_BK_S = O_BK_P + 1048576;
constexpr size_t O_BV_P = O_BK_S + 16777216;
constexpr size_t O_BV_S = O_BV_P + 1048576;
constexpr size_t O_END = O_BV_S + 16777216;

constexpr size_t al256(size_t x) { return (x + 255) & ~(size_t)255; }
constexpr size_t WS_CTL = 0;
constexpr size_t WS_DECAY = 4096;
constexpr size_t WS_SUMSQ = 16384;
constexpr size_t WS_WT_IN = 131072;
constexpr size_t WS_WT_G = WS_WT_IN + (size_t)5376 * 1024 * 2;
constexpr size_t WS_WT_QUP = WS_WT_G + (size_t)4096 * 1024 * 2;
constexpr size_t WS_WT_KVUP = WS_WT_QUP + (size_t)768 * 384 * 2;
constexpr size_t WS_WT_OUT = WS_WT_KVUP + (size_t)1024 * 256 * 2;
constexpr size_t WS_WT_O = WS_WT_OUT + (size_t)4 * 1024 * 1024 * 2;
constexpr size_t WS_WT_UP = WS_WT_O + (size_t)1024 * 1024 * 2;
constexpr size_t WS_WT_DOWN = WS_WT_UP + (size_t)5632 * 1024 * 2;
constexpr size_t WS_HB = al256(WS_WT_DOWN + (size_t)1024 * 2816 * 2);
constexpr size_t WS_PA = WS_HB + (size_t)R * 1024 * 2;
constexpr size_t WS_PD = WS_PA + (size_t)R * 1536 * 2;
constexpr size_t WS_ZB = WS_PD + (size_t)R * 1536 * 2;
constexpr size_t WS_CKVP = WS_ZB + (size_t)R * 768 * 2;
constexpr size_t WS_XR = WS_ZB + (size_t)R * 1024 * 2;
constexpr size_t WS_Q = WS_XR + (size_t)67584 * 1024 * 2;
constexpr size_t WS_KPEP = WS_Q + (size_t)R * 768 * 2;
constexpr size_t WS_KPES = WS_KPEP + (size_t)16384 * 32 * 2;
constexpr size_t WS_KVP = WS_KPES + (size_t)67584 * 32 * 2;
constexpr size_t WS_STATES = WS_KVP + (size_t)16384 * 1024 * 2;
constexpr size_t WS_YBC = WS_STATES + (size_t)2048 * 64 * 128 * 2;
constexpr size_t WS_CKVS = WS_YBC + (size_t)R * 1024 * 2;
constexpr size_t WS_END = WS_CKVS + (size_t)67584 * 256 * 2;
static_assert(WS_END < (size_t)553000000, "ws map too large");
static_assert((size_t)R * 768 * 2 + (size_t)16384 * 256 * 2 <= (size_t)R * 1024 * 2, "ZB");
static_assert((size_t)67584 * 256 * 2 <= (size_t)R * 1024 * 2, "ckvS in HB");

__device__ __forceinline__ unsigned f2bf(float f) { unsigned u = __builtin_bit_cast(unsigned, f); return (u + 0x7fffu + ((u >> 16) & 1u)) >> 16; }
__device__ __forceinline__ unsigned pk2(float lo, float hi) { return f2bf(lo) | (f2bf(hi) << 16); }
__device__ __forceinline__ float bflo(unsigned u) { return __builtin_bit_cast(float, u << 16); }
__device__ __forceinline__ float bfhi(unsigned u) { return __builtin_bit_cast(float, u & 0xffff0000u); }
__device__ __forceinline__ float bf1(bf16_t h) { return __builtin_bit_cast(float, (unsigned)h << 16); }
__device__ __forceinline__ float fexp2(float x) { return __builtin_amdgcn_exp2f(x); }
__device__ __forceinline__ float fexp(float x) { return __builtin_amdgcn_exp2f(x * LOG2E); }
__device__ __forceinline__ float frcp(float x) { return __builtin_amdgcn_rcpf(x); }
__device__ __forceinline__ float sigmoidf_(float x) { return frcp(1.f + fexp(-x)); }
__device__ __forceinline__ float siluf_(float x) { return x * sigmoidf_(x); }
__device__ __forceinline__ float wave_sum(float v) {
#pragma unroll
    for (int o = 1; o < 64; o <<= 1) v += __shfl_xor(v, o);
    return v;
}
#define LDS_WAIT() asm volatile("s_waitcnt lgkmcnt(0)" ::: "memory")
__device__ __forceinline__ void unpack8(u32x4 v, float* f) {
    f[0] = bflo(v.x); f[1] = bfhi(v.x); f[2] = bflo(v.y); f[3] = bfhi(v.y); f[4] = bflo(v.z); f[5] = bfhi(v.z); f[6] = bflo(v.w); f[7] = bfhi(v.w);
}
__device__ __forceinline__ u32x4 pack8(const float* f) { u32x4 o; o.x = pk2(f[0], f[1]); o.y = pk2(f[2], f[3]); o.z = pk2(f[4], f[5]); o.w = pk2(f[6], f[7]); return o; }
__device__ __forceinline__ u32x4 load8(const void* base, size_t idx, bool is_f32) {
    if (is_f32) { const f32x4* p = (const f32x4*)((const float*)base + idx); f32x4 a = p[0], b = p[1];
        u32x4 o; o.x = pk2(a.x, a.y); o.y = pk2(a.z, a.w); o.z = pk2(b.x, b.y); o.w = pk2(b.z, b.w); return o; }
    return *(const u32x4*)((const bf16_t*)base + idx);
}

namespace pg8 {
constexpr int BM = 256, BK = 64, HALF = 128, HTB = HALF * BK * 2, STAGE_BYTES = 8 * HTB, NXCD = 8, WGM = 8;
__device__ __forceinline__ int lds_byte(int r, int c) { const int st = (r >> 4) * 2 + (c >> 5), rr = r & 15, cc = c & 31, ob = rr * 64 + cc * 2; return st * 1024 + (ob ^ (((ob >> 9) & 1) << 5)); }
__device__ __forceinline__ void stage_rc(int b, int& Rr, int& C) { const int st = b / 1024, sb = b % 1024, swz = sb ^ (((sb >> 9) & 1) << 5); Rr = (st >> 1) * 16 + swz / 64; C = (st & 1) * 32 + (swz % 64) / 2; }
__device__ __forceinline__ int perm32(int rho) { const int n = rho >> 4, i = rho & 15; return 8 * (i >> 2) + 4 * n + (i & 3); }

struct GUnit { const bf16_t* A; const bf16_t* B; int lda, ldb, nt; int pm, pn, sub; bf16_t* C; int ldc; };

__device__ __forceinline__ void tile_map(int L, int nM, int nN, int& pm, int& pn) {
    const int nwg = nM * nN; int wgid = L;
    { const int q = nwg / NXCD, r = nwg % NXCD, xcd = wgid % NXCD, off = wgid / NXCD; wgid = (xcd < r ? xcd * (q + 1) : r * (q + 1) + (xcd - r) * q) + off; }
    const int nig = WGM * nN, gid = wgid / nig, fm = gid * WGM, gsz = (nM - fm) < WGM ? (nM - fm) : WGM;
    pm = fm + ((wgid % nig) % gsz); pn = (wgid % nig) / gsz;
}
typedef float f32x2_t __attribute__((ext_vector_type(2)));
typedef __bf16 bf16x2_t __attribute__((ext_vector_type(2)));
__device__ __forceinline__ unsigned cvt_pk_bf16(float lo, float hi) { f32x2_t v = {lo, hi}; bf16x2_t b = __builtin_convertvector(v, bf16x2_t); return __builtin_bit_cast(unsigned, b); }

template <class Epi, class Sched>
__device__ __forceinline__ void gemm_phase(LAS unsigned char* lds, const Sched& S, Epi& E, int tid) {
    const int wid = __builtin_amdgcn_readfirstlane(tid >> 6), lane = tid & 63, wr = wid >> 2, wc = wid & 3, fr = lane & 15, fq = lane >> 4;
    int RA[2], RB[2], CC[2];
#pragma unroll
    for (int i = 0; i < 2; ++i) { int Rr, C; stage_rc(tid * 16 + i * 8192, Rr, C); RA[i] = Rr; RB[i] = (Rr & ~31) + perm32(Rr & 31); CC[i] = C; }
    const size_t kstep = (size_t)(BK * 2);
    const unsigned ldsw = (unsigned)wid * 1024u;
    const int aoff = lds_byte(wr * 64 + fr, fq * 8), boff = lds_byte(wc * 32 + fr, fq * 8);
#define PG8_SA(b, h) (((b) * 2 + (h)) * HTB)
#define PG8_SB(b, h) ((4 + (b) * 2 + (h)) * HTB)
#define PG8_STAGE(bufoff, gbase, v0, v1) do { \
        __builtin_amdgcn_global_load_lds((const unsigned*)((const char*)(gbase) + (v0)), (LAS unsigned*)(lds + (bufoff) + ldsw), 16, 0, 0); \
        __builtin_amdgcn_global_load_lds((const unsigned*)((const char*)(gbase) + (v1)), (LAS unsigned*)(lds + (bufoff) + ldsw + 8192), 16, 0, 0); } while (0)
#define PG8_LDA(dst, b, h) do { _Pragma("unroll") for (int m = 0; m < 4; ++m) _Pragma("unroll") for (int k = 0; k < 2; ++k) dst[m][k] = *(const LAS bf16x8*)(lds + PG8_SA(b, h) + aoff + m * 2048 + k * 1024); } while (0)
#define PG8_LDB(dst, b, h) do { _Pragma("unroll") for (int n = 0; n < 2; ++n) _Pragma("unroll") for (int k = 0; k < 2; ++k) dst[n][k] = *(const LAS bf16x8*)(lds + PG8_SB(b, h) + boff + n * 2048 + k * 1024); } while (0)
#define PG8_MMA(ai, bj, At, Bt) do { __builtin_amdgcn_s_setprio(1); _Pragma("unroll") for (int m = 0; m < 4; ++m) _Pragma("unroll") for (int n = 0; n < 2; ++n) _Pragma("unroll") for (int k = 0; k < 2; ++k) \
        acc[ai][bj][m][n] = __builtin_amdgcn_mfma_f32_16x16x32_bf16(Bt[n][k], At[m][k], acc[ai][bj][m][n], 0, 0, 0); __builtin_amdgcn_s_setprio(0); } while (0)
#define PG8_WAIT_V(n) asm volatile("s_waitcnt vmcnt(" #n ")" ::: "memory")
#define PG8_WAIT_L(n) asm volatile("s_waitcnt lgkmcnt(" #n ")" ::: "memory")
#define PG8_BAR __builtin_amdgcn_s_barrier()
#define PG8_SCHED __builtin_amdgcn_sched_barrier(0)
    GUnit cur, nxt; int ui = 0;
    if (!S.next(0, cur)) return;
    f32x4 acc[2][2][4][2];
#pragma unroll
    for (int a = 0; a < 2; ++a)
#pragma unroll
        for (int b = 0; b < 2; ++b)
#pragma unroll
            for (int m = 0; m < 4; ++m)
#pragma unroll
                for (int n = 0; n < 2; ++n) acc[a][b][m][n] = (f32x4){0.f, 0.f, 0.f, 0.f};
    bf16x8 At[4][2], B0[2][2], B1[2][2];
    const char* cA = (const char*)cur.A; const char* cB = (const char*)cur.B;
    int clda = cur.lda, cldb = cur.ldb;
#define VA0(ld) ((unsigned)(RA[0] * (ld) + CC[0]) * 2u)
#define VA1(ld) ((unsigned)(RA[1] * (ld) + CC[1]) * 2u)
#define VB0(ld) ((unsigned)(RB[0] * (ld) + CC[0]) * 2u)
#define VB1(ld) ((unsigned)(RB[1] * (ld) + CC[1]) * 2u)
    unsigned vAc0 = VA0(clda), vAc1 = VA1(clda), vBc0 = VB0(cldb), vBc1 = VB1(cldb);
    size_t hsAc = (size_t)HALF * clda * 2, hsBc = (size_t)HALF * cldb * 2;
    PG8_STAGE(PG8_SB(0, 0), cB, vBc0, vBc1); PG8_STAGE(PG8_SB(0, 1), cB + hsBc, vBc0, vBc1); PG8_STAGE(PG8_SA(0, 0), cA, vAc0, vAc1); PG8_STAGE(PG8_SA(0, 1), cA + hsAc, vAc0, vAc1);
    if (wr == 1) PG8_BAR;
    PG8_WAIT_V(2); PG8_BAR;
    PG8_STAGE(PG8_SB(1, 0), cB + kstep, vBc0, vBc1); PG8_STAGE(PG8_SA(1, 0), cA + kstep, vAc0, vAc1); PG8_STAGE(PG8_SB(1, 1), cB + hsBc + kstep, vBc0, vBc1);
    PG8_WAIT_V(6); PG8_BAR;
    for (;;) {
        const bool has_next = S.next(ui + 1, nxt);
        const char* nA = has_next ? (const char*)nxt.A : cA; const char* nB = has_next ? (const char*)nxt.B : cB;
        const int nlda = has_next ? nxt.lda : cur.lda, nldb = has_next ? nxt.ldb : cur.ldb;
        const size_t hsAn = (size_t)HALF * nlda * 2, hsBn = (size_t)HALF * nldb * 2;
        const int nt = cur.nt;
        for (int t = 0; t < nt; t += 2) {
            const bool last = (t == nt - 2);
            const char* a1 = cA + (size_t)(t + 1) * kstep;
            const char* a2 = last ? nA : cA + (size_t)(t + 2) * kstep; const char* b2 = last ? nB : cB + (size_t)(t + 2) * kstep;
            const char* a3 = a2 + kstep; const char* b3 = b2 + kstep;
            const int lda2 = last ? nlda : clda, ldb2 = last ? nldb : cldb;
            const unsigned vA0 = VA0(lda2), vA1 = VA1(lda2), vB0 = VB0(ldb2), vB1 = VB1(ldb2);
            vAc0 = VA0(clda); vAc1 = VA1(clda);
            const size_t hsA2 = last ? hsAn : hsAc, hsB2 = last ? hsBn : hsBc;
            PG8_LDB(B0, 0, 0); PG8_LDB(B1, 0, 1); PG8_SCHED; PG8_LDA(At, 0, 0); PG8_STAGE(PG8_SA(1, 1), a1 + hsAc, vAc0, vAc1);
            PG8_WAIT_V(8); PG8_WAIT_L(0); PG8_BAR; PG8_MMA(0, 0, At, B0); PG8_MMA(0, 1, At, B1); PG8_BAR; PG8_SCHED;
            PG8_LDA(At, 0, 1); PG8_STAGE(PG8_SB(0, 0), b2, vB0, vB1); PG8_STAGE(PG8_SB(0, 1), b2 + hsB2, vB0, vB1); PG8_STAGE(PG8_SA(0, 0), a2, vA0, vA1);
            PG8_WAIT_V(8); PG8_WAIT_L(0); PG8_BAR; PG8_MMA(1, 0, At, B0); PG8_MMA(1, 1, At, B1); PG8_BAR; PG8_SCHED;
            PG8_LDB(B0, 1, 0); PG8_LDB(B1, 1, 1); PG8_SCHED; PG8_LDA(At, 1, 0); PG8_STAGE(PG8_SA(0, 1), a2 + hsA2, vA0, vA1);
            PG8_WAIT_V(8); PG8_WAIT_L(0); PG8_BAR; PG8_MMA(0, 0, At, B0); PG8_MMA(0, 1, At, B1); PG8_BAR; PG8_SCHED;
            PG8_LDA(At, 1, 1); PG8_STAGE(PG8_SB(1, 0), b3, vB0, vB1); PG8_STAGE(PG8_SB(1, 1), b3 + hsB2, vB0, vB1); PG8_STAGE(PG8_SA(1, 0), a3, vA0, vA1);
            PG8_WAIT_V(8); PG8_WAIT_L(0); PG8_BAR; PG8_MMA(1, 0, At, B0); PG8_MMA(1, 1, At, B1); PG8_BAR; PG8_SCHED;
        }
        if (wr == 0) PG8_BAR;
        const bool clear = E(acc, cur, wr, wc, fr, fq);
        if (!has_next) break;
        if (clear) {
#pragma unroll
        for (int a = 0; a < 2; ++a)
#pragma unroll
            for (int b = 0; b < 2; ++b)
#pragma unroll
                for (int m = 0; m < 4; ++m)
#pragma unroll
                    for (int n = 0; n < 2; ++n) acc[a][b][m][n] = (f32x4){0.f, 0.f, 0.f, 0.f};
        }
        cur = nxt; cA = nA; cB = nB; ++ui;
        clda = nlda; cldb = nldb; vAc0 = VA0(clda); vAc1 = VA1(clda); hsAc = hsAn; hsBc = hsBn;
        if (wr == 1) PG8_BAR;
    }
    PG8_WAIT_V(0);
    PG8_BAR;
#undef VA0
#undef VA1
#undef VB0
#undef VB1
#undef PG8_SA
#undef PG8_SB
#undef PG8_STAGE
#undef PG8_LDA
#undef PG8_LDB
#undef PG8_MMA
#undef PG8_WAIT_V
#undef PG8_WAIT_L
#undef PG8_BAR
#undef PG8_SCHED
}

struct EpiStore {
    __device__ __forceinline__ bool operator()(const f32x4 (&acc)[2][2][4][2], const GUnit& u, int wr, int wc, int fr, int fq) {
#pragma unroll
        for (int ai = 0; ai < 2; ++ai)
#pragma unroll
            for (int m = 0; m < 4; ++m) { bf16_t* rowp = u.C + (size_t)(ai * HALF + wr * 64 + m * 16 + fr) * u.ldc + wc * 32 + 8 * fq;
#pragma unroll
                for (int bj = 0; bj < 2; ++bj) { const f32x4 v0 = acc[ai][bj][m][0], v1 = acc[ai][bj][m][1];
                    u32x4 w; w.x = cvt_pk_bf16(v0[0], v0[1]); w.y = cvt_pk_bf16(v0[2], v0[3]); w.z = cvt_pk_bf16(v1[0], v1[1]); w.w = cvt_pk_bf16(v1[2], v1[3]);
                    *(GAS u32x4*)(rowp + bj * HALF) = w; } }
        return true;
    }
};
struct EpiResid {
    const float* xp; const float* xs; float* out;
    __device__ __forceinline__ bool operator()(const f32x4 (&acc)[2][2][4][2], const GUnit& u, int wr, int wc, int fr, int fq) {
        const unsigned off0 = (unsigned)(wr * 64 + fr) * DM + u.pn * 256 + wc * 32 + 8 * fq;
        const float* xin = ((u.pm < 64) ? xp + (size_t)u.pm * 256 * DM : xs + (size_t)(u.pm - 64) * 256 * DM) + off0;
        float* o = out + (size_t)u.pm * 256 * DM + off0;
#pragma unroll
        for (int ai = 0; ai < 2; ++ai)
#pragma unroll
            for (int m = 0; m < 4; ++m)
#pragma unroll
                for (int bj = 0; bj < 2; ++bj) { const unsigned ro = (unsigned)(ai * HALF + m * 16) * DM + bj * HALF;
                    const f32x4 x0 = *(const GAS f32x4*)(xin + ro), x1 = *(const GAS f32x4*)(xin + ro + 4);
                    *(GAS f32x4*)(o + ro) = x0 + acc[ai][bj][m][0]; *(GAS f32x4*)(o + ro + 4) = x1 + acc[ai][bj][m][1]; }
        return true;
    }
};
struct EpiResidNorm {
    const float* xp; const float* xs; float* out; bf16_t* hbo; const float* g2; float* sumsq;
    __device__ __forceinline__ bool operator()(const f32x4 (&acc)[2][2][4][2], const GUnit& u, int wr, int wc, int fr, int fq) {
        const unsigned col0 = u.pn * 256 + wc * 32 + 8 * fq;
        const unsigned off0 = (unsigned)(wr * 64 + fr) * DM + col0;
        const float* xin = ((u.pm < 64) ? xp + (size_t)u.pm * 256 * DM : xs + (size_t)(u.pm - 64) * 256 * DM) + off0;
        float* o = out + (size_t)u.pm * 256 * DM + off0;
        bf16_t* ho = hbo + (size_t)u.pm * 256 * DM + off0;
        f32x4 gg[2][2];
#pragma unroll
        for (int bj = 0; bj < 2; ++bj) { gg[bj][0] = *(const GAS f32x4*)(g2 + col0 + bj * HALF); gg[bj][1] = *(const GAS f32x4*)(g2 + col0 + bj * HALF + 4); }
#pragma unroll
        for (int ai = 0; ai < 2; ++ai)
#pragma unroll
            for (int m = 0; m < 4; ++m) { float ss = 0.f;
#pragma unroll
                for (int bj = 0; bj < 2; ++bj) { const unsigned ro = (unsigned)(ai * HALF + m * 16) * DM + bj * HALF;
                    const f32x4 x0 = *(const GAS f32x4*)(xin + ro) + acc[ai][bj][m][0], x1 = *(const GAS f32x4*)(xin + ro + 4) + acc[ai][bj][m][1];
                    *(GAS f32x4*)(o + ro) = x0; *(GAS f32x4*)(o + ro + 4) = x1;
                    ss += (x0[0] * x0[0] + x0[1] * x0[1]) + (x0[2] * x0[2] + x0[3] * x0[3]) + (x1[0] * x1[0] + x1[1] * x1[1]) + (x1[2] * x1[2] + x1[3] * x1[3]);
                    const f32x4 h0 = x0 * gg[bj][0], h1 = x1 * gg[bj][1]; u32x4 w;
                    w.x = cvt_pk_bf16(h0[0], h0[1]); w.y = cvt_pk_bf16(h0[2], h0[3]); w.z = cvt_pk_bf16(h1[0], h1[1]); w.w = cvt_pk_bf16(h1[2], h1[3]);
                    *(GAS u32x4*)(ho + ro) = w; }
                ss += __shfl_xor(ss, 16); ss += __shfl_xor(ss, 32);
                if (fq == 0) atomicAdd(sumsq + u.pm * 256 + ai * HALF + wr * 64 + m * 16 + fr, ss); }
        return true;
    }
};
struct EpiSwigluNorm {
    bf16_t* act; const float* sumsq;
    __device__ __forceinline__ bool operator()(const f32x4 (&acc)[2][2][4][2], const GUnit& u, int wr, int wc, int fr, int fq) {
#pragma unroll
        for (int ai = 0; ai < 2; ++ai)
#pragma unroll
            for (int m = 0; m < 4; ++m) { const int row = u.pm * 256 + ai * HALF + wr * 64 + m * 16 + fr;
                const float rs = 1.f / sqrtf(*(const GAS float*)(sumsq + row) * (1.f / DM) + EPS);
                bf16_t* rowp = act + (size_t)row * FF + u.pn * 128 + wc * 32 + 8 * fq;
                float o[8];
#pragma unroll
                for (int n = 0; n < 2; ++n)
#pragma unroll
                    for (int i = 0; i < 4; ++i) o[4 * n + i] = siluf_(rs * acc[ai][0][m][n][i]) * (rs * acc[ai][1][m][n][i]);
                u32x4 w; w.x = cvt_pk_bf16(o[0], o[1]); w.y = cvt_pk_bf16(o[2], o[3]); w.z = cvt_pk_bf16(o[4], o[5]); w.w = cvt_pk_bf16(o[6], o[7]);
                *(GAS u32x4*)rowp = w; }
        return true;
    }
};
struct EpiSwiglu {
    bf16_t* act;
    __device__ __forceinline__ bool operator()(const f32x4 (&acc)[2][2][4][2], const GUnit& u, int wr, int wc, int fr, int fq) {
#pragma unroll
        for (int ai = 0; ai < 2; ++ai)
#pragma unroll
            for (int m = 0; m < 4; ++m) { bf16_t* rowp = act + (size_t)(u.pm * 256 + ai * HALF + wr * 64 + m * 16 + fr) * FF + u.pn * 128 + wc * 32 + 8 * fq;
                float o[8];
#pragma unroll
                for (int n = 0; n < 2; ++n)
#pragma unroll
                    for (int i = 0; i < 4; ++i) o[4 * n + i] = siluf_(acc[ai][0][m][n][i]) * acc[ai][1][m][n][i];
                u32x4 w; w.x = cvt_pk_bf16(o[0], o[1]); w.y = cvt_pk_bf16(o[2], o[3]); w.z = cvt_pk_bf16(o[4], o[5]); w.w = cvt_pk_bf16(o[6], o[7]);
                *(GAS u32x4*)rowp = w; }
        return true;
    }
};
struct EpiMerge {
    const float* bgate; bf16_t* merged; bf16_t* gtmp;
    __device__ __forceinline__ bool operator()(const f32x4 (&acc)[2][2][4][2], const GUnit& u, int wr, int wc, int fr, int fq) {
        const int br = u.sub >> 1;
        const unsigned off0 = (unsigned)(u.pm * 256 + wr * 64 + fr) * DM + u.pn * 256 + wc * 32 + 8 * fq;
        if ((u.sub & 1) == 0) {
#pragma unroll
            for (int bj = 0; bj < 2; ++bj) { const float* bp = bgate + br * 1024 + u.pn * 256 + bj * HALF + wc * 32 + 8 * fq;
                const f32x4 b0 = *(const GAS f32x4*)bp, b1 = *(const GAS f32x4*)(bp + 4);
#pragma unroll
                for (int ai = 0; ai < 2; ++ai)
#pragma unroll
                    for (int m = 0; m < 4; ++m) { const f32x4 v0 = acc[ai][bj][m][0] + b0, v1 = acc[ai][bj][m][1] + b1; u32x4 w;
                        w.x = cvt_pk_bf16(sigmoidf_(v0[0]), sigmoidf_(v0[1])); w.y = cvt_pk_bf16(sigmoidf_(v0[2]), sigmoidf_(v0[3]));
                        w.z = cvt_pk_bf16(sigmoidf_(v1[0]), sigmoidf_(v1[1])); w.w = cvt_pk_bf16(sigmoidf_(v1[2]), sigmoidf_(v1[3]));
                        *(GAS u32x4*)(gtmp + off0 + (unsigned)(ai * HALF + m * 16) * DM + bj * HALF) = w; } }
        } else {
#pragma unroll
            for (int ai = 0; ai < 2; ++ai)
#pragma unroll
                for (int m = 0; m < 4; ++m)
#pragma unroll
                    for (int bj = 0; bj < 2; ++bj) { const unsigned off = off0 + (unsigned)(ai * HALF + m * 16) * DM + bj * HALF;
                        const u32x4 gg = *(const GAS u32x4*)(gtmp + off); u32x4 mm = (u32x4){0u, 0u, 0u, 0u}; if (br > 0) mm = *(const GAS u32x4*)(merged + off);
                        const f32x4 a0 = acc[ai][bj][m][0], a1 = acc[ai][bj][m][1]; u32x4 w;
                        w.x = cvt_pk_bf16(bflo(mm.x) + bflo(gg.x) * a0[0], bfhi(mm.x) + bfhi(gg.x) * a0[1]); w.y = cvt_pk_bf16(bflo(mm.y) + bflo(gg.y) * a0[2], bfhi(mm.y) + bfhi(gg.y) * a0[3]);
                        w.z = cvt_pk_bf16(bflo(mm.z) + bflo(gg.z) * a1[0], bfhi(mm.z) + bfhi(gg.z) * a1[1]); w.w = cvt_pk_bf16(bflo(mm.w) + bflo(gg.w) * a1[2], bfhi(mm.w) + bfhi(gg.w) * a1[3]);
                        *(GAS u32x4*)(merged + off) = w; }
        }
        return true;
    }
};
}

struct Args { const float* in[38]; float* out; unsigned char* ws; int ph_lo, ph_hi; };
struct Ctx {
    const Args* A; float* out; unsigned char* ws; LAS unsigned char* lds;
    int tid, lane, wave, gw, NGW, l, G, bid;
};
#define WSB(off) ((bf16_t*)(C.ws + (off)))
#define INL(i, sz) (C.A->in[i] + (size_t)C.l * (size_t)(sz))
#define IN0(i) (C.A->in[i])

using pg8::GUnit;
struct SchedOne {
    const bf16_t* A; const bf16_t* B; bf16_t* Cp; int lda, ldb, ldc, nM, nN, nt, G, c;
    __device__ __forceinline__ bool next(int i, GUnit& u) const {
        const long L = (long)i * G + c; if (L >= (long)nM * nN) return false;
        int pm, pn; pg8::tile_map((int)L, nM, nN, pm, pn);
        u.A = A + (size_t)pm * 256 * lda; u.B = B + (size_t)pn * 256 * ldb; u.lda = lda; u.ldb = ldb; u.nt = nt; u.pm = pm; u.pn = pn; u.sub = 0;
        u.C = Cp ? Cp + (size_t)pm * 256 * ldc + (size_t)pn * 256 : nullptr; u.ldc = ldc; return true;
    }
};
struct SchedInproj {
    const bf16_t* A; const bf16_t* B; bf16_t *pA, *pB, *pC, *pD; int G, c;
    __device__ __forceinline__ bool next(int i, GUnit& u) const {
        const long L = (long)i * G + c; if (L >= 72 * 21) return false;
        int pm, pn; pg8::tile_map((int)L, 72, 21, pm, pn);
        u.A = A + (size_t)pm * 256 * 1024; u.B = B + (size_t)pn * 256 * 1024; u.lda = 1024; u.ldb = 1024; u.nt = 16; u.pm = pm; u.pn = pn; u.sub = 0;
        if (pn < 6) { u.C = pA + (size_t)pm * 256 * 1536 + pn * 256; u.ldc = 1536; }
        else if (pn < 9) { u.C = pB + (size_t)pm * 256 * 768 + (pn - 6) * 256; u.ldc = 768; }
        else if (pn < 15) { u.C = pC + (size_t)pm * 256 * 1536 + (pn - 9) * 256; u.ldc = 1536; }
        else { u.C = pD + (size_t)pm * 256 * 1536 + (pn - 15) * 256; u.ldc = 1536; }
        return true;
    }
};
struct SchedP3 {
    const bf16_t *pB, *wq, *ckvP, *ckvS, *wkv; bf16_t *Q, *KVP, *KVS; int G, c;
    __device__ __forceinline__ bool next(int i, GUnit& u) const {
        long L = (long)i * G + c; int pm, pn; u.sub = 0;
        if (L < 264 * 4) { pg8::tile_map((int)L, 264, 4, pm, pn); u.A = ckvS + (size_t)pm * 256 * 256; u.B = wkv + (size_t)pn * 256 * 256; u.lda = 256; u.ldb = 256; u.nt = 4;
            u.C = KVS + (size_t)pm * 256 * 1024 + pn * 256; u.ldc = 1024; u.pm = pm; u.pn = pn; return true; }
        L -= 264 * 4;
        if (L < 64 * 4) { pg8::tile_map((int)L, 64, 4, pm, pn); u.A = ckvP + (size_t)pm * 256 * 256; u.B = wkv + (size_t)pn * 256 * 256; u.lda = 256; u.ldb = 256; u.nt = 4;
            u.C = KVP + (size_t)pm * 256 * 1024 + pn * 256; u.ldc = 1024; u.pm = pm; u.pn = pn; return true; }
        L -= 64 * 4;
        if (L < 72 * 3) { pg8::tile_map((int)L, 72, 3, pm, pn); u.A = pB + (size_t)pm * 256 * 768; u.B = wq + (size_t)pn * 256 * 384; u.lda = 768; u.ldb = 384; u.nt = 6;
            u.C = Q + (size_t)pm * 256 * 768 + pn * 256; u.ldc = 768; u.pm = pm; u.pn = pn; return true; }
        return false;
    }
};
struct SchedMerge {
    const bf16_t *hb, *wg, *wout, *pA, *ybc, *pD; int G, c;
    __device__ __forceinline__ bool next(int i, GUnit& u) const {
        const long L = (long)(i >> 3) * G + c; if (L >= 72 * 4) return false;
        int pm, pn; pg8::tile_map((int)L, 72, 4, pm, pn); const int sub = i & 7, br = sub >> 1;
        u.pm = pm; u.pn = pn; u.sub = sub; u.C = nullptr; u.ldc = 0; u.ldb = 1024;
        if ((sub & 1) == 0) { u.A = hb + (size_t)pm * 256 * 1024; u.lda = 1024; u.nt = 16; u.B = wg + (size_t)(br * 1024 + pn * 256) * 1024; }
        else { u.nt = 8; u.B = wout + (size_t)(br * 1024 + pn * 256) * 1024;
            if (br == 0) { u.A = pA + (size_t)pm * 256 * 1536; u.lda = 1536; }
            else if (br == 1) { u.A = ybc + (size_t)pm * 256 * 1024; u.lda = 1024; }
            else if (br == 2) { u.A = ybc + (size_t)pm * 256 * 1024 + 512; u.lda = 1024; }
            else { u.A = pD + (size_t)pm * 256 * 1536; u.lda = 1536; } }
        return true;
    }
};

template <class Map>
__device__ __forceinline__ void transpose_w(const Ctx& C, const float* W, int ldw, int K, int Nout, bf16_t* WT, int ldt, Map map) {
    LAS float* scr = (LAS float*)(C.lds + C.wave * 8704);
    const int lane = C.lane, nblk = Nout / 32, items = (K / 64) * nblk;
    for (int it = C.gw; it < items; it += C.NGW) {
        const int kb = it / nblk, nb = it % nblk, k0 = 64 * kb, n0 = 32 * nb;
        const int col = map(n0 + (lane & 31));
#pragma unroll 8
        for (int i = 0; i < 32; ++i) { const int kk = 2 * i + (lane >> 5); scr[kk * 33 + (lane & 31)] = (col >= 0) ? W[(size_t)(k0 + kk) * ldw + col] : 0.f; }
        LDS_WAIT();
        const int c = lane & 7;
#pragma unroll
        for (int j = 0; j < 4; ++j) { const int n = (lane >> 3) + 8 * j; const LAS float* s = scr + (8 * c) * 33 + n;
            u32x4 o; o.x = pk2(s[0 * 33], s[1 * 33]); o.y = pk2(s[2 * 33], s[3 * 33]); o.z = pk2(s[4 * 33], s[5 * 33]); o.w = pk2(s[6 * 33], s[7 * 33]);
            *(u32x4*)(WT + (size_t)(n0 + n) * ldt + k0 + 8 * c) = o; }
        LDS_WAIT();
    }
}
struct MapId { __device__ __forceinline__ int operator()(int n) const { return n; } };
struct MapOff { int off; __device__ __forceinline__ int operator()(int n) const { return n + off; } };
struct MapIn { __device__ __forceinline__ int operator()(int n) const { return n < 1536 ? n : (n < 2208 ? n + 8 : (n < 2216 ? n - 2208 + 1536 : (n < 2304 ? -1 : n - 88))); } };
struct MapKv { __device__ __forceinline__ int operator()(int n) const { return n < 512 ? ((n >> 6) * 128 + (n & 63)) : (((n - 512) >> 6) * 128 + 64 + (n & 63)); } };
struct MapUp { __device__ __forceinline__ int operator()(int n) const { const int t = n >> 8, w = n & 255; return w < 128 ? 128 * t + w : 2816 + 128 * t + (w - 128); } };

__device__ __forceinline__ void phase_wprep(const Ctx& C) {
    transpose_w(C, INL(10, 1024 * IN_COLS), IN_COLS, 1024, 5376, WSB(WS_WT_IN), 1024, MapIn());
    transpose_w(C, INL(10, 1024 * IN_COLS), IN_COLS, 1024, 4096, WSB(WS_WT_G), 1024, MapOff{5288});
    transpose_w(C, INL(20, 384 * 768), 768, 384, 768, WSB(WS_WT_QUP), 384, MapId());
    transpose_w(C, INL(22, 256 * 1024), 1024, 256, 1024, WSB(WS_WT_KVUP), 256, MapKv());
    transpose_w(C, INL(18, 512 * 1024), 1024, 512, 1024, WSB(WS_WT_OUT), 1024, MapId());
    transpose_w(C, INL(27, 512 * 1024), 1024, 512, 1024, WSB(WS_WT_OUT) + (size_t)1 * 1024 * 1024, 1024, MapId());
    transpose_w(C, INL(29, 512 * 1024), 1024, 512, 1024, WSB(WS_WT_OUT) + (size_t)2 * 1024 * 1024, 1024, MapId());
    transpose_w(C, INL(33, 512 * 1024), 1024, 512, 1024, WSB(WS_WT_OUT) + (size_t)3 * 1024 * 1024, 1024, MapId());
    transpose_w(C, INL(34, 1024 * 1024), 1024, 1024, 1024, WSB(WS_WT_O), 1024, MapId());
    transpose_w(C, INL(36, 1024 * 5632), 5632, 1024, 5632, WSB(WS_WT_UP), 1024, MapUp());
    transpose_w(C, INL(37, 2816 * 1024), 1024, 2816, 1024, WSB(WS_WT_DOWN), 2816, MapId());
}

__device__ __forceinline__ const float* xrow(const Ctx& C, int row, bool from_out) {
    if (from_out) return C.out + (size_t)row * DM;
    return row < NP ? IN0(0) + (size_t)row * DM : IN0(1) + (size_t)(row - NP) * DM;
}
__device__ __forceinline__ void phase_norm(const Ctx& C, const float* g, bool from_out) {
    const int lane = C.lane;
    f32x4 gv[4];
#pragma unroll
    for (int j = 0; j < 4; ++j) gv[j] = ((const f32x4*)g)[64 * j + lane];
    for (int row = C.gw; row < R; row += C.NGW) {
        const f32x4* xr = (const f32x4*)xrow(C, row, from_out) + lane;
        f32x4 v[4]; float s = 0.f;
#pragma unroll
        for (int j = 0; j < 4; ++j) { v[j] = xr[64 * j]; s += (v[j].x * v[j].x + v[j].y * v[j].y) + (v[j].z * v[j].z + v[j].w * v[j].w); }
        const float rstd = 1.f / sqrtf(wave_sum(s) * (1.f / DM) + EPS);
        u32x2* o = (u32x2*)(WSB(WS_HB) + (size_t)row * DM) + lane;
#pragma unroll
        for (int j = 0; j < 4; ++j) { u32x2 w; w.x = pk2(v[j].x * rstd * gv[j].x, v[j].y * rstd * gv[j].y); w.y = pk2(v[j].z * rstd * gv[j].z, v[j].w * rstd * gv[j].w); o[64 * j] = w; }
    }
}
__device__ __forceinline__ void rope_cs(int pos, int i, float& c, float& s) {
    const float chi = ((i & 8) ? ((i & 4) ? ((i & 2) ? ((i & 1) ? 2.831220627e-05f : 5.030632019e-05f) : ((i & 1) ? 8.952617645e-05f : 1.592636108e-04f)) : ((i & 2) ? ((i & 1) ? 2.832412720e-04f : 5.035400391e-04f) : ((i & 1) ? 8.945465088e-04f : 1.590728760e-03f))) : ((i & 4) ? ((i & 2) ? ((i & 1) ? 2.830505371e-03f : 5.035400391e-03f) : ((i & 1) ? 8.956909180e-03f : 1.593017578e-02f)) : ((i & 2) ? ((i & 1) ? 2.828979492e-02f : 5.035400391e-02f) : ((i & 1) ? 8.947753906e-02f : 1.591796875e-01f))));
    const float clo = ((i & 8) ? ((i & 4) ? ((i & 2) ? ((i & 1) ? -1.001043781e-08f : 2.289191414e-08f) : ((i & 1) ? -2.677484368e-08f : -1.086677486e-07f)) : ((i & 2) ? ((i & 1) ? -2.193136623e-07f : -2.479180239e-07f) : ((i & 1) ? 4.475072899e-07f : 8.206711755e-07f))) : ((i & 4) ? ((i & 2) ? ((i & 1) ? -2.857880190e-07f : -2.479180239e-06f) : ((i & 1) ? -6.969018614e-06f : -1.468147184e-05f)) : ((i & 2) ? ((i & 1) ? 1.240090842e-05f : -2.479180148e-05f) : ((i & 1) ? 2.186254642e-05f : -2.474440771e-05f))));
    const float pf = (float)pos, rh = pf * chi, f1 = rh - __builtin_rintf(rh), fr = f1 + pf * clo;
    c = __builtin_amdgcn_cosf(fr); s = __builtin_amdgcn_sinf(fr);
}
__device__ __forceinline__ int row_pos(int row) { return row < NP ? (row & (TP - 1)) : PAST + ((row - NP) & 63); }

__device__ __forceinline__ void phase_mla_prep(const Ctx& C) {
    const int lane = C.lane; const int l = C.l;
    const float* gq = INL(19, 384); const float* gkv = INL(21, 256); const float* gkr = INL(26, 32);
    for (int row = C.gw; row < R; row += C.NGW) {
        bf16_t* pb = WSB(WS_ZB) + (size_t)row * 768;
        unsigned q[3]; float ss = 0.f;
#pragma unroll
        for (int j = 0; j < 3; ++j) { q[j] = *(const unsigned*)(pb + 2 * lane + 128 * j); const float a = bflo(q[j]), b = bfhi(q[j]); ss += a * a + b * b; }
        float rstd = 1.f / sqrtf(wave_sum(ss) * (1.f / 384.f) + EPS);
#pragma unroll
        for (int j = 0; j < 3; ++j) { const int c = 2 * lane + 128 * j; *(unsigned*)(pb + c) = pk2(bflo(q[j]) * rstd * gq[c], bfhi(q[j]) * rstd * gq[c + 1]); }
        const u32x2 kv = *(const u32x2*)(pb + 384 + 4 * lane);
        float k0 = bflo(kv.x), k1 = bfhi(kv.x), k2 = bflo(kv.y), k3 = bfhi(kv.y);
        rstd = 1.f / sqrtf(wave_sum(k0 * k0 + k1 * k1 + k2 * k2 + k3 * k3) * (1.f / 256.f) + EPS);
        const f32x4 g4 = *(const f32x4*)(gkv + 4 * lane);
        f32x4 ck; ck.x = k0 * rstd * g4.x; ck.y = k1 * rstd * g4.y; ck.z = k2 * rstd * g4.z; ck.w = k3 * rstd * g4.w;
        u32x2 ckb; ckb.x = pk2(ck.x, ck.y); ckb.y = pk2(ck.z, ck.w);
        const int pos = row_pos(row);
        size_t srow = 0;
        if (row < NP) { *(f32x4*)(C.out + O_CKV_P + ((size_t)l * NP + row) * 256 + 4 * lane) = ck; *(u32x2*)(WSB(WS_CKVP) + (size_t)row * 256 + 4 * lane) = ckb; }
        else { const int rs = row - NP; srow = (size_t)(rs >> 6) * KS_ALL + PAST + (rs & 63);
            *(f32x4*)(C.out + O_CKV_S + ((size_t)l * NS + rs) * 256 + 4 * lane) = ck; *(u32x2*)(WSB(WS_CKVS) + srow * 256 + 4 * lane) = ckb; }
        const float x = (lane < 32) ? bf1(pb[640 + lane]) : 0.f;
        rstd = 1.f / sqrtf(wave_sum(x * x) * (1.f / 32.f) + EPS);
        const float y = x * rstd * gkr[lane & 31];
        const float part = __shfl_xor(y, 16);
        float cs, sn; rope_cs(pos, lane & 15, cs, sn);
        const float o = (lane < 16) ? (y * cs - part * sn) : (part * sn + y * cs);
        if (lane < 32) {
            if (row < NP) { C.out[O_KPE_P + ((size_t)l * NP + row) * 32 + lane] = o; WSB(WS_KPEP)[(size_t)row * 32 + lane] = (bf16_t)f2bf(o); }
            else { C.out[O_KPE_S + ((size_t)l * NS + (row - NP)) * 32 + lane] = o; WSB(WS_KPES)[srow * 32 + lane] = (bf16_t)f2bf(o); }
        }
    }
    const size_t gt = (size_t)C.bid * NTHREADS + C.tid, GT = (size_t)C.G * NTHREADS;
    { const float* src = INL(4, (size_t)BS * PAST * 256);
      for (size_t i = gt; i < (size_t)BS * PAST * 256 / 8; i += GT) { const size_t e = i * 8, b = e / ((size_t)PAST * 256), rem = e % ((size_t)PAST * 256);
          *(u32x4*)(WSB(WS_CKVS) + b * KS_ALL * 256 + rem) = load8(src, e, true); } }
    { const float* src = INL(5, (size_t)BS * PAST * 32);
      for (size_t i = gt; i < (size_t)BS * PAST * 32 / 8; i += GT) { const size_t e = i * 8, b = e / ((size_t)PAST * 32), rem = e % ((size_t)PAST * 32);
          *(u32x4*)(WSB(WS_KPES) + b * KS_ALL * 32 + rem) = load8(src, e, true); } }
}

__device__ __forceinline__ float red8(float v) { v += __shfl_xor(v, 1); v += __shfl_xor(v, 2); v += __shfl_xor(v, 4); return v; }

__device__ __forceinline__ void phase_band_prep(const Ctx& C) {
    const int lane = C.lane, l = C.l, d0 = (lane & 7) * 8;
    float gq[8], gk[8];
#pragma unroll
    for (int e = 0; e < 8; ++e) { gq[e] = INL(30, 64)[d0 + e] * (0.125f * LOG2E); gk[e] = INL(31, 64)[d0 + e]; }
    for (int row = C.gw; row < R; row += C.NGW) {
        bf16_t* pd = WSB(WS_PD) + (size_t)row * 1536 + 8 * lane;
        float f[8], kf[8], vf[8];
        unpack8(*(const u32x4*)pd, f); float ss = 0.f;
#pragma unroll
        for (int e = 0; e < 8; ++e) ss += f[e] * f[e];
        float rstd = 1.f / sqrtf(red8(ss) * (1.f / 64.f) + EPS);
#pragma unroll
        for (int e = 0; e < 8; ++e) f[e] *= rstd * gq[e];
        *(u32x4*)pd = pack8(f);
        unpack8(*(const u32x4*)(pd + 512), kf); ss = 0.f;
#pragma unroll
        for (int e = 0; e < 8; ++e) ss += kf[e] * kf[e];
        rstd = 1.f / sqrtf(red8(ss) * (1.f / 64.f) + EPS);
#pragma unroll
        for (int e = 0; e < 8; ++e) kf[e] *= rstd * gk[e];
        *(u32x4*)(pd + 512) = pack8(kf);
        unpack8(*(const u32x4*)(pd + 1024), vf);
        long dst = -1;
        if (row < NP) { const int t = row & (TP - 1), b = row >> 13; if (t >= TP - 512) dst = (long)(((size_t)(l * BP + b) * 512 + (t - (TP - 512))) * 512 + 8 * lane); }
        else { const int rs = row - NP, b = rs >> 6, t = rs & 63; dst = (long)(((size_t)(l * BS + b) * 512 + 448 + t) * 512 + 8 * lane); }
        if (dst >= 0) { float* ko = C.out + (row < NP ? O_BK_P : O_BK_S) + dst; float* vo = C.out + (row < NP ? O_BV_P : O_BV_S) + dst;
            *(f32x4*)ko = (f32x4){kf[0], kf[1], kf[2], kf[3]}; *(f32x4*)(ko + 4) = (f32x4){kf[4], kf[5], kf[6], kf[7]};
            *(f32x4*)vo = (f32x4){vf[0], vf[1], vf[2], vf[3]}; *(f32x4*)(vo + 4) = (f32x4){vf[4], vf[5], vf[6], vf[7]}; }
    }
    const size_t gt = (size_t)C.bid * NTHREADS + C.tid, GT = (size_t)C.G * NTHREADS;
    const f32x4* sk = (const f32x4*)INL(7, (size_t)BS * 512 * 512); const f32x4* sv = (const f32x4*)INL(8, (size_t)BS * 512 * 512);
    f32x4* dk = (f32x4*)(C.out + O_BK_S + (size_t)l * BS * 512 * 512); f32x4* dv = (f32x4*)(C.out + O_BV_S + (size_t)l * BS * 512 * 512);
    for (size_t i = gt; i < (size_t)BS * 448 * 128; i += GT) { const size_t b = i / (448 * 128), rem = i % (448 * 128);
        dk[b * 512 * 128 + rem] = sk[b * 512 * 128 + 64 * 128 + rem]; dv[b * 512 * 128 + rem] = sv[b * 512 * 128 + 64 * 128 + rem]; }
}

__device__ __forceinline__ void phase_sconv(const Ctx& C) {
    const int lane = C.lane, l = C.l, ch = 8 * lane;
    const float* w = INL(28, 3 * 512);
    float w0[8], w1[8], w2[8];
#pragma unroll
    for (int e = 0; e < 8; ++e) { w0[e] = w[ch + e]; w1[e] = w[512 + ch + e]; w2[e] = w[1024 + ch + e]; }
    for (int row = C.gw; row < R; row += C.NGW) {
        const bf16_t* pc = WSB(WS_XR) + (size_t)row * 1536 + ch;
        const bool pr = row < NP; const int t = pr ? (row & (TP - 1)) : ((row - NP) & 63); const int b = pr ? (row >> 13) : ((row - NP) >> 6);
        float cb[8], a[8], x[8], u0[8], u1[8], u2[8];
        unpack8(*(const u32x4*)pc, cb); unpack8(*(const u32x4*)(pc + 512), a); unpack8(*(const u32x4*)(pc + 1024), x);
#pragma unroll
        for (int e = 0; e < 8; ++e) u0[e] = a[e] * x[e];
        const float* st = INL(6, BS * 2 * 512) + (size_t)b * 2 * 512 + ch;
        if (t >= 1) { unpack8(*(const u32x4*)(pc - 1536 + 512), a); unpack8(*(const u32x4*)(pc - 1536 + 1024), x);
#pragma unroll
            for (int e = 0; e < 8; ++e) u1[e] = a[e] * x[e]; }
        else {
#pragma unroll
            for (int e = 0; e < 8; ++e) u1[e] = pr ? 0.f : st[512 + e]; }
        if (t >= 2) { unpack8(*(const u32x4*)(pc - 3072 + 512), a); unpack8(*(const u32x4*)(pc - 3072 + 1024), x);
#pragma unroll
            for (int e = 0; e < 8; ++e) u2[e] = a[e] * x[e]; }
        else {
#pragma unroll
            for (int e = 0; e < 8; ++e) u2[e] = pr ? 0.f : st[(t == 1 ? 512 : 0) + e]; }
        float y[8];
#pragma unroll
        for (int e = 0; e < 8; ++e) y[e] = cb[e] * (w0[e] * u2[e] + w1[e] * u1[e] + w2[e] * u0[e]);
        *(u32x4*)(WSB(WS_YBC) + (size_t)row * 1024 + 512 + ch) = pack8(y);
        const int T = pr ? TP : TS;
        if (t >= T - 2) { float* o = C.out + (pr ? O_SC_P + ((size_t)(l * BP + b) * 2 + (t - (T - 2))) * 512 : O_SC_S + ((size_t)(l * BS + b) * 2 + (t - (T - 2))) * 512) + ch;
            *(f32x4*)o = (f32x4){u0[0], u0[1], u0[2], u0[3]}; *(f32x4*)(o + 4) = (f32x4){u0[4], u0[5], u0[6], u0[7]}; }
    }
}

__device__ __forceinline__ void phase_qk_post(const Ctx& C) {
    const int lane = C.lane, head = lane >> 3, sub = lane & 7;
    const float SC = 0.10206207261596577f * LOG2E;
    float gn[8], gr[8], gk[8];
#pragma unroll
    for (int e = 0; e < 8; ++e) { gn[e] = INL(23, 64)[8 * sub + e] * SC; gr[e] = INL(25, 32)[8 * (sub & 3) + e]; gk[e] = INL(24, 64)[8 * sub + e]; }
    for (int row = C.gw; row < R; row += C.NGW) {
        bf16_t* qp = WSB(WS_Q) + (size_t)row * 768 + 96 * head;
        float f[8]; unpack8(*(const u32x4*)(qp + 8 * sub), f); float ss = 0.f;
#pragma unroll
        for (int e = 0; e < 8; ++e) ss += f[e] * f[e];
        float rstd = 1.f / sqrtf(red8(ss) * (1.f / 64.f) + EPS);
#pragma unroll
        for (int e = 0; e < 8; ++e) f[e] *= rstd * gn[e];
        *(u32x4*)(qp + 8 * sub) = pack8(f);
        float r[8];
        if (sub < 4) unpack8(*(const u32x4*)(qp + 64 + 8 * sub), r);
        else {
#pragma unroll
            for (int e = 0; e < 8; ++e) r[e] = 0.f; }
        ss = 0.f;
#pragma unroll
        for (int e = 0; e < 8; ++e) ss += r[e] * r[e];
        ss += __shfl_xor(ss, 1); ss += __shfl_xor(ss, 2);
        rstd = 1.f / sqrtf(ss * (1.f / 32.f) + EPS);
        const int pos = row_pos(row);
        float o[8];
#pragma unroll
        for (int e = 0; e < 8; ++e) { const float y = r[e] * rstd * gr[e]; const float part = __shfl_xor(y, 2);
            float cs, sn; rope_cs(pos, 8 * (sub & 1) + e, cs, sn);
            o[e] = ((sub < 2) ? (y * cs - part * sn) : (part * sn + y * cs)) * SC; }
        if (sub < 4) *(u32x4*)(qp + 64 + 8 * sub) = pack8(o);
    }
    for (int row = C.gw; row < NP + BS * KS_ALL; row += C.NGW) {
        bf16_t* kp = (row < NP ? WSB(WS_KVP) + (size_t)row * 1024 : WSB(WS_XR) + (size_t)(row - NP) * 1024) + 8 * lane;
        float f[8]; unpack8(*(const u32x4*)kp, f); float ss = 0.f;
#pragma unroll
        for (int e = 0; e < 8; ++e) ss += f[e] * f[e];
        const float rstd = 1.f / sqrtf(red8(ss) * (1.f / 64.f) + EPS);
#pragma unroll
        for (int e = 0; e < 8; ++e) f[e] *= rstd * gk[e];
        *(u32x4*)kp = pack8(f);
    }
}

__device__ __forceinline__ bf16x8 mk_frag(u32x2 lo, u32x2 hi) { u32x4 v; v.x = lo.x; v.y = lo.y; v.z = hi.x; v.w = hi.y; return __builtin_bit_cast(bf16x8, v); }
__device__ __forceinline__ bf16x8 as_frag(u32x4 v) { return __builtin_bit_cast(bf16x8, v); }
#define MFMA16(a, b, c) __builtin_amdgcn_mfma_f32_16x16x32_bf16((a), (b), (c), 0, 0, 0)

__device__ __forceinline__ int ssd_row0(int seq, int c) { return seq < 2 ? seq * TP + c * 64 : NP + (seq - 2) * 64; }
__device__ __forceinline__ void ssd_dt(const Ctx& C, int row0, LAS float* sDT, LAS float* sACS) {
    const int h = C.wave, lane = C.lane;
    const float adt = bf1(WSB(WS_ZB)[(size_t)(row0 + lane) * 768 + 672 + h]) + INL(14, 8)[h];
    float dt; { const float e_ = fexp(adt), u_ = 1.f + e_; dt = (adt > 20.f) ? adt : ((u_ == 1.f) ? e_ : (__builtin_amdgcn_logf(u_) * 0.6931471805599453f) * e_ * frcp(u_ - 1.f)); }
    const float A = -fexp(INL(15, 8)[h]);
    float cs = dt * A;
#pragma unroll
    for (int o = 1; o < 64; o <<= 1) { const float t = __shfl_up(cs, o); if (lane >= o) cs += t; }
    sDT[h * 64 + lane] = dt; sACS[h * 64 + lane] = cs;
}
template <class F>
__device__ __forceinline__ void ssd_load_chunk(const Ctx& C, int seq, int c, int row0, F store) {
    const int lane = C.lane, w = C.wave;
    const bf16_t* base = WSB(WS_PA) + (size_t)(row0 + lane) * 1536 + 512;
    const float* cw = INL(12, 4 * 1024); const float* cbias = INL(13, 1024);
    for (int j = 0; j < 16; ++j) {
        const int ch0 = 128 * w + 8 * j;
        const u32x4 v0 = *(const u32x4*)(base + ch0);
        u32x4 ex = (u32x4){0u, 0u, 0u, 0u};
        if (lane < 3) {
            if (seq < 2) { if (c > 0) ex = *(const u32x4*)(base - (size_t)3 * 1536 + ch0); }
            else ex = load8(INL(3, BS * 3 * 1024) + ((size_t)(seq - 2) * 3 + lane) * 1024 + ch0, 0, true);
        }
        float x0[8], xk[3][8];
        unpack8(v0, x0);
#pragma unroll
        for (int k = 1; k <= 3; ++k) {
            u32x4 a, b;
            a.x = __shfl(v0.x, (lane - k) & 63); a.y = __shfl(v0.y, (lane - k) & 63); a.z = __shfl(v0.z, (lane - k) & 63); a.w = __shfl(v0.w, (lane - k) & 63);
            b.x = __shfl(ex.x, (lane - k + 3) & 63); b.y = __shfl(ex.y, (lane - k + 3) & 63); b.z = __shfl(ex.z, (lane - k + 3) & 63); b.w = __shfl(ex.w, (lane - k + 3) & 63);
            unpack8(lane >= k ? a : b, xk[k - 1]);
        }
        float y[8];
#pragma unroll
        for (int e = 0; e < 8; ++e) {
            const float a = cbias[ch0 + e] + cw[3 * 1024 + ch0 + e] * x0[e] + cw[2 * 1024 + ch0 + e] * xk[0][e] + cw[1 * 1024 + ch0 + e] * xk[1][e] + cw[ch0 + e] * xk[2][e];
            y[e] = siluf_(a);
        }
        store(ch0, y, x0);
    }
}

constexpr int XT_ST = 72;
__device__ __forceinline__ void ssd_s1_item(const Ctx& C, int item) {
    const int seq = item < 256 ? (item >> 7) : 2 + (item - 256), c = item < 256 ? (item & 127) : 0, row0 = ssd_row0(seq, c);
    const int lane = C.lane, h = C.wave, fr = lane & 15, fq = lane >> 4, l = C.l;
    LAS bf16_t* XT = (LAS bf16_t*)C.lds; LAS bf16_t* BT = (LAS bf16_t*)(C.lds + 73728);
    LAS float* sDT = (LAS float*)(C.lds + 110592); LAS float* sACS = (LAS float*)(C.lds + 112640);
    ssd_dt(C, row0, sDT, sACS);
    __syncthreads();
    const bool lastc = (seq >= 2) || (c == 127);
    float* convo = C.out + (seq < 2 ? O_CONV_P + (size_t)(l * BP + seq) * 3 * 1024 : O_CONV_S + (size_t)(l * BS + seq - 2) * 3 * 1024);
    ssd_load_chunk(C, seq, c, row0, [&](int ch0, const float* y, const float* raw) {
        if (ch0 < 512) { const int hh = ch0 >> 6, p0 = ch0 & 63; const float wgt = sDT[hh * 64 + lane] * fexp(sACS[hh * 64 + 63] - sACS[hh * 64 + lane]);
#pragma unroll
            for (int e = 0; e < 8; ++e) XT[(hh * 64 + p0 + e) * XT_ST + lane] = (bf16_t)f2bf(y[e] * wgt); }
        else if (ch0 < 768) { const int g = (ch0 - 512) >> 7, n0 = (ch0 - 512) & 127;
#pragma unroll
            for (int e = 0; e < 8; ++e) BT[(g * 128 + n0 + e) * XT_ST + lane] = (bf16_t)f2bf(y[e]); }
        if (lastc && lane >= 61) {
#pragma unroll
            for (int e = 0; e < 8; ++e) convo[(size_t)(lane - 61) * 1024 + ch0 + e] = raw[e]; }
    });
    __syncthreads();
    const int g = h >> 2;
    bf16x8 bx[4][2];
#pragma unroll
    for (int pt = 0; pt < 4; ++pt)
#pragma unroll
        for (int ks = 0; ks < 2; ++ks) bx[pt][ks] = *(const LAS bf16x8*)(XT + (h * 64 + 16 * pt + fr) * XT_ST + 32 * ks + 8 * fq);
    const float dall = fexp(sACS[h * 64 + 63]);
    for (int nt = 0; nt < 8; ++nt) {
        bf16x8 a[2];
#pragma unroll
        for (int ks = 0; ks < 2; ++ks) a[ks] = *(const LAS bf16x8*)(BT + (g * 128 + 16 * nt + fr) * XT_ST + 32 * ks + 8 * fq);
#pragma unroll
        for (int pt = 0; pt < 4; ++pt) {
            f32x4 acc = (f32x4){0.f, 0.f, 0.f, 0.f};
#pragma unroll
            for (int ks = 0; ks < 2; ++ks) acc = MFMA16(a[ks], bx[pt][ks], acc);
            const int p = 16 * pt + fr, n = 16 * nt + 4 * fq;
            if (seq < 2) { u32x2 w; w.x = pk2(acc[0], acc[1]); w.y = pk2(acc[2], acc[3]);
                *(u32x2*)(WSB(WS_STATES) + ((size_t)((seq * 128 + c) * 8 + h) * 64 + p) * 128 + n) = w; }
            else { const size_t o = ((size_t)((l * BS + seq - 2) * 8 + h) * 64 + p) * 128 + n;
                const f32x4 h0 = *(const f32x4*)(IN0(2) + o);
                *(f32x4*)(C.out + O_SSM_S + o) = h0 * dall + acc; }
        }
    }
    if (seq < 2 && lane == 0) ((float*)(C.ws + WS_DECAY))[(seq * 128 + c) * 8 + h] = dall;
    __syncthreads();
}
__device__ __forceinline__ void ssd_scan(const Ctx& C) {
    const size_t gt = (size_t)C.bid * NTHREADS + C.tid;
    if (gt >= (size_t)2 * 8 * 64 * 128) return;
    const int b = (int)(gt >> 16), h = (int)(gt >> 13) & 7, pn = (int)(gt & 8191);
    bf16_t* st = WSB(WS_STATES) + ((size_t)(b * 128) * 8 + h) * 8192 + pn;
    const float* dec = (const float*)(C.ws + WS_DECAY) + (b * 128) * 8 + h;
    float hst = 0.f;
#pragma unroll 8
    for (int c = 0; c < 128; ++c) { const float s = bf1(st[(size_t)c * 8 * 8192]); st[(size_t)c * 8 * 8192] = (bf16_t)f2bf(hst); hst = dec[c * 8] * hst + s; }
    C.out[O_SSM_P + ((size_t)(C.l * BP + b) * 8 + h) * 8192 + pn] = hst;
}
constexpr int CN_ST = 136;
__device__ __forceinline__ void ssd_s3_item(const Ctx& C, int item) {
    const int seq = item < 256 ? (item >> 7) : 2 + (item - 256), c = item < 256 ? (item & 127) : 0, row0 = ssd_row0(seq, c);
    const int lane = C.lane, h = C.wave, fr = lane & 15, fq = lane >> 4, l = C.l, g = h >> 2;
    LAS bf16_t* Cn = (LAS bf16_t*)C.lds; LAS bf16_t* Bn = (LAS bf16_t*)(C.lds + 34816); LAS bf16_t* XT = (LAS bf16_t*)(C.lds + 69632);
    LAS float* sDT = (LAS float*)(C.lds + 143360); LAS float* sACS = (LAS float*)(C.lds + 145408); LAS float* sRed = (LAS float*)(C.lds + 147456);
    ssd_dt(C, row0, sDT, sACS);
    ssd_load_chunk(C, seq, c, row0, [&](int ch0, const float* y, const float*) {
        if (ch0 < 512) { const int hh = ch0 >> 6, p0 = ch0 & 63;
#pragma unroll
            for (int e = 0; e < 8; ++e) XT[(hh * 64 + p0 + e) * XT_ST + lane] = (bf16_t)f2bf(y[e]); }
        else if (ch0 < 768) { const int gg = (ch0 - 512) >> 7, n0 = (ch0 - 512) & 127; *(LAS u32x4*)(Bn + (gg * 64 + lane) * CN_ST + n0) = pack8(y); }
        else { const int gg = (ch0 - 768) >> 7, n0 = (ch0 - 768) & 127; *(LAS u32x4*)(Cn + (gg * 64 + lane) * CN_ST + n0) = pack8(y); }
    });
    __syncthreads();
#define CF(lt, ks) (*(const LAS bf16x8*)(Cn + (g * 64 + 16 * (lt) + fr) * CN_ST + 32 * (ks) + 8 * fq))
    f32x4 yacc[4][4];
    const void* hin; bool hin_f32;
    if (seq < 2) { hin = WSB(WS_STATES) + (size_t)((seq * 128 + c) * 8 + h) * 8192; hin_f32 = false; }
    else { hin = IN0(2) + (size_t)((l * BS + seq - 2) * 8 + h) * 8192; hin_f32 = true; }
#pragma unroll
    for (int pt = 0; pt < 4; ++pt) {
#pragma unroll
        for (int lt = 0; lt < 4; ++lt) yacc[pt][lt] = (f32x4){0.f, 0.f, 0.f, 0.f};
        bf16x8 af[4];
        if (hin_f32) {
#pragma unroll
            for (int ks = 0; ks < 4; ++ks) af[ks] = as_frag(load8(hin, (size_t)(16 * pt + fr) * 128 + 32 * ks + 8 * fq, true));
        } else {
#pragma unroll
            for (int ks = 0; ks < 4; ++ks) af[ks] = as_frag(load8(hin, (size_t)(16 * pt + fr) * 128 + 32 * ks + 8 * fq, false));
        }
#pragma unroll
        for (int ks = 0; ks < 4; ++ks)
#pragma unroll
            for (int lt = 0; lt < 4; ++lt) yacc[pt][lt] = MFMA16(af[ks], CF(lt, ks), yacc[pt][lt]);
        __builtin_amdgcn_sched_barrier(0);
    }
    float acl[4];
#pragma unroll
    for (int lt = 0; lt < 4; ++lt) { acl[lt] = sACS[h * 64 + 16 * lt + fr]; const float el = fexp(acl[lt]);
#pragma unroll
        for (int pt = 0; pt < 4; ++pt) yacc[pt][lt] = yacc[pt][lt] * el; }
    const float Dh = INL(16, 8)[h];
#pragma unroll
    for (int lt = 0; lt < 4; ++lt) {
        bf16x8 pf[2], cfl[4];
#pragma unroll
        for (int ks = 0; ks < 4; ++ks) cfl[ks] = CF(lt, ks);
        unsigned pw[4][2];
#pragma unroll
        for (int st = 0; st < 4; ++st) {
            f32x4 cb = (f32x4){0.f, 0.f, 0.f, 0.f};
#pragma unroll
            for (int ks = 0; ks < 4; ++ks) { const bf16x8 a = *(const LAS bf16x8*)(Bn + (g * 64 + 16 * st + fr) * CN_ST + 32 * ks + 8 * fq); cb = MFMA16(a, cfl[ks], cb); }
            const f32x4 as4 = *(const LAS f32x4*)(sACS + h * 64 + 16 * st + 4 * fq), dt4 = *(const LAS f32x4*)(sDT + h * 64 + 16 * st + 4 * fq);
            float m[4];
#pragma unroll
            for (int i = 0; i < 4; ++i) { const int s = 16 * st + 4 * fq + i, ll = 16 * lt + fr;
                float v = (s <= ll) ? cb[i] * fexp(acl[lt] - as4[i]) * dt4[i] : 0.f; if (s == ll) v += Dh; m[i] = v; }
            pw[st][0] = pk2(m[0], m[1]); pw[st][1] = pk2(m[2], m[3]);
        }
        { u32x4 v; v.x = pw[0][0]; v.y = pw[0][1]; v.z = pw[1][0]; v.w = pw[1][1]; pf[0] = as_frag(v); v.x = pw[2][0]; v.y = pw[2][1]; v.z = pw[3][0]; v.w = pw[3][1]; pf[1] = as_frag(v); }
#pragma unroll
        for (int pt = 0; pt < 4; ++pt)
#pragma unroll
            for (int kk = 0; kk < 2; ++kk) { const LAS bf16_t* xp = XT + (h * 64 + 16 * pt + fr) * XT_ST + 32 * kk + 4 * fq;
                const bf16x8 a = mk_frag(*(const LAS u32x2*)xp, *(const LAS u32x2*)(xp + 16)); yacc[pt][lt] = MFMA16(a, pf[kk], yacc[pt][lt]); }
        asm volatile("" ::: "memory");
    }
    float ss[4] = {0.f, 0.f, 0.f, 0.f};
#pragma unroll
    for (int lt = 0; lt < 4; ++lt)
#pragma unroll
        for (int pt = 0; pt < 4; ++pt) { const u32x2 z = *(const u32x2*)(WSB(WS_PA) + (size_t)(row0 + 16 * lt + fr) * 1536 + h * 64 + 16 * pt + 4 * fq);
            f32x4 v = yacc[pt][lt]; v[0] *= siluf_(bflo(z.x)); v[1] *= siluf_(bfhi(z.x)); v[2] *= siluf_(bflo(z.y)); v[3] *= siluf_(bfhi(z.y));
            yacc[pt][lt] = v; ss[lt] += v[0] * v[0] + v[1] * v[1] + v[2] * v[2] + v[3] * v[3]; }
#pragma unroll
    for (int lt = 0; lt < 4; ++lt) { ss[lt] += __shfl_xor(ss[lt], 16); ss[lt] += __shfl_xor(ss[lt], 32); if (fq == 0) sRed[h * 64 + 16 * lt + fr] = ss[lt]; }
    __syncthreads();
    const float* ng = INL(17, 512);
#pragma unroll
    for (int lt = 0; lt < 4; ++lt) { float tot = 0.f;
#pragma unroll
        for (int hh = 0; hh < 8; ++hh) tot += sRed[hh * 64 + 16 * lt + fr];
        const float rstd = 1.f / sqrtf(tot * (1.f / 512.f) + EPS);
#pragma unroll
        for (int pt = 0; pt < 4; ++pt) { const f32x4 gg = *(const f32x4*)(ng + h * 64 + 16 * pt + 4 * fq); const f32x4 v = yacc[pt][lt];
            u32x2 w; w.x = pk2(v[0] * rstd * gg[0], v[1] * rstd * gg[1]); w.y = pk2(v[2] * rstd * gg[2], v[3] * rstd * gg[3]);
            *(u32x2*)(WSB(WS_PA) + (size_t)(row0 + 16 * lt + fr) * 1536 + h * 64 + 16 * pt + 4 * fq) = w; } }
    __syncthreads();
}

struct AH {
    const bf16_t* q; int qld; bf16_t* o; int old_;
    const void* kn; size_t knld; bool kn_f32; const bf16_t* kn2; size_t kn2ld; int split;
    const bf16_t* kp; size_t kpld;
    const void* v; size_t vld; bool v_f32; const bf16_t* v2; size_t v2ld;
    int count, cdiff0;
};
template <int DK, bool BIAS>
__device__ __forceinline__ void attn_core(const Ctx& C, const AH& H, int n_iter) {
    constexpr int KST = DK + 8, VST = 72, KBYTES = 64 * KST * 2, VBYTES = 64 * VST * 2, HBY = KBYTES + VBYTES;
    const int lane = C.lane, hf = C.wave >> 2, wq = C.wave & 3, tid_h = C.tid & 255, fr = lane & 15, fq = lane >> 4;
    LAS float* tab = (LAS float*)(C.lds + 4 * HBY) + hf * 260;
    bf16x8 qf[DK / 32];
#pragma unroll
    for (int ks = 0; ks < DK / 32; ++ks) qf[ks] = *(const bf16x8*)(H.q + (size_t)(16 * wq + fr) * H.qld + 32 * ks + 8 * fq);
    f32x4 oacc[4];
#pragma unroll
    for (int d = 0; d < 4; ++d) oacc[d] = (f32x4){0.f, 0.f, 0.f, 0.f};
    float m_run = -1e30f, l_run = 0.f;
    u32x4 rk[2], rp = (u32x4){0u, 0u, 0u, 0u}, rv[2];
#define ATT_GLOAD(t) do { if ((t) < H.count) { const bool sec = (t) >= H.split; const int tk = sec ? (t) - H.split : (t); \
        _Pragma("unroll") for (int i = 0; i < 2; ++i) { const int p = tid_h + 256 * i; \
            { const int key = p >> 3, ch = p & 7; rk[i] = sec ? load8(H.kn2, (size_t)(tk * 64 + key) * H.kn2ld + 8 * ch, false) : load8(H.kn, (size_t)(tk * 64 + key) * H.knld + 8 * ch, H.kn_f32); } \
            { const int key = p & 63, dc = p >> 6; rv[i] = sec ? load8(H.v2, (size_t)(tk * 64 + key) * H.v2ld + 8 * dc, false) : load8(H.v, (size_t)(tk * 64 + key) * H.vld + 8 * dc, H.v_f32); } } \
        if (DK == 96) { const int key = tid_h >> 2, ch = tid_h & 3; rp = *(const u32x4*)(H.kp + (size_t)((t) * 64 + key) * H.kpld + 8 * ch); } } } while (0)
#define ATT_SSTORE(t, buf) do { if ((t) < H.count) { LAS unsigned char* base = C.lds + ((buf) * 2 + hf) * HBY; \
        _Pragma("unroll") for (int i = 0; i < 2; ++i) { const int p = tid_h + 256 * i; \
            { const int key = p >> 3, ch = p & 7; *(LAS u32x4*)(base + (key * KST + 8 * ch) * 2) = rk[i]; } \
            { const int key = p & 63, dc = p >> 6; LAS bf16_t* vt = (LAS bf16_t*)(base + KBYTES) + (8 * dc) * VST + key; const u32x4 vv = rv[i]; \
              vt[0] = (bf16_t)(vv.x & 0xffffu); vt[VST] = (bf16_t)(vv.x >> 16); vt[2 * VST] = (bf16_t)(vv.y & 0xffffu); vt[3 * VST] = (bf16_t)(vv.y >> 16); \
              vt[4 * VST] = (bf16_t)(vv.z & 0xffffu); vt[5 * VST] = (bf16_t)(vv.z >> 16); vt[6 * VST] = (bf16_t)(vv.w & 0xffffu); vt[7 * VST] = (bf16_t)(vv.w >> 16); } } \
        if (DK == 96) { const int key = tid_h >> 2, ch = tid_h & 3; *(LAS u32x4*)(base + (key * KST + 64 + 8 * ch) * 2) = rp; } } } while (0)
    ATT_GLOAD(0); ATT_SSTORE(0, 0);
    __syncthreads();
    for (int t = 0; t < n_iter; ++t) {
        ATT_GLOAD(t + 1);
        if (t < H.count) {
            const LAS unsigned char* base = C.lds + ((t & 1) * 2 + hf) * HBY;
            f32x4 s[4];
#pragma unroll
            for (int mt = 0; mt < 4; ++mt) { s[mt] = (f32x4){0.f, 0.f, 0.f, 0.f};
#pragma unroll
                for (int ks = 0; ks < DK / 32; ++ks) { const bf16x8 a = *(const LAS bf16x8*)(base + ((16 * mt + fr) * KST + 32 * ks + 8 * fq) * 2); s[mt] = MFMA16(a, qf[ks], s[mt]); } }
            if (BIAS) { const int cd = H.cdiff0 - t, ql = 16 * wq + fr;
                if (cd >= 3) { const float bb = tab[256];
#pragma unroll
                    for (int mt = 0; mt < 4; ++mt) s[mt] = s[mt] + bb; }
                else {
#pragma unroll
                    for (int mt = 0; mt < 4; ++mt)
#pragma unroll
                        for (int i = 0; i < 4; ++i) { int rel = cd * 64 + ql - (16 * mt + 4 * fq + i); rel = rel > 128 ? 128 : rel; s[mt][i] += tab[rel + 128]; } } }
            float mx = s[0][0];
#pragma unroll
            for (int mt = 0; mt < 4; ++mt)
#pragma unroll
                for (int i = 0; i < 4; ++i) mx = fmaxf(mx, s[mt][i]);
            mx = fmaxf(mx, __shfl_xor(mx, 16)); mx = fmaxf(mx, __shfl_xor(mx, 32));
            const float mnew = fmaxf(m_run, mx), alpha = fexp2(m_run - mnew); m_run = mnew;
            float psum = 0.f;
#pragma unroll
            for (int mt = 0; mt < 4; ++mt)
#pragma unroll
                for (int i = 0; i < 4; ++i) { const float p = fexp2(s[mt][i] - mnew); s[mt][i] = p; psum += p; }
            l_run = l_run * alpha + psum;
#pragma unroll
            for (int d = 0; d < 4; ++d) oacc[d] = oacc[d] * alpha;
            bf16x8 pf[2];
#pragma unroll
            for (int kk = 0; kk < 2; ++kk) { u32x4 v; v.x = pk2(s[2 * kk][0], s[2 * kk][1]); v.y = pk2(s[2 * kk][2], s[2 * kk][3]); v.z = pk2(s[2 * kk + 1][0], s[2 * kk + 1][1]); v.w = pk2(s[2 * kk + 1][2], s[2 * kk + 1][3]); pf[kk] = as_frag(v); }
            const LAS bf16_t* vt = (const LAS bf16_t*)(base + KBYTES);
#pragma unroll
            for (int d = 0; d < 4; ++d)
#pragma unroll
                for (int kk = 0; kk < 2; ++kk) { const LAS bf16_t* vp = vt + (16 * d + fr) * VST + 32 * kk + 4 * fq;
                    const bf16x8 a = mk_frag(*(const LAS u32x2*)vp, *(const LAS u32x2*)(vp + 16)); oacc[d] = MFMA16(a, pf[kk], oacc[d]); }
        }
        ATT_SSTORE(t + 1, (t + 1) & 1);
        __syncthreads();
    }
#undef ATT_GLOAD
#undef ATT_SSTORE
    l_run += __shfl_xor(l_run, 16); l_run += __shfl_xor(l_run, 32);
    const float inv = 1.f / l_run;
#pragma unroll
    for (int d = 0; d < 4; ++d) { u32x2 w; w.x = pk2(oacc[d][0] * inv, oacc[d][1] * inv); w.y = pk2(oacc[d][2] * inv, oacc[d][3] * inv);
        *(u32x2*)(H.o + (size_t)(16 * wq + fr) * H.old_ + 16 * d + 4 * fq) = w; }
}

constexpr int N_MLAP = 1024, N_S3 = 288, N_MLAS = 128, N_BANDP = 1024, N_BANDS = 128, N_P5 = N_MLAP + N_S3 + N_MLAS + N_BANDP + N_BANDS;
#ifndef P5SEL
#define P5SEL 7
#endif
__device__ __forceinline__ void p5_unit(const Ctx& C, int idx) {
    const int hf = C.wave >> 2, l = C.l;
    AH H; H.split = 1 << 30; H.kn2 = nullptr; H.kn2ld = 0; H.v2 = nullptr; H.v2ld = 0; H.kn_f32 = false; H.v_f32 = false; H.kp = nullptr; H.kpld = 0; H.cdiff0 = 0;
    if (idx < N_MLAP) {
        const int cp = 63 - (idx >> 4), b = (idx >> 3) & 1, h = idx & 7, c = 2 * cp + hf; const size_t row0 = (size_t)b * TP + c * 64;
        H.q = WSB(WS_Q) + row0 * 768 + h * 96; H.qld = 768; H.o = WSB(WS_YBC) + row0 * 1024 + h * 64; H.old_ = 1024;
        H.kn = WSB(WS_KVP) + (size_t)b * TP * 1024 + h * 64; H.knld = 1024; H.kp = WSB(WS_KPEP) + (size_t)b * TP * 32; H.kpld = 32;
        H.v = WSB(WS_KVP) + (size_t)b * TP * 1024 + 512 + h * 64; H.vld = 1024; H.count = c + 1;
        if (P5SEL & 1) attn_core<96, false>(C, H, 2 * cp + 2); return;
    }
    idx -= N_MLAP;
    if (idx < N_S3) { if (P5SEL & 2) ssd_s3_item(C, idx); return; }
    idx -= N_S3;
    if (idx < N_MLAS) {
        const int b = idx >> 2, h = (idx & 3) * 2 + hf; const size_t row0 = (size_t)NP + b * 64;
        H.q = WSB(WS_Q) + row0 * 768 + h * 96; H.qld = 768; H.o = WSB(WS_YBC) + row0 * 1024 + h * 64; H.old_ = 1024;
        H.kn = WSB(WS_XR) + (size_t)b * KS_ALL * 1024 + h * 64; H.knld = 1024; H.kp = WSB(WS_KPES) + (size_t)b * KS_ALL * 32; H.kpld = 32;
        H.v = WSB(WS_XR) + (size_t)b * KS_ALL * 1024 + 512 + h * 64; H.vld = 1024; H.count = 33;
        if (P5SEL & 1) attn_core<96, false>(C, H, 33); return;
    }
    idx -= N_MLAS;
    constexpr int HBY64 = 64 * 72 * 2 * 2;
    if (idx < N_BANDP) {
        const int cp = idx >> 4, b = (idx >> 3) & 1, h = idx & 7, c = 2 * cp + hf, kt0 = c > 8 ? c - 8 : 0; const size_t row0 = (size_t)b * TP + c * 64;
        LAS float* tab = (LAS float*)(C.lds + 4 * HBY64) + hf * 260; const float* rb = INL(32, 8 * 257) + h * 257;
        for (int i = C.tid & 255; i < 257; i += 256) tab[i] = rb[i] * LOG2E;
        H.q = WSB(WS_PD) + row0 * 1536 + h * 64; H.qld = 1536; H.o = WSB(WS_PD) + row0 * 1536 + h * 64; H.old_ = 1536;
        H.kn = WSB(WS_PD) + ((size_t)b * TP + kt0 * 64) * 1536 + 512 + h * 64; H.knld = 1536;
        H.v = WSB(WS_PD) + ((size_t)b * TP + kt0 * 64) * 1536 + 1024 + h * 64; H.vld = 1536; H.count = c - kt0 + 1; H.cdiff0 = c - kt0;
        const int c1 = 2 * cp + 1;
        if (P5SEL & 4) attn_core<64, true>(C, H, (c1 > 8 ? 8 : c1) + 1); return;
    }
    idx -= N_BANDP;
    {
        const int b = idx >> 2, h = (idx & 3) * 2 + hf; const size_t row0 = (size_t)NP + b * 64;
        LAS float* tab = (LAS float*)(C.lds + 4 * HBY64) + hf * 260; const float* rb = INL(32, 8 * 257) + h * 257;
        for (int i = C.tid & 255; i < 257; i += 256) tab[i] = rb[i] * LOG2E;
        H.q = WSB(WS_PD) + row0 * 1536 + h * 64; H.qld = 1536; H.o = WSB(WS_PD) + row0 * 1536 + h * 64; H.old_ = 1536;
        H.kn = INL(7, (size_t)BS * 512 * 512) + (size_t)b * 512 * 512 + h * 64; H.knld = 512; H.kn_f32 = true;
        H.v = INL(8, (size_t)BS * 512 * 512) + (size_t)b * 512 * 512 + h * 64; H.vld = 512; H.v_f32 = true;
        H.split = 8; H.kn2 = WSB(WS_PD) + row0 * 1536 + 512 + h * 64; H.kn2ld = 1536; H.v2 = WSB(WS_PD) + row0 * 1536 + 1024 + h * 64; H.v2ld = 1536;
        H.count = 9; H.cdiff0 = 8;
        if (P5SEL & 4) attn_core<64, true>(C, H, 9);
    }
}

__global__ void __launch_bounds__(NTHREADS) mk_fwd(Args args) {
    extern __shared__ __attribute__((aligned(16))) unsigned char lds_raw[];
    cg::grid_group grid = cg::this_grid();
    Ctx C;
    C.A = &args;
    C.out = args.out; C.ws = args.ws; C.lds = (LAS unsigned char*)lds_raw;
    C.tid = threadIdx.x; C.lane = C.tid & 63; C.wave = __builtin_amdgcn_readfirstlane(C.tid >> 6);
    C.G = gridDim.x; C.bid = blockIdx.x; C.gw = C.bid * NWAVES + C.wave; C.NGW = C.G * NWAVES;
    unsigned* ctl = (unsigned*)(C.ws + WS_CTL);
    LAS int* sIdx = (LAS int*)(C.lds + LDS_BYTES - 16);
#ifndef PMASK
#define PMASK 0xFFF
#endif
#define REFRESH() do { int t_ = threadIdx.x; asm volatile("" : "+v"(t_)); C.tid = t_; C.lane = t_ & 63; C.wave = __builtin_amdgcn_readfirstlane(t_ >> 6); C.gw = C.bid * NWAVES + C.wave; GAS unsigned char* w_ = (GAS unsigned char*)args.ws; asm volatile("" : "+s"(w_)); C.ws = (unsigned char*)w_; GAS float* o_ = (GAS float*)args.out; asm volatile("" : "+s"(o_)); C.out = (float*)o_; } while (0)
#define PH_BEGIN(n) if ((PMASK >> (n)) & 1) { REFRESH();
#define PH_END } grid.sync();
#pragma unroll 1
    for (int l = 0; l < 2; ++l) {
        C.l = l;
        PH_BEGIN(0)
            if (C.bid == 0 && C.tid == 0) { ctl[l] = 0u; ctl[2 + l] = 0u; }
            { const size_t gt = (size_t)C.bid * NTHREADS + C.tid, GT = (size_t)C.G * NTHREADS; for (size_t i = gt; i < (size_t)R; i += GT) ((float*)(C.ws + WS_SUMSQ))[i] = 0.f; }
            phase_wprep(C);
            phase_norm(C, INL(9, 1024), l > 0);
        PH_END
        PH_BEGIN(1)
            SchedInproj S{WSB(WS_HB), WSB(WS_WT_IN), WSB(WS_PA), WSB(WS_ZB), WSB(WS_XR), WSB(WS_PD), C.G, C.bid};
            pg8::EpiStore E; pg8::gemm_phase(C.lds, S, E, C.tid);
        PH_END
        PH_BEGIN(2)
            phase_mla_prep(C); phase_band_prep(C); phase_sconv(C);
            for (int it = C.G - 1 - C.bid; it < N_S3; it += C.G) { REFRESH(); ssd_s1_item(C, it); }
        PH_END
        PH_BEGIN(3)
            ssd_scan(C);
            SchedP3 S{WSB(WS_ZB), WSB(WS_WT_QUP), WSB(WS_CKVP), WSB(WS_CKVS), WSB(WS_WT_KVUP), WSB(WS_Q), WSB(WS_KVP), WSB(WS_XR), C.G, C.bid};
            pg8::EpiStore E; pg8::gemm_phase(C.lds, S, E, C.tid);
        PH_END
        PH_BEGIN(4)
            phase_qk_post(C);
        PH_END
        PH_BEGIN(5)
            for (;;) {
                if (C.tid == 0) *sIdx = (int)atomicAdd(&ctl[l], 1u);
                __syncthreads();
                const int idx = *sIdx;
                __syncthreads();
                if (idx >= N_P5) break;
                REFRESH();
                p5_unit(C, idx);
            }
        PH_END
        PH_BEGIN(7)
            SchedMerge S{WSB(WS_HB), WSB(WS_WT_G), WSB(WS_WT_OUT), WSB(WS_PA), WSB(WS_YBC), WSB(WS_PD), C.G, C.bid};
            pg8::EpiMerge E{INL(11, 4096), WSB(WS_ZB), WSB(WS_XR)}; pg8::gemm_phase(C.lds, S, E, C.tid);
        PH_END
        PH_BEGIN(8)
            SchedOne S{WSB(WS_ZB), WSB(WS_WT_O), nullptr, 1024, 1024, 0, 72, 4, 16, C.G, C.bid};
            pg8::EpiResidNorm E{l > 0 ? C.out : IN0(0), l > 0 ? C.out + (size_t)NP * DM : IN0(1), C.out, WSB(WS_HB), INL(35, 1024), (float*)(C.ws + WS_SUMSQ)}; pg8::gemm_phase(C.lds, S, E, C.tid);
        PH_END
        PH_BEGIN(10)
            SchedOne S{WSB(WS_HB), WSB(WS_WT_UP), nullptr, 1024, 1024, 0, 72, 22, 16, C.G, C.bid};
            pg8::EpiSwigluNorm E{WSB(WS_XR), (const float*)(C.ws + WS_SUMSQ)}; pg8::gemm_phase(C.lds, S, E, C.tid);
        PH_END
        PH_BEGIN(11)
            SchedOne S{WSB(WS_XR), WSB(WS_WT_DOWN), nullptr, 2816, 2816, 0, 72, 4, 44, C.G, C.bid};
            pg8::EpiResid E{C.out, C.out + (size_t)NP * DM, C.out}; pg8::gemm_phase(C.lds, S, E, C.tid);
        PH_END
    }
}

extern "C" void kernel_launch(void* const* d_in, const int* in_sizes, int n_in, void* d_out, int out_size, void* d_ws, size_t ws_size, hipStream_t stream) {
    static int grid = 0;
    if (grid == 0) {
        int dev = 0, cus = 0, per_cu = 0;
        (void)hipGetDevice(&dev);
        (void)hipDeviceGetAttribute(&cus, hipDeviceAttributeMultiprocessorCount, dev);
        (void)hipFuncSetAttribute((const void*)mk_fwd, hipFuncAttributeMaxDynamicSharedMemorySize, LDS_BYTES);
        (void)hipOccupancyMaxActiveBlocksPerMultiprocessor(&per_cu, (const void*)mk_fwd, NTHREADS, LDS_BYTES);
        if (per_cu < 1) per_cu = 1;
        grid = cus * per_cu;
        if (ws_size < WS_END || n_in != 38 || (size_t)out_size != O_END) { fprintf(stderr, "kernel_launch: bad sizes ws %zu n_in %d out %d\n", ws_size, n_in, out_size); grid = -1; }
    }
    if (grid < 0) return;
    Args a{};
    for (int i = 0; i < 38; ++i) a.in[i] = (const float*)d_in[i];
    a.out = (float*)d_out; a.ws = (unsigned char*)d_ws; a.ph_lo = 0; a.ph_hi = 1000;
    void* kargs[] = {&a};
    hipError_t e = hipLaunchCooperativeKernel((const void*)mk_fwd, dim3(grid), dim3(NTHREADS), kargs, LDS_BYTES, stream);
    if (e != hipSuccess) fprintf(stderr, "cooperative launch failed: %s (grid %d)\n", hipGetErrorString(e), grid);
}
```

```cpp
#include <hip/hip_runtime.h>
#include <hip/hip_cooperative_groups.h>
#include <cstdio>
#include <cstdint>
namespace cg = cooperative_groups;

#define LAS __attribute__((address_space(3)))
#define GAS __attribute__((address_space(1)))
typedef unsigned short bf16_t;
typedef short bf16x8 __attribute__((ext_vector_type(8)));
typedef float f32x4 __attribute__((ext_vector_type(4)));
typedef unsigned u32x4 __attribute__((ext_vector_type(4)));
typedef unsigned u32x2 __attribute__((ext_vector_type(2)));

constexpr int NTHREADS = 512, NWAVES = 8;
constexpr int LDS_BYTES = 155648;
constexpr int NP = 16384, NS = 2048, R = NP + NS;
constexpr int TP = 8192, TS = 64, BP = 2, BS = 32, PAST = 2048, KS_ALL = PAST + TS;
constexpr int DM = 1024, FF = 2816;
constexpr int IN_COLS = 9384;
constexpr float EPS = 1e-6f;
constexpr float LOG2E = 1.4426950408889634f;

constexpr size_t O_Y = 0;
constexpr size_t O_SSM_P = (size_t)R * DM;
constexpr size_t O_SSM_S = O_SSM_P + 262144;
constexpr size_t O_CONV_P = O_SSM_S + 4194304;
constexpr size_t O_CONV_S = O_CONV_P + 12288;
constexpr size_t O_CKV_P = O_CONV_S + 196608;
constexpr size_t O_CKV_S = O_CKV_P + 8388608;
constexpr size_t O_KPE_P = O_CKV_S + 1048576;
constexpr size_t O_KPE_S = O_KPE_P + 1048576;
constexpr size_t O_SC_P = O_KPE_S + 131072;
constexpr size_t O_SC_S = O_SC_P + 4096;
constexpr size_t O_BK_P = O_SC_S + 65536;
constexpr size_t O_BK_S = O_BK_P + 1048576;
constexpr size_t O_BV_P = O_BK_S + 16777216;
constexpr size_t O_BV_S = O_BV_P + 1048576;
constexpr size_t O_END = O_BV_S + 16777216;

constexpr size_t al256(size_t x) { return (x + 255) & ~(size_t)255; }
constexpr size_t WS_CTL = 0;
constexpr size_t WS_DECAY = 4096;
constexpr size_t WS_SUMSQ = 16384;
constexpr size_t WS_WT_IN = 131072;
constexpr size_t WS_WT_G = WS_WT_IN + (size_t)5376 * 1024 * 2;
constexpr size_t WS_WT_QUP = WS_WT_G + (size_t)4096 * 1024 * 2;
constexpr size_t WS_WT_KVUP = WS_WT_QUP + (size_t)768 * 384 * 2;
constexpr size_t WS_WT_OUT = WS_WT_KVUP + (size_t)1024 * 256 * 2;
constexpr size_t WS_WT_O = WS_WT_OUT + (size_t)4 * 1024 * 1024 * 2;
constexpr size_t WS_WT_UP = WS_WT_O + (size_t)1024 * 1024 * 2;
constexpr size_t WS_WT_DOWN = WS_WT_UP + (size_t)5632 * 1024 * 2;
constexpr size_t WS_HB = al256(WS_WT_DOWN + (size_t)1024 * 2816 * 2);
constexpr size_t WS_PA = WS_HB + (size_t)R * 1024 * 2;
constexpr size_t WS_PD = WS_PA + (size_t)R * 1536 * 2;
constexpr size_t WS_ZB = WS_PD + (size_t)R * 1536 * 2;
constexpr size_t WS_CKVP = WS_ZB + (size_t)R * 768 * 2;
constexpr size_t WS_XR = WS_ZB + (size_t)R * 1024 * 2;
constexpr size_t WS_Q = WS_XR + (size_t)67584 * 1024 * 2;
constexpr size_t WS_KPEP = WS_Q + (size_t)R * 768 * 2;
constexpr size_t WS_KPES = WS_KPEP + (size_t)16384 * 32 * 2;
constexpr size_t WS_KVP = WS_KPES + (size_t)67584 * 32 * 2;
constexpr size_t WS_STATES = WS_KVP + (size_t)16384 * 1024 * 2;
constexpr size_t WS_YBC = WS_STATES + (size_t)2048 * 64 * 128 * 2;
constexpr size_t WS_CKVS = WS_YBC + (size_t)R * 1024 * 2;
constexpr size_t WS_END = WS_CKVS + (size_t)67584 * 256 * 2;
static_assert(WS_END < (size_t)553000000, "ws map too large");
static_assert((size_t)R * 768 * 2 + (size_t)16384 * 256 * 2 <= (size_t)R * 1024 * 2, "ZB");
static_assert((size_t)67584 * 256 * 2 <= (size_t)R * 1024 * 2, "ckvS in HB");

__device__ __forceinline__ unsigned f2bf(float f) { unsigned u = __builtin_bit_cast(unsigned, f); return (u + 0x7fffu + ((u >> 16) & 1u)) >> 16; }
__device__ __forceinline__ unsigned pk2(float lo, float hi) { return f2bf(lo) | (f2bf(hi) << 16); }
__device__ __forceinline__ float bflo(unsigned u) { return __builtin_bit_cast(float, u << 16); }
__device__ __forceinline__ float bfhi(unsigned u) { return __builtin_bit_cast(float, u & 0xffff0000u); }
__device__ __forceinline__ float bf1(bf16_t h) { return __builtin_bit_cast(float, (unsigned)h << 16); }
__device__ __forceinline__ float fexp2(float x) { return __builtin_amdgcn_exp2f(x); }
__device__ __forceinline__ float fexp(float x) { return __builtin_amdgcn_exp2f(x * LOG2E); }
__device__ __forceinline__ float frcp(float x) { return __builtin_amdgcn_rcpf(x); }
__device__ __forceinline__ float sigmoidf_(float x) { return frcp(1.f + fexp(-x)); }
__device__ __forceinline__ float siluf_(float x) { return x * sigmoidf_(x); }
__device__ __forceinline__ float wave_sum(float v) {
#pragma unroll
    for (int o = 1; o < 64; o <<= 1) v += __shfl_xor(v, o);
    return v;
}
#define LDS_WAIT() asm volatile("s_waitcnt lgkmcnt(0)" ::: "memory")
__device__ __forceinline__ void unpack8(u32x4 v, float* f) {
    f[0] = bflo(v.x); f[1] = bfhi(v.x); f[2] = bflo(v.y); f[3] = bfhi(v.y); f[4] = bflo(v.z); f[5] = bfhi(v.z); f[6] = bflo(v.w); f[7] = bfhi(v.w);
}
__device__ __forceinline__ u32x4 pack8(const float* f) { u32x4 o; o.x = pk2(f[0], f[1]); o.y = pk2(f[2], f[3]); o.z = pk2(f[4], f[5]); o.w = pk2(f[6], f[7]); return o; }
__device__ __forceinline__ u32x4 load8(const void* base, size_t idx, bool is_f32) {
    if (is_f32) { const f32x4* p = (const f32x4*)((const float*)base + idx); f32x4 a = p[0], b = p[1];
        u32x4 o; o.x = pk2(a.x, a.y); o.y = pk2(a.z, a.w); o.z = pk2(b.x, b.y); o.w = pk2(b.z, b.w); return o; }
    return *(const u32x4*)((const bf16_t*)base + idx);
}

namespace pg8 {
constexpr int BM = 256, BK = 64, HALF = 128, HTB = HALF * BK * 2, STAGE_BYTES = 8 * HTB, NXCD = 8, WGM = 8;
__device__ __forceinline__ int lds_byte(int r, int c) { const int st = (r >> 4) * 2 + (c >> 5), rr = r & 15, cc = c & 31, ob = rr * 64 + cc * 2; return st * 1024 + (ob ^ (((ob >> 9) & 1) << 5)); }
__device__ __forceinline__ void stage_rc(int b, int& Rr, int& C) { const int st = b / 1024, sb = b % 1024, swz = sb ^ (((sb >> 9) & 1) << 5); Rr = (st >> 1) * 16 + swz / 64; C = (st & 1) * 32 + (swz % 64) / 2; }
__device__ __forceinline__ int perm32(int rho) { const int n = rho >> 4, i = rho & 15; return 8 * (i >> 2) + 4 * n + (i & 3); }

struct GUnit { const bf16_t* A; const bf16_t* B; int lda, ldb, nt; int pm, pn, sub; bf16_t* C; int ldc; };

__device__ __forceinline__ void tile_map(int L, int nM, int nN, int& pm, int& pn) {
    const int nwg = nM * nN; int wgid = L;
    { const int q = nwg / NXCD, r = nwg % NXCD, xcd = wgid % NXCD, off = wgid / NXCD; wgid = (xcd < r ? xcd * (q + 1) : r * (q + 1) + (xcd - r) * q) + off; }
    const int nig = WGM * nN, gid = wgid / nig, fm = gid * WGM, gsz = (nM - fm) < WGM ? (nM - fm) : WGM;
    pm = fm + ((wgid % nig) % gsz); pn = (wgid % nig) / gsz;
}
typedef float f32x2_t __attribute__((ext_vector_type(2)));
typedef __bf16 bf16x2_t __attribute__((ext_vector_type(2)));
__device__ __forceinline__ unsigned cvt_pk_bf16(float lo, float hi) { f32x2_t v = {lo, hi}; bf16x2_t b = __builtin_convertvector(v, bf16x2_t); return __builtin_bit_cast(unsigned, b); }

template <class Epi, class Sched>
__device__ __forceinline__ void gemm_phase(LAS unsigned char* lds, const Sched& S, Epi& E, int tid) {
    const int wid = __builtin_amdgcn_readfirstlane(tid >> 6), lane = tid & 63, wr = wid >> 2, wc = wid & 3, fr = lane & 15, fq = lane >> 4;
    int RA[2], RB[2], CC[2];
#pragma unroll
    for (int i = 0; i < 2; ++i) { int Rr, C; stage_rc(tid * 16 + i * 8192, Rr, C); RA[i] = Rr; RB[i] = (Rr & ~31) + perm32(Rr & 31); CC[i] = C; }
    const size_t kstep = (size_t)(BK * 2);
    const unsigned ldsw = (unsigned)wid * 1024u;
    const int aoff = lds_byte(wr * 64 + fr, fq * 8), boff = lds_byte(wc * 32 + fr, fq * 8);
#define PG8_SA(b, h) (((b) * 2 + (h)) * HTB)
#define PG8_SB(b, h) ((4 + (b) * 2 + (h)) * HTB)
#define PG8_STAGE(bufoff, gbase, v0, v1) do { \
        __builtin_amdgcn_global_load_lds((const unsigned*)((const char*)(gbase) + (v0)), (LAS unsigned*)(lds + (bufoff) + ldsw), 16, 0, 0); \
        __builtin_amdgcn_global_load_lds((const unsigned*)((const char*)(gbase) + (v1)), (LAS unsigned*)(lds + (bufoff) + ldsw + 8192), 16, 0, 0); } while (0)
#define PG8_LDA(dst, b, h) do { _Pragma("unroll") for (int m = 0; m < 4; ++m) _Pragma("unroll") for (int k = 0; k < 2; ++k) dst[m][k] = *(const LAS bf16x8*)(lds + PG8_SA(b, h) + aoff + m * 2048 + k * 1024); } while (0)
#define PG8_LDB(dst, b, h) do { _Pragma("unroll") for (int n = 0; n < 2; ++n) _Pragma("unroll") for (int k = 0; k < 2; ++k) dst[n][k] = *(const LAS bf16x8*)(lds + PG8_SB(b, h) + boff + n * 2048 + k * 1024); } while (0)
#define PG8_MMA(ai, bj, At, Bt) do { __builtin_amdgcn_s_setprio(1); _Pragma("unroll") for (int m = 0; m < 4; ++m) _Pragma("unroll") for (int n = 0; n < 2; ++n) _Pragma("unroll") for (int k = 0; k < 2; ++k) \
        acc[ai][bj][m][n] = __builtin_amdgcn_mfma_f32_16x16x32_bf16(Bt[n][k], At[m][k], acc[ai][bj][m][n], 0, 0, 0); __builtin_amdgcn_s_setprio(0); } while (0)
#define PG8_WAIT_V(n) asm volatile("s_waitcnt vmcnt(" #n ")" ::: "memory")
#define PG8_WAIT_L(n) asm volatile("s_waitcnt lgkmcnt(" #n ")" ::: "memory")
#define PG8_BAR __builtin_amdgcn_s_barrier()
#define PG8_SCHED __builtin_amdgcn_sched_barrier(0)
    GUnit cur, nxt; int ui = 0;
    if (!S.next(0, cur)) return;
    f32x4 acc[2][2][4][2];
#pragma unroll
    for (int a = 0; a < 2; ++a)
#pragma unroll
        for (int b = 0; b < 2; ++b)
#pragma unroll
            for (int m = 0; m < 4; ++m)
#pragma unroll
                for (int n = 0; n < 2; ++n) acc[a][b][m][n] = (f32x4){0.f, 0.f, 0.f, 0.f};
    bf16x8 At[4][2], B0[2][2], B1[2][2];
    const char* cA = (const char*)cur.A; const char* cB = (const char*)cur.B;
    int clda = cur.lda, cldb = cur.ldb;
#define VA0(ld) ((unsigned)(RA[0] * (ld) + CC[0]) * 2u)
#define VA1(ld) ((unsigned)(RA[1] * (ld) + CC[1]) * 2u)
#define VB0(ld) ((unsigned)(RB[0] * (ld) + CC[0]) * 2u)
#define VB1(ld) ((unsigned)(RB[1] * (ld) + CC[1]) * 2u)
    unsigned vAc0 = VA0(clda), vAc1 = VA1(clda), vBc0 = VB0(cldb), vBc1 = VB1(cldb);
    size_t hsAc = (size_t)HALF * clda * 2, hsBc = (size_t)HALF * cldb * 2;
    PG8_STAGE(PG8_SB(0, 0), cB, vBc0, vBc1); PG8_STAGE(PG8_SB(0, 1), cB + hsBc, vBc0, vBc1); PG8_STAGE(PG8_SA(0, 0), cA, vAc0, vAc1); PG8_STAGE(PG8_SA(0, 1), cA + hsAc, vAc0, vAc1);
    if (wr == 1) PG8_BAR;
    PG8_WAIT_V(2); PG8_BAR;
    PG8_STAGE(PG8_SB(1, 0), cB + kstep, vBc0, vBc1); PG8_STAGE(PG8_SA(1, 0), cA + kstep, vAc0, vAc1); PG8_STAGE(PG8_SB(1, 1), cB + hsBc + kstep, vBc0, vBc1);
    PG8_WAIT_V(6); PG8_BAR;
    for (;;) {
        const bool has_next = S.next(ui + 1, nxt);
        const char* nA = has_next ? (const char*)nxt.A : cA; const char* nB = has_next ? (const char*)nxt.B : cB;
        const int nlda = has_next ? nxt.lda : cur.lda, nldb = has_next ? nxt.ldb : cur.ldb;
        const size_t hsAn = (size_t)HALF * nlda * 2, hsBn = (size_t)HALF * nldb * 2;
        const int nt = cur.nt;
        for (int t = 0; t < nt; t += 2) {
            const bool last = (t == nt - 2);
            const char* a1 = cA + (size_t)(t + 1) * kstep;
            const char* a2 = last ? nA : cA + (size_t)(t + 2) * kstep; const char* b2 = last ? nB : cB + (size_t)(t + 2) * kstep;
            const char* a3 = a2 + kstep; const char* b3 = b2 + kstep;
            const int lda2 = last ? nlda : clda, ldb2 = last ? nldb : cldb;
            const unsigned vA0 = VA0(lda2), vA1 = VA1(lda2), vB0 = VB0(ldb2), vB1 = VB1(ldb2);
            vAc0 = VA0(clda); vAc1 = VA1(clda);
            const size_t hsA2 = last ? hsAn : hsAc, hsB2 = last ? hsBn : hsBc;
            PG8_LDB(B0, 0, 0); PG8_LDB(B1, 0, 1); PG8_SCHED; PG8_LDA(At, 0, 0); PG8_STAGE(PG8_SA(1, 1), a1 + hsAc, vAc0, vAc1);
            PG8_WAIT_V(8); PG8_WAIT_L(0); PG8_BAR; PG8_MMA(0, 0, At, B0); PG8_MMA(0, 1, At, B1); PG8_BAR; PG8_SCHED;
            PG8_LDA(At, 0, 1); PG8_STAGE(PG8_SB(0, 0), b2, vB0, vB1); PG8_STAGE(PG8_SB(0, 1), b2 + hsB2, vB0, vB1); PG8_STAGE(PG8_SA(0, 0), a2, vA0, vA1);
            PG8_WAIT_V(8); PG8_WAIT_L(0); PG8_BAR; PG8_MMA(1, 0, At, B0); PG8_MMA(1, 1, At, B1); PG8_BAR; PG8_SCHED;
            PG8_LDB(B0, 1, 0); PG8_LDB(B1, 1, 1); PG8_SCHED; PG8_LDA(At, 1, 0); PG8_STAGE(PG8_SA(0, 1), a2 + hsA2, vA0, vA1);
            PG8_WAIT_V(8); PG8_WAIT_L(0); PG8_BAR; PG8_MMA(0, 0, At, B0); PG8_MMA(0, 1, At, B1); PG8_BAR; PG8_SCHED;
            PG8_LDA(At, 1, 1); PG8_STAGE(PG8_SB(1, 0), b3, vB0, vB1); PG8_STAGE(PG8_SB(1, 1), b3 + hsB2, vB0, vB1); PG8_STAGE(PG8_SA(1, 0), a3, vA0, vA1);
            PG8_WAIT_V(8); PG8_WAIT_L(0); PG8_BAR; PG8_MMA(1, 0, At, B0); PG8_MMA(1, 1, At, B1); PG8_BAR; PG8_SCHED;
        }
        if (wr == 0) PG8_BAR;
        const bool clear = E(acc, cur, wr, wc, fr, fq);
        if (!has_next) break;
        if (clear) {
#pragma unroll
        for (int a = 0; a < 2; ++a)
#pragma unroll
            for (int b = 0; b < 2; ++b)
#pragma unroll
                for (int m = 0; m < 4; ++m)
#pragma unroll
                    for (int n = 0; n < 2; ++n) acc[a][b][m][n] = (f32x4){0.f, 0.f, 0.f, 0.f};
        }
        cur = nxt; cA = nA; cB = nB; ++ui;
        clda = nlda; cldb = nldb; vAc0 = VA0(clda); vAc1 = VA1(clda); hsAc = hsAn; hsBc = hsBn;
        if (wr == 1) PG8_BAR;
    }
    PG8_WAIT_V(0);
    PG8_BAR;
#undef VA0
#undef VA1
#undef VB0
#undef VB1
#undef PG8_SA
#undef PG8_SB
#undef PG8_STAGE
#undef PG8_LDA
#undef PG8_LDB
#undef PG8_MMA
#undef PG8_WAIT_V
#undef PG8_WAIT_L
#undef PG8_BAR
#undef PG8_SCHED
}

struct EpiStore {
    __device__ __forceinline__ bool operator()(const f32x4 (&acc)[2][2][4][2], const GUnit& u, int wr, int wc, int fr, int fq) {
#pragma unroll
        for (int ai = 0; ai < 2; ++ai)
#pragma unroll
            for (int m = 0; m < 4; ++m) { bf16_t* rowp = u.C + (size_t)(ai * HALF + wr * 64 + m * 16 + fr) * u.ldc + wc * 32 + 8 * fq;
#pragma unroll
                for (int bj = 0; bj < 2; ++bj) { const f32x4 v0 = acc[ai][bj][m][0], v1 = acc[ai][bj][m][1];
                    u32x4 w; w.x = cvt_pk_bf16(v0[0], v0[1]); w.y = cvt_pk_bf16(v0[2], v0[3]); w.z = cvt_pk_bf16(v1[0], v1[1]); w.w = cvt_pk_bf16(v1[2], v1[3]);
                    *(GAS u32x4*)(rowp + bj * HALF) = w; } }
        return true;
    }
};
struct EpiResid {
    const float* xp; const float* xs; float* out;
    __device__ __forceinline__ bool operator()(const f32x4 (&acc)[2][2][4][2], const GUnit& u, int wr, int wc, int fr, int fq) {
        const unsigned off0 = (unsigned)(wr * 64 + fr) * DM + u.pn * 256 + wc * 32 + 8 * fq;
        const float* xin = ((u.pm < 64) ? xp + (size_t)u.pm * 256 * DM : xs + (size_t)(u.pm - 64) * 256 * DM) + off0;
        float* o = out + (size_t)u.pm * 256 * DM + off0;
#pragma unroll
        for (int ai = 0; ai < 2; ++ai)
#pragma unroll
            for (int m = 0; m < 4; ++m)
#pragma unroll
                for (int bj = 0; bj < 2; ++bj) { const unsigned ro = (unsigned)(ai * HALF + m * 16) * DM + bj * HALF;
                    const f32x4 x0 = *(const GAS f32x4*)(xin + ro), x1 = *(const GAS f32x4*)(xin + ro + 4);
                    *(GAS f32x4*)(o + ro) = x0 + acc[ai][bj][m][0]; *(GAS f32x4*)(o + ro + 4) = x1 + acc[ai][bj][m][1]; }
        return true;
    }
};
struct EpiResidNorm {
    const float* xp; const float* xs; float* out; bf16_t* hbo; const float* g2; float* sumsq;
    __device__ __forceinline__ bool operator()(const f32x4 (&acc)[2][2][4][2], const GUnit& u, int wr, int wc, int fr, int fq) {
        const unsigned col0 = u.pn * 256 + wc * 32 + 8 * fq;
        const unsigned off0 = (unsigned)(wr * 64 + fr) * DM + col0;
        const float* xin = ((u.pm < 64) ? xp + (size_t)u.pm * 256 * DM : xs + (size_t)(u.pm - 64) * 256 * DM) + off0;
        float* o = out + (size_t)u.pm * 256 * DM + off0;
        bf16_t* ho = hbo + (size_t)u.pm * 256 * DM + off0;
        f32x4 gg[2][2];
#pragma unroll
        for (int bj = 0; bj < 2; ++bj) { gg[bj][0] = *(const GAS f32x4*)(g2 + col0 + bj * HALF); gg[bj][1] = *(const GAS f32x4*)(g2 + col0 + bj * HALF + 4); }
#pragma unroll
        for (int ai = 0; ai < 2; ++ai)
#pragma unroll
            for (int m = 0; m < 4; ++m) { float ss = 0.f;
#pragma unroll
                for (int bj = 0; bj < 2; ++bj) { const unsigned ro = (unsigned)(ai * HALF + m * 16) * DM + bj * HALF;
                    const f32x4 x0 = *(const GAS f32x4*)(xin + ro) + acc[ai][bj][m][0], x1 = *(const GAS f32x4*)(xin + ro + 4) + acc[ai][bj][m][1];
                    *(GAS f32x4*)(o + ro) = x0; *(GAS f32x4*)(o + ro + 4) = x1;
                    ss += (x0[0] * x0[0] + x0[1] * x0[1]) + (x0[2] * x0[2] + x0[3] * x0[3]) + (x1[0] * x1[0] + x1[1] * x1[1]) + (x1[2] * x1[2] + x1[3] * x1[3]);
                    const f32x4 h0 = x0 * gg[bj][0], h1 = x1 * gg[bj][1]; u32x4 w;
                    w.x = cvt_pk_bf16(h0[0], h0[1]); w.y = cvt_pk_bf16(h0[2], h0[3]); w.z = cvt_pk_bf16(h1[0], h1[1]); w.w = cvt_pk_bf16(h1[2], h1[3]);
                    *(GAS u32x4*)(ho + ro) = w; }
                ss += __shfl_xor(ss, 16); ss += __shfl_xor(ss, 32);
                if (fq == 0) atomicAdd(sumsq + u.pm * 256 + ai * HALF + wr * 64 + m * 16 + fr, ss); }
        return true;
    }
};
struct EpiSwigluNorm {
    bf16_t* act; const float* sumsq;
    __device__ __forceinline__ bool operator()(const f32x4 (&acc)[2][2][4][2], const GUnit& u, int wr, int wc, int fr, int fq) {
#pragma unroll
        for (int ai = 0; ai < 2; ++ai)
#pragma unroll
            for (int m = 0; m < 4; ++m) { const int row = u.pm * 256 + ai * HALF + wr * 64 + m * 16 + fr;
                const float rs = 1.f / sqrtf(*(const GAS float*)(sumsq + row) * (1.f / DM) + EPS);
                bf16_t* rowp = act + (size_t)row * FF + u.pn * 128 + wc * 32 + 8 * fq;
                float o[8];
#pragma unroll
                for (int n = 0; n < 2; ++n)
#pragma unroll
                    for (int i = 0; i < 4; ++i) o[4 * n + i] = siluf_(rs * acc[ai][0][m][n][i]) * (rs * acc[ai][1][m][n][i]);
                u32x4 w; w.x = cvt_pk_bf16(o[0], o[1]); w.y = cvt_pk_bf16(o[2], o[3]); w.z = cvt_pk_bf16(o[4], o[5]); w.w = cvt_pk_bf16(o[6], o[7]);
                *(GAS u32x4*)rowp = w; }
        return true;
    }
};
struct EpiSwiglu {
    bf16_t* act;
    __device__ __forceinline__ bool operator()(const f32x4 (&acc)[2][2][4][2], const GUnit& u, int wr, int wc, int fr, int fq) {
#pragma unroll
        for (int ai = 0; ai < 2; ++ai)
#pragma unroll
            for (int m = 0; m < 4; ++m) { bf16_t* rowp = act + (size_t)(u.pm * 256 + ai * HALF + wr * 64 + m * 16 + fr) * FF + u.pn * 128 + wc * 32 + 8 * fq;
                float o[8];
#pragma unroll
                for (int n = 0; n < 2; ++n)
#pragma unroll
                    for (int i = 0; i < 4; ++i) o[4 * n + i] = siluf_(acc[ai][0][m][n][i]) * acc[ai][1][m][n][i];
                u32x4 w; w.x = cvt_pk_bf16(o[0], o[1]); w.y = cvt_pk_bf16(o[2], o[3]); w.z = cvt_pk_bf16(o[4], o[5]); w.w = cvt_pk_bf16(o[6], o[7]);
                *(GAS u32x4*)rowp = w; }
        return true;
    }
};
struct EpiMerge {
    const float* bgate; bf16_t* merged; bf16_t* gtmp;
    __device__ __forceinline__ bool operator()(const f32x4 (&acc)[2][2][4][2], const GUnit& u, int wr, int wc, int fr, int fq) {
        const int br = u.sub >> 1;
        const unsigned off0 = (unsigned)(u.pm * 256 + wr * 64 + fr) * DM + u.pn * 256 + wc * 32 + 8 * fq;
        if ((u.sub & 1) == 0) {
#pragma unroll
            for (int bj = 0; bj < 2; ++bj) { const float* bp = bgate + br * 1024 + u.pn * 256 + bj * HALF + wc * 32 + 8 * fq;
                const f32x4 b0 = *(const GAS f32x4*)bp, b1 = *(const GAS f32x4*)(bp + 4);
#pragma unroll
                for (int ai = 0; ai < 2; ++ai)
#pragma unroll
                    for (int m = 0; m < 4; ++m) { const f32x4 v0 = acc[ai][bj][m][0] + b0, v1 = acc[ai][bj][m][1] + b1; u32x4 w;
                        w.x = cvt_pk_bf16(sigmoidf_(v0[0]), sigmoidf_(v0[1])); w.y = cvt_pk_bf16(sigmoidf_(v0[2]), sigmoidf_(v0[3]));
                        w.z = cvt_pk_bf16(sigmoidf_(v1[0]), sigmoidf_(v1[1])); w.w = cvt_pk_bf16(sigmoidf_(v1[2]), sigmoidf_(v1[3]));
                        *(GAS u32x4*)(gtmp + off0 + (unsigned)(ai * HALF + m * 16) * DM + bj * HALF) = w; } }
        } else {
#pragma unroll
            for (int ai = 0; ai < 2; ++ai)
#pragma unroll
                for (int m = 0; m < 4; ++m)
#pragma unroll
                    for (int bj = 0; bj < 2; ++bj) { const unsigned off = off0 + (unsigned)(ai * HALF + m * 16) * DM + bj * HALF;
                        const u32x4 gg = *(const GAS u32x4*)(gtmp + off); u32x4 mm = (u32x4){0u, 0u, 0u, 0u}; if (br > 0) mm = *(const GAS u32x4*)(merged + off);
                        const f32x4 a0 = acc[ai][bj][m][0], a1 = acc[ai][bj][m][1]; u32x4 w;
                        w.x = cvt_pk_bf16(bflo(mm.x) + bflo(gg.x) * a0[0], bfhi(mm.x) + bfhi(gg.x) * a0[1]); w.y = cvt_pk_bf16(bflo(mm.y) + bflo(gg.y) * a0[2], bfhi(mm.y) + bfhi(gg.y) * a0[3]);
                        w.z = cvt_pk_bf16(bflo(mm.z) + bflo(gg.z) * a1[0], bfhi(mm.z) + bfhi(gg.z) * a1[1]); w.w = cvt_pk_bf16(bflo(mm.w) + bflo(gg.w) * a1[2], bfhi(mm.w) + bfhi(gg.w) * a1[3]);
                        *(GAS u32x4*)(merged + off) = w; }
        }
        return true;
    }
};
}

struct Args { const float* in[38]; float* out; unsigned char* ws; int ph_lo, ph_hi; };
struct Ctx {
    const Args* A; float* out; unsigned char* ws; LAS unsigned char* lds;
    int tid, lane, wave, gw, NGW, l, G, bid;
};
#define WSB(off) ((bf16_t*)(C.ws + (off)))
#define INL(i, sz) (C.A->in[i] + (size_t)C.l * (size_t)(sz))
#define IN0(i) (C.A->in[i])

using pg8::GUnit;
struct SchedOne {
    const bf16_t* A; const bf16_t* B; bf16_t* Cp; int lda, ldb, ldc, nM, nN, nt, G, c;
    __device__ __forceinline__ bool next(int i, GUnit& u) const {
        const long L = (long)i * G + c; if (L >= (long)nM * nN) return false;
        int pm, pn; pg8::tile_map((int)L, nM, nN, pm, pn);
        u.A = A + (size_t)pm * 256 * lda; u.B = B + (size_t)pn * 256 * ldb; u.lda = lda; u.ldb = ldb; u.nt = nt; u.pm = pm; u.pn = pn; u.sub = 0;
        u.C = Cp ? Cp + (size_t)pm * 256 * ldc + (size_t)pn * 256 : nullptr; u.ldc = ldc; return true;
    }
};
struct SchedInproj {
    const bf16_t* A; const bf16_t* B; bf16_t *pA, *pB, *pC, *pD; int G, c;
    __device__ __forceinline__ bool next(int i, GUnit& u) const {
        const long L = (long)i * G + c; if (L >= 72 * 21) return false;
        int pm, pn; pg8::tile_map((int)L, 72, 21, pm, pn);
        u.A = A + (size_t)pm * 256 * 1024; u.B = B + (size_t)pn * 256 * 1024; u.lda = 1024; u.ldb = 1024; u.nt = 16; u.pm = pm; u.pn = pn; u.sub = 0;
        if (pn < 6) { u.C = pA + (size_t)pm * 256 * 1536 + pn * 256; u.ldc = 1536; }
        else if (pn < 9) { u.C = pB + (size_t)pm * 256 * 768 + (pn - 6) * 256; u.ldc = 768; }
        else if (pn < 15) { u.C = pC + (size_t)pm * 256 * 1536 + (pn - 9) * 256; u.ldc = 1536; }
        else { u.C = pD + (size_t)pm * 256 * 1536 + (pn - 15) * 256; u.ldc = 1536; }
        return true;
    }
};
struct SchedP3 {
    const bf16_t *pB, *wq, *ckvP, *ckvS, *wkv; bf16_t *Q, *KVP, *KVS; int G, c;
    __device__ __forceinline__ bool next(int i, GUnit& u) const {
        long L = (long)i * G + c; int pm, pn; u.sub = 0;
        if (L < 264 * 4) { pg8::tile_map((int)L, 264, 4, pm, pn); u.A = ckvS + (size_t)pm * 256 * 256; u.B = wkv + (size_t)pn * 256 * 256; u.lda = 256; u.ldb = 256; u.nt = 4;
            u.C = KVS + (size_t)pm * 256 * 1024 + pn * 256; u.ldc = 1024; u.pm = pm; u.pn = pn; return true; }
        L -= 264 * 4;
        if (L < 64 * 4) { pg8::tile_map((int)L, 64, 4, pm, pn); u.A = ckvP + (size_t)pm * 256 * 256; u.B = wkv + (size_t)pn * 256 * 256; u.lda = 256; u.ldb = 256; u.nt = 4;
            u.C = KVP + (size_t)pm * 256 * 1024 + pn * 256; u.ldc = 1024; u.pm = pm; u.pn = pn; return true; }
        L -= 64 * 4;
        if (L < 72 * 3) { pg8::tile_map((int)L, 72, 3, pm, pn); u.A = pB + (size_t)pm * 256 * 768; u.B = wq + (size_t)pn * 256 * 384; u.lda = 768; u.ldb = 384; u.nt = 6;
            u.C = Q + (size_t)pm * 256 * 768 + pn * 256; u.ldc = 768; u.pm = pm; u.pn = pn; return true; }
        return false;
    }
};
struct SchedMerge {
    const bf16_t *hb, *wg, *wout, *pA, *ybc, *pD; int G, c;
    __device__ __forceinline__ bool next(int i, GUnit& u) const {
        const long L = (long)(i >> 3) * G + c; if (L >= 72 * 4) return false;
        int pm, pn; pg8::tile_map((int)L, 72, 4, pm, pn); const int sub = i & 7, br = sub >> 1;
        u.pm = pm; u.pn = pn; u.sub = sub; u.C = nullptr; u.ldc = 0; u.ldb = 1024;
        if ((sub & 1) == 0) { u.A = hb + (size_t)pm * 256 * 1024; u.lda = 1024; u.nt = 16; u.B = wg + (size_t)(br * 1024 + pn * 256) * 1024; }
        else { u.nt = 8; u.B = wout + (size_t)(br * 1024 + pn * 256) * 1024;
            if (br == 0) { u.A = pA + (size_t)pm * 256 * 1536; u.lda = 1536; }
            else if (br == 1) { u.A = ybc + (size_t)pm * 256 * 1024; u.lda = 1024; }
            else if (br == 2) { u.A = ybc + (size_t)pm * 256 * 1024 + 512; u.lda = 1024; }
            else { u.A = pD + (size_t)pm * 256 * 1536; u.lda = 1536; } }
        return true;
    }
};

template <class Map>
__device__ __forceinline__ void transpose_w(const Ctx& C, const float* W, int ldw, int K, int Nout, bf16_t* WT, int ldt, Map map) {
    LAS float* scr = (LAS float*)(C.lds + C.wave * 8704);
    const int lane = C.lane, nblk = Nout / 32, items = (K / 64) * nblk;
    for (int it = C.gw; it < items; it += C.NGW) {
        const int kb = it / nblk, nb = it % nblk, k0 = 64 * kb, n0 = 32 * nb;
        const int col = map(n0 + (lane & 31));
#pragma unroll 8
        for (int i = 0; i < 32; ++i) { const int kk = 2 * i + (lane >> 5); scr[kk * 33 + (lane & 31)] = (col >= 0) ? W[(size_t)(k0 + kk) * ldw + col] : 0.f; }
        LDS_WAIT();
        const int c = lane & 7;
#pragma unroll
        for (int j = 0; j < 4; ++j) { const int n = (lane >> 3) + 8 * j; const LAS float* s = scr + (8 * c) * 33 + n;
            u32x4 o; o.x = pk2(s[0 * 33], s[1 * 33]); o.y = pk2(s[2 * 33], s[3 * 33]); o.z = pk2(s[4 * 33], s[5 * 33]); o.w = pk2(s[6 * 33], s[7 * 33]);
            *(u32x4*)(WT + (size_t)(n0 + n) * ldt + k0 + 8 * c) = o; }
        LDS_WAIT();
    }
}
struct MapId { __device__ __forceinline__ int operator()(int n) const { return n; } };
struct MapOff { int off; __device__ __forceinline__ int operator()(int n) const { return n + off; } };
struct MapIn { __device__ __forceinline__ int operator()(int n) const { return n < 1536 ? n : (n < 2208 ? n + 8 : (n < 2216 ? n - 2208 + 1536 : (n < 2304 ? -1 : n - 88))); } };
struct MapKv { __device__ __forceinline__ int operator()(int n) const { return n < 512 ? ((n >> 6) * 128 + (n & 63)) : (((n - 512) >> 6) * 128 + 64 + (n & 63)); } };
struct MapUp { __device__ __forceinline__ int operator()(int n) const { const int t = n >> 8, w = n & 255; return w < 128 ? 128 * t + w : 2816 + 128 * t + (w - 128); } };

__device__ __forceinline__ void phase_wprep(const Ctx& C) {
    transpose_w(C, INL(10, 1024 * IN_COLS), IN_COLS, 1024, 5376, WSB(WS_WT_IN), 1024, MapIn());
    transpose_w(C, INL(10, 1024 * IN_COLS), IN_COLS, 1024, 4096, WSB(WS_WT_G), 1024, MapOff{5288});
    transpose_w(C, INL(20, 384 * 768), 768, 384, 768, WSB(WS_WT_QUP), 384, MapId());
    transpose_w(C, INL(22, 256 * 1024), 1024, 256, 1024, WSB(WS_WT_KVUP), 256, MapKv());
    transpose_w(C, INL(18, 512 * 1024), 1024, 512, 1024, WSB(WS_WT_OUT), 1024, MapId());
    transpose_w(C, INL(27, 512 * 1024), 1024, 512, 1024, WSB(WS_WT_OUT) + (size_t)1 * 1024 * 1024, 1024, MapId());
    transpose_w(C, INL(29, 512 * 1024), 1024, 512, 1024, WSB(WS_WT_OUT) + (size_t)2 * 1024 * 1024, 1024, MapId());
    transpose_w(C, INL(33, 512 * 1024), 1024, 512, 1024, WSB(WS_WT_OUT) + (size_t)3 * 1024 * 1024, 1024, MapId());
    transpose_w(C, INL(34, 1024 * 1024), 1024, 1024, 1024, WSB(WS_WT_O), 1024, MapId());
    transpose_w(C, INL(36, 1024 * 5632), 5632, 1024, 5632, WSB(WS_WT_UP), 1024, MapUp());
    transpose_w(C, INL(37, 2816 * 1024), 1024, 2816, 1024, WSB(WS_WT_DOWN), 2816, MapId());
}

__device__ __forceinline__ const float* xrow(const Ctx& C, int row, bool from_out) {
    if (from_out) return C.out + (size_t)row * DM;
    return row < NP ? IN0(0) + (size_t)row * DM : IN0(1) + (size_t)(row - NP) * DM;
}
__device__ __forceinline__ void phase_norm(const Ctx& C, const float* g, bool from_out) {
    const int lane = C.lane;
    f32x4 gv[4];
#pragma unroll
    for (int j = 0; j < 4; ++j) gv[j] = ((const f32x4*)g)[64 * j + lane];
    for (int row = C.gw; row < R; row += C.NGW) {
        const f32x4* xr = (const f32x4*)xrow(C, row, from_out) + lane;
        f32x4 v[4]; float s = 0.f;
#pragma unroll
        for (int j = 0; j < 4; ++j) { v[j] = xr[64 * j]; s += (v[j].x * v[j].x + v[j].y * v[j].y) + (v[j].z * v[j].z + v[j].w * v[j].w); }
        const float rstd = 1.f / sqrtf(wave_sum(s) * (1.f / DM) + EPS);
        u32x2* o = (u32x2*)(WSB(WS_HB) + (size_t)row * DM) + lane;
#pragma unroll
        for (int j = 0; j < 4; ++j) { u32x2 w; w.x = pk2(v[j].x * rstd * gv[j].x, v[j].y * rstd * gv[j].y); w.y = pk2(v[j].z * rstd * gv[j].z, v[j].w * rstd * gv[j].w); o[64 * j] = w; }
    }
}
__device__ __forceinline__ void rope_cs(int pos, int i, float& c, float& s) {
    const float chi = ((i & 8) ? ((i & 4) ? ((i & 2) ? ((i & 1) ? 2.831220627e-05f : 5.030632019e-05f) : ((i & 1) ? 8.952617645e-05f : 1.592636108e-04f)) : ((i & 2) ? ((i & 1) ? 2.832412720e-04f : 5.035400391e-04f) : ((i & 1) ? 8.945465088e-04f : 1.590728760e-03f))) : ((i & 4) ? ((i & 2) ? ((i & 1) ? 2.830505371e-03f : 5.035400391e-03f) : ((i & 1) ? 8.956909180e-03f : 1.593017578e-02f)) : ((i & 2) ? ((i & 1) ? 2.828979492e-02f : 5.035400391e-02f) : ((i & 1) ? 8.947753906e-02f : 1.591796875e-01f))));
    const float clo = ((i & 8) ? ((i & 4) ? ((i & 2) ? ((i & 1) ? -1.001043781e-08f : 2.289191414e-08f) : ((i & 1) ? -2.677484368e-08f : -1.086677486e-07f)) : ((i & 2) ? ((i & 1) ? -2.193136623e-07f : -2.479180239e-07f) : ((i & 1) ? 4.475072899e-07f : 8.206711755e-07f))) : ((i & 4) ? ((i & 2) ? ((i & 1) ? -2.857880190e-07f : -2.479180239e-06f) : ((i & 1) ? -6.969018614e-06f : -1.468147184e-05f)) : ((i & 2) ? ((i & 1) ? 1.240090842e-05f : -2.479180148e-05f) : ((i & 1) ? 2.186254642e-05f : -2.474440771e-05f))));
    const float pf = (float)pos, rh = pf * chi, f1 = rh - __builtin_rintf(rh), fr = f1 + pf * clo;
    c = __builtin_amdgcn_cosf(fr); s = __builtin_amdgcn_sinf(fr);
}
__device__ __forceinline__ int row_pos(int row) { return row < NP ? (row & (TP - 1)) : PAST + ((row - NP) & 63); }

__device__ __forceinline__ void phase_mla_prep(const Ctx& C) {
    const int lane = C.lane; const int l = C.l;
    const float* gq = INL(19, 384); const float* gkv = INL(21, 256); const float* gkr = INL(26, 32);
    for (int row = C.gw; row < R; row += C.NGW) {
        bf16_t* pb = WSB(WS_ZB) + (size_t)row * 768;
        unsigned q[3]; float ss = 0.f;
#pragma unroll
        for (int j = 0; j < 3; ++j) { q[j] = *(const unsigned*)(pb + 2 * lane + 128 * j); const float a = bflo(q[j]), b = bfhi(q[j]); ss += a * a + b * b; }
        float rstd = 1.f / sqrtf(wave_sum(ss) * (1.f / 384.f) + EPS);
#pragma unroll
        for (int j = 0; j < 3; ++j) { const int c = 2 * lane + 128 * j; *(unsigned*)(pb + c) = pk2(bflo(q[j]) * rstd * gq[c], bfhi(q[j]) * rstd * gq[c + 1]); }
        const u32x2 kv = *(const u32x2*)(pb + 384 + 4 * lane);
        float k0 = bflo(kv.x), k1 = bfhi(kv.x), k2 = bflo(kv.y), k3 = bfhi(kv.y);
        rstd = 1.f / sqrtf(wave_sum(k0 * k0 + k1 * k1 + k2 * k2 + k3 * k3) * (1.f / 256.f) + EPS);
        const f32x4 g4 = *(const f32x4*)(gkv + 4 * lane);
        f32x4 ck; ck.x = k0 * rstd * g4.x; ck.y = k1 * rstd * g4.y; ck.z = k2 * rstd * g4.z; ck.w = k3 * rstd * g4.w;
        u32x2 ckb; ckb.x = pk2(ck.x, ck.y); ckb.y = pk2(ck.z, ck.w);
        const int pos = row_pos(row);
        size_t srow = 0;
        if (row < NP) { *(f32x4*)(C.out + O_CKV_P + ((size_t)l * NP + row) * 256 + 4 * lane) = ck; *(u32x2*)(WSB(WS_CKVP) + (size_t)row * 256 + 4 * lane) = ckb; }
        else { const int rs = row - NP; srow = (size_t)(rs >> 6) * KS_ALL + PAST + (rs & 63);
            *(f32x4*)(C.out + O_CKV_S + ((size_t)l * NS + rs) * 256 + 4 * lane) = ck; *(u32x2*)(WSB(WS_CKVS) + srow * 256 + 4 * lane) = ckb; }
        const float x = (lane < 32) ? bf1(pb[640 + lane]) : 0.f;
        rstd = 1.f / sqrtf(wave_sum(x * x) * (1.f / 32.f) + EPS);
        const float y = x * rstd * gkr[lane & 31];
        const float part = __shfl_xor(y, 16);
        float cs, sn; rope_cs(pos, lane & 15, cs, sn);
        const float o = (lane < 16) ? (y * cs - part * sn) : (part * sn + y * cs);
        if (lane < 32) {
            if (row < NP) { C.out[O_KPE_P + ((size_t)l * NP + row) * 32 + lane] = o; WSB(WS_KPEP)[(size_t)row * 32 + lane] = (bf16_t)f2bf(o); }
            else { C.out[O_KPE_S + ((size_t)l * NS + (row - NP)) * 32 + lane] = o; WSB(WS_KPES)[srow * 32 + lane] = (bf16_t)f2bf(o); }
        }
    }
    const size_t gt = (size_t)C.bid * NTHREADS + C.tid, GT = (size_t)C.G * NTHREADS;
    { const float* src = INL(4, (size_t)BS * PAST * 256);
      for (size_t i = gt; i < (size_t)BS * PAST * 256 / 8; i += GT) { const size_t e = i * 8, b = e / ((size_t)PAST * 256), rem = e % ((size_t)PAST * 256);
          *(u32x4*)(WSB(WS_CKVS) + b * KS_ALL * 256 + rem) = load8(src, e, true); } }
    { const float* src = INL(5, (size_t)BS * PAST * 32);
      for (size_t i = gt; i < (size_t)BS * PAST * 32 / 8; i += GT) { const size_t e = i * 8, b = e / ((size_t)PAST * 32), rem = e % ((size_t)PAST * 32);
          *(u32x4*)(WSB(WS_KPES) + b * KS_ALL * 32 + rem) = load8(src, e, true); } }
}

__device__ __forceinline__ float red8(float v) { v += __shfl_xor(v, 1); v += __shfl_xor(v, 2); v += __shfl_xor(v, 4); return v; }

__device__ __forceinline__ void phase_band_prep(const Ctx& C) {
    const int lane = C.lane, l = C.l, d0 = (lane & 7) * 8;
    float gq[8], gk[8];
#pragma unroll
    for (int e = 0; e < 8; ++e) { gq[e] = INL(30, 64)[d0 + e] * (0.125f * LOG2E); gk[e] = INL(31, 64)[d0 + e]; }
    for (int row = C.gw; row < R; row += C.NGW) {
        bf16_t* pd = WSB(WS_PD) + (size_t)row * 1536 + 8 * lane;
        float f[8], kf[8], vf[8];
        unpack8(*(const u32x4*)pd, f); float ss = 0.f;
#pragma unroll
        for (int e = 0; e < 8; ++e) ss += f[e] * f[e];
        float rstd = 1.f / sqrtf(red8(ss) * (1.f / 64.f) + EPS);
#pragma unroll
        for (int e = 0; e < 8; ++e) f[e] *= rstd * gq[e];
        *(u32x4*)pd = pack8(f);
        unpack8(*(const u32x4*)(pd + 512), kf); ss = 0.f;
#pragma unroll
        for (int e = 0; e < 8; ++e) ss += kf[e] * kf[e];
        rstd = 1.f / sqrtf(red8(ss) * (1.f / 64.f) + EPS);
#pragma unroll
        for (int e = 0; e < 8; ++e) kf[e] *= rstd * gk[e];
        *(u32x4*)(pd + 512) = pack8(kf);
        unpack8(*(const u32x4*)(pd + 1024), vf);
        long dst = -1;
        if (row < NP) { const int t = row & (TP - 1), b = row >> 13; if (t >= TP - 512) dst = (long)(((size_t)(l * BP + b) * 512 + (t - (TP - 512))) * 512 + 8 * lane); }
        else { const int rs = row - NP, b = rs >> 6, t = rs & 63; dst = (long)(((size_t)(l * BS + b) * 512 + 448 + t) * 512 + 8 * lane); }
        if (dst >= 0) { float* ko = C.out + (row < NP ? O_BK_P : O_BK_S) + dst; float* vo = C.out + (row < NP ? O_BV_P : O_BV_S) + dst;
            *(f32x4*)ko = (f32x4){kf[0], kf[1], kf[2], kf[3]}; *(f32x4*)(ko + 4) = (f32x4){kf[4], kf[5], kf[6], kf[7]};
            *(f32x4*)vo = (f32x4){vf[0], vf[1], vf[2], vf[3]}; *(f32x4*)(vo + 4) = (f32x4){vf[4], vf[5], vf[6], vf[7]}; }
    }
    const size_t gt = (size_t)C.bid * NTHREADS + C.tid, GT = (size_t)C.G * NTHREADS;
    const f32x4* sk = (const f32x4*)INL(7, (size_t)BS * 512 * 512); const f32x4* sv = (const f32x4*)INL(8, (size_t)BS * 512 * 512);
    f32x4* dk = (f32x4*)(C.out + O_BK_S + (size_t)l * BS * 512 * 512); f32x4* dv = (f32x4*)(C.out + O_BV_S + (size_t)l * BS * 512 * 512);
    for (size_t i = gt; i < (size_t)BS * 448 * 128; i += GT) { const size_t b = i / (448 * 128), rem = i % (448 * 128);
        dk[b * 512 * 128 + rem] = sk[b * 512 * 128 + 64 * 128 + rem]; dv[b * 512 * 128 + rem] = sv[b * 512 * 128 + 64 * 128 + rem]; }
}

__device__ __forceinline__ void phase_sconv(const Ctx& C) {
    const int lane = C.lane, l = C.l, ch = 8 * lane;
    const float* w = INL(28, 3 * 512);
    float w0[8], w1[8], w2[8];
#pragma unroll
    for (int e = 0; e < 8; ++e) { w0[e] = w[ch + e]; w1[e] = w[512 + ch + e]; w2[e] = w[1024 + ch + e]; }
    for (int row = C.gw; row < R; row += C.NGW) {
        const bf16_t* pc = WSB(WS_XR) + (size_t)row * 1536 + ch;
        const bool pr = row < NP; const int t = pr ? (row & (TP - 1)) : ((row - NP) & 63); const int b = pr ? (row >> 13) : ((row - NP) >> 6);
        float cb[8], a[8], x[8], u0[8], u1[8], u2[8];
        unpack8(*(const u32x4*)pc, cb); unpack8(*(const u32x4*)(pc + 512), a); unpack8(*(const u32x4*)(pc + 1024), x);
#pragma unroll
        for (int e = 0; e < 8; ++e) u0[e] = a[e] * x[e];
        const float* st = INL(6, BS * 2 * 512) + (size_t)b * 2 * 512 + ch;
        if (t >= 1) { unpack8(*(const u32x4*)(pc - 1536 + 512), a); unpack8(*(const u32x4*)(pc - 1536 + 1024), x);
#pragma unroll
            for (int e = 0; e < 8; ++e) u1[e] = a[e] * x[e]; }
        else {
#pragma unroll
            for (int e = 0; e < 8; ++e) u1[e] = pr ? 0.f : st[512 + e]; }
        if (t >= 2) { unpack8(*(const u32x4*)(pc - 3072 + 512), a); unpack8(*(const u32x4*)(pc - 3072 + 1024), x);
#pragma unroll
            for (int e = 0; e < 8; ++e) u2[e] = a[e] * x[e]; }
        else {
#pragma unroll
            for (int e = 0; e < 8; ++e) u2[e] = pr ? 0.f : st[(t == 1 ? 512 : 0) + e]; }
        float y[8];
#pragma unroll
        for (int e = 0; e < 8; ++e) y[e] = cb[e] * (w0[e] * u2[e] + w1[e] * u1[e] + w2[e] * u0[e]);
        *(u32x4*)(WSB(WS_YBC) + (size_t)row * 1024 + 512 + ch) = pack8(y);
        const int T = pr ? TP : TS;
        if (t >= T - 2) { float* o = C.out + (pr ? O_SC_P + ((size_t)(l * BP + b) * 2 + (t - (T - 2))) * 512 : O_SC_S + ((size_t)(l * BS + b) * 2 + (t - (T - 2))) * 512) + ch;
            *(f32x4*)o = (f32x4){u0[0], u0[1], u0[2], u0[3]}; *(f32x4*)(o + 4) = (f32x4){u0[4], u0[5], u0[6], u0[7]}; }
    }
}

__device__ __forceinline__ void phase_qk_post(const Ctx& C) {
    const int lane = C.lane, head = lane >> 3, sub = lane & 7;
    const float SC = 0.10206207261596577f * LOG2E;
    float gn[8], gr[8], gk[8];
#pragma unroll
    for (int e = 0; e < 8; ++e) { gn[e] = INL(23, 64)[8 * sub + e] * SC; gr[e] = INL(25, 32)[8 * (sub & 3) + e]; gk[e] = INL(24, 64)[8 * sub + e]; }
    for (int row = C.gw; row < R; row += C.NGW) {
        bf16_t* qp = WSB(WS_Q) + (size_t)row * 768 + 96 * head;
        float f[8]; unpack8(*(const u32x4*)(qp + 8 * sub), f); float ss = 0.f;
#pragma unroll
        for (int e = 0; e < 8; ++e) ss += f[e] * f[e];
        float rstd = 1.f / sqrtf(red8(ss) * (1.f / 64.f) + EPS);
#pragma unroll
        for (int e = 0; e < 8; ++e) f[e] *= rstd * gn[e];
        *(u32x4*)(qp + 8 * sub) = pack8(f);
        float r[8];
        if (sub < 4) unpack8(*(const u32x4*)(qp + 64 + 8 * sub), r);
        else {
#pragma unroll
            for (int e = 0; e < 8; ++e) r[e] = 0.f; }
        ss = 0.f;
#pragma unroll
        for (int e = 0; e < 8; ++e) ss += r[e] * r[e];
        ss += __shfl_xor(ss, 1); ss += __shfl_xor(ss, 2);
        rstd = 1.f / sqrtf(ss * (1.f / 32.f) + EPS);
        const int pos = row_pos(row);
        float o[8];
#pragma unroll
        for (int e = 0; e < 8; ++e) { const float y = r[e] * rstd * gr[e]; const float part = __shfl_xor(y, 2);
            float cs, sn; rope_cs(pos, 8 * (sub & 1) + e, cs, sn);
            o[e] = ((sub < 2) ? (y * cs - part * sn) : (part * sn + y * cs)) * SC; }
        if (sub < 4) *(u32x4*)(qp + 64 + 8 * sub) = pack8(o);
    }
    for (int row = C.gw; row < NP + BS * KS_ALL; row += C.NGW) {
        bf16_t* kp = (row < NP ? WSB(WS_KVP) + (size_t)row * 1024 : WSB(WS_XR) + (size_t)(row - NP) * 1024) + 8 * lane;
        float f[8]; unpack8(*(const u32x4*)kp, f); float ss = 0.f;
#pragma unroll
        for (int e = 0; e < 8; ++e) ss += f[e] * f[e];
        const float rstd = 1.f / sqrtf(red8(ss) * (1.f / 64.f) + EPS);
#pragma unroll
        for (int e = 0; e < 8; ++e) f[e] *= rstd * gk[e];
        *(u32x4*)kp = pack8(f);
    }
}

__device__ __forceinline__ bf16x8 mk_frag(u32x2 lo, u32x2 hi) { u32x4 v; v.x = lo.x; v.y = lo.y; v.z = hi.x; v.w = hi.y; return __builtin_bit_cast(bf16x8, v); }
__device__ __forceinline__ bf16x8 as_frag(u32x4 v) { return __builtin_bit_cast(bf16x8, v); }
#define MFMA16(a, b, c) __builtin_amdgcn_mfma_f32_16x16x32_bf16((a), (b), (c), 0, 0, 0)

__device__ __forceinline__ int ssd_row0(int seq, int c) { return seq < 2 ? seq * TP + c * 64 : NP + (seq - 2) * 64; }
__device__ __forceinline__ void ssd_dt(const Ctx& C, int row0, LAS float* sDT, LAS float* sACS) {
    const int h = C.wave, lane = C.lane;
    const float adt = bf1(WSB(WS_ZB)[(size_t)(row0 + lane) * 768 + 672 + h]) + INL(14, 8)[h];
    float dt; { const float e_ = fexp(adt), u_ = 1.f + e_; dt = (adt > 20.f) ? adt : ((u_ == 1.f) ? e_ : (__builtin_amdgcn_logf(u_) * 0.6931471805599453f) * e_ * frcp(u_ - 1.f)); }
    const float A = -fexp(INL(15, 8)[h]);
    float cs = dt * A;
#pragma unroll
    for (int o = 1; o < 64; o <<= 1) { const float t = __shfl_up(cs, o); if (lane >= o) cs += t; }
    sDT[h * 64 + lane] = dt; sACS[h * 64 + lane] = cs;
}
template <class F>
__device__ __forceinline__ void ssd_load_chunk(const Ctx& C, int seq, int c, int row0, F store) {
    const int lane = C.lane, w = C.wave;
    const bf16_t* base = WSB(WS_PA) + (size_t)(row0 + lane) * 1536 + 512;
    const float* cw = INL(12, 4 * 1024); const float* cbias = INL(13, 1024);
    for (int j = 0; j < 16; ++j) {
        const int ch0 = 128 * w + 8 * j;
        const u32x4 v0 = *(const u32x4*)(base + ch0);
        u32x4 ex = (u32x4){0u, 0u, 0u, 0u};
        if (lane < 3) {
            if (seq < 2) { if (c > 0) ex = *(const u32x4*)(base - (size_t)3 * 1536 + ch0); }
            else ex = load8(INL(3, BS * 3 * 1024) + ((size_t)(seq - 2) * 3 + lane) * 1024 + ch0, 0, true);
        }
        float x0[8], xk[3][8];
        unpack8(v0, x0);
#pragma unroll
        for (int k = 1; k <= 3; ++k) {
            u32x4 a, b;
            a.x = __shfl(v0.x, (lane - k) & 63); a.y = __shfl(v0.y, (lane - k) & 63); a.z = __shfl(v0.z, (lane - k) & 63); a.w = __shfl(v0.w, (lane - k) & 63);
            b.x = __shfl(ex.x, (lane - k + 3) & 63); b.y = __shfl(ex.y, (lane - k + 3) & 63); b.z = __shfl(ex.z, (lane - k + 3) & 63); b.w = __shfl(ex.w, (lane - k + 3) & 63);
            unpack8(lane >= k ? a : b, xk[k - 1]);
        }
        float y[8];
#pragma unroll
        for (int e = 0; e < 8; ++e) {
            const float a = cbias[ch0 + e] + cw[3 * 1024 + ch0 + e] * x0[e] + cw[2 * 1024 + ch0 + e] * xk[0][e] + cw[1 * 1024 + ch0 + e] * xk[1][e] + cw[ch0 + e] * xk[2][e];
            y[e] = siluf_(a);
        }
        store(ch0, y, x0);
    }
}

constexpr int XT_ST = 72;
__device__ __forceinline__ void ssd_s1_item(const Ctx& C, int item) {
    const int seq = item < 256 ? (item >> 7) : 2 + (item - 256), c = item < 256 ? (item & 127) : 0, row0 = ssd_row0(seq, c);
    const int lane = C.lane, h = C.wave, fr = lane & 15, fq = lane >> 4, l = C.l;
    LAS bf16_t* XT = (LAS bf16_t*)C.lds; LAS bf16_t* BT = (LAS bf16_t*)(C.lds + 73728);
    LAS float* sDT = (LAS float*)(C.lds + 110592); LAS float* sACS = (LAS float*)(C.lds + 112640);
    ssd_dt(C, row0, sDT, sACS);
    __syncthreads();
    const bool lastc = (seq >= 2) || (c == 127);
    float* convo = C.out + (seq < 2 ? O_CONV_P + (size_t)(l * BP + seq) * 3 * 1024 : O_CONV_S + (size_t)(l * BS + seq - 2) * 3 * 1024);
    ssd_load_chunk(C, seq, c, row0, [&](int ch0, const float* y, const float* raw) {
        if (ch0 < 512) { const int hh = ch0 >> 6, p0 = ch0 & 63; const float wgt = sDT[hh * 64 + lane] * fexp(sACS[hh * 64 + 63] - sACS[hh * 64 + lane]);
#pragma unroll
            for (int e = 0; e < 8; ++e) XT[(hh * 64 + p0 + e) * XT_ST + lane] = (bf16_t)f2bf(y[e] * wgt); }
        else if (ch0 < 768) { const int g = (ch0 - 512) >> 7, n0 = (ch0 - 512) & 127;
#pragma unroll
            for (int e = 0; e < 8; ++e) BT[(g * 128 + n0 + e) * XT_ST + lane] = (bf16_t)f2bf(y[e]); }
        if (lastc && lane >= 61) {
#pragma unroll
            for (int e = 0; e < 8; ++e) convo[(size_t)(lane - 61) * 1024 + ch0 + e] = raw[e]; }
    });
    __syncthreads();
    const int g = h >> 2;
    bf16x8 bx[4][2];
#pragma unroll
    for (int pt = 0; pt < 4; ++pt)
#pragma unroll
        for (int ks = 0; ks < 2; ++ks) bx[pt][ks] = *(const LAS bf16x8*)(XT + (h * 64 + 16 * pt + fr) * XT_ST + 32 * ks + 8 * fq);
    const float dall = fexp(sACS[h * 64 + 63]);
    for (int nt = 0; nt < 8; ++nt) {
        bf16x8 a[2];
#pragma unroll
        for (int ks = 0; ks < 2; ++ks) a[ks] = *(const LAS bf16x8*)(BT + (g * 128 + 16 * nt + fr) * XT_ST + 32 * ks + 8 * fq);
#pragma unroll
        for (int pt = 0; pt < 4; ++pt) {
            f32x4 acc = (f32x4){0.f, 0.f, 0.f, 0.f};
#pragma unroll
            for (int ks = 0; ks < 2; ++ks) acc = MFMA16(a[ks], bx[pt][ks], acc);
            const int p = 16 * pt + fr, n = 16 * nt + 4 * fq;
            if (seq < 2) { u32x2 w; w.x = pk2(acc[0], acc[1]); w.y = pk2(acc[2], acc[3]);
                *(u32x2*)(WSB(WS_STATES) + ((size_t)((seq * 128 + c) * 8 + h) * 64 + p) * 128 + n) = w; }
            else { const size_t o = ((size_t)((l * BS + seq - 2) * 8 + h) * 64 + p) * 128 + n;
                const f32x4 h0 = *(const f32x4*)(IN0(2) + o);
                *(f32x4*)(C.out + O_SSM_S + o) = h0 * dall + acc; }
        }
    }
    if (seq < 2 && lane == 0) ((float*)(C.ws + WS_DECAY))[(seq * 128 + c) * 8 + h] = dall;
    __syncthreads();
}
__device__ __forceinline__ void ssd_scan(const Ctx& C) {
    const size_t gt = (size_t)C.bid * NTHREADS + C.tid;
    if (gt >= (size_t)2 * 8 * 64 * 128) return;
    const int b = (int)(gt >> 16), h = (int)(gt >> 13) & 7, pn = (int)(gt & 8191);
    bf16_t* st = WSB(WS_STATES) + ((size_t)(b * 128) * 8 + h) * 8192 + pn;
    const float* dec = (const float*)(C.ws + WS_DECAY) + (b * 128) * 8 + h;
    float hst = 0.f;
#pragma unroll 8
    for (int c = 0; c < 128; ++c) { const float s = bf1(st[(size_t)c * 8 * 8192]); st[(size_t)c * 8 * 8192] = (bf16_t)f2bf(hst); hst = dec[c * 8] * hst + s; }
    C.out[O_SSM_P + ((size_t)(C.l * BP + b) * 8 + h) * 8192 + pn] = hst;
}
constexpr int CN_ST = 136;
__device__ __forceinline__ void ssd_s3_item(const Ctx& C, int item) {
    const int seq = item < 256 ? (item >> 7) : 2 + (item - 256), c = item < 256 ? (item & 127) : 0, row0 = ssd_row0(seq, c);
    const int lane = C.lane, h = C.wave, fr = lane & 15, fq = lane >> 4, l = C.l, g = h >> 2;
    LAS bf16_t* Cn = (LAS bf16_t*)C.lds; LAS bf16_t* Bn = (LAS bf16_t*)(C.lds + 34816); LAS bf16_t* XT = (LAS bf16_t*)(C.lds + 69632);
    LAS float* sDT = (LAS float*)(C.lds + 143360); LAS float* sACS = (LAS float*)(C.lds + 145408); LAS float* sRed = (LAS float*)(C.lds + 147456);
    ssd_dt(C, row0, sDT, sACS);
    ssd_load_chunk(C, seq, c, row0, [&](int ch0, const float* y, const float*) {
        if (ch0 < 512) { const int hh = ch0 >> 6, p0 = ch0 & 63;
#pragma unroll
            for (int e = 0; e < 8; ++e) XT[(hh * 64 + p0 + e) * XT_ST + lane] = (bf16_t)f2bf(y[e]); }
        else if (ch0 < 768) { const int gg = (ch0 - 512) >> 7, n0 = (ch0 - 512) & 127; *(LAS u32x4*)(Bn + (gg * 64 + lane) * CN_ST + n0) = pack8(y); }
        else { const int gg = (ch0 - 768) >> 7, n0 = (ch0 - 768) & 127; *(LAS u32x4*)(Cn + (gg * 64 + lane) * CN_ST + n0) = pack8(y); }
    });
    __syncthreads();
#define CF(lt, ks) (*(const LAS bf16x8*)(Cn + (g * 64 + 16 * (lt) + fr) * CN_ST + 32 * (ks) + 8 * fq))
    f32x4 yacc[4][4];
    const void* hin; bool hin_f32;
    if (seq < 2) { hin = WSB(WS_STATES) + (size_t)((seq * 128 + c) * 8 + h) * 8192; hin_f32 = false; }
    else { hin = IN0(2) + (size_t)((l * BS + seq - 2) * 8 + h) * 8192; hin_f32 = true; }
#pragma unroll
    for (int pt = 0; pt < 4; ++pt) {
#pragma unroll
        for (int lt = 0; lt < 4; ++lt) yacc[pt][lt] = (f32x4){0.f, 0.f, 0.f, 0.f};
        bf16x8 af[4];
        if (hin_f32) {
#pragma unroll
            for (int ks = 0; ks < 4; ++ks) af[ks] = as_frag(load8(hin, (size_t)(16 * pt + fr) * 128 + 32 * ks + 8 * fq, true));
        } else {
#pragma unroll
            for (int ks = 0; ks < 4; ++ks) af[ks] = as_frag(load8(hin, (size_t)(16 * pt + fr) * 128 + 32 * ks + 8 * fq, false));
        }
#pragma unroll
        for (int ks = 0; ks < 4; ++ks)
#pragma unroll
            for (int lt = 0; lt < 4; ++lt) yacc[pt][lt] = MFMA16(af[ks], CF(lt, ks), yacc[pt][lt]);
        __builtin_amdgcn_sched_barrier(0);
    }
    float acl[4];
#pragma unroll
    for (int lt = 0; lt < 4; ++lt) { acl[lt] = sACS[h * 64 + 16 * lt + fr]; const float el = fexp(acl[lt]);
#pragma unroll
        for (int pt = 0; pt < 4; ++pt) yacc[pt][lt] = yacc[pt][lt] * el; }
    const float Dh = INL(16, 8)[h];
#pragma unroll
    for (int lt = 0; lt < 4; ++lt) {
        bf16x8 pf[2], cfl[4];
#pragma unroll
        for (int ks = 0; ks < 4; ++ks) cfl[ks] = CF(lt, ks);
        unsigned pw[4][2];
#pragma unroll
        for (int st = 0; st < 4; ++st) {
            f32x4 cb = (f32x4){0.f, 0.f, 0.f, 0.f};
#pragma unroll
            for (int ks = 0; ks < 4; ++ks) { const bf16x8 a = *(const LAS bf16x8*)(Bn + (g * 64 + 16 * st + fr) * CN_ST + 32 * ks + 8 * fq); cb = MFMA16(a, cfl[ks], cb); }
            const f32x4 as4 = *(const LAS f32x4*)(sACS + h * 64 + 16 * st + 4 * fq), dt4 = *(const LAS f32x4*)(sDT + h * 64 + 16 * st + 4 * fq);
            float m[4];
#pragma unroll
            for (int i = 0; i < 4; ++i) { const int s = 16 * st + 4 * fq + i, ll = 16 * lt + fr;
                float v = (s <= ll) ? cb[i] * fexp(acl[lt] - as4[i]) * dt4[i] : 0.f; if (s == ll) v += Dh; m[i] = v; }
            pw[st][0] = pk2(m[0], m[1]); pw[st][1] = pk2(m[2], m[3]);
        }
        { u32x4 v; v.x = pw[0][0]; v.y = pw[0][1]; v.z = pw[1][0]; v.w = pw[1][1]; pf[0] = as_frag(v); v.x = pw[2][0]; v.y = pw[2][1]; v.z = pw[3][0]; v.w = pw[3][1]; pf[1] = as_frag(v); }
#pragma unroll
        for (int pt = 0; pt < 4; ++pt)
#pragma unroll
            for (int kk = 0; kk < 2; ++kk) { const LAS bf16_t* xp = XT + (h * 64 + 16 * pt + fr) * XT_ST + 32 * kk + 4 * fq;
                const bf16x8 a = mk_frag(*(const LAS u32x2*)xp, *(const LAS u32x2*)(xp + 16)); yacc[pt][lt] = MFMA16(a, pf[kk], yacc[pt][lt]); }
        asm volatile("" ::: "memory");
    }
    float ss[4] = {0.f, 0.f, 0.f, 0.f};
#pragma unroll
    for (int lt = 0; lt < 4; ++lt)
#pragma unroll
        for (int pt = 0; pt < 4; ++pt) { const u32x2 z = *(const u32x2*)(WSB(WS_PA) + (size_t)(row0 + 16 * lt + fr) * 1536 + h * 64 + 16 * pt + 4 * fq);
            f32x4 v = yacc[pt][lt]; v[0] *= siluf_(bflo(z.x)); v[1] *= siluf_(bfhi(z.x)); v[2] *= siluf_(bflo(z.y)); v[3] *= siluf_(bfhi(z.y));
            yacc[pt][lt] = v; ss[lt] += v[0] * v[0] + v[1] * v[1] + v[2] * v[2] + v[3] * v[3]; }
#pragma unroll
    for (int lt = 0; lt < 4; ++lt) { ss[lt] += __shfl_xor(ss[lt], 16); ss[lt] += __shfl_xor(ss[lt], 32); if (fq == 0) sRed[h * 64 + 16 * lt + fr] = ss[lt]; }
    __syncthreads();
    const float* ng = INL(17, 512);
#pragma unroll
    for (int lt = 0; lt < 4; ++lt) { float tot = 0.f;
#pragma unroll
        for (int hh = 0; hh < 8; ++hh) tot += sRed[hh * 64 + 16 * lt + fr];
        const float rstd = 1.f / sqrtf(tot * (1.f / 512.f) + EPS);
#pragma unroll
        for (int pt = 0; pt < 4; ++pt) { const f32x4 gg = *(const f32x4*)(ng + h * 64 + 16 * pt + 4 * fq); const f32x4 v = yacc[pt][lt];
            u32x2 w; w.x = pk2(v[0] * rstd * gg[0], v[1] * rstd * gg[1]); w.y = pk2(v[2] * rstd * gg[2], v[3] * rstd * gg[3]);
            *(u32x2*)(WSB(WS_PA) + (size_t)(row0 + 16 * lt + fr) * 1536 + h * 64 + 16 * pt + 4 * fq) = w; } }
    __syncthreads();
}

struct AH {
    const bf16_t* q; int qld; bf16_t* o; int old_;
    const void* kn; size_t knld; bool kn_f32; const bf16_t* kn2; size_t kn2ld; int split;
    const bf16_t* kp; size_t kpld;
    const void* v; size_t vld; bool v_f32; const bf16_t* v2; size_t v2ld;
    int count, cdiff0;
};
template <int DK, bool BIAS, bool SHARED>
__device__ __forceinline__ void attn_core(const Ctx& C, const AH& H, int n_iter) {
    constexpr int KST = DK + 8, VST = 72, KBYTES = 64 * KST * 2, VBYTES = 64 * VST * 2, HBY = KBYTES + VBYTES;
    const int lane = C.lane, hf = C.wave >> 2, wq = C.wave & 3, tid_h = C.tid & 255, fr = lane & 15, fq = lane >> 4;
    LAS float* tab = (LAS float*)(C.lds + 4 * HBY) + hf * 260;
    bf16x8 qf[DK / 32];
#pragma unroll
    for (int ks = 0; ks < DK / 32; ++ks) qf[ks] = *(const bf16x8*)(H.q + (size_t)(16 * wq + fr) * H.qld + 32 * ks + 8 * fq);
    f32x4 oacc[4];
#pragma unroll
    for (int d = 0; d < 4; ++d) oacc[d] = (f32x4){0.f, 0.f, 0.f, 0.f};
    float m_run = -1e30f, l_run = 0.f;
    u32x4 rk[2], rp = (u32x4){0u, 0u, 0u, 0u}, rv[2];
    const int NPI = SHARED ? 1 : 2, PSTR = SHARED ? 0 : 256, ptid = SHARED ? C.tid : tid_h, lcount = SHARED ? n_iter : H.count, hsl = SHARED ? 0 : hf;
#define ATT_GLOAD(t) do { if ((t) < lcount) { const bool sec = (t) >= H.split; const int tk = sec ? (t) - H.split : (t); \
        _Pragma("unroll") for (int i = 0; i < NPI; ++i) { const int p = ptid + PSTR * i; \
            { const int key = p >> 3, ch = p & 7; rk[i] = sec ? load8(H.kn2, (size_t)(tk * 64 + key) * H.kn2ld + 8 * ch, false) : load8(H.kn, (size_t)(tk * 64 + key) * H.knld + 8 * ch, H.kn_f32); } \
            { const int key = p & 63, dc = p >> 6; rv[i] = sec ? load8(H.v2, (size_t)(tk * 64 + key) * H.v2ld + 8 * dc, false) : load8(H.v, (size_t)(tk * 64 + key) * H.vld + 8 * dc, H.v_f32); } } \
        if (DK == 96 && (!SHARED || ptid < 256)) { const int key = (ptid & 255) >> 2, ch = ptid & 3; rp = *(const u32x4*)(H.kp + (size_t)((t) * 64 + key) * H.kpld + 8 * ch); } } } while (0)
#define ATT_SSTORE(t, buf) do { if ((t) < lcount) { LAS unsigned char* base = C.lds + ((buf) * 2 + hsl) * HBY; \
        _Pragma("unroll") for (int i = 0; i < NPI; ++i) { const int p = ptid + PSTR * i; \
            { const int key = p >> 3, ch = p & 7; *(LAS u32x4*)(base + (key * KST + 8 * ch) * 2) = rk[i]; } \
            { const int key = p & 63, dc = p >> 6; LAS bf16_t* vt = (LAS bf16_t*)(base + KBYTES) + (8 * dc) * VST + key; const u32x4 vv = rv[i]; \
              vt[0] = (bf16_t)(vv.x & 0xffffu); vt[VST] = (bf16_t)(vv.x >> 16); vt[2 * VST] = (bf16_t)(vv.y & 0xffffu); vt[3 * VST] = (bf16_t)(vv.y >> 16); \
              vt[4 * VST] = (bf16_t)(vv.z & 0xffffu); vt[5 * VST] = (bf16_t)(vv.z >> 16); vt[6 * VST] = (bf16_t)(vv.w & 0xffffu); vt[7 * VST] = (bf16_t)(vv.w >> 16); } } \
        if (DK == 96 && (!SHARED || ptid < 256)) { const int key = (ptid & 255) >> 2, ch = ptid & 3; *(LAS u32x4*)(base + (key * KST + 64 + 8 * ch) * 2) = rp; } } } while (0)
    ATT_GLOAD(0); ATT_SSTORE(0, 0);
    __syncthreads();
    for (int t = 0; t < n_iter; ++t) {
        ATT_GLOAD(t + 1);
        if (t < H.count) {
            const LAS unsigned char* base = C.lds + ((t & 1) * 2 + hsl) * HBY;
            f32x4 s[4];
#pragma unroll
            for (int mt = 0; mt < 4; ++mt) { s[mt] = (f32x4){0.f, 0.f, 0.f, 0.f};
#pragma unroll
                for (int ks = 0; ks < DK / 32; ++ks) { const bf16x8 a = *(const LAS bf16x8*)(base + ((16 * mt + fr) * KST + 32 * ks + 8 * fq) * 2); s[mt] = MFMA16(a, qf[ks], s[mt]); } }
            if (BIAS) { const int cd = H.cdiff0 - t, ql = 16 * wq + fr;
                if (cd >= 3) { const float bb = tab[256];
#pragma unroll
                    for (int mt = 0; mt < 4; ++mt) s[mt] = s[mt] + bb; }
                else {
#pragma unroll
                    for (int mt = 0; mt < 4; ++mt)
#pragma unroll
                        for (int i = 0; i < 4; ++i) { int rel = cd * 64 + ql - (16 * mt + 4 * fq + i); rel = rel > 128 ? 128 : rel; s[mt][i] += tab[rel + 128]; } } }
            float mx = s[0][0];
#pragma unroll
            for (int mt = 0; mt < 4; ++mt)
#pragma unroll
                for (int i = 0; i < 4; ++i) mx = fmaxf(mx, s[mt][i]);
            mx = fmaxf(mx, __shfl_xor(mx, 16)); mx = fmaxf(mx, __shfl_xor(mx, 32));
            const float mnew = fmaxf(m_run, mx), alpha = fexp2(m_run - mnew); m_run = mnew;
            float psum = 0.f;
#pragma unroll
            for (int mt = 0; mt < 4; ++mt)
#pragma unroll
                for (int i = 0; i < 4; ++i) { const float p = fexp2(s[mt][i] - mnew); s[mt][i] = p; psum += p; }
            l_run = l_run * alpha + psum;
#pragma unroll
            for (int d = 0; d < 4; ++d) oacc[d] = oacc[d] * alpha;
            bf16x8 pf[2];
#pragma unroll
            for (int kk = 0; kk < 2; ++kk) { u32x4 v; v.x = pk2(s[2 * kk][0], s[2 * kk][1]); v.y = pk2(s[2 * kk][2], s[2 * kk][3]); v.z = pk2(s[2 * kk + 1][0], s[2 * kk + 1][1]); v.w = pk2(s[2 * kk + 1][2], s[2 * kk + 1][3]); pf[kk] = as_frag(v); }
            const LAS bf16_t* vt = (const LAS bf16_t*)(base + KBYTES);
#pragma unroll
            for (int d = 0; d < 4; ++d)
#pragma unroll
                for (int kk = 0; kk < 2; ++kk) { const LAS bf16_t* vp = vt + (16 * d + fr) * VST + 32 * kk + 4 * fq;
                    const bf16x8 a = mk_frag(*(const LAS u32x2*)vp, *(const LAS u32x2*)(vp + 16)); oacc[d] = MFMA16(a, pf[kk], oacc[d]); }
        }
        ATT_SSTORE(t + 1, (t + 1) & 1);
        __syncthreads();
    }
#undef ATT_GLOAD
#undef ATT_SSTORE
    l_run += __shfl_xor(l_run, 16); l_run += __shfl_xor(l_run, 32);
    const float inv = 1.f / l_run;
#pragma unroll
    for (int d = 0; d < 4; ++d) { u32x2 w; w.x = pk2(oacc[d][0] * inv, oacc[d][1] * inv); w.y = pk2(oacc[d][2] * inv, oacc[d][3] * inv);
        *(u32x2*)(H.o + (size_t)(16 * wq + fr) * H.old_ + 16 * d + 4 * fq) = w; }
}

constexpr int N_MLAP = 1024, N_S3 = 288, N_MLAS = 128, N_BANDP = 1024, N_BANDS = 128, N_P5 = N_MLAP + N_S3 + N_MLAS + N_BANDP + N_BANDS;
#ifndef P5SEL
#define P5SEL 7
#endif
__device__ __forceinline__ void p5_unit(const Ctx& C, int idx) {
    const int hf = C.wave >> 2, l = C.l;
    AH H; H.split = 1 << 30; H.kn2 = nullptr; H.kn2ld = 0; H.v2 = nullptr; H.v2ld = 0; H.kn_f32 = false; H.v_f32 = false; H.kp = nullptr; H.kpld = 0; H.cdiff0 = 0;
    if (idx < N_MLAP) {
        const int cp = 63 - (idx >> 4), b = (idx >> 3) & 1, h = idx & 7, c = 2 * cp + hf; const size_t row0 = (size_t)b * TP + c * 64;
        H.q = WSB(WS_Q) + row0 * 768 + h * 96; H.qld = 768; H.o = WSB(WS_YBC) + row0 * 1024 + h * 64; H.old_ = 1024;
        H.kn = WSB(WS_KVP) + (size_t)b * TP * 1024 + h * 64; H.knld = 1024; H.kp = WSB(WS_KPEP) + (size_t)b * TP * 32; H.kpld = 32;
        H.v = WSB(WS_KVP) + (size_t)b * TP * 1024 + 512 + h * 64; H.vld = 1024; H.count = c + 1;
        if (P5SEL & 1) attn_core<96, false, true>(C, H, 2 * cp + 2); return;
    }
    idx -= N_MLAP;
    if (idx < N_S3) { if (P5SEL & 2) ssd_s3_item(C, idx); return; }
    idx -= N_S3;
    if (idx < N_MLAS) {
        const int b = idx >> 2, h = (idx & 3) * 2 + hf; const size_t row0 = (size_t)NP + b * 64;
        H.q = WSB(WS_Q) + row0 * 768 + h * 96; H.qld = 768; H.o = WSB(WS_YBC) + row0 * 1024 + h * 64; H.old_ = 1024;
        H.kn = WSB(WS_XR) + (size_t)b * KS_ALL * 1024 + h * 64; H.knld = 1024; H.kp = WSB(WS_KPES) + (size_t)b * KS_ALL * 32; H.kpld = 32;
        H.v = WSB(WS_XR) + (size_t)b * KS_ALL * 1024 + 512 + h * 64; H.vld = 1024; H.count = 33;
        if (P5SEL & 1) attn_core<96, false, false>(C, H, 33); return;
    }
    idx -= N_MLAS;
    constexpr int HBY64 = 64 * 72 * 2 * 2;
    if (idx < N_BANDP) {
        const int cp = idx >> 4, b = (idx >> 3) & 1, h = idx & 7, c = 2 * cp + hf, kt0 = c > 8 ? c - 8 : 0; const size_t row0 = (size_t)b * TP + c * 64;
        LAS float* tab = (LAS float*)(C.lds + 4 * HBY64) + hf * 260; const float* rb = INL(32, 8 * 257) + h * 257;
        for (int i = C.tid & 255; i < 257; i += 256) tab[i] = rb[i] * LOG2E;
        H.q = WSB(WS_PD) + row0 * 1536 + h * 64; H.qld = 1536; H.o = WSB(WS_PD) + row0 * 1536 + h * 64; H.old_ = 1536;
        H.kn = WSB(WS_PD) + ((size_t)b * TP + kt0 * 64) * 1536 + 512 + h * 64; H.knld = 1536;
        H.v = WSB(WS_PD) + ((size_t)b * TP + kt0 * 64) * 1536 + 1024 + h * 64; H.vld = 1536; H.count = c - kt0 + 1; H.cdiff0 = c - kt0;
        const int c1 = 2 * cp + 1;
        if (P5SEL & 4) attn_core<64, true, false>(C, H, (c1 > 8 ? 8 : c1) + 1); return;
    }
    idx -= N_BANDP;
    {
        const int b = idx >> 2, h = (idx & 3) * 2 + hf; const size_t row0 = (size_t)NP + b * 64;
        LAS float* tab = (LAS float*)(C.lds + 4 * HBY64) + hf * 260; const float* rb = INL(32, 8 * 257) + h * 257;
        for (int i = C.tid & 255; i < 257; i += 256) tab[i] = rb[i] * LOG2E;
        H.q = WSB(WS_PD) + row0 * 1536 + h * 64; H.qld = 1536; H.o = WSB(WS_PD) + row0 * 1536 + h * 64; H.old_ = 1536;
        H.kn = INL(7, (size_t)BS * 512 * 512) + (size_t)b * 512 * 512 + h * 64; H.knld = 512; H.kn_f32 = true;
        H.v = INL(8, (size_t)BS * 512 * 512) + (size_t)b * 512 * 512 + h * 64; H.vld = 512; H.v_f32 = true;
        H.split = 8; H.kn2 = WSB(WS_PD) + row0 * 1536 + 512 + h * 64; H.kn2ld = 1536; H.v2 = WSB(WS_PD) + row0 * 1536 + 1024 + h * 64; H.v2ld = 1536;
        H.count = 9; H.cdiff0 = 8;
        if (P5SEL & 4) attn_core<64, true, false>(C, H, 9);
    }
}

__global__ void __launch_bounds__(NTHREADS) mk_fwd(Args args) {
    extern __shared__ __attribute__((aligned(16))) unsigned char lds_raw[];
    cg::grid_group grid = cg::this_grid();
    Ctx C;
    C.A = &args;
    C.out = args.out; C.ws = args.ws; C.lds = (LAS unsigned char*)lds_raw;
    C.tid = threadIdx.x; C.lane = C.tid & 63; C.wave = __builtin_amdgcn_readfirstlane(C.tid >> 6);
    C.G = gridDim.x; C.bid = blockIdx.x; C.gw = C.bid * NWAVES + C.wave; C.NGW = C.G * NWAVES;
    unsigned* ctl = (unsigned*)(C.ws + WS_CTL);
    LAS int* sIdx = (LAS int*)(C.lds + LDS_BYTES - 16);
#ifndef PMASK
#define PMASK 0xFFF
#endif
#define REFRESH() do { int t_ = threadIdx.x; asm volatile("" : "+v"(t_)); C.tid = t_; C.lane = t_ & 63; C.wave = __builtin_amdgcn_readfirstlane(t_ >> 6); C.gw = C.bid * NWAVES + C.wave; GAS unsigned char* w_ = (GAS unsigned char*)args.ws; asm volatile("" : "+s"(w_)); C.ws = (unsigned char*)w_; GAS float* o_ = (GAS float*)args.out; asm volatile("" : "+s"(o_)); C.out = (float*)o_; } while (0)
#define PH_BEGIN(n) if ((PMASK >> (n)) & 1) { REFRESH();
#define PH_END } grid.sync();
#pragma unroll 1
    for (int l = 0; l < 2; ++l) {
        C.l = l;
        PH_BEGIN(0)
            if (C.bid == 0 && C.tid == 0) { ctl[l] = 0u; ctl[2 + l] = 0u; }
            { const size_t gt = (size_t)C.bid * NTHREADS + C.tid, GT = (size_t)C.G * NTHREADS; for (size_t i = gt; i < (size_t)R; i += GT) ((float*)(C.ws + WS_SUMSQ))[i] = 0.f; }
            phase_wprep(C);
            phase_norm(C, INL(9, 1024), l > 0);
        PH_END
        PH_BEGIN(1)
            SchedInproj S{WSB(WS_HB), WSB(WS_WT_IN), WSB(WS_PA), WSB(WS_ZB), WSB(WS_XR), WSB(WS_PD), C.G, C.bid};
            pg8::EpiStore E; pg8::gemm_phase(C.lds, S, E, C.tid);
        PH_END
        PH_BEGIN(2)
            phase_mla_prep(C); phase_band_prep(C); phase_sconv(C);
            for (int it = C.G - 1 - C.bid; it < N_S3; it += C.G) { REFRESH(); ssd_s1_item(C, it); }
        PH_END
        PH_BEGIN(3)
            ssd_scan(C);
            SchedP3 S{WSB(WS_ZB), WSB(WS_WT_QUP), WSB(WS_CKVP), WSB(WS_CKVS), WSB(WS_WT_KVUP), WSB(WS_Q), WSB(WS_KVP), WSB(WS_XR), C.G, C.bid};
            pg8::EpiStore E; pg8::gemm_phase(C.lds, S, E, C.tid);
        PH_END
        PH_BEGIN(4)
            phase_qk_post(C);
        PH_END
        PH_BEGIN(5)
            for (;;) {
                if (C.tid == 0) *sIdx = (int)atomicAdd(&ctl[l], 1u);
                __syncthreads();
                const int idx = *sIdx;
                __syncthreads();
                if (idx >= N_P5) break;
                REFRESH();
                p5_unit(C, idx);
            }
        PH_END
        PH_BEGIN(7)
            SchedMerge S{WSB(WS_HB), WSB(WS_WT_G), WSB(WS_WT_OUT), WSB(WS_PA), WSB(WS_YBC), WSB(WS_PD), C.G, C.bid};
            pg8::EpiMerge E{INL(11, 4096), WSB(WS_ZB), WSB(WS_XR)}; pg8::gemm_phase(C.lds, S, E, C.tid);
        PH_END
        PH_BEGIN(8)
            SchedOne S{WSB(WS_ZB), WSB(WS_WT_O), nullptr, 1024, 1024, 0, 72, 4, 16, C.G, C.bid};
            pg8::EpiResidNorm E{l > 0 ? C.out : IN0(0), l > 0 ? C.out + (size_t)NP * DM : IN0(1), C.out, WSB(WS_HB), INL(35, 1024), (float*)(C.ws + WS_SUMSQ)}; pg8::gemm_phase(C.lds, S, E, C.tid);
        PH_END
        PH_BEGIN(10)
            SchedOne S{WSB(WS_HB), WSB(WS_WT_UP), nullptr, 1024, 1024, 0, 72, 22, 16, C.G, C.bid};
            pg8::EpiSwigluNorm E{WSB(WS_XR), (const float*)(C.ws + WS_SUMSQ)}; pg8::gemm_phase(C.lds, S, E, C.tid);
        PH_END
        PH_BEGIN(11)
            SchedOne S{WSB(WS_XR), WSB(WS_WT_DOWN), nullptr, 2816, 2816, 0, 72, 4, 44, C.G, C.bid};
            pg8::EpiResid E{C.out, C.out + (size_t)NP * DM, C.out}; pg8::gemm_phase(C.lds, S, E, C.tid);
        PH_END
    }
}

extern "C" void kernel_launch(void* const* d_in, const int* in_sizes, int n_in, void* d_out, int out_size, void* d_ws, size_t ws_size, hipStream_t stream) {
    static int grid = 0;
    if (grid == 0) {
        int dev = 0, cus = 0, per_cu = 0;
        (void)hipGetDevice(&dev);
        (void)hipDeviceGetAttribute(&cus, hipDeviceAttributeMultiprocessorCount, dev);
        (void)hipFuncSetAttribute((const void*)mk_fwd, hipFuncAttributeMaxDynamicSharedMemorySize, LDS_BYTES);
        (void)hipOccupancyMaxActiveBlocksPerMultiprocessor(&per_cu, (const void*)mk_fwd, NTHREADS, LDS_BYTES);
        if (per_cu < 1) per_cu = 1;
        grid = cus * per_cu;
        if (ws_size < WS_END || n_in != 38 || (size_t)out_size != O_END) { fprintf(stderr, "kernel_launch: bad sizes ws %zu n_in %d out %d\n", ws_size, n_in, out_size); grid = -1; }
    }
    if (grid < 0) return;
    Args a{};
    for (int i = 0; i < 38; ++i) a.in[i] = (const float*)d_in[i];
    a.out = (float*)d_out; a.ws = (unsigned char*)d_ws; a.ph_lo = 0; a.ph_hi = 1000;
    void* kargs[] = {&a};
    hipError_t e = hipLaunchCooperativeKernel((const void*)mk_fwd, dim3(grid), dim3(NTHREADS), kargs, LDS_BYTES, stream);
    if (e != hipSuccess) fprintf(stderr, "cooperative launch failed: %s (grid %d)\n", hipGetErrorString(e), grid);
}
```

```cpp
#include <hip/hip_runtime.h>
#include <hip/hip_cooperative_groups.h>
#include <cstdio>
#include <cstdint>
namespace cg = cooperative_groups;

#define LAS __attribute__((address_space(3)))
#define GAS __attribute__((address_space(1)))
typedef unsigned short bf16_t;
typedef short bf16x8 __attribute__((ext_vector_type(8)));
typedef float f32x4 __attribute__((ext_vector_type(4)));
typedef unsigned u32x4 __attribute__((ext_vector_type(4)));
typedef unsigned u32x2 __attribute__((ext_vector_type(2)));

constexpr int NTHREADS = 512, NWAVES = 8;
constexpr int LDS_BYTES = 155648;
constexpr int NP = 16384, NS = 2048, R = NP + NS;
constexpr int TP = 8192, TS = 64, BP = 2, BS = 32, PAST = 2048, KS_ALL = PAST + TS;
constexpr int DM = 1024, FF = 2816;
constexpr int IN_COLS = 9384;
constexpr float EPS = 1e-6f;
constexpr float LOG2E = 1.4426950408889634f;

constexpr size_t O_Y = 0;
constexpr size_t O_SSM_P = (size_t)R * DM;
constexpr size_t O_SSM_S = O_SSM_P + 262144;
constexpr size_t O_CONV_P = O_SSM_S + 4194304;
constexpr size_t O_CONV_S = O_CONV_P + 12288;
constexpr size_t O_CKV_P = O_CONV_S + 196608;
constexpr size_t O_CKV_S = O_CKV_P + 8388608;
constexpr size_t O_KPE_P = O_CKV_S + 1048576;
constexpr size_t O_KPE_S = O_KPE_P + 1048576;
constexpr size_t O_SC_P = O_KPE_S + 131072;
constexpr size_t O_SC_S = O_SC_P + 4096;
constexpr size_t O_BK_P = O_SC_S + 65536;
constexpr size_t O_BK_S = O_BK_P + 1048576;
constexpr size_t O_BV_P = O_BK_S + 16777216;
constexpr size_t O_BV_S = O_BV_P + 1048576;
constexpr size_t O_END = O_BV_S + 16777216;

constexpr size_t al256(size_t x) { return (x + 255) & ~(size_t)255; }
constexpr size_t WS_CTL = 0;
constexpr size_t WS_DECAY = 4096;
constexpr size_t WS_SUMSQ = 16384;
constexpr size_t WS_WT_IN = 131072;
constexpr size_t WS_WT_G = WS_WT_IN + (size_t)5376 * 1024 * 2;
constexpr size_t WS_WT_QUP = WS_WT_G + (size_t)4096 * 1024 * 2;
constexpr size_t WS_WT_KVUP = WS_WT_QUP + (size_t)768 * 384 * 2;
constexpr size_t WS_WT_OUT = WS_WT_KVUP + (size_t)1024 * 256 * 2;
constexpr size_t WS_WT_O = WS_WT_OUT + (size_t)4 * 1024 * 1024 * 2;
constexpr size_t WS_WT_UP = WS_WT_O + (size_t)1024 * 1024 * 2;
constexpr size_t WS_WT_DOWN = WS_WT_UP + (size_t)5632 * 1024 * 2;
constexpr size_t WS_HB = al256(WS_WT_DOWN + (size_t)1024 * 2816 * 2);
constexpr size_t WS_PA = WS_HB + (size_t)R * 1024 * 2;
constexpr size_t WS_PD = WS_PA + (size_t)R * 1536 * 2;
constexpr size_t WS_ZB = WS_PD + (size_t)R * 1536 * 2;
constexpr size_t WS_CKVP = WS_ZB + (size_t)R * 768 * 2;
constexpr size_t WS_XR = WS_ZB + (size_t)R * 1024 * 2;
constexpr size_t WS_Q = WS_XR + (size_t)67584 * 1024 * 2;
constexpr size_t WS_KPEP = WS_Q + (size_t)R * 768 * 2;
constexpr size_t WS_KPES = WS_KPEP + (size_t)16384 * 32 * 2;
constexpr size_t WS_KVP = WS_KPES + (size_t)67584 * 32 * 2;
constexpr size_t WS_STATES = WS_KVP + (size_t)16384 * 1024 * 2;
constexpr size_t WS_YBC = WS_STATES + (size_t)2048 * 64 * 128 * 2;
constexpr size_t WS_CKVS = WS_YBC + (size_t)R * 1024 * 2;
constexpr size_t WS_END = WS_CKVS + (size_t)67584 * 256 * 2;
static_assert(WS_END < (size_t)553000000, "ws map too large");
static_assert((size_t)R * 768 * 2 + (size_t)16384 * 256 * 2 <= (size_t)R * 1024 * 2, "ZB");
static_assert((size_t)67584 * 256 * 2 <= (size_t)R * 1024 * 2, "ckvS in HB");

__device__ __forceinline__ unsigned f2bf(float f) { unsigned u = __builtin_bit_cast(unsigned, f); return (u + 0x7fffu + ((u >> 16) & 1u)) >> 16; }
__device__ __forceinline__ unsigned pk2(float lo, float hi) { return f2bf(lo) | (f2bf(hi) << 16); }
__device__ __forceinline__ float bflo(unsigned u) { return __builtin_bit_cast(float, u << 16); }
__device__ __forceinline__ float bfhi(unsigned u) { return __builtin_bit_cast(float, u & 0xffff0000u); }
__device__ __forceinline__ float bf1(bf16_t h) { return __builtin_bit_cast(float, (unsigned)h << 16); }
__device__ __forceinline__ float fexp2(float x) { return __builtin_amdgcn_exp2f(x); }
__device__ __forceinline__ float fexp(float x) { return __builtin_amdgcn_exp2f(x * LOG2E); }
__device__ __forceinline__ float frcp(float x) { return __builtin_amdgcn_rcpf(x); }
__device__ __forceinline__ float sigmoidf_(float x) { return frcp(1.f + fexp(-x)); }
__device__ __forceinline__ float siluf_(float x) { return x * sigmoidf_(x); }
__device__ __forceinline__ float wave_sum(float v) {
#pragma unroll
    for (int o = 1; o < 64; o <<= 1) v += __shfl_xor(v, o);
    return v;
}
#define LDS_WAIT() asm volatile("s_waitcnt lgkmcnt(0)" ::: "memory")
__device__ __forceinline__ void unpack8(u32x4 v, float* f) {
    f[0] = bflo(v.x); f[1] = bfhi(v.x); f[2] = bflo(v.y); f[3] = bfhi(v.y); f[4] = bflo(v.z); f[5] = bfhi(v.z); f[6] = bflo(v.w); f[7] = bfhi(v.w);
}
__device__ __forceinline__ u32x4 pack8(const float* f) { u32x4 o; o.x = pk2(f[0], f[1]); o.y = pk2(f[2], f[3]); o.z = pk2(f[4], f[5]); o.w = pk2(f[6], f[7]); return o; }
__device__ __forceinline__ u32x4 load8(const void* base, size_t idx, bool is_f32) {
    if (is_f32) { const f32x4* p = (const f32x4*)((const float*)base + idx); f32x4 a = p[0], b = p[1];
        u32x4 o; o.x = pk2(a.x, a.y); o.y = pk2(a.z, a.w); o.z = pk2(b.x, b.y); o.w = pk2(b.z, b.w); return o; }
    return *(const u32x4*)((const bf16_t*)base + idx);
}

namespace pg8 {
constexpr int BM = 256, BK = 64, HALF = 128, HTB = HALF * BK * 2, STAGE_BYTES = 8 * HTB, NXCD = 8, WGM = 8;
__device__ __forceinline__ int lds_byte(int r, int c) { const int st = (r >> 4) * 2 + (c >> 5), rr = r & 15, cc = c & 31, ob = rr * 64 + cc * 2; return st * 1024 + (ob ^ (((ob >> 9) & 1) << 5)); }
__device__ __forceinline__ void stage_rc(int b, int& Rr, int& C) { const int st = b / 1024, sb = b % 1024, swz = sb ^ (((sb >> 9) & 1) << 5); Rr = (st >> 1) * 16 + swz / 64; C = (st & 1) * 32 + (swz % 64) / 2; }
__device__ __forceinline__ int perm32(int rho) { const int n = rho >> 4, i = rho & 15; return 8 * (i >> 2) + 4 * n + (i & 3); }

struct GUnit { const bf16_t* A; const bf16_t* B; int lda, ldb, nt; int pm, pn, sub; bf16_t* C; int ldc; };

__device__ __forceinline__ void tile_map(int L, int nM, int nN, int& pm, int& pn) {
    const int nwg = nM * nN; int wgid = L;
    { const int q = nwg / NXCD, r = nwg % NXCD, xcd = wgid % NXCD, off = wgid / NXCD; wgid = (xcd < r ? xcd * (q + 1) : r * (q + 1) + (xcd - r) * q) + off; }
    const int nig = WGM * nN, gid = wgid / nig, fm = gid * WGM, gsz = (nM - fm) < WGM ? (nM - fm) : WGM;
    pm = fm + ((wgid % nig) % gsz); pn = (wgid % nig) / gsz;
}
typedef float f32x2_t __attribute__((ext_vector_type(2)));
typedef __bf16 bf16x2_t __attribute__((ext_vector_type(2)));
__device__ __forceinline__ unsigned cvt_pk_bf16(float lo, float hi) { f32x2_t v = {lo, hi}; bf16x2_t b = __builtin_convertvector(v, bf16x2_t); return __builtin_bit_cast(unsigned, b); }

template <class Epi, class Sched>
__device__ __forceinline__ void gemm_phase(LAS unsigned char* lds, const Sched& S, Epi& E, int tid) {
    const int wid = __builtin_amdgcn_readfirstlane(tid >> 6), lane = tid & 63, wr = wid >> 2, wc = wid & 3, fr = lane & 15, fq = lane >> 4;
    int RA[2], RB[2], CC[2];
#pragma unroll
    for (int i = 0; i < 2; ++i) { int Rr, C; stage_rc(tid * 16 + i * 8192, Rr, C); RA[i] = Rr; RB[i] = (Rr & ~31) + perm32(Rr & 31); CC[i] = C; }
    const size_t kstep = (size_t)(BK * 2);
    const unsigned ldsw = (unsigned)wid * 1024u;
    const int aoff = lds_byte(wr * 64 + fr, fq * 8), boff = lds_byte(wc * 32 + fr, fq * 8);
#define PG8_SA(b, h) (((b) * 2 + (h)) * HTB)
#define PG8_SB(b, h) ((4 + (b) * 2 + (h)) * HTB)
#define PG8_STAGE(bufoff, gbase, v0, v1) do { \
        __builtin_amdgcn_global_load_lds((const unsigned*)((const char*)(gbase) + (v0)), (LAS unsigned*)(lds + (bufoff) + ldsw), 16, 0, 0); \
        __builtin_amdgcn_global_load_lds((const unsigned*)((const char*)(gbase) + (v1)), (LAS unsigned*)(lds + (bufoff) + ldsw + 8192), 16, 0, 0); } while (0)
#define PG8_LDA(dst, b, h) do { _Pragma("unroll") for (int m = 0; m < 4; ++m) _Pragma("unroll") for (int k = 0; k < 2; ++k) dst[m][k] = *(const LAS bf16x8*)(lds + PG8_SA(b, h) + aoff + m * 2048 + k * 1024); } while (0)
#define PG8_LDB(dst, b, h) do { _Pragma("unroll") for (int n = 0; n < 2; ++n) _Pragma("unroll") for (int k = 0; k < 2; ++k) dst[n][k] = *(const LAS bf16x8*)(lds + PG8_SB(b, h) + boff + n * 2048 + k * 1024); } while (0)
#define PG8_MMA(ai, bj, At, Bt) do { __builtin_amdgcn_s_setprio(1); _Pragma("unroll") for (int m = 0; m < 4; ++m) _Pragma("unroll") for (int n = 0; n < 2; ++n) _Pragma("unroll") for (int k = 0; k < 2; ++k) \
        acc[ai][bj][m][n] = __builtin_amdgcn_mfma_f32_16x16x32_bf16(Bt[n][k], At[m][k], acc[ai][bj][m][n], 0, 0, 0); __builtin_amdgcn_s_setprio(0); } while (0)
#define PG8_WAIT_V(n) asm volatile("s_waitcnt vmcnt(" #n ")" ::: "memory")
#define PG8_WAIT_L(n) asm volatile("s_waitcnt lgkmcnt(" #n ")" ::: "memory")
#define PG8_BAR __builtin_amdgcn_s_barrier()
#define PG8_SCHED __builtin_amdgcn_sched_barrier(0)
    GUnit cur, nxt; int ui = 0;
    if (!S.next(0, cur)) return;
    f32x4 acc[2][2][4][2];
#pragma unroll
    for (int a = 0; a < 2; ++a)
#pragma unroll
        for (int b = 0; b < 2; ++b)
#pragma unroll
            for (int m = 0; m < 4; ++m)
#pragma unroll
                for (int n = 0; n < 2; ++n) acc[a][b][m][n] = (f32x4){0.f, 0.f, 0.f, 0.f};
    bf16x8 At[4][2], B0[2][2], B1[2][2];
    const char* cA = (const char*)cur.A; const char* cB = (const char*)cur.B;
    int clda = cur.lda, cldb = cur.ldb;
#define VA0(ld) ((unsigned)(RA[0] * (ld) + CC[0]) * 2u)
#define VA1(ld) ((unsigned)(RA[1] * (ld) + CC[1]) * 2u)
#define VB0(ld) ((unsigned)(RB[0] * (ld) + CC[0]) * 2u)
#define VB1(ld) ((unsigned)(RB[1] * (ld) + CC[1]) * 2u)
    unsigned vAc0 = VA0(clda), vAc1 = VA1(clda), vBc0 = VB0(cldb), vBc1 = VB1(cldb);
    size_t hsAc = (size_t)HALF * clda * 2, hsBc = (size_t)HALF * cldb * 2;
    PG8_STAGE(PG8_SB(0, 0), cB, vBc0, vBc1); PG8_STAGE(PG8_SB(0, 1), cB + hsBc, vBc0, vBc1); PG8_STAGE(PG8_SA(0, 0), cA, vAc0, vAc1); PG8_STAGE(PG8_SA(0, 1), cA + hsAc, vAc0, vAc1);
    if (wr == 1) PG8_BAR;
    PG8_WAIT_V(2); PG8_BAR;
    PG8_STAGE(PG8_SB(1, 0), cB + kstep, vBc0, vBc1); PG8_STAGE(PG8_SA(1, 0), cA + kstep, vAc0, vAc1); PG8_STAGE(PG8_SB(1, 1), cB + hsBc + kstep, vBc0, vBc1);
    PG8_WAIT_V(6); PG8_BAR;
    for (;;) {
        const bool has_next = S.next(ui + 1, nxt);
        const char* nA = has_next ? (const char*)nxt.A : cA; const char* nB = has_next ? (const char*)nxt.B : cB;
        const int nlda = has_next ? nxt.lda : cur.lda, nldb = has_next ? nxt.ldb : cur.ldb;
        const size_t hsAn = (size_t)HALF * nlda * 2, hsBn = (size_t)HALF * nldb * 2;
        const int nt = cur.nt;
        for (int t = 0; t < nt; t += 2) {
            const bool last = (t == nt - 2);
            const char* a1 = cA + (size_t)(t + 1) * kstep;
            const char* a2 = last ? nA : cA + (size_t)(t + 2) * kstep; const char* b2 = last ? nB : cB + (size_t)(t + 2) * kstep;
            const char* a3 = a2 + kstep; const char* b3 = b2 + kstep;
            const int lda2 = last ? nlda : clda, ldb2 = last ? nldb : cldb;
            const unsigned vA0 = VA0(lda2), vA1 = VA1(lda2), vB0 = VB0(ldb2), vB1 = VB1(ldb2);
            vAc0 = VA0(clda); vAc1 = VA1(clda);
            const size_t hsA2 = last ? hsAn : hsAc, hsB2 = last ? hsBn : hsBc;
            PG8_LDB(B0, 0, 0); PG8_LDB(B1, 0, 1); PG8_SCHED; PG8_LDA(At, 0, 0); PG8_STAGE(PG8_SA(1, 1), a1 + hsAc, vAc0, vAc1);
            PG8_WAIT_V(8); PG8_WAIT_L(0); PG8_BAR; PG8_MMA(0, 0, At, B0); PG8_MMA(0, 1, At, B1); PG8_BAR; PG8_SCHED;
            PG8_LDA(At, 0, 1); PG8_STAGE(PG8_SB(0, 0), b2, vB0, vB1); PG8_STAGE(PG8_SB(0, 1), b2 + hsB2, vB0, vB1); PG8_STAGE(PG8_SA(0, 0), a2, vA0, vA1);
            PG8_WAIT_V(8); PG8_WAIT_L(0); PG8_BAR; PG8_MMA(1, 0, At, B0); PG8_MMA(1, 1, At, B1); PG8_BAR; PG8_SCHED;
            PG8_LDB(B0, 1, 0); PG8_LDB(B1, 1, 1); PG8_SCHED; PG8_LDA(At, 1, 0); PG8_STAGE(PG8_SA(0, 1), a2 + hsA2, vA0, vA1);
            PG8_WAIT_V(8); PG8_WAIT_L(0); PG8_BAR; PG8_MMA(0, 0, At, B0); PG8_MMA(0, 1, At, B1); PG8_BAR; PG8_SCHED;
            PG8_LDA(At, 1, 1); PG8_STAGE(PG8_SB(1, 0), b3, vB0, vB1); PG8_STAGE(PG8_SB(1, 1), b3 + hsB2, vB0, vB1); PG8_STAGE(PG8_SA(1, 0), a3, vA0, vA1);
            PG8_WAIT_V(8); PG8_WAIT_L(0); PG8_BAR; PG8_MMA(1, 0, At, B0); PG8_MMA(1, 1, At, B1); PG8_BAR; PG8_SCHED;
        }
        if (wr == 0) PG8_BAR;
        const bool clear = E(acc, cur, wr, wc, fr, fq);
        if (!has_next) break;
        if (clear) {
#pragma unroll
        for (int a = 0; a < 2; ++a)
#pragma unroll
            for (int b = 0; b < 2; ++b)
#pragma unroll
                for (int m = 0; m < 4; ++m)
#pragma unroll
                    for (int n = 0; n < 2; ++n) acc[a][b][m][n] = (f32x4){0.f, 0.f, 0.f, 0.f};
        }
        cur = nxt; cA = nA; cB = nB; ++ui;
        clda = nlda; cldb = nldb; vAc0 = VA0(clda); vAc1 = VA1(clda); hsAc = hsAn; hsBc = hsBn;
        if (wr == 1) PG8_BAR;
    }
    PG8_WAIT_V(0);
    PG8_BAR;
#undef VA0
#undef VA1
#undef VB0
#undef VB1
#undef PG8_SA
#undef PG8_SB
#undef PG8_STAGE
#undef PG8_LDA
#undef PG8_LDB
#undef PG8_MMA
#undef PG8_WAIT_V
#undef PG8_WAIT_L
#undef PG8_BAR
#undef PG8_SCHED
}

struct EpiStore {
    __device__ __forceinline__ bool operator()(const f32x4 (&acc)[2][2][4][2], const GUnit& u, int wr, int wc, int fr, int fq) {
#pragma unroll
        for (int ai = 0; ai < 2; ++ai)
#pragma unroll
            for (int m = 0; m < 4; ++m) { bf16_t* rowp = u.C + (size_t)(ai * HALF + wr * 64 + m * 16 + fr) * u.ldc + wc * 32 + 8 * fq;
#pragma unroll
                for (int bj = 0; bj < 2; ++bj) { const f32x4 v0 = acc[ai][bj][m][0], v1 = acc[ai][bj][m][1];
                    u32x4 w; w.x = cvt_pk_bf16(v0[0], v0[1]); w.y = cvt_pk_bf16(v0[2], v0[3]); w.z = cvt_pk_bf16(v1[0], v1[1]); w.w = cvt_pk_bf16(v1[2], v1[3]);
                    *(GAS u32x4*)(rowp + bj * HALF) = w; } }
        return true;
    }
};
struct EpiResid {
    const float* xp; const float* xs; float* out;
    __device__ __forceinline__ bool operator()(const f32x4 (&acc)[2][2][4][2], const GUnit& u, int wr, int wc, int fr, int fq) {
        const unsigned off0 = (unsigned)(wr * 64 + fr) * DM + u.pn * 256 + wc * 32 + 8 * fq;
        const float* xin = ((u.pm < 64) ? xp + (size_t)u.pm * 256 * DM : xs + (size_t)(u.pm - 64) * 256 * DM) + off0;
        float* o = out + (size_t)u.pm * 256 * DM + off0;
#pragma unroll
        for (int ai = 0; ai < 2; ++ai)
#pragma unroll
            for (int m = 0; m < 4; ++m)
#pragma unroll
                for (int bj = 0; bj < 2; ++bj) { const unsigned ro = (unsigned)(ai * HALF + m * 16) * DM + bj * HALF;
                    const f32x4 x0 = *(const GAS f32x4*)(xin + ro), x1 = *(const GAS f32x4*)(xin + ro + 4);
                    *(GAS f32x4*)(o + ro) = x0 + acc[ai][bj][m][0]; *(GAS f32x4*)(o + ro + 4) = x1 + acc[ai][bj][m][1]; }
        return true;
    }
};
struct EpiResidNorm {
    const float* xp; const float* xs; float* out; bf16_t* hbo; const float* g2; float* sumsq;
    __device__ __forceinline__ bool operator()(const f32x4 (&acc)[2][2][4][2], const GUnit& u, int wr, int wc, int fr, int fq) {
        const unsigned col0 = u.pn * 256 + wc * 32 + 8 * fq;
        const unsigned off0 = (unsigned)(wr * 64 + fr) * DM + col0;
        const float* xin = ((u.pm < 64) ? xp + (size_t)u.pm * 256 * DM : xs + (size_t)(u.pm - 64) * 256 * DM) + off0;
        float* o = out + (size_t)u.pm * 256 * DM + off0;
        bf16_t* ho = hbo + (size_t)u.pm * 256 * DM + off0;
        f32x4 gg[2][2];
#pragma unroll
        for (int bj = 0; bj < 2; ++bj) { gg[bj][0] = *(const GAS f32x4*)(g2 + col0 + bj * HALF); gg[bj][1] = *(const GAS f32x4*)(g2 + col0 + bj * HALF + 4); }
#pragma unroll
        for (int ai = 0; ai < 2; ++ai)
#pragma unroll
            for (int m = 0; m < 4; ++m) { float ss = 0.f;
#pragma unroll
                for (int bj = 0; bj < 2; ++bj) { const unsigned ro = (unsigned)(ai * HALF + m * 16) * DM + bj * HALF;
                    const f32x4 x0 = *(const GAS f32x4*)(xin + ro) + acc[ai][bj][m][0], x1 = *(const GAS f32x4*)(xin + ro + 4) + acc[ai][bj][m][1];
                    *(GAS f32x4*)(o + ro) = x0; *(GAS f32x4*)(o + ro + 4) = x1;
                    ss += (x0[0] * x0[0] + x0[1] * x0[1]) + (x0[2] * x0[2] + x0[3] * x0[3]) + (x1[0] * x1[0] + x1[1] * x1[1]) + (x1[2] * x1[2] + x1[3] * x1[3]);
                    const f32x4 h0 = x0 * gg[bj][0], h1 = x1 * gg[bj][1]; u32x4 w;
                    w.x = cvt_pk_bf16(h0[0], h0[1]); w.y = cvt_pk_bf16(h0[2], h0[3]); w.z = cvt_pk_bf16(h1[0], h1[1]); w.w = cvt_pk_bf16(h1[2], h1[3]);
                    *(GAS u32x4*)(ho + ro) = w; }
                ss += __shfl_xor(ss, 16); ss += __shfl_xor(ss, 32);
                if (fq == 0) atomicAdd(sumsq + u.pm * 256 + ai * HALF + wr * 64 + m * 16 + fr, ss); }
        return true;
    }
};
struct EpiSwigluNorm {
    bf16_t* act; const float* sumsq;
    __device__ __forceinline__ bool operator()(const f32x4 (&acc)[2][2][4][2], const GUnit& u, int wr, int wc, int fr, int fq) {
#pragma unroll
        for (int ai = 0; ai < 2; ++ai)
#pragma unroll
            for (int m = 0; m < 4; ++m) { const int row = u.pm * 256 + ai * HALF + wr * 64 + m * 16 + fr;
                const float rs = 1.f / sqrtf(*(const GAS float*)(sumsq + row) * (1.f / DM) + EPS);
                bf16_t* rowp = act + (size_t)row * FF + u.pn * 128 + wc * 32 + 8 * fq;
                float o[8];
#pragma unroll
                for (int n = 0; n < 2; ++n)
#pragma unroll
                    for (int i = 0; i < 4; ++i) o[4 * n + i] = siluf_(rs * acc[ai][0][m][n][i]) * (rs * acc[ai][1][m][n][i]);
                u32x4 w; w.x = cvt_pk_bf16(o[0], o[1]); w.y = cvt_pk_bf16(o[2], o[3]); w.z = cvt_pk_bf16(o[4], o[5]); w.w = cvt_pk_bf16(o[6], o[7]);
                *(GAS u32x4*)rowp = w; }
        return true;
    }
};
struct EpiSwiglu {
    bf16_t* act;
    __device__ __forceinline__ bool operator()(const f32x4 (&acc)[2][2][4][2], const GUnit& u, int wr, int wc, int fr, int fq) {
#pragma unroll
        for (int ai = 0; ai < 2; ++ai)
#pragma unroll
            for (int m = 0; m < 4; ++m) { bf16_t* rowp = act + (size_t)(u.pm * 256 + ai * HALF + wr * 64 + m * 16 + fr) * FF + u.pn * 128 + wc * 32 + 8 * fq;
                float o[8];
#pragma unroll
                for (int n = 0; n < 2; ++n)
#pragma unroll
                    for (int i = 0; i < 4; ++i) o[4 * n + i] = siluf_(acc[ai][0][m][n][i]) * acc[ai][1][m][n][i];
                u32x4 w; w.x = cvt_pk_bf16(o[0], o[1]); w.y = cvt_pk_bf16(o[2], o[3]); w.z = cvt_pk_bf16(o[4], o[5]); w.w = cvt_pk_bf16(o[6], o[7]);
                *(GAS u32x4*)rowp = w; }
        return true;
    }
};
struct EpiMerge {
    const float* bgate; bf16_t* merged; bf16_t* gtmp;
    __device__ __forceinline__ bool operator()(const f32x4 (&acc)[2][2][4][2], const GUnit& u, int wr, int wc, int fr, int fq) {
        const int br = u.sub >> 1;
        const unsigned off0 = (unsigned)(u.pm * 256 + wr * 64 + fr) * DM + u.pn * 256 + wc * 32 + 8 * fq;
        if ((u.sub & 1) == 0) {
#pragma unroll
            for (int bj = 0; bj < 2; ++bj) { const float* bp = bgate + br * 1024 + u.pn * 256 + bj * HALF + wc * 32 + 8 * fq;
                const f32x4 b0 = *(const GAS f32x4*)bp, b1 = *(const GAS f32x4*)(bp + 4);
#pragma unroll
                for (int ai = 0; ai < 2; ++ai)
#pragma unroll
                    for (int m = 0; m < 4; ++m) { const f32x4 v0 = acc[ai][bj][m][0] + b0, v1 = acc[ai][bj][m][1] + b1; u32x4 w;
                        w.x = cvt_pk_bf16(sigmoidf_(v0[0]), sigmoidf_(v0[1])); w.y = cvt_pk_bf16(sigmoidf_(v0[2]), sigmoidf_(v0[3]));
                        w.z = cvt_pk_bf16(sigmoidf_(v1[0]), sigmoidf_(v1[1])); w.w = cvt_pk_bf16(sigmoidf_(v1[2]), sigmoidf_(v1[3]));
                        *(GAS u32x4*)(gtmp + off0 + (unsigned)(ai * HALF + m * 16) * DM + bj * HALF) = w; } }
        } else {
#pragma unroll
            for (int ai = 0; ai < 2; ++ai)
#pragma unroll
                for (int m = 0; m < 4; ++m)
#pragma unroll
                    for (int bj = 0; bj < 2; ++bj) { const unsigned off = off0 + (unsigned)(ai * HALF + m * 16) * DM + bj * HALF;
                        const u32x4 gg = *(const GAS u32x4*)(gtmp + off); u32x4 mm = (u32x4){0u, 0u, 0u, 0u}; if (br > 0) mm = *(const GAS u32x4*)(merged + off);
                        const f32x4 a0 = acc[ai][bj][m][0], a1 = acc[ai][bj][m][1]; u32x4 w;
                        w.x = cvt_pk_bf16(bflo(mm.x) + bflo(gg.x) * a0[0], bfhi(mm.x) + bfhi(gg.x) * a0[1]); w.y = cvt_pk_bf16(bflo(mm.y) + bflo(gg.y) * a0[2], bfhi(mm.y) + bfhi(gg.y) * a0[3]);
                        w.z = cvt_pk_bf16(bflo(mm.z) + bflo(gg.z) * a1[0], bfhi(mm.z) + bfhi(gg.z) * a1[1]); w.w = cvt_pk_bf16(bflo(mm.w) + bflo(gg.w) * a1[2], bfhi(mm.w) + bfhi(gg.w) * a1[3]);
                        *(GAS u32x4*)(merged + off) = w; }
        }
        return true;
    }
};
}

struct Args { const float* in[38]; float* out; unsigned char* ws; int ph_lo, ph_hi; };
struct Ctx {
    const Args* A; float* out; unsigned char* ws; LAS unsigned char* lds;
    int tid, lane, wave, gw, NGW, l, G, bid;
};
#define WSB(off) ((bf16_t*)(C.ws + (off)))
#define INL(i, sz) (C.A->in[i] + (size_t)C.l * (size_t)(sz))
#define IN0(i) (C.A->in[i])

using pg8::GUnit;
struct SchedOne {
    const bf16_t* A; const bf16_t* B; bf16_t* Cp; int lda, ldb, ldc, nM, nN, nt, G, c;
    __device__ __forceinline__ bool next(int i, GUnit& u) const {
        const long L = (long)i * G + c; if (L >= (long)nM * nN) return false;
        int pm, pn; pg8::tile_map((int)L, nM, nN, pm, pn);
        u.A = A + (size_t)pm * 256 * lda; u.B = B + (size_t)pn * 256 * ldb; u.lda = lda; u.ldb = ldb; u.nt = nt; u.pm = pm; u.pn = pn; u.sub = 0;
        u.C = Cp ? Cp + (size_t)pm * 256 * ldc + (size_t)pn * 256 : nullptr; u.ldc = ldc; return true;
    }
};
struct SchedInproj {
    const bf16_t* A; const bf16_t* B; bf16_t *pA, *pB, *pC, *pD; int G, c;
    __device__ __forceinline__ bool next(int i, GUnit& u) const {
        const long L = (long)i * G + c; if (L >= 72 * 21) return false;
        int pm, pn; pg8::tile_map((int)L, 72, 21, pm, pn);
        u.A = A + (size_t)pm * 256 * 1024; u.B = B + (size_t)pn * 256 * 1024; u.lda = 1024; u.ldb = 1024; u.nt = 16; u.pm = pm; u.pn = pn; u.sub = 0;
        if (pn < 6) { u.C = pA + (size_t)pm * 256 * 1536 + pn * 256; u.ldc = 1536; }
        else if (pn < 9) { u.C = pB + (size_t)pm * 256 * 768 + (pn - 6) * 256; u.ldc = 768; }
        else if (pn < 15) { u.C = pC + (size_t)pm * 256 * 1536 + (pn - 9) * 256; u.ldc = 1536; }
        else { u.C = pD + (size_t)pm * 256 * 1536 + (pn - 15) * 256; u.ldc = 1536; }
        return true;
    }
};
struct SchedP3 {
    const bf16_t *pB, *wq, *ckvP, *ckvS, *wkv; bf16_t *Q, *KVP, *KVS; int G, c;
    __device__ __forceinline__ bool next(int i, GUnit& u) const {
        long L = (long)i * G + c; int pm, pn; u.sub = 0;
        if (L < 264 * 4) { pg8::tile_map((int)L, 264, 4, pm, pn); u.A = ckvS + (size_t)pm * 256 * 256; u.B = wkv + (size_t)pn * 256 * 256; u.lda = 256; u.ldb = 256; u.nt = 4;
            u.C = KVS + (size_t)pm * 256 * 1024 + pn * 256; u.ldc = 1024; u.pm = pm; u.pn = pn; return true; }
        L -= 264 * 4;
        if (L < 64 * 4) { pg8::tile_map((int)L, 64, 4, pm, pn); u.A = ckvP + (size_t)pm * 256 * 256; u.B = wkv + (size_t)pn * 256 * 256; u.lda = 256; u.ldb = 256; u.nt = 4;
            u.C = KVP + (size_t)pm * 256 * 1024 + pn * 256; u.ldc = 1024; u.pm = pm; u.pn = pn; return true; }
        L -= 64 * 4;
        if (L < 72 * 3) { pg8::tile_map((int)L, 72, 3, pm, pn); u.A = pB + (size_t)pm * 256 * 768; u.B = wq + (size_t)pn * 256 * 384; u.lda = 768; u.ldb = 384; u.nt = 6;
            u.C = Q + (size_t)pm * 256 * 768 + pn * 256; u.ldc = 768; u.pm = pm; u.pn = pn; return true; }
        return false;
    }
};
struct SchedMerge {
    const bf16_t *hb, *wg, *wout, *pA, *ybc, *pD; int G, c;
    __device__ __forceinline__ bool next(int i, GUnit& u) const {
        const long L = (long)(i >> 3) * G + c; if (L >= 72 * 4) return false;
        int pm, pn; pg8::tile_map((int)L, 72, 4, pm, pn); const int sub = i & 7, br = sub >> 1;
        u.pm = pm; u.pn = pn; u.sub = sub; u.C = nullptr; u.ldc = 0; u.ldb = 1024;
        if ((sub & 1) == 0) { u.A = hb + (size_t)pm * 256 * 1024; u.lda = 1024; u.nt = 16; u.B = wg + (size_t)(br * 1024 + pn * 256) * 1024; }
        else { u.nt = 8; u.B = wout + (size_t)(br * 1024 + pn * 256) * 1024;
            if (br == 0) { u.A = pA + (size_t)pm * 256 * 1536; u.lda = 1536; }
            else if (br == 1) { u.A = ybc + (size_t)pm * 256 * 1024; u.lda = 1024; }
            else if (br == 2) { u.A = ybc + (size_t)pm * 256 * 1024 + 512; u.lda = 1024; }
            else { u.A = pD + (size_t)pm * 256 * 1536; u.lda = 1536; } }
        return true;
    }
};

template <class Map>
__device__ __forceinline__ void transpose_w(const Ctx& C, const float* W, int ldw, int K, int Nout, bf16_t* WT, int ldt, Map map) {
    LAS float* scr = (LAS float*)(C.lds + C.wave * 8704);
    const int lane = C.lane, nblk = Nout / 32, items = (K / 64) * nblk;
    for (int it = C.gw; it < items; it += C.NGW) {
        const int kb = it / nblk, nb = it % nblk, k0 = 64 * kb, n0 = 32 * nb;
        const int col = map(n0 + (lane & 31));
#pragma unroll 8
        for (int i = 0; i < 32; ++i) { const int kk = 2 * i + (lane >> 5); scr[kk * 33 + (lane & 31)] = (col >= 0) ? W[(size_t)(k0 + kk) * ldw + col] : 0.f; }
        LDS_WAIT();
        const int c = lane & 7;
#pragma unroll
        for (int j = 0; j < 4; ++j) { const int n = (lane >> 3) + 8 * j; const LAS float* s = scr + (8 * c) * 33 + n;
            u32x4 o; o.x = pk2(s[0 * 33], s[1 * 33]); o.y = pk2(s[2 * 33], s[3 * 33]); o.z = pk2(s[4 * 33], s[5 * 33]); o.w = pk2(s[6 * 33], s[7 * 33]);
            *(u32x4*)(WT + (size_t)(n0 + n) * ldt + k0 + 8 * c) = o; }
        LDS_WAIT();
    }
}
struct MapId { __device__ __forceinline__ int operator()(int n) const { return n; } };
struct MapOff { int off; __device__ __forceinline__ int operator()(int n) const { return n + off; } };
struct MapIn { __device__ __forceinline__ int operator()(int n) const { return n < 1536 ? n : (n < 2208 ? n + 8 : (n < 2216 ? n - 2208 + 1536 : (n < 2304 ? -1 : n - 88))); } };
struct MapKv { __device__ __forceinline__ int operator()(int n) const { return n < 512 ? ((n >> 6) * 128 + (n & 63)) : (((n - 512) >> 6) * 128 + 64 + (n & 63)); } };
struct MapUp { __device__ __forceinline__ int operator()(int n) const { const int t = n >> 8, w = n & 255; return w < 128 ? 128 * t + w : 2816 + 128 * t + (w - 128); } };

__device__ __forceinline__ void phase_wprep(const Ctx& C) {
    transpose_w(C, INL(10, 1024 * IN_COLS), IN_COLS, 1024, 5376, WSB(WS_WT_IN), 1024, MapIn());
    transpose_w(C, INL(10, 1024 * IN_COLS), IN_COLS, 1024, 4096, WSB(WS_WT_G), 1024, MapOff{5288});
    transpose_w(C, INL(20, 384 * 768), 768, 384, 768, WSB(WS_WT_QUP), 384, MapId());
    transpose_w(C, INL(22, 256 * 1024), 1024, 256, 1024, WSB(WS_WT_KVUP), 256, MapKv());
    transpose_w(C, INL(18, 512 * 1024), 1024, 512, 1024, WSB(WS_WT_OUT), 1024, MapId());
    transpose_w(C, INL(27, 512 * 1024), 1024, 512, 1024, WSB(WS_WT_OUT) + (size_t)1 * 1024 * 1024, 1024, MapId());
    transpose_w(C, INL(29, 512 * 1024), 1024, 512, 1024, WSB(WS_WT_OUT) + (size_t)2 * 1024 * 1024, 1024, MapId());
    transpose_w(C, INL(33, 512 * 1024), 1024, 512, 1024, WSB(WS_WT_OUT) + (size_t)3 * 1024 * 1024, 1024, MapId());
    transpose_w(C, INL(34, 1024 * 1024), 1024, 1024, 1024, WSB(WS_WT_O), 1024, MapId());
    transpose_w(C, INL(36, 1024 * 5632), 5632, 1024, 5632, WSB(WS_WT_UP), 1024, MapUp());
    transpose_w(C, INL(37, 2816 * 1024), 1024, 2816, 1024, WSB(WS_WT_DOWN), 2816, MapId());
}

__device__ __forceinline__ const float* xrow(const Ctx& C, int row, bool from_out) {
    if (from_out) return C.out + (size_t)row * DM;
    return row < NP ? IN0(0) + (size_t)row * DM : IN0(1) + (size_t)(row - NP) * DM;
}
__device__ __forceinline__ void phase_norm(const Ctx& C, const float* g, bool from_out) {
    const int lane = C.lane;
    f32x4 gv[4];
#pragma unroll
    for (int j = 0; j < 4; ++j) gv[j] = ((const f32x4*)g)[64 * j + lane];
    for (int row = C.gw; row < R; row += C.NGW) {
        const f32x4* xr = (const f32x4*)xrow(C, row, from_out) + lane;
        f32x4 v[4]; float s = 0.f;
#pragma unroll
        for (int j = 0; j < 4; ++j) { v[j] = xr[64 * j]; s += (v[j].x * v[j].x + v[j].y * v[j].y) + (v[j].z * v[j].z + v[j].w * v[j].w); }
        const float rstd = 1.f / sqrtf(wave_sum(s) * (1.f / DM) + EPS);
        u32x2* o = (u32x2*)(WSB(WS_HB) + (size_t)row * DM) + lane;
#pragma unroll
        for (int j = 0; j < 4; ++j) { u32x2 w; w.x = pk2(v[j].x * rstd * gv[j].x, v[j].y * rstd * gv[j].y); w.y = pk2(v[j].z * rstd * gv[j].z, v[j].w * rstd * gv[j].w); o[64 * j] = w; }
    }
}
__device__ __forceinline__ void rope_cs(int pos, int i, float& c, float& s) {
    const float chi = ((i & 8) ? ((i & 4) ? ((i & 2) ? ((i & 1) ? 2.831220627e-05f : 5.030632019e-05f) : ((i & 1) ? 8.952617645e-05f : 1.592636108e-04f)) : ((i & 2) ? ((i & 1) ? 2.832412720e-04f : 5.035400391e-04f) : ((i & 1) ? 8.945465088e-04f : 1.590728760e-03f))) : ((i & 4) ? ((i & 2) ? ((i & 1) ? 2.830505371e-03f : 5.035400391e-03f) : ((i & 1) ? 8.956909180e-03f : 1.593017578e-02f)) : ((i & 2) ? ((i & 1) ? 2.828979492e-02f : 5.035400391e-02f) : ((i & 1) ? 8.947753906e-02f : 1.591796875e-01f))));
    const float clo = ((i & 8) ? ((i & 4) ? ((i & 2) ? ((i & 1) ? -1.001043781e-08f : 2.289191414e-08f) : ((i & 1) ? -2.677484368e-08f : -1.086677486e-07f)) : ((i & 2) ? ((i & 1) ? -2.193136623e-07f : -2.479180239e-07f) : ((i & 1) ? 4.475072899e-07f : 8.206711755e-07f))) : ((i & 4) ? ((i & 2) ? ((i & 1) ? -2.857880190e-07f : -2.479180239e-06f) : ((i & 1) ? -6.969018614e-06f : -1.468147184e-05f)) : ((i & 2) ? ((i & 1) ? 1.240090842e-05f : -2.479180148e-05f) : ((i & 1) ? 2.186254642e-05f : -2.474440771e-05f))));
    const float pf = (float)pos, rh = pf * chi, f1 = rh - __builtin_rintf(rh), fr = f1 + pf * clo;
    c = __builtin_amdgcn_cosf(fr); s = __builtin_amdgcn_sinf(fr);
}
__device__ __forceinline__ int row_pos(int row) { return row < NP ? (row & (TP - 1)) : PAST + ((row - NP) & 63); }

__device__ __forceinline__ void phase_mla_prep(const Ctx& C) {
    const int lane = C.lane; const int l = C.l;
    const float* gq = INL(19, 384); const float* gkv = INL(21, 256); const float* gkr = INL(26, 32);
    for (int row = C.gw; row < R; row += C.NGW) {
        bf16_t* pb = WSB(WS_ZB) + (size_t)row * 768;
        unsigned q[3]; float ss = 0.f;
#pragma unroll
        for (int j = 0; j < 3; ++j) { q[j] = *(const unsigned*)(pb + 2 * lane + 128 * j); const float a = bflo(q[j]), b = bfhi(q[j]); ss += a * a + b * b; }
        float rstd = 1.f / sqrtf(wave_sum(ss) * (1.f / 384.f) + EPS);
#pragma unroll
        for (int j = 0; j < 3; ++j) { const int c = 2 * lane + 128 * j; *(unsigned*)(pb + c) = pk2(bflo(q[j]) * rstd * gq[c], bfhi(q[j]) * rstd * gq[c + 1]); }
        const u32x2 kv = *(const u32x2*)(pb + 384 + 4 * lane);
        float k0 = bflo(kv.x), k1 = bfhi(kv.x), k2 = bflo(kv.y), k3 = bfhi(kv.y);
        rstd = 1.f / sqrtf(wave_sum(k0 * k0 + k1 * k1 + k2 * k2 + k3 * k3) * (1.f / 256.f) + EPS);
        const f32x4 g4 = *(const f32x4*)(gkv + 4 * lane);
        f32x4 ck; ck.x = k0 * rstd * g4.x; ck.y = k1 * rstd * g4.y; ck.z = k2 * rstd * g4.z; ck.w = k3 * rstd * g4.w;
        u32x2 ckb; ckb.x = pk2(ck.x, ck.y); ckb.y = pk2(ck.z, ck.w);
        const int pos = row_pos(row);
        size_t srow = 0;
        if (row < NP) { *(f32x4*)(C.out + O_CKV_P + ((size_t)l * NP + row) * 256 + 4 * lane) = ck; *(u32x2*)(WSB(WS_CKVP) + (size_t)row * 256 + 4 * lane) = ckb; }
        else { const int rs = row - NP; srow = (size_t)(rs >> 6) * KS_ALL + PAST + (rs & 63);
            *(f32x4*)(C.out + O_CKV_S + ((size_t)l * NS + rs) * 256 + 4 * lane) = ck; *(u32x2*)(WSB(WS_CKVS) + srow * 256 + 4 * lane) = ckb; }
        const float x = (lane < 32) ? bf1(pb[640 + lane]) : 0.f;
        rstd = 1.f / sqrtf(wave_sum(x * x) * (1.f / 32.f) + EPS);
        const float y = x * rstd * gkr[lane & 31];
        const float part = __shfl_xor(y, 16);
        float cs, sn; rope_cs(pos, lane & 15, cs, sn);
        const float o = (lane < 16) ? (y * cs - part * sn) : (part * sn + y * cs);
        if (lane < 32) {
            if (row < NP) { C.out[O_KPE_P + ((size_t)l * NP + row) * 32 + lane] = o; WSB(WS_KPEP)[(size_t)row * 32 + lane] = (bf16_t)f2bf(o); }
            else { C.out[O_KPE_S + ((size_t)l * NS + (row - NP)) * 32 + lane] = o; WSB(WS_KPES)[srow * 32 + lane] = (bf16_t)f2bf(o); }
        }
    }
    const size_t gt = (size_t)C.bid * NTHREADS + C.tid, GT = (size_t)C.G * NTHREADS;
    { const float* src = INL(4, (size_t)BS * PAST * 256);
      for (size_t i = gt; i < (size_t)BS * PAST * 256 / 8; i += GT) { const size_t e = i * 8, b = e / ((size_t)PAST * 256), rem = e % ((size_t)PAST * 256);
          *(u32x4*)(WSB(WS_CKVS) + b * KS_ALL * 256 + rem) = load8(src, e, true); } }
    { const float* src = INL(5, (size_t)BS * PAST * 32);
      for (size_t i = gt; i < (size_t)BS * PAST * 32 / 8; i += GT) { const size_t e = i * 8, b = e / ((size_t)PAST * 32), rem = e % ((size_t)PAST * 32);
          *(u32x4*)(WSB(WS_KPES) + b * KS_ALL * 32 + rem) = load8(src, e, true); } }
}

__device__ __forceinline__ float red8(float v) { v += __shfl_xor(v, 1); v += __shfl_xor(v, 2); v += __shfl_xor(v, 4); return v; }

__device__ __forceinline__ void phase_band_prep(const Ctx& C) {
    const int lane = C.lane, l = C.l, d0 = (lane & 7) * 8;
    float gq[8], gk[8];
#pragma unroll
    for (int e = 0; e < 8; ++e) { gq[e] = INL(30, 64)[d0 + e] * (0.125f * LOG2E); gk[e] = INL(31, 64)[d0 + e]; }
    for (int row = C.gw; row < R; row += C.NGW) {
        bf16_t* pd = WSB(WS_PD) + (size_t)row * 1536 + 8 * lane;
        float f[8], kf[8], vf[8];
        unpack8(*(const u32x4*)pd, f); float ss = 0.f;
#pragma unroll
        for (int e = 0; e < 8; ++e) ss += f[e] * f[e];
        float rstd = 1.f / sqrtf(red8(ss) * (1.f / 64.f) + EPS);
#pragma unroll
        for (int e = 0; e < 8; ++e) f[e] *= rstd * gq[e];
        *(u32x4*)pd = pack8(f);
        unpack8(*(const u32x4*)(pd + 512), kf); ss = 0.f;
#pragma unroll
        for (int e = 0; e < 8; ++e) ss += kf[e] * kf[e];
        rstd = 1.f / sqrtf(red8(ss) * (1.f / 64.f) + EPS);
#pragma unroll
        for (int e = 0; e < 8; ++e) kf[e] *= rstd * gk[e];
        *(u32x4*)(pd + 512) = pack8(kf);
        unpack8(*(const u32x4*)(pd + 1024), vf);
        long dst = -1;
        if (row < NP) { const int t = row & (TP - 1), b = row >> 13; if (t >= TP - 512) dst = (long)(((size_t)(l * BP + b) * 512 + (t - (TP - 512))) * 512 + 8 * lane); }
        else { const int rs = row - NP, b = rs >> 6, t = rs & 63; dst = (long)(((size_t)(l * BS + b) * 512 + 448 + t) * 512 + 8 * lane); }
        if (dst >= 0) { float* ko = C.out + (row < NP ? O_BK_P : O_BK_S) + dst; float* vo = C.out + (row < NP ? O_BV_P : O_BV_S) + dst;
            *(f32x4*)ko = (f32x4){kf[0], kf[1], kf[2], kf[3]}; *(f32x4*)(ko + 4) = (f32x4){kf[4], kf[5], kf[6], kf[7]};
            *(f32x4*)vo = (f32x4){vf[0], vf[1], vf[2], vf[3]}; *(f32x4*)(vo + 4) = (f32x4){vf[4], vf[5], vf[6], vf[7]}; }
    }
    const size_t gt = (size_t)C.bid * NTHREADS + C.tid, GT = (size_t)C.G * NTHREADS;
    const f32x4* sk = (const f32x4*)INL(7, (size_t)BS * 512 * 512); const f32x4* sv = (const f32x4*)INL(8, (size_t)BS * 512 * 512);
    f32x4* dk = (f32x4*)(C.out + O_BK_S + (size_t)l * BS * 512 * 512); f32x4* dv = (f32x4*)(C.out + O_BV_S + (size_t)l * BS * 512 * 512);
    for (size_t i = gt; i < (size_t)BS * 448 * 128; i += GT) { const size_t b = i / (448 * 128), rem = i % (448 * 128);
        dk[b * 512 * 128 + rem] = sk[b * 512 * 128 + 64 * 128 + rem]; dv[b * 512 * 128 + rem] = sv[b * 512 * 128 + 64 * 128 + rem]; }
}

__device__ __forceinline__ void phase_sconv(const Ctx& C) {
    const int lane = C.lane, l = C.l, ch = 8 * lane;
    const float* w = INL(28, 3 * 512);
    float w0[8], w1[8], w2[8];
#pragma unroll
    for (int e = 0; e < 8; ++e) { w0[e] = w[ch + e]; w1[e] = w[512 + ch + e]; w2[e] = w[1024 + ch + e]; }
    for (int row = C.gw; row < R; row += C.NGW) {
        const bf16_t* pc = WSB(WS_XR) + (size_t)row * 1536 + ch;
        const bool pr = row < NP; const int t = pr ? (row & (TP - 1)) : ((row - NP) & 63); const int b = pr ? (row >> 13) : ((row - NP) >> 6);
        float cb[8], a[8], x[8], u0[8], u1[8], u2[8];
        unpack8(*(const u32x4*)pc, cb); unpack8(*(const u32x4*)(pc + 512), a); unpack8(*(const u32x4*)(pc + 1024), x);
#pragma unroll
        for (int e = 0; e < 8; ++e) u0[e] = a[e] * x[e];
        const float* st = INL(6, BS * 2 * 512) + (size_t)b * 2 * 512 + ch;
        if (t >= 1) { unpack8(*(const u32x4*)(pc - 1536 + 512), a); unpack8(*(const u32x4*)(pc - 1536 + 1024), x);
#pragma unroll
            for (int e = 0; e < 8; ++e) u1[e] = a[e] * x[e]; }
        else {
#pragma unroll
            for (int e = 0; e < 8; ++e) u1[e] = pr ? 0.f : st[512 + e]; }
        if (t >= 2) { unpack8(*(const u32x4*)(pc - 3072 + 512), a); unpack8(*(const u32x4*)(pc - 3072 + 1024), x);
#pragma unroll
            for (int e = 0; e < 8; ++e) u2[e] = a[e] * x[e]; }
        else {
#pragma unroll
            for (int e = 0; e < 8; ++e) u2[e] = pr ? 0.f : st[(t == 1 ? 512 : 0) + e]; }
        float y[8];
#pragma unroll
        for (int e = 0; e < 8; ++e) y[e] = cb[e] * (w0[e] * u2[e] + w1[e] * u1[e] + w2[e] * u0[e]);
        *(u32x4*)(WSB(WS_YBC) + (size_t)row * 1024 + 512 + ch) = pack8(y);
        const int T = pr ? TP : TS;
        if (t >= T - 2) { float* o = C.out + (pr ? O_SC_P + ((size_t)(l * BP + b) * 2 + (t - (T - 2))) * 512 : O_SC_S + ((size_t)(l * BS + b) * 2 + (t - (T - 2))) * 512) + ch;
            *(f32x4*)o = (f32x4){u0[0], u0[1], u0[2], u0[3]}; *(f32x4*)(o + 4) = (f32x4){u0[4], u0[5], u0[6], u0[7]}; }
    }
}

__device__ __forceinline__ void phase_qk_post(const Ctx& C) {
    const int lane = C.lane, head = lane >> 3, sub = lane & 7;
    const float SC = 0.10206207261596577f * LOG2E;
    float gn[8], gr[8], gk[8];
#pragma unroll
    for (int e = 0; e < 8; ++e) { gn[e] = INL(23, 64)[8 * sub + e] * SC; gr[e] = INL(25, 32)[8 * (sub & 3) + e]; gk[e] = INL(24, 64)[8 * sub + e]; }
    for (int row = C.gw; row < R; row += C.NGW) {
        bf16_t* qp = WSB(WS_Q) + (size_t)row * 768 + 96 * head;
        float f[8]; unpack8(*(const u32x4*)(qp + 8 * sub), f); float ss = 0.f;
#pragma unroll
        for (int e = 0; e < 8; ++e) ss += f[e] * f[e];
        float rstd = 1.f / sqrtf(red8(ss) * (1.f / 64.f) + EPS);
#pragma unroll
        for (int e = 0; e < 8; ++e) f[e] *= rstd * gn[e];
        *(u32x4*)(qp + 8 * sub) = pack8(f);
        float r[8];
        if (sub < 4) unpack8(*(const u32x4*)(qp + 64 + 8 * sub), r);
        else {
#pragma unroll
            for (int e = 0; e < 8; ++e) r[e] = 0.f; }
        ss = 0.f;
#pragma unroll
        for (int e = 0; e < 8; ++e) ss += r[e] * r[e];
        ss += __shfl_xor(ss, 1); ss += __shfl_xor(ss, 2);
        rstd = 1.f / sqrtf(ss * (1.f / 32.f) + EPS);
        const int pos = row_pos(row);
        float o[8];
#pragma unroll
        for (int e = 0; e < 8; ++e) { const float y = r[e] * rstd * gr[e]; const float part = __shfl_xor(y, 2);
            float cs, sn; rope_cs(pos, 8 * (sub & 1) + e, cs, sn);
            o[e] = ((sub < 2) ? (y * cs - part * sn) : (part * sn + y * cs)) * SC; }
        if (sub < 4) *(u32x4*)(qp + 64 + 8 * sub) = pack8(o);
    }
    for (int row = C.gw; row < NP + BS * KS_ALL; row += C.NGW) {
        bf16_t* kp = (row < NP ? WSB(WS_KVP) + (size_t)row * 1024 : WSB(WS_XR) + (size_t)(row - NP) * 1024) + 8 * lane;
        float f[8]; unpack8(*(const u32x4*)kp, f); float ss = 0.f;
#pragma unroll
        for (int e = 0; e < 8; ++e) ss += f[e] * f[e];
        const float rstd = 1.f / sqrtf(red8(ss) * (1.f / 64.f) + EPS);
#pragma unroll
        for (int e = 0; e < 8; ++e) f[e] *= rstd * gk[e];
        *(u32x4*)kp = pack8(f);
    }
}

__device__ __forceinline__ bf16x8 mk_frag(u32x2 lo, u32x2 hi) { u32x4 v; v.x = lo.x; v.y = lo.y; v.z = hi.x; v.w = hi.y; return __builtin_bit_cast(bf16x8, v); }
__device__ __forceinline__ bf16x8 as_frag(u32x4 v) { return __builtin_bit_cast(bf16x8, v); }
#define MFMA16(a, b, c) __builtin_amdgcn_mfma_f32_16x16x32_bf16((a), (b), (c), 0, 0, 0)

__device__ __forceinline__ int ssd_row0(int seq, int c) { return seq < 2 ? seq * TP + c * 64 : NP + (seq - 2) * 64; }
__device__ __forceinline__ void ssd_dt(const Ctx& C, int row0, LAS float* sDT, LAS float* sACS) {
    const int h = C.wave, lane = C.lane;
    const float adt = bf1(WSB(WS_ZB)[(size_t)(row0 + lane) * 768 + 672 + h]) + INL(14, 8)[h];
    float dt; { const float e_ = fexp(adt), u_ = 1.f + e_; dt = (adt > 20.f) ? adt : ((u_ == 1.f) ? e_ : (__builtin_amdgcn_logf(u_) * 0.6931471805599453f) * e_ * frcp(u_ - 1.f)); }
    const float A = -fexp(INL(15, 8)[h]);
    float cs = dt * A;
#pragma unroll
    for (int o = 1; o < 64; o <<= 1) { const float t = __shfl_up(cs, o); if (lane >= o) cs += t; }
    sDT[h * 64 + lane] = dt; sACS[h * 64 + lane] = cs;
}
template <class F>
__device__ __forceinline__ void ssd_load_chunk(const Ctx& C, int seq, int c, int row0, F store) {
    const int lane = C.lane, w = C.wave;
    const bf16_t* base = WSB(WS_PA) + (size_t)(row0 + lane) * 1536 + 512;
    const float* cw = INL(12, 4 * 1024); const float* cbias = INL(13, 1024);
    for (int j = 0; j < 16; ++j) {
        const int ch0 = 128 * w + 8 * j;
        const u32x4 v0 = *(const u32x4*)(base + ch0);
        u32x4 ex = (u32x4){0u, 0u, 0u, 0u};
        if (lane < 3) {
            if (seq < 2) { if (c > 0) ex = *(const u32x4*)(base - (size_t)3 * 1536 + ch0); }
            else ex = load8(INL(3, BS * 3 * 1024) + ((size_t)(seq - 2) * 3 + lane) * 1024 + ch0, 0, true);
        }
        float x0[8], xk[3][8];
        unpack8(v0, x0);
#pragma unroll
        for (int k = 1; k <= 3; ++k) {
            u32x4 a, b;
            a.x = __shfl(v0.x, (lane - k) & 63); a.y = __shfl(v0.y, (lane - k) & 63); a.z = __shfl(v0.z, (lane - k) & 63); a.w = __shfl(v0.w, (lane - k) & 63);
            b.x = __shfl(ex.x, (lane - k + 3) & 63); b.y = __shfl(ex.y, (lane - k + 3) & 63); b.z = __shfl(ex.z, (lane - k + 3) & 63); b.w = __shfl(ex.w, (lane - k + 3) & 63);
            unpack8(lane >= k ? a : b, xk[k - 1]);
        }
        float y[8];
#pragma unroll
        for (int e = 0; e < 8; ++e) {
            const float a = cbias[ch0 + e] + cw[3 * 1024 + ch0 + e] * x0[e] + cw[2 * 1024 + ch0 + e] * xk[0][e] + cw[1 * 1024 + ch0 + e] * xk[1][e] + cw[ch0 + e] * xk[2][e];
            y[e] = siluf_(a);
        }
        store(ch0, y, x0);
    }
}

constexpr int XT_ST = 72;
__device__ __forceinline__ void ssd_s1_item(const Ctx& C, int item) {
    const int seq = item < 256 ? (item >> 7) : 2 + (item - 256), c = item < 256 ? (item & 127) : 0, row0 = ssd_row0(seq, c);
    const int lane = C.lane, h = C.wave, fr = lane & 15, fq = lane >> 4, l = C.l;
    LAS bf16_t* XT = (LAS bf16_t*)C.lds; LAS bf16_t* BT = (LAS bf16_t*)(C.lds + 73728);
    LAS float* sDT = (LAS float*)(C.lds + 110592); LAS float* sACS = (LAS float*)(C.lds + 112640);
    ssd_dt(C, row0, sDT, sACS);
    __syncthreads();
    const bool lastc = (seq >= 2) || (c == 127);
    float* convo = C.out + (seq < 2 ? O_CONV_P + (size_t)(l * BP + seq) * 3 * 1024 : O_CONV_S + (size_t)(l * BS + seq - 2) * 3 * 1024);
    ssd_load_chunk(C, seq, c, row0, [&](int ch0, const float* y, const float* raw) {
        if (ch0 < 512) { const int hh = ch0 >> 6, p0 = ch0 & 63; const float wgt = sDT[hh * 64 + lane] * fexp(sACS[hh * 64 + 63] - sACS[hh * 64 + lane]);
#pragma unroll
            for (int e = 0; e < 8; ++e) XT[(hh * 64 + p0 + e) * XT_ST + lane] = (bf16_t)f2bf(y[e] * wgt); }
        else if (ch0 < 768) { const int g = (ch0 - 512) >> 7, n0 = (ch0 - 512) & 127;
#pragma unroll
            for (int e = 0; e < 8; ++e) BT[(g * 128 + n0 + e) * XT_ST + lane] = (bf16_t)f2bf(y[e]); }
        if (lastc && lane >= 61) {
#pragma unroll
            for (int e = 0; e < 8; ++e) convo[(size_t)(lane - 61) * 1024 + ch0 + e] = raw[e]; }
    });
    __syncthreads();
    const int g = h >> 2;
    bf16x8 bx[4][2];
#pragma unroll
    for (int pt = 0; pt < 4; ++pt)
#pragma unroll
        for (int ks = 0; ks < 2; ++ks) bx[pt][ks] = *(const LAS bf16x8*)(XT + (h * 64 + 16 * pt + fr) * XT_ST + 32 * ks + 8 * fq);
    const float dall = fexp(sACS[h * 64 + 63]);
    for (int nt = 0; nt < 8; ++nt) {
        bf16x8 a[2];
#pragma unroll
        for (int ks = 0; ks < 2; ++ks) a[ks] = *(const LAS bf16x8*)(BT + (g * 128 + 16 * nt + fr) * XT_ST + 32 * ks + 8 * fq);
#pragma unroll
        for (int pt = 0; pt < 4; ++pt) {
            f32x4 acc = (f32x4){0.f, 0.f, 0.f, 0.f};
#pragma unroll
            for (int ks = 0; ks < 2; ++ks) acc = MFMA16(a[ks], bx[pt][ks], acc);
            const int p = 16 * pt + fr, n = 16 * nt + 4 * fq;
            if (seq < 2) { u32x2 w; w.x = pk2(acc[0], acc[1]); w.y = pk2(acc[2], acc[3]);
                *(u32x2*)(WSB(WS_STATES) + ((size_t)((seq * 128 + c) * 8 + h) * 64 + p) * 128 + n) = w; }
            else { const size_t o = ((size_t)((l * BS + seq - 2) * 8 + h) * 64 + p) * 128 + n;
                const f32x4 h0 = *(const f32x4*)(IN0(2) + o);
                *(f32x4*)(C.out + O_SSM_S + o) = h0 * dall + acc; }
        }
    }
    if (seq < 2 && lane == 0) ((float*)(C.ws + WS_DECAY))[(seq * 128 + c) * 8 + h] = dall;
    __syncthreads();
}
__device__ __forceinline__ void ssd_scan(const Ctx& C) {
    const size_t gt = (size_t)C.bid * NTHREADS + C.tid;
    if (gt >= (size_t)2 * 8 * 64 * 128) return;
    const int b = (int)(gt >> 16), h = (int)(gt >> 13) & 7, pn = (int)(gt & 8191);
    bf16_t* st = WSB(WS_STATES) + ((size_t)(b * 128) * 8 + h) * 8192 + pn;
    const float* dec = (const float*)(C.ws + WS_DECAY) + (b * 128) * 8 + h;
    float hst = 0.f;
#pragma unroll 8
    for (int c = 0; c < 128; ++c) { const float s = bf1(st[(size_t)c * 8 * 8192]); st[(size_t)c * 8 * 8192] = (bf16_t)f2bf(hst); hst = dec[c * 8] * hst + s; }
    C.out[O_SSM_P + ((size_t)(C.l * BP + b) * 8 + h) * 8192 + pn] = hst;
}
constexpr int CN_ST = 136;
__device__ __forceinline__ void ssd_s3_item(const Ctx& C, int item) {
    const int seq = item < 256 ? (item >> 7) : 2 + (item - 256), c = item < 256 ? (item & 127) : 0, row0 = ssd_row0(seq, c);
    const int lane = C.lane, h = C.wave, fr = lane & 15, fq = lane >> 4, l = C.l, g = h >> 2;
    LAS bf16_t* Cn = (LAS bf16_t*)C.lds; LAS bf16_t* Bn = (LAS bf16_t*)(C.lds + 34816); LAS bf16_t* XT = (LAS bf16_t*)(C.lds + 69632);
    LAS float* sDT = (LAS float*)(C.lds + 143360); LAS float* sACS = (LAS float*)(C.lds + 145408); LAS float* sRed = (LAS float*)(C.lds + 147456);
    ssd_dt(C, row0, sDT, sACS);
    ssd_load_chunk(C, seq, c, row0, [&](int ch0, const float* y, const float*) {
        if (ch0 < 512) { const int hh = ch0 >> 6, p0 = ch0 & 63;
#pragma unroll
            for (int e = 0; e < 8; ++e) XT[(hh * 64 + p0 + e) * XT_ST + lane] = (bf16_t)f2bf(y[e]); }
        else if (ch0 < 768) { const int gg = (ch0 - 512) >> 7, n0 = (ch0 - 512) & 127; *(LAS u32x4*)(Bn + (gg * 64 + lane) * CN_ST + n0) = pack8(y); }
        else { const int gg = (ch0 - 768) >> 7, n0 = (ch0 - 768) & 127; *(LAS u32x4*)(Cn + (gg * 64 + lane) * CN_ST + n0) = pack8(y); }
    });
    __syncthreads();
#define CF(lt, ks) (*(const LAS bf16x8*)(Cn + (g * 64 + 16 * (lt) + fr) * CN_ST + 32 * (ks) + 8 * fq))
    f32x4 yacc[4][4];
    const void* hin; bool hin_f32;
    if (seq < 2) { hin = WSB(WS_STATES) + (size_t)((seq * 128 + c) * 8 + h) * 8192; hin_f32 = false; }
    else { hin = IN0(2) + (size_t)((l * BS + seq - 2) * 8 + h) * 8192; hin_f32 = true; }
#pragma unroll
    for (int pt = 0; pt < 4; ++pt) {
#pragma unroll
        for (int lt = 0; lt < 4; ++lt) yacc[pt][lt] = (f32x4){0.f, 0.f, 0.f, 0.f};
        bf16x8 af[4];
        if (hin_f32) {
#pragma unroll
            for (int ks = 0; ks < 4; ++ks) af[ks] = as_frag(load8(hin, (size_t)(16 * pt + fr) * 128 + 32 * ks + 8 * fq, true));
        } else {
#pragma unroll
            for (int ks = 0; ks < 4; ++ks) af[ks] = as_frag(load8(hin, (size_t)(16 * pt + fr) * 128 + 32 * ks + 8 * fq, false));
        }
#pragma unroll
        for (int ks = 0; ks < 4; ++ks)
#pragma unroll
            for (int lt = 0; lt < 4; ++lt) yacc[pt][lt] = MFMA16(af[ks], CF(lt, ks), yacc[pt][lt]);
        __builtin_amdgcn_sched_barrier(0);
    }
    float acl[4];
#pragma unroll
    for (int lt = 0; lt < 4; ++lt) { acl[lt] = sACS[h * 64 + 16 * lt + fr]; const float el = fexp(acl[lt]);
#pragma unroll
        for (int pt = 0; pt < 4; ++pt) yacc[pt][lt] = yacc[pt][lt] * el; }
    const float Dh = INL(16, 8)[h];
#pragma unroll
    for (int lt = 0; lt < 4; ++lt) {
        bf16x8 pf[2], cfl[4];
#pragma unroll
        for (int ks = 0; ks < 4; ++ks) cfl[ks] = CF(lt, ks);
        unsigned pw[4][2];
#pragma unroll
        for (int st = 0; st < 4; ++st) {
            f32x4 cb = (f32x4){0.f, 0.f, 0.f, 0.f};
#pragma unroll
            for (int ks = 0; ks < 4; ++ks) { const bf16x8 a = *(const LAS bf16x8*)(Bn + (g * 64 + 16 * st + fr) * CN_ST + 32 * ks + 8 * fq); cb = MFMA16(a, cfl[ks], cb); }
            const f32x4 as4 = *(const LAS f32x4*)(sACS + h * 64 + 16 * st + 4 * fq), dt4 = *(const LAS f32x4*)(sDT + h * 64 + 16 * st + 4 * fq);
            float m[4];
#pragma unroll
            for (int i = 0; i < 4; ++i) { const int s = 16 * st + 4 * fq + i, ll = 16 * lt + fr;
                float v = (s <= ll) ? cb[i] * fexp(acl[lt] - as4[i]) * dt4[i] : 0.f; if (s == ll) v += Dh; m[i] = v; }
            pw[st][0] = pk2(m[0], m[1]); pw[st][1] = pk2(m[2], m[3]);
        }
        { u32x4 v; v.x = pw[0][0]; v.y = pw[0][1]; v.z = pw[1][0]; v.w = pw[1][1]; pf[0] = as_frag(v); v.x = pw[2][0]; v.y = pw[2][1]; v.z = pw[3][0]; v.w = pw[3][1]; pf[1] = as_frag(v); }
#pragma unroll
        for (int pt = 0; pt < 4; ++pt)
#pragma unroll
            for (int kk = 0; kk < 2; ++kk) { const LAS bf16_t* xp = XT + (h * 64 + 16 * pt + fr) * XT_ST + 32 * kk + 4 * fq;
                const bf16x8 a = mk_frag(*(const LAS u32x2*)xp, *(const LAS u32x2*)(xp + 16)); yacc[pt][lt] = MFMA16(a, pf[kk], yacc[pt][lt]); }
        asm volatile("" ::: "memory");
    }
    float ss[4] = {0.f, 0.f, 0.f, 0.f};
#pragma unroll
    for (int lt = 0; lt < 4; ++lt)
#pragma unroll
        for (int pt = 0; pt < 4; ++pt) { const u32x2 z = *(const u32x2*)(WSB(WS_PA) + (size_t)(row0 + 16 * lt + fr) * 1536 + h * 64 + 16 * pt + 4 * fq);
            f32x4 v = yacc[pt][lt]; v[0] *= siluf_(bflo(z.x)); v[1] *= siluf_(bfhi(z.x)); v[2] *= siluf_(bflo(z.y)); v[3] *= siluf_(bfhi(z.y));
            yacc[pt][lt] = v; ss[lt] += v[0] * v[0] + v[1] * v[1] + v[2] * v[2] + v[3] * v[3]; }
#pragma unroll
    for (int lt = 0; lt < 4; ++lt) { ss[lt] += __shfl_xor(ss[lt], 16); ss[lt] += __shfl_xor(ss[lt], 32); if (fq == 0) sRed[h * 64 + 16 * lt + fr] = ss[lt]; }
    __syncthreads();
    const float* ng = INL(17, 512);
#pragma unroll
    for (int lt = 0; lt < 4; ++lt) { float tot = 0.f;
#pragma unroll
        for (int hh = 0; hh < 8; ++hh) tot += sRed[hh * 64 + 16 * lt + fr];
        const float rstd = 1.f / sqrtf(tot * (1.f / 512.f) + EPS);
#pragma unroll
        for (int pt = 0; pt < 4; ++pt) { const f32x4 gg = *(const f32x4*)(ng + h * 64 + 16 * pt + 4 * fq); const f32x4 v = yacc[pt][lt];
            u32x2 w; w.x = pk2(v[0] * rstd * gg[0], v[1] * rstd * gg[1]); w.y = pk2(v[2] * rstd * gg[2], v[3] * rstd * gg[3]);
            *(u32x2*)(WSB(WS_PA) + (size_t)(row0 + 16 * lt + fr) * 1536 + h * 64 + 16 * pt + 4 * fq) = w; } }
    __syncthreads();
}

struct AH {
    const bf16_t* q; int qld; bf16_t* o; int old_;
    const void* kn; size_t knld; bool kn_f32; const bf16_t* kn2; size_t kn2ld; int split;
    const bf16_t* kp; size_t kpld;
    const void* v; size_t vld; bool v_f32; const bf16_t* v2; size_t v2ld;
    int count, cdiff0;
};
template <int DK, bool BIAS, bool SHARED>
__device__ __forceinline__ void attn_core(const Ctx& C, const AH& H, int n_iter) {
    constexpr int KST = DK + 8, VST = 72, KBYTES = 64 * KST * 2, VBYTES = 64 * VST * 2, HBY = KBYTES + VBYTES;
    const int lane = C.lane, hf = C.wave >> 2, wq = C.wave & 3, tid_h = C.tid & 255, fr = lane & 15, fq = lane >> 4;
    LAS float* tab = (LAS float*)(C.lds + 4 * HBY) + hf * 260;
    bf16x8 qf[DK / 32];
#pragma unroll
    for (int ks = 0; ks < DK / 32; ++ks) qf[ks] = *(const bf16x8*)(H.q + (size_t)(16 * wq + fr) * H.qld + 32 * ks + 8 * fq);
    f32x4 oacc[4];
#pragma unroll
    for (int d = 0; d < 4; ++d) oacc[d] = (f32x4){0.f, 0.f, 0.f, 0.f};
    float m_run = -1e30f, l_run = 0.f;
    u32x4 rk[2], rp = (u32x4){0u, 0u, 0u, 0u}, rv[2];
    const int NPI = SHARED ? 1 : 2, PSTR = SHARED ? 0 : 256, ptid = SHARED ? C.tid : tid_h, lcount = SHARED ? n_iter : H.count, hsl = SHARED ? 0 : hf;
#define ATT_GLOAD(t) do { if ((t) < lcount) { const bool sec = (t) >= H.split; const int tk = sec ? (t) - H.split : (t); \
        _Pragma("unroll") for (int i = 0; i < NPI; ++i) { const int p = ptid + PSTR * i; \
            { const int key = p >> 3, ch = p & 7; rk[i] = sec ? load8(H.kn2, (size_t)(tk * 64 + key) * H.kn2ld + 8 * ch, false) : load8(H.kn, (size_t)(tk * 64 + key) * H.knld + 8 * ch, H.kn_f32); } \
            { const int key = p & 63, dc = p >> 6; rv[i] = sec ? load8(H.v2, (size_t)(tk * 64 + key) * H.v2ld + 8 * dc, false) : load8(H.v, (size_t)(tk * 64 + key) * H.vld + 8 * dc, H.v_f32); } } \
        if (DK == 96 && (!SHARED || ptid < 256)) { const int key = (ptid & 255) >> 2, ch = ptid & 3; rp = *(const u32x4*)(H.kp + (size_t)((t) * 64 + key) * H.kpld + 8 * ch); } } } while (0)
#define ATT_SSTORE(t, buf) do { if ((t) < lcount) { LAS unsigned char* base = C.lds + ((buf) * 2 + hsl) * HBY; \
        _Pragma("unroll") for (int i = 0; i < NPI; ++i) { const int p = ptid + PSTR * i; \
            { const int key = p >> 3, ch = p & 7; *(LAS u32x4*)(base + (key * KST + 8 * ch) * 2) = rk[i]; } \
            { const int key = p & 63, dc = p >> 6; LAS bf16_t* vt = (LAS bf16_t*)(base + KBYTES) + (8 * dc) * VST + key; const u32x4 vv = rv[i]; \
              vt[0] = (bf16_t)(vv.x & 0xffffu); vt[VST] = (bf16_t)(vv.x >> 16); vt[2 * VST] = (bf16_t)(vv.y & 0xffffu); vt[3 * VST] = (bf16_t)(vv.y >> 16); \
              vt[4 * VST] = (bf16_t)(vv.z & 0xffffu); vt[5 * VST] = (bf16_t)(vv.z >> 16); vt[6 * VST] = (bf16_t)(vv.w & 0xffffu); vt[7 * VST] = (bf16_t)(vv.w >> 16); } } \
        if (DK == 96 && (!SHARED || ptid < 256)) { const int key = (ptid & 255) >> 2, ch = ptid & 3; *(LAS u32x4*)(base + (key * KST + 64 + 8 * ch) * 2) = rp; } } } while (0)
    ATT_GLOAD(0); ATT_SSTORE(0, 0);
    __syncthreads();
    for (int t = 0; t < n_iter; ++t) {
        ATT_GLOAD(t + 1);
        if (t < H.count) {
            const LAS unsigned char* base = C.lds + ((t & 1) * 2 + hsl) * HBY;
            f32x4 s[4];
#pragma unroll
            for (int mt = 0; mt < 4; ++mt) { s[mt] = (f32x4){0.f, 0.f, 0.f, 0.f};
#pragma unroll
                for (int ks = 0; ks < DK / 32; ++ks) { const bf16x8 a = *(const LAS bf16x8*)(base + ((16 * mt + fr) * KST + 32 * ks + 8 * fq) * 2); s[mt] = MFMA16(a, qf[ks], s[mt]); } }
            if (BIAS) { const int cd = H.cdiff0 - t, ql = 16 * wq + fr;
                if (cd >= 3) { const float bb = tab[256];
#pragma unroll
                    for (int mt = 0; mt < 4; ++mt) s[mt] = s[mt] + bb; }
                else {
#pragma unroll
                    for (int mt = 0; mt < 4; ++mt)
#pragma unroll
                        for (int i = 0; i < 4; ++i) { int rel = cd * 64 + ql - (16 * mt + 4 * fq + i); rel = rel > 128 ? 128 : rel; s[mt][i] += tab[rel + 128]; } } }
            float mx = s[0][0];
#pragma unroll
            for (int mt = 0; mt < 4; ++mt)
#pragma unroll
                for (int i = 0; i < 4; ++i) mx = fmaxf(mx, s[mt][i]);
            mx = fmaxf(mx, __shfl_xor(mx, 16)); mx = fmaxf(mx, __shfl_xor(mx, 32));
            const float mnew = fmaxf(m_run, mx), alpha = fexp2(m_run - mnew); m_run = mnew;
            float psum = 0.f;
#pragma unroll
            for (int mt = 0; mt < 4; ++mt)
#pragma unroll
                for (int i = 0; i < 4; ++i) { const float p = fexp2(s[mt][i] - mnew); s[mt][i] = p; psum += p; }
            l_run = l_run * alpha + psum;
#pragma unroll
            for (int d = 0; d < 4; ++d) oacc[d] = oacc[d] * alpha;
            bf16x8 pf[2];
#pragma unroll
            for (int kk = 0; kk < 2; ++kk) { u32x4 v; v.x = pk2(s[2 * kk][0], s[2 * kk][1]); v.y = pk2(s[2 * kk][2], s[2 * kk][3]); v.z = pk2(s[2 * kk + 1][0], s[2 * kk + 1][1]); v.w = pk2(s[2 * kk + 1][2], s[2 * kk + 1][3]); pf[kk] = as_frag(v); }
            const LAS bf16_t* vt = (const LAS bf16_t*)(base + KBYTES);
#pragma unroll
            for (int d = 0; d < 4; ++d)
#pragma unroll
                for (int kk = 0; kk < 2; ++kk) { const LAS bf16_t* vp = vt + (16 * d + fr) * VST + 32 * kk + 4 * fq;
                    const bf16x8 a = mk_frag(*(const LAS u32x2*)vp, *(const LAS u32x2*)(vp + 16)); oacc[d] = MFMA16(a, pf[kk], oacc[d]); }
        }
        ATT_SSTORE(t + 1, (t + 1) & 1);
        __syncthreads();
    }
#undef ATT_GLOAD
#undef ATT_SSTORE
    l_run += __shfl_xor(l_run, 16); l_run += __shfl_xor(l_run, 32);
    const float inv = 1.f / l_run;
#pragma unroll
    for (int d = 0; d < 4; ++d) { u32x2 w; w.x = pk2(oacc[d][0] * inv, oacc[d][1] * inv); w.y = pk2(oacc[d][2] * inv, oacc[d][3] * inv);
        *(u32x2*)(H.o + (size_t)(16 * wq + fr) * H.old_ + 16 * d + 4 * fq) = w; }
}

__device__ __forceinline__ void attn_core2(const Ctx& C, const AH& H, int n_iter) {
    constexpr int DK = 96, KST = DK + 8, VST = 72, KBYTES = 64 * KST * 2, VBYTES = 64 * VST * 2, HBY = KBYTES + VBYTES;
    const int lane = C.lane, fr = lane & 15, fq = lane >> 4, p = C.tid;
    bf16x8 qf[2][3];
#pragma unroll
    for (int sb = 0; sb < 2; ++sb)
#pragma unroll
        for (int ks = 0; ks < 3; ++ks) qf[sb][ks] = *(const bf16x8*)(H.q + (size_t)(16 * sb + fr) * H.qld + 32 * ks + 8 * fq);
    f32x4 oacc[2][4];
#pragma unroll
    for (int sb = 0; sb < 2; ++sb)
#pragma unroll
        for (int d = 0; d < 4; ++d) oacc[sb][d] = (f32x4){0.f, 0.f, 0.f, 0.f};
    float m_run[2] = {-1e30f, -1e30f}, l_run[2] = {0.f, 0.f};
    u32x4 rk, rp = (u32x4){0u, 0u, 0u, 0u}, rv;
#define A2_GLOAD(t) do { if ((t) < n_iter) { \
        { const int key = p >> 3, ch = p & 7; rk = *(const u32x4*)((const bf16_t*)H.kn + (size_t)((t) * 64 + key) * H.knld + 8 * ch); } \
        { const int key = p & 63, dc = p >> 6; rv = *(const u32x4*)((const bf16_t*)H.v + (size_t)((t) * 64 + key) * H.vld + 8 * dc); } \
        if (p < 256) { const int key = p >> 2, ch = p & 3; rp = *(const u32x4*)(H.kp + (size_t)((t) * 64 + key) * H.kpld + 8 * ch); } } } while (0)
#define A2_SSTORE(t, buf) do { if ((t) < n_iter) { LAS unsigned char* base = C.lds + (buf) * HBY; \
        { const int key = p >> 3, ch = p & 7; *(LAS u32x4*)(base + (key * KST + 8 * ch) * 2) = rk; } \
        { const int key = p & 63, dc = p >> 6; LAS bf16_t* vt = (LAS bf16_t*)(base + KBYTES) + (8 * dc) * VST + key; const u32x4 vv = rv; \
          vt[0] = (bf16_t)(vv.x & 0xffffu); vt[VST] = (bf16_t)(vv.x >> 16); vt[2 * VST] = (bf16_t)(vv.y & 0xffffu); vt[3 * VST] = (bf16_t)(vv.y >> 16); \
          vt[4 * VST] = (bf16_t)(vv.z & 0xffffu); vt[5 * VST] = (bf16_t)(vv.z >> 16); vt[6 * VST] = (bf16_t)(vv.w & 0xffffu); vt[7 * VST] = (bf16_t)(vv.w >> 16); } \
        if (p < 256) { const int key = p >> 2, ch = p & 3; *(LAS u32x4*)(base + (key * KST + 64 + 8 * ch) * 2) = rp; } } } while (0)
    A2_GLOAD(0); A2_SSTORE(0, 0);
    __syncthreads();
    for (int t = 0; t < n_iter; ++t) {
        A2_GLOAD(t + 1);
        if (t < H.count) {
            const LAS unsigned char* base = C.lds + (t & 1) * HBY;
            f32x4 s[2][4];
#pragma unroll
            for (int mt = 0; mt < 4; ++mt) { s[0][mt] = (f32x4){0.f, 0.f, 0.f, 0.f}; s[1][mt] = (f32x4){0.f, 0.f, 0.f, 0.f};
#pragma unroll
                for (int ks = 0; ks < 3; ++ks) { const bf16x8 a = *(const LAS bf16x8*)(base + ((16 * mt + fr) * KST + 32 * ks + 8 * fq) * 2);
                    s[0][mt] = MFMA16(a, qf[0][ks], s[0][mt]); s[1][mt] = MFMA16(a, qf[1][ks], s[1][mt]); } }
            bf16x8 pf[2][2];
#pragma unroll
            for (int sb = 0; sb < 2; ++sb) {
                float mx = s[sb][0][0];
#pragma unroll
                for (int mt = 0; mt < 4; ++mt)
#pragma unroll
                    for (int i = 0; i < 4; ++i) mx = fmaxf(mx, s[sb][mt][i]);
                mx = fmaxf(mx, __shfl_xor(mx, 16)); mx = fmaxf(mx, __shfl_xor(mx, 32));
                const float mnew = fmaxf(m_run[sb], mx), alpha = fexp2(m_run[sb] - mnew); m_run[sb] = mnew;
                float psum = 0.f;
#pragma unroll
                for (int mt = 0; mt < 4; ++mt)
#pragma unroll
                    for (int i = 0; i < 4; ++i) { const float pp = fexp2(s[sb][mt][i] - mnew); s[sb][mt][i] = pp; psum += pp; }
                l_run[sb] = l_run[sb] * alpha + psum;
#pragma unroll
                for (int d = 0; d < 4; ++d) oacc[sb][d] = oacc[sb][d] * alpha;
#pragma unroll
                for (int kk = 0; kk < 2; ++kk) { u32x4 v; v.x = pk2(s[sb][2 * kk][0], s[sb][2 * kk][1]); v.y = pk2(s[sb][2 * kk][2], s[sb][2 * kk][3]); v.z = pk2(s[sb][2 * kk + 1][0], s[sb][2 * kk + 1][1]); v.w = pk2(s[sb][2 * kk + 1][2], s[sb][2 * kk + 1][3]); pf[sb][kk] = as_frag(v); }
            }
            const LAS bf16_t* vt = (const LAS bf16_t*)(base + KBYTES);
#pragma unroll
            for (int d = 0; d < 4; ++d)
#pragma unroll
                for (int kk = 0; kk < 2; ++kk) { const LAS bf16_t* vp = vt + (16 * d + fr) * VST + 32 * kk + 4 * fq;
                    const bf16x8 a = mk_frag(*(const LAS u32x2*)vp, *(const LAS u32x2*)(vp + 16));
                    oacc[0][d] = MFMA16(a, pf[0][kk], oacc[0][d]); oacc[1][d] = MFMA16(a, pf[1][kk], oacc[1][d]); }
        }
        A2_SSTORE(t + 1, (t + 1) & 1);
        __syncthreads();
    }
#undef A2_GLOAD
#undef A2_SSTORE
#pragma unroll
    for (int sb = 0; sb < 2; ++sb) { float l = l_run[sb]; l += __shfl_xor(l, 16); l += __shfl_xor(l, 32);
        const float inv = 1.f / l;
#pragma unroll
        for (int d = 0; d < 4; ++d) { u32x2 w; w.x = pk2(oacc[sb][d][0] * inv, oacc[sb][d][1] * inv); w.y = pk2(oacc[sb][d][2] * inv, oacc[sb][d][3] * inv);
            *(u32x2*)(H.o + (size_t)(16 * sb + fr) * H.old_ + 16 * d + 4 * fq) = w; } }
}

constexpr int N_MLAP = 512, N_S3 = 288, N_MLAS = 128, N_BANDP = 1024, N_BANDS = 128, N_P5 = N_MLAP + N_S3 + N_MLAS + N_BANDP + N_BANDS;
#ifndef P5SEL
#define P5SEL 7
#endif
__device__ __forceinline__ void p5_unit(const Ctx& C, int idx) {
    const int hf = C.wave >> 2, l = C.l;
    AH H; H.split = 1 << 30; H.kn2 = nullptr; H.kn2ld = 0; H.v2 = nullptr; H.v2ld = 0; H.kn_f32 = false; H.v_f32 = false; H.kp = nullptr; H.kpld = 0; H.cdiff0 = 0;
    if (idx < N_MLAP) {
        const int q4 = 31 - (idx >> 4), b = (idx >> 3) & 1, h = idx & 7, c = 4 * q4 + (C.wave >> 1); const size_t row0 = (size_t)b * TP + c * 64 + 32 * (C.wave & 1);
        H.q = WSB(WS_Q) + row0 * 768 + h * 96; H.qld = 768; H.o = WSB(WS_YBC) + row0 * 1024 + h * 64; H.old_ = 1024;
        H.kn = WSB(WS_KVP) + (size_t)b * TP * 1024 + h * 64; H.knld = 1024; H.kp = WSB(WS_KPEP) + (size_t)b * TP * 32; H.kpld = 32;
        H.v = WSB(WS_KVP) + (size_t)b * TP * 1024 + 512 + h * 64; H.vld = 1024; H.count = c + 1;
        if (P5SEL & 1) attn_core2(C, H, 4 * q4 + 4); return;
    }
    idx -= N_MLAP;
    if (idx < N_S3) { if (P5SEL & 2) ssd_s3_item(C, idx); return; }
    idx -= N_S3;
    if (idx < N_MLAS) {
        const int b = idx >> 2, h = (idx & 3) * 2 + hf; const size_t row0 = (size_t)NP + b * 64;
        H.q = WSB(WS_Q) + row0 * 768 + h * 96; H.qld = 768; H.o = WSB(WS_YBC) + row0 * 1024 + h * 64; H.old_ = 1024;
        H.kn = WSB(WS_XR) + (size_t)b * KS_ALL * 1024 + h * 64; H.knld = 1024; H.kp = WSB(WS_KPES) + (size_t)b * KS_ALL * 32; H.kpld = 32;
        H.v = WSB(WS_XR) + (size_t)b * KS_ALL * 1024 + 512 + h * 64; H.vld = 1024; H.count = 33;
        if (P5SEL & 1) attn_core<96, false, false>(C, H, 33); return;
    }
    idx -= N_MLAS;
    constexpr int HBY64 = 64 * 72 * 2 * 2;
    if (idx < N_BANDP) {
        const int cp = idx >> 4, b = (idx >> 3) & 1, h = idx & 7, c = 2 * cp + hf, kt0 = c > 8 ? c - 8 : 0; const size_t row0 = (size_t)b * TP + c * 64;
        LAS float* tab = (LAS float*)(C.lds + 4 * HBY64) + hf * 260; const float* rb = INL(32, 8 * 257) + h * 257;
        for (int i = C.tid & 255; i < 257; i += 256) tab[i] = rb[i] * LOG2E;
        H.q = WSB(WS_PD) + row0 * 1536 + h * 64; H.qld = 1536; H.o = WSB(WS_PD) + row0 * 1536 + h * 64; H.old_ = 1536;
        H.kn = WSB(WS_PD) + ((size_t)b * TP + kt0 * 64) * 1536 + 512 + h * 64; H.knld = 1536;
        H.v = WSB(WS_PD) + ((size_t)b * TP + kt0 * 64) * 1536 + 1024 + h * 64; H.vld = 1536; H.count = c - kt0 + 1; H.cdiff0 = c - kt0;
        const int c1 = 2 * cp + 1;
        if (P5SEL & 4) attn_core<64, true, false>(C, H, (c1 > 8 ? 8 : c1) + 1); return;
    }
    idx -= N_BANDP;
    {
        const int b = idx >> 2, h = (idx & 3) * 2 + hf; const size_t row0 = (size_t)NP + b * 64;
        LAS float* tab = (LAS float*)(C.lds + 4 * HBY64) + hf * 260; const float* rb = INL(32, 8 * 257) + h * 257;
        for (int i = C.tid & 255; i < 257; i += 256) tab[i] = rb[i] * LOG2E;
        H.q = WSB(WS_PD) + row0 * 1536 + h * 64; H.qld = 1536; H.o = WSB(WS_PD) + row0 * 1536 + h * 64; H.old_ = 1536;
        H.kn = INL(7, (size_t)BS * 512 * 512) + (size_t)b * 512 * 512 + h * 64; H.knld = 512; H.kn_f32 = true;
        H.v = INL(8, (size_t)BS * 512 * 512) + (size_t)b * 512 * 512 + h * 64; H.vld = 512; H.v_f32 = true;
        H.split = 8; H.kn2 = WSB(WS_PD) + row0 * 1536 + 512 + h * 64; H.kn2ld = 1536; H.v2 = WSB(WS_PD) + row0 * 1536 + 1024 + h * 64; H.v2ld = 1536;
        H.count = 9; H.cdiff0 = 8;
        if (P5SEL & 4) attn_core<64, true, false>(C, H, 9);
    }
}

__global__ void __launch_bounds__(NTHREADS) mk_fwd(Args args) {
    extern __shared__ __attribute__((aligned(16))) unsigned char lds_raw[];
    cg::grid_group grid = cg::this_grid();
    Ctx C;
    C.A = &args;
    C.out = args.out; C.ws = args.ws; C.lds = (LAS unsigned char*)lds_raw;
    C.tid = threadIdx.x; C.lane = C.tid & 63; C.wave = __builtin_amdgcn_readfirstlane(C.tid >> 6);
    C.G = gridDim.x; C.bid = blockIdx.x; C.gw = C.bid * NWAVES + C.wave; C.NGW = C.G * NWAVES;
    unsigned* ctl = (unsigned*)(C.ws + WS_CTL);
    LAS int* sIdx = (LAS int*)(C.lds + LDS_BYTES - 16);
#ifndef PMASK
#define PMASK 0xFFF
#endif
#define REFRESH() do { int t_ = threadIdx.x; asm volatile("" : "+v"(t_)); C.tid = t_; C.lane = t_ & 63; C.wave = __builtin_amdgcn_readfirstlane(t_ >> 6); C.gw = C.bid * NWAVES + C.wave; GAS unsigned char* w_ = (GAS unsigned char*)args.ws; asm volatile("" : "+s"(w_)); C.ws = (unsigned char*)w_; GAS float* o_ = (GAS float*)args.out; asm volatile("" : "+s"(o_)); C.out = (float*)o_; } while (0)
#define PH_BEGIN(n) if ((PMASK >> (n)) & 1) { REFRESH();
#define PH_END } grid.sync();
#pragma unroll 1
    for (int l = 0; l < 2; ++l) {
        C.l = l;
        PH_BEGIN(0)
            if (C.bid == 0 && C.tid == 0) { ctl[l] = 0u; ctl[2 + l] = 0u; }
            { const size_t gt = (size_t)C.bid * NTHREADS + C.tid, GT = (size_t)C.G * NTHREADS; for (size_t i = gt; i < (size_t)R; i += GT) ((float*)(C.ws + WS_SUMSQ))[i] = 0.f; }
            phase_wprep(C);
            phase_norm(C, INL(9, 1024), l > 0);
        PH_END
        PH_BEGIN(1)
            SchedInproj S{WSB(WS_HB), WSB(WS_WT_IN), WSB(WS_PA), WSB(WS_ZB), WSB(WS_XR), WSB(WS_PD), C.G, C.bid};
            pg8::EpiStore E; pg8::gemm_phase(C.lds, S, E, C.tid);
        PH_END
        PH_BEGIN(2)
            phase_mla_prep(C); phase_band_prep(C); phase_sconv(C);
            for (int it = C.G - 1 - C.bid; it < N_S3; it += C.G) { REFRESH(); ssd_s1_item(C, it); }
        PH_END
        PH_BEGIN(3)
            ssd_scan(C);
            SchedP3 S{WSB(WS_ZB), WSB(WS_WT_QUP), WSB(WS_CKVP), WSB(WS_CKVS), WSB(WS_WT_KVUP), WSB(WS_Q), WSB(WS_KVP), WSB(WS_XR), C.G, C.bid};
            pg8::EpiStore E; pg8::gemm_phase(C.lds, S, E, C.tid);
        PH_END
        PH_BEGIN(4)
            phase_qk_post(C);
        PH_END
        PH_BEGIN(5)
            for (;;) {
                if (C.tid == 0) *sIdx = (int)atomicAdd(&ctl[l], 1u);
                __syncthreads();
                const int idx = *sIdx;
                __syncthreads();
                if (idx >= N_P5) break;
                REFRESH();
                p5_unit(C, idx);
            }
        PH_END
        PH_BEGIN(7)
            SchedMerge S{WSB(WS_HB), WSB(WS_WT_G), WSB(WS_WT_OUT), WSB(WS_PA), WSB(WS_YBC), WSB(WS_PD), C.G, C.bid};
            pg8::EpiMerge E{INL(11, 4096), WSB(WS_ZB), WSB(WS_XR)}; pg8::gemm_phase(C.lds, S, E, C.tid);
        PH_END
        PH_BEGIN(8)
            SchedOne S{WSB(WS_ZB), WSB(WS_WT_O), nullptr, 1024, 1024, 0, 72, 4, 16, C.G, C.bid};
            pg8::EpiResidNorm E{l > 0 ? C.out : IN0(0), l > 0 ? C.out + (size_t)NP * DM : IN0(1), C.out, WSB(WS_HB), INL(35, 1024), (float*)(C.ws + WS_SUMSQ)}; pg8::gemm_phase(C.lds, S, E, C.tid);
        PH_END
        PH_BEGIN(10)
            SchedOne S{WSB(WS_HB), WSB(WS_WT_UP), nullptr, 1024, 1024, 0, 72, 22, 16, C.G, C.bid};
            pg8::EpiSwigluNorm E{WSB(WS_XR), (const float*)(C.ws + WS_SUMSQ)}; pg8::gemm_phase(C.lds, S, E, C.tid);
        PH_END
        PH_BEGIN(11)
            SchedOne S{WSB(WS_XR), WSB(WS_WT_DOWN), nullptr, 2816, 2816, 0, 72, 4, 44, C.G, C.bid};
            pg8::EpiResid E{C.out, C.out + (size_t)NP * DM, C.out}; pg8::gemm_phase(C.lds, S, E, C.tid);
        PH_END
    }
}

extern "C" void kernel_launch(void* const* d_in, const int* in_sizes, int n_in, void* d_out, int out_size, void* d_ws, size_t ws_size, hipStream_t stream) {
    static int grid = 0;
    if (grid == 0) {
        int dev = 0, cus = 0, per_cu = 0;
        (void)hipGetDevice(&dev);
        (void)hipDeviceGetAttribute(&cus, hipDeviceAttributeMultiprocessorCount, dev);
        (void)hipFuncSetAttribute((const void*)mk_fwd, hipFuncAttributeMaxDynamicSharedMemorySize, LDS_BYTES);
        (void)hipOccupancyMaxActiveBlocksPerMultiprocessor(&per_cu, (const void*)mk_fwd, NTHREADS, LDS_BYTES);
        if (per_cu < 1) per_cu = 1;
        grid = cus * per_cu;
        if (ws_size < WS_END || n_in != 38 || (size_t)out_size != O_END) { fprintf(stderr, "kernel_launch: bad sizes ws %zu n_in %d out %d\n", ws_size, n_in, out_size); grid = -1; }
    }
    if (grid < 0) return;
    Args a{};
    for (int i = 0; i < 38; ++i) a.in[i] = (const float*)d_in[i];
    a.out = (float*)d_out; a.ws = (unsigned char*)d_ws; a.ph_lo = 0; a.ph_hi = 1000;
    void* kargs[] = {&a};
    hipError_t e = hipLaunchCooperativeKernel((const void*)mk_fwd, dim3(grid), dim3(NTHREADS), kargs, LDS_BYTES, stream);
    if (e != hipSuccess) fprintf(stderr, "cooperative launch failed: %s (grid %d)\n", hipGetErrorString(e), grid);
}
```

```cpp
#include <hip/hip_runtime.h>
#include <hip/hip_cooperative_groups.h>
#include <cstdio>
#include <cstdint>
namespace cg = cooperative_groups;

#define LAS __attribute__((address_space(3)))
#define GAS __attribute__((address_space(1)))
typedef unsigned short bf16_t;
typedef short bf16x8 __attribute__((ext_vector_type(8)));
typedef float f32x4 __attribute__((ext_vector_type(4)));
typedef unsigned u32x4 __attribute__((ext_vector_type(4)));
typedef unsigned u32x2 __attribute__((ext_vector_type(2)));

constexpr int NTHREADS = 512, NWAVES = 8;
constexpr int LDS_BYTES = 155648;
constexpr int NP = 16384, NS = 2048, R = NP + NS;
constexpr int TP = 8192, TS = 64, BP = 2, BS = 32, PAST = 2048, KS_ALL = PAST + TS;
constexpr int DM = 1024, FF = 2816;
constexpr int IN_COLS = 9384;
constexpr float EPS = 1e-6f;
constexpr float LOG2E = 1.4426950408889634f;

constexpr size_t O_Y = 0;
constexpr size_t O_SSM_P = (size_t)R * DM;
constexpr size_t O_SSM_S = O_SSM_P + 262144;
constexpr size_t O_CONV_P = O_SSM_S + 4194304;
constexpr size_t O_CONV_S = O_CONV_P + 12288;
constexpr size_t O_CKV_P = O_CONV_S + 196608;
constexpr size_t O_CKV_S = O_CKV_P + 8388608;
constexpr size_t O_KPE_P = O_CKV_S + 1048576;
constexpr size_t O_KPE_S = O_KPE_P + 1048576;
constexpr size_t O_SC_P = O_KPE_S + 131072;
constexpr size_t O_SC_S = O_SC_P + 4096;
constexpr size_t O_BK_P = O_SC_S + 65536;
constexpr size_t O_BK_S = O_BK_P + 1048576;
constexpr size_t O_BV_P = O_BK_S + 16777216;
constexpr size_t O_BV_S = O_BV_P + 1048576;
constexpr size_t O_END = O_BV_S + 16777216;

constexpr size_t al256(size_t x) { return (x + 255) & ~(size_t)255; }
constexpr size_t WS_CTL = 0;
constexpr size_t WS_DECAY = 4096;
constexpr size_t WS_SUMSQ = 16384;
constexpr size_t WS_WT_IN = 131072;
constexpr size_t WS_WT_G = WS_WT_IN + (size_t)5376 * 1024 * 2;
constexpr size_t WS_WT_QUP = WS_WT_G + (size_t)4096 * 1024 * 2;
constexpr size_t WS_WT_KVUP = WS_WT_QUP + (size_t)768 * 384 * 2;
constexpr size_t WS_WT_OUT = WS_WT_KVUP + (size_t)1024 * 256 * 2;
constexpr size_t WS_WT_O = WS_WT_OUT + (size_t)4 * 1024 * 1024 * 2;
constexpr size_t WS_WT_UP = WS_WT_O + (size_t)1024 * 1024 * 2;
constexpr size_t WS_WT_DOWN = WS_WT_UP + (size_t)5632 * 1024 * 2;
constexpr size_t WS_HB = al256(WS_WT_DOWN + (size_t)1024 * 2816 * 2);
constexpr size_t WS_PA = WS_HB + (size_t)R * 1024 * 2;
constexpr size_t WS_PD = WS_PA + (size_t)R * 1536 * 2;
constexpr size_t WS_ZB = WS_PD + (size_t)R * 1536 * 2;
constexpr size_t WS_CKVP = WS_ZB + (size_t)R * 768 * 2;
constexpr size_t WS_XR = WS_ZB + (size_t)R * 1024 * 2;
constexpr size_t WS_Q = WS_XR + (size_t)67584 * 1024 * 2;
constexpr size_t WS_KPEP = WS_Q + (size_t)R * 768 * 2;
constexpr size_t WS_KPES = WS_KPEP + (size_t)16384 * 32 * 2;
constexpr size_t WS_KVP = WS_KPES + (size_t)67584 * 32 * 2;
constexpr size_t WS_STATES = WS_KVP + (size_t)16384 * 1024 * 2;
constexpr size_t WS_YBC = WS_STATES + (size_t)2048 * 64 * 128 * 2;
constexpr size_t WS_CKVS = WS_YBC + (size_t)R * 1024 * 2;
constexpr size_t WS_END = WS_CKVS + (size_t)67584 * 256 * 2;
static_assert(WS_END < (size_t)553000000, "ws map too large");
static_assert((size_t)R * 768 * 2 + (size_t)16384 * 256 * 2 <= (size_t)R * 1024 * 2, "ZB");
static_assert((size_t)67584 * 256 * 2 <= (size_t)R * 1024 * 2, "ckvS in HB");

typedef float f32x2_g __attribute__((ext_vector_type(2)));
typedef __bf16 bf16x2_g __attribute__((ext_vector_type(2)));
__device__ __forceinline__ unsigned pk2(float lo, float hi) { f32x2_g v = {lo, hi}; bf16x2_g b = __builtin_convertvector(v, bf16x2_g); return __builtin_bit_cast(unsigned, b); }
__device__ __forceinline__ unsigned f2bf(float f) { return pk2(f, 0.f) & 0xffffu; }
__device__ __forceinline__ float bflo(unsigned u) { return __builtin_bit_cast(float, u << 16); }
__device__ __forceinline__ float bfhi(unsigned u) { return __builtin_bit_cast(float, u & 0xffff0000u); }
__device__ __forceinline__ float bf1(bf16_t h) { return __builtin_bit_cast(float, (unsigned)h << 16); }
__device__ __forceinline__ float fexp2(float x) { return __builtin_amdgcn_exp2f(x); }
__device__ __forceinline__ float fexp(float x) { return __builtin_amdgcn_exp2f(x * LOG2E); }
__device__ __forceinline__ float frcp(float x) { return __builtin_amdgcn_rcpf(x); }
__device__ __forceinline__ float sigmoidf_(float x) { return frcp(1.f + fexp(-x)); }
__device__ __forceinline__ float siluf_(float x) { return x * sigmoidf_(x); }
__device__ __forceinline__ float wave_sum(float v) {
#pragma unroll
    for (int o = 1; o < 64; o <<= 1) v += __shfl_xor(v, o);
    return v;
}
#define LDS_WAIT() asm volatile("s_waitcnt lgkmcnt(0)" ::: "memory")
__device__ __forceinline__ void unpack8(u32x4 v, float* f) {
    f[0] = bflo(v.x); f[1] = bfhi(v.x); f[2] = bflo(v.y); f[3] = bfhi(v.y); f[4] = bflo(v.z); f[5] = bfhi(v.z); f[6] = bflo(v.w); f[7] = bfhi(v.w);
}
__device__ __forceinline__ u32x4 pack8(const float* f) { u32x4 o; o.x = pk2(f[0], f[1]); o.y = pk2(f[2], f[3]); o.z = pk2(f[4], f[5]); o.w = pk2(f[6], f[7]); return o; }
__device__ __forceinline__ u32x4 load8(const void* base, size_t idx, bool is_f32) {
    if (is_f32) { const f32x4* p = (const f32x4*)((const float*)base + idx); f32x4 a = p[0], b = p[1];
        u32x4 o; o.x = pk2(a.x, a.y); o.y = pk2(a.z, a.w); o.z = pk2(b.x, b.y); o.w = pk2(b.z, b.w); return o; }
    return *(const u32x4*)((const bf16_t*)base + idx);
}

namespace pg8 {
constexpr int BM = 256, BK = 64, HALF = 128, HTB = HALF * BK * 2, STAGE_BYTES = 8 * HTB, NXCD = 8, WGM = 8;
__device__ __forceinline__ int lds_byte(int r, int c) { const int st = (r >> 4) * 2 + (c >> 5), rr = r & 15, cc = c & 31, ob = rr * 64 + cc * 2; return st * 1024 + (ob ^ (((ob >> 9) & 1) << 5)); }
__device__ __forceinline__ void stage_rc(int b, int& Rr, int& C) { const int st = b / 1024, sb = b % 1024, swz = sb ^ (((sb >> 9) & 1) << 5); Rr = (st >> 1) * 16 + swz / 64; C = (st & 1) * 32 + (swz % 64) / 2; }
__device__ __forceinline__ int perm32(int rho) { const int n = rho >> 4, i = rho & 15; return 8 * (i >> 2) + 4 * n + (i & 3); }

struct GUnit { const bf16_t* A; const bf16_t* B; int lda, ldb, nt; int pm, pn, sub; bf16_t* C; int ldc; };

__device__ __forceinline__ void tile_map(int L, int nM, int nN, int& pm, int& pn) {
    const int nwg = nM * nN; int wgid = L;
    { const int q = nwg / NXCD, r = nwg % NXCD, xcd = wgid % NXCD, off = wgid / NXCD; wgid = (xcd < r ? xcd * (q + 1) : r * (q + 1) + (xcd - r) * q) + off; }
    const int nig = WGM * nN, gid = wgid / nig, fm = gid * WGM, gsz = (nM - fm) < WGM ? (nM - fm) : WGM;
    pm = fm + ((wgid % nig) % gsz); pn = (wgid % nig) / gsz;
}
typedef float f32x2_t __attribute__((ext_vector_type(2)));
typedef __bf16 bf16x2_t __attribute__((ext_vector_type(2)));
__device__ __forceinline__ unsigned cvt_pk_bf16(float lo, float hi) { f32x2_t v = {lo, hi}; bf16x2_t b = __builtin_convertvector(v, bf16x2_t); return __builtin_bit_cast(unsigned, b); }

template <class Epi, class Sched>
__device__ __forceinline__ void gemm_phase(LAS unsigned char* lds, const Sched& S, Epi& E, int tid) {
    const int wid = __builtin_amdgcn_readfirstlane(tid >> 6), lane = tid & 63, wr = wid >> 2, wc = wid & 3, fr = lane & 15, fq = lane >> 4;
    int RA[2], RB[2], CC[2];
#pragma unroll
    for (int i = 0; i < 2; ++i) { int Rr, C; stage_rc(tid * 16 + i * 8192, Rr, C); RA[i] = Rr; RB[i] = (Rr & ~31) + perm32(Rr & 31); CC[i] = C; }
    const size_t kstep = (size_t)(BK * 2);
    const unsigned ldsw = (unsigned)wid * 1024u;
    const int aoff = lds_byte(wr * 64 + fr, fq * 8), boff = lds_byte(wc * 32 + fr, fq * 8);
#define PG8_SA(b, h) (((b) * 2 + (h)) * HTB)
#define PG8_SB(b, h) ((4 + (b) * 2 + (h)) * HTB)
#define PG8_STAGE(bufoff, gbase, v0, v1) do { \
        __builtin_amdgcn_global_load_lds((const unsigned*)((const char*)(gbase) + (v0)), (LAS unsigned*)(lds + (bufoff) + ldsw), 16, 0, 0); \
        __builtin_amdgcn_global_load_lds((const unsigned*)((const char*)(gbase) + (v1)), (LAS unsigned*)(lds + (bufoff) + ldsw + 8192), 16, 0, 0); } while (0)
#define PG8_LDA(dst, b, h) do { _Pragma("unroll") for (int m = 0; m < 4; ++m) _Pragma("unroll") for (int k = 0; k < 2; ++k) dst[m][k] = *(const LAS bf16x8*)(lds + PG8_SA(b, h) + aoff + m * 2048 + k * 1024); } while (0)
#define PG8_LDB(dst, b, h) do { _Pragma("unroll") for (int n = 0; n < 2; ++n) _Pragma("unroll") for (int k = 0; k < 2; ++k) dst[n][k] = *(const LAS bf16x8*)(lds + PG8_SB(b, h) + boff + n * 2048 + k * 1024); } while (0)
#define PG8_MMA(ai, bj, At, Bt) do { __builtin_amdgcn_s_setprio(1); _Pragma("unroll") for (int m = 0; m < 4; ++m) _Pragma("unroll") for (int n = 0; n < 2; ++n) _Pragma("unroll") for (int k = 0; k < 2; ++k) \
        acc[ai][bj][m][n] = __builtin_amdgcn_mfma_f32_16x16x32_bf16(Bt[n][k], At[m][k], acc[ai][bj][m][n], 0, 0, 0); __builtin_amdgcn_s_setprio(0); } while (0)
#define PG8_WAIT_V(n) asm volatile("s_waitcnt vmcnt(" #n ")" ::: "memory")
#define PG8_WAIT_L(n) asm volatile("s_waitcnt lgkmcnt(" #n ")" ::: "memory")
#define PG8_BAR __builtin_amdgcn_s_barrier()
#define PG8_SCHED __builtin_amdgcn_sched_barrier(0)
    GUnit cur, nxt; int ui = 0;
    if (!S.next(0, cur)) return;
    f32x4 acc[2][2][4][2];
#pragma unroll
    for (int a = 0; a < 2; ++a)
#pragma unroll
        for (int b = 0; b < 2; ++b)
#pragma unroll
            for (int m = 0; m < 4; ++m)
#pragma unroll
                for (int n = 0; n < 2; ++n) acc[a][b][m][n] = (f32x4){0.f, 0.f, 0.f, 0.f};
    bf16x8 At[4][2], B0[2][2], B1[2][2];
    const char* cA = (const char*)cur.A; const char* cB = (const char*)cur.B;
    int clda = cur.lda, cldb = cur.ldb;
#define VA0(ld) ((unsigned)(RA[0] * (ld) + CC[0]) * 2u)
#define VA1(ld) ((unsigned)(RA[1] * (ld) + CC[1]) * 2u)
#define VB0(ld) ((unsigned)(RB[0] * (ld) + CC[0]) * 2u)
#define VB1(ld) ((unsigned)(RB[1] * (ld) + CC[1]) * 2u)
    unsigned vAc0 = VA0(clda), vAc1 = VA1(clda), vBc0 = VB0(cldb), vBc1 = VB1(cldb);
    size_t hsAc = (size_t)HALF * clda * 2, hsBc = (size_t)HALF * cldb * 2;
    PG8_STAGE(PG8_SB(0, 0), cB, vBc0, vBc1); PG8_STAGE(PG8_SB(0, 1), cB + hsBc, vBc0, vBc1); PG8_STAGE(PG8_SA(0, 0), cA, vAc0, vAc1); PG8_STAGE(PG8_SA(0, 1), cA + hsAc, vAc0, vAc1);
    if (wr == 1) PG8_BAR;
    PG8_WAIT_V(2); PG8_BAR;
    PG8_STAGE(PG8_SB(1, 0), cB + kstep, vBc0, vBc1); PG8_STAGE(PG8_SA(1, 0), cA + kstep, vAc0, vAc1); PG8_STAGE(PG8_SB(1, 1), cB + hsBc + kstep, vBc0, vBc1);
    PG8_WAIT_V(6); PG8_BAR;
    for (;;) {
        const bool has_next = S.next(ui + 1, nxt);
        const char* nA = has_next ? (const char*)nxt.A : cA; const char* nB = has_next ? (const char*)nxt.B : cB;
        const int nlda = has_next ? nxt.lda : cur.lda, nldb = has_next ? nxt.ldb : cur.ldb;
        const size_t hsAn = (size_t)HALF * nlda * 2, hsBn = (size_t)HALF * nldb * 2;
        const int nt = cur.nt;
        for (int t = 0; t < nt; t += 2) {
            const bool last = (t == nt - 2);
            const char* a1 = cA + (size_t)(t + 1) * kstep;
            const char* a2 = last ? nA : cA + (size_t)(t + 2) * kstep; const char* b2 = last ? nB : cB + (size_t)(t + 2) * kstep;
            const char* a3 = a2 + kstep; const char* b3 = b2 + kstep;
            const int lda2 = last ? nlda : clda, ldb2 = last ? nldb : cldb;
            const unsigned vA0 = VA0(lda2), vA1 = VA1(lda2), vB0 = VB0(ldb2), vB1 = VB1(ldb2);
            vAc0 = VA0(clda); vAc1 = VA1(clda);
            const size_t hsA2 = last ? hsAn : hsAc, hsB2 = last ? hsBn : hsBc;
            PG8_LDB(B0, 0, 0); PG8_LDB(B1, 0, 1); PG8_SCHED; PG8_LDA(At, 0, 0); PG8_STAGE(PG8_SA(1, 1), a1 + hsAc, vAc0, vAc1);
            PG8_WAIT_V(8); PG8_WAIT_L(0); PG8_BAR; PG8_MMA(0, 0, At, B0); PG8_MMA(0, 1, At, B1); PG8_BAR; PG8_SCHED;
            PG8_LDA(At, 0, 1); PG8_STAGE(PG8_SB(0, 0), b2, vB0, vB1); PG8_STAGE(PG8_SB(0, 1), b2 + hsB2, vB0, vB1); PG8_STAGE(PG8_SA(0, 0), a2, vA0, vA1);
            PG8_WAIT_V(8); PG8_WAIT_L(0); PG8_BAR; PG8_MMA(1, 0, At, B0); PG8_MMA(1, 1, At, B1); PG8_BAR; PG8_SCHED;
            PG8_LDB(B0, 1, 0); PG8_LDB(B1, 1, 1); PG8_SCHED; PG8_LDA(At, 1, 0); PG8_STAGE(PG8_SA(0, 1), a2 + hsA2, vA0, vA1);
            PG8_WAIT_V(8); PG8_WAIT_L(0); PG8_BAR; PG8_MMA(0, 0, At, B0); PG8_MMA(0, 1, At, B1); PG8_BAR; PG8_SCHED;
            PG8_LDA(At, 1, 1); PG8_STAGE(PG8_SB(1, 0), b3, vB0, vB1); PG8_STAGE(PG8_SB(1, 1), b3 + hsB2, vB0, vB1); PG8_STAGE(PG8_SA(1, 0), a3, vA0, vA1);
            PG8_WAIT_V(8); PG8_WAIT_L(0); PG8_BAR; PG8_MMA(1, 0, At, B0); PG8_MMA(1, 1, At, B1); PG8_BAR; PG8_SCHED;
        }
        if (wr == 0) PG8_BAR;
        const bool clear = E(acc, cur, wr, wc, fr, fq);
        if (!has_next) break;
        if (clear) {
#pragma unroll
        for (int a = 0; a < 2; ++a)
#pragma unroll
            for (int b = 0; b < 2; ++b)
#pragma unroll
                for (int m = 0; m < 4; ++m)
#pragma unroll
                    for (int n = 0; n < 2; ++n) acc[a][b][m][n] = (f32x4){0.f, 0.f, 0.f, 0.f};
        }
        cur = nxt; cA = nA; cB = nB; ++ui;
        clda = nlda; cldb = nldb; vAc0 = VA0(clda); vAc1 = VA1(clda); hsAc = hsAn; hsBc = hsBn;
        if (wr == 1) PG8_BAR;
    }
    PG8_WAIT_V(0);
    PG8_BAR;
#undef VA0
#undef VA1
#undef VB0
#undef VB1
#undef PG8_SA
#undef PG8_SB
#undef PG8_STAGE
#undef PG8_LDA
#undef PG8_LDB
#undef PG8_MMA
#undef PG8_WAIT_V
#undef PG8_WAIT_L
#undef PG8_BAR
#undef PG8_SCHED
}

struct EpiStore {
    __device__ __forceinline__ bool operator()(const f32x4 (&acc)[2][2][4][2], const GUnit& u, int wr, int wc, int fr, int fq) {
#pragma unroll
        for (int ai = 0; ai < 2; ++ai)
#pragma unroll
            for (int m = 0; m < 4; ++m) { bf16_t* rowp = u.C + (size_t)(ai * HALF + wr * 64 + m * 16 + fr) * u.ldc + wc * 32 + 8 * fq;
#pragma unroll
                for (int bj = 0; bj < 2; ++bj) { const f32x4 v0 = acc[ai][bj][m][0], v1 = acc[ai][bj][m][1];
                    u32x4 w; w.x = cvt_pk_bf16(v0[0], v0[1]); w.y = cvt_pk_bf16(v0[2], v0[3]); w.z = cvt_pk_bf16(v1[0], v1[1]); w.w = cvt_pk_bf16(v1[2], v1[3]);
                    *(GAS u32x4*)(rowp + bj * HALF) = w; } }
        return true;
    }
};
struct EpiResid {
    const float* xp; const float* xs; float* out;
    __device__ __forceinline__ bool operator()(const f32x4 (&acc)[2][2][4][2], const GUnit& u, int wr, int wc, int fr, int fq) {
        const unsigned off0 = (unsigned)(wr * 64 + fr) * DM + u.pn * 256 + wc * 32 + 8 * fq;
        const float* xin = ((u.pm < 64) ? xp + (size_t)u.pm * 256 * DM : xs + (size_t)(u.pm - 64) * 256 * DM) + off0;
        float* o = out + (size_t)u.pm * 256 * DM + off0;
#pragma unroll
        for (int ai = 0; ai < 2; ++ai)
#pragma unroll
            for (int m = 0; m < 4; ++m)
#pragma unroll
                for (int bj = 0; bj < 2; ++bj) { const unsigned ro = (unsigned)(ai * HALF + m * 16) * DM + bj * HALF;
                    const f32x4 x0 = *(const GAS f32x4*)(xin + ro), x1 = *(const GAS f32x4*)(xin + ro + 4);
                    *(GAS f32x4*)(o + ro) = x0 + acc[ai][bj][m][0]; *(GAS f32x4*)(o + ro + 4) = x1 + acc[ai][bj][m][1]; }
        return true;
    }
};
struct EpiResidNorm {
    const float* xp; const float* xs; float* out; bf16_t* hbo; const float* g2; float* sumsq;
    __device__ __forceinline__ bool operator()(const f32x4 (&acc)[2][2][4][2], const GUnit& u, int wr, int wc, int fr, int fq) {
        const unsigned col0 = u.pn * 256 + wc * 32 + 8 * fq;
        const unsigned off0 = (unsigned)(wr * 64 + fr) * DM + col0;
        const float* xin = ((u.pm < 64) ? xp + (size_t)u.pm * 256 * DM : xs + (size_t)(u.pm - 64) * 256 * DM) + off0;
        float* o = out + (size_t)u.pm * 256 * DM + off0;
        bf16_t* ho = hbo + (size_t)u.pm * 256 * DM + off0;
        f32x4 gg[2][2];
#pragma unroll
        for (int bj = 0; bj < 2; ++bj) { gg[bj][0] = *(const GAS f32x4*)(g2 + col0 + bj * HALF); gg[bj][1] = *(const GAS f32x4*)(g2 + col0 + bj * HALF + 4); }
#pragma unroll
        for (int ai = 0; ai < 2; ++ai)
#pragma unroll
            for (int m = 0; m < 4; ++m) { float ss = 0.f;
#pragma unroll
                for (int bj = 0; bj < 2; ++bj) { const unsigned ro = (unsigned)(ai * HALF + m * 16) * DM + bj * HALF;
                    const f32x4 x0 = *(const GAS f32x4*)(xin + ro) + acc[ai][bj][m][0], x1 = *(const GAS f32x4*)(xin + ro + 4) + acc[ai][bj][m][1];
                    *(GAS f32x4*)(o + ro) = x0; *(GAS f32x4*)(o + ro + 4) = x1;
                    ss += (x0[0] * x0[0] + x0[1] * x0[1]) + (x0[2] * x0[2] + x0[3] * x0[3]) + (x1[0] * x1[0] + x1[1] * x1[1]) + (x1[2] * x1[2] + x1[3] * x1[3]);
                    const f32x4 h0 = x0 * gg[bj][0], h1 = x1 * gg[bj][1]; u32x4 w;
                    w.x = cvt_pk_bf16(h0[0], h0[1]); w.y = cvt_pk_bf16(h0[2], h0[3]); w.z = cvt_pk_bf16(h1[0], h1[1]); w.w = cvt_pk_bf16(h1[2], h1[3]);
                    *(GAS u32x4*)(ho + ro) = w; }
                ss += __shfl_xor(ss, 16); ss += __shfl_xor(ss, 32);
                if (fq == 0) atomicAdd(sumsq + u.pm * 256 + ai * HALF + wr * 64 + m * 16 + fr, ss); }
        return true;
    }
};
struct EpiSwigluNorm {
    bf16_t* act; const float* sumsq;
    __device__ __forceinline__ bool operator()(const f32x4 (&acc)[2][2][4][2], const GUnit& u, int wr, int wc, int fr, int fq) {
#pragma unroll
        for (int ai = 0; ai < 2; ++ai)
#pragma unroll
            for (int m = 0; m < 4; ++m) { const int row = u.pm * 256 + ai * HALF + wr * 64 + m * 16 + fr;
                const float rs = 1.f / sqrtf(*(const GAS float*)(sumsq + row) * (1.f / DM) + EPS);
                bf16_t* rowp = act + (size_t)row * FF + u.pn * 128 + wc * 32 + 8 * fq;
                float o[8];
#pragma unroll
                for (int n = 0; n < 2; ++n)
#pragma unroll
                    for (int i = 0; i < 4; ++i) o[4 * n + i] = siluf_(rs * acc[ai][0][m][n][i]) * (rs * acc[ai][1][m][n][i]);
                u32x4 w; w.x = cvt_pk_bf16(o[0], o[1]); w.y = cvt_pk_bf16(o[2], o[3]); w.z = cvt_pk_bf16(o[4], o[5]); w.w = cvt_pk_bf16(o[6], o[7]);
                *(GAS u32x4*)rowp = w; }
        return true;
    }
};
struct EpiSwiglu {
    bf16_t* act;
    __device__ __forceinline__ bool operator()(const f32x4 (&acc)[2][2][4][2], const GUnit& u, int wr, int wc, int fr, int fq) {
#pragma unroll
        for (int ai = 0; ai < 2; ++ai)
#pragma unroll
            for (int m = 0; m < 4; ++m) { bf16_t* rowp = act + (size_t)(u.pm * 256 + ai * HALF + wr * 64 + m * 16 + fr) * FF + u.pn * 128 + wc * 32 + 8 * fq;
                float o[8];
#pragma unroll
                for (int n = 0; n < 2; ++n)
#pragma unroll
                    for (int i = 0; i < 4; ++i) o[4 * n + i] = siluf_(acc[ai][0][m][n][i]) * acc[ai][1][m][n][i];
                u32x4 w; w.x = cvt_pk_bf16(o[0], o[1]); w.y = cvt_pk_bf16(o[2], o[3]); w.z = cvt_pk_bf16(o[4], o[5]); w.w = cvt_pk_bf16(o[6], o[7]);
                *(GAS u32x4*)rowp = w; }
        return true;
    }
};
struct EpiMerge {
    const float* bgate; bf16_t* merged; bf16_t* gtmp;
    __device__ __forceinline__ bool operator()(const f32x4 (&acc)[2][2][4][2], const GUnit& u, int wr, int wc, int fr, int fq) {
        const int br = u.sub >> 1;
        const unsigned off0 = (unsigned)(u.pm * 256 + wr * 64 + fr) * DM + u.pn * 256 + wc * 32 + 8 * fq;
        if ((u.sub & 1) == 0) {
#pragma unroll
            for (int bj = 0; bj < 2; ++bj) { const float* bp = bgate + br * 1024 + u.pn * 256 + bj * HALF + wc * 32 + 8 * fq;
                const f32x4 b0 = *(const GAS f32x4*)bp, b1 = *(const GAS f32x4*)(bp + 4);
#pragma unroll
                for (int ai = 0; ai < 2; ++ai)
#pragma unroll
                    for (int m = 0; m < 4; ++m) { const f32x4 v0 = acc[ai][bj][m][0] + b0, v1 = acc[ai][bj][m][1] + b1; u32x4 w;
                        w.x = cvt_pk_bf16(sigmoidf_(v0[0]), sigmoidf_(v0[1])); w.y = cvt_pk_bf16(sigmoidf_(v0[2]), sigmoidf_(v0[3]));
                        w.z = cvt_pk_bf16(sigmoidf_(v1[0]), sigmoidf_(v1[1])); w.w = cvt_pk_bf16(sigmoidf_(v1[2]), sigmoidf_(v1[3]));
                        *(GAS u32x4*)(gtmp + off0 + (unsigned)(ai * HALF + m * 16) * DM + bj * HALF) = w; } }
        } else {
#pragma unroll
            for (int ai = 0; ai < 2; ++ai)
#pragma unroll
                for (int m = 0; m < 4; ++m)
#pragma unroll
                    for (int bj = 0; bj < 2; ++bj) { const unsigned off = off0 + (unsigned)(ai * HALF + m * 16) * DM + bj * HALF;
                        const u32x4 gg = *(const GAS u32x4*)(gtmp + off); u32x4 mm = (u32x4){0u, 0u, 0u, 0u}; if (br > 0) mm = *(const GAS u32x4*)(merged + off);
                        const f32x4 a0 = acc[ai][bj][m][0], a1 = acc[ai][bj][m][1]; u32x4 w;
                        w.x = cvt_pk_bf16(bflo(mm.x) + bflo(gg.x) * a0[0], bfhi(mm.x) + bfhi(gg.x) * a0[1]); w.y = cvt_pk_bf16(bflo(mm.y) + bflo(gg.y) * a0[2], bfhi(mm.y) + bfhi(gg.y) * a0[3]);
                        w.z = cvt_pk_bf16(bflo(mm.z) + bflo(gg.z) * a1[0], bfhi(mm.z) + bfhi(gg.z) * a1[1]); w.w = cvt_pk_bf16(bflo(mm.w) + bflo(gg.w) * a1[2], bfhi(mm.w) + bfhi(gg.w) * a1[3]);
                        *(GAS u32x4*)(merged + off) = w; }
        }
        return true;
    }
};
}

struct Args { const float* in[38]; float* out; unsigned char* ws; int ph_lo, ph_hi; };
struct Ctx {
    const Args* A; float* out; unsigned char* ws; LAS unsigned char* lds;
    int tid, lane, wave, gw, NGW, l, G, bid;
};
#define WSB(off) ((bf16_t*)(C.ws + (off)))
#define INL(i, sz) (C.A->in[i] + (size_t)C.l * (size_t)(sz))
#define IN0(i) (C.A->in[i])

using pg8::GUnit;
struct SchedOne {
    const bf16_t* A; const bf16_t* B; bf16_t* Cp; int lda, ldb, ldc, nM, nN, nt, G, c;
    __device__ __forceinline__ bool next(int i, GUnit& u) const {
        const long L = (long)i * G + c; if (L >= (long)nM * nN) return false;
        int pm, pn; pg8::tile_map((int)L, nM, nN, pm, pn);
        u.A = A + (size_t)pm * 256 * lda; u.B = B + (size_t)pn * 256 * ldb; u.lda = lda; u.ldb = ldb; u.nt = nt; u.pm = pm; u.pn = pn; u.sub = 0;
        u.C = Cp ? Cp + (size_t)pm * 256 * ldc + (size_t)pn * 256 : nullptr; u.ldc = ldc; return true;
    }
};
struct SchedInproj {
    const bf16_t* A; const bf16_t* B; bf16_t *pA, *pB, *pC, *pD; int G, c;
    __device__ __forceinline__ bool next(int i, GUnit& u) const {
        const long L = (long)i * G + c; if (L >= 72 * 21) return false;
        int pm, pn; pg8::tile_map((int)L, 72, 21, pm, pn);
        u.A = A + (size_t)pm * 256 * 1024; u.B = B + (size_t)pn * 256 * 1024; u.lda = 1024; u.ldb = 1024; u.nt = 16; u.pm = pm; u.pn = pn; u.sub = 0;
        if (pn < 6) { u.C = pA + (size_t)pm * 256 * 1536 + pn * 256; u.ldc = 1536; }
        else if (pn < 9) { u.C = pB + (size_t)pm * 256 * 768 + (pn - 6) * 256; u.ldc = 768; }
        else if (pn < 15) { u.C = pC + (size_t)pm * 256 * 1536 + (pn - 9) * 256; u.ldc = 1536; }
        else { u.C = pD + (size_t)pm * 256 * 1536 + (pn - 15) * 256; u.ldc = 1536; }
        return true;
    }
};
struct SchedP3 {
    const bf16_t *pB, *wq, *ckvP, *ckvS, *wkv; bf16_t *Q, *KVP, *KVS; int G, c;
    __device__ __forceinline__ bool next(int i, GUnit& u) const {
        long L = (long)i * G + c; int pm, pn; u.sub = 0;
        if (L < 264 * 4) { pg8::tile_map((int)L, 264, 4, pm, pn); u.A = ckvS + (size_t)pm * 256 * 256; u.B = wkv + (size_t)pn * 256 * 256; u.lda = 256; u.ldb = 256; u.nt = 4;
            u.C = KVS + (size_t)pm * 256 * 1024 + pn * 256; u.ldc = 1024; u.pm = pm; u.pn = pn; return true; }
        L -= 264 * 4;
        if (L < 64 * 4) { pg8::tile_map((int)L, 64, 4, pm, pn); u.A = ckvP + (size_t)pm * 256 * 256; u.B = wkv + (size_t)pn * 256 * 256; u.lda = 256; u.ldb = 256; u.nt = 4;
            u.C = KVP + (size_t)pm * 256 * 1024 + pn * 256; u.ldc = 1024; u.pm = pm; u.pn = pn; return true; }
        L -= 64 * 4;
        if (L < 72 * 3) { pg8::tile_map((int)L, 72, 3, pm, pn); u.A = pB + (size_t)pm * 256 * 768; u.B = wq + (size_t)pn * 256 * 384; u.lda = 768; u.ldb = 384; u.nt = 6;
            u.C = Q + (size_t)pm * 256 * 768 + pn * 256; u.ldc = 768; u.pm = pm; u.pn = pn; return true; }
        return false;
    }
};
struct SchedMerge {
    const bf16_t *hb, *wg, *wout, *pA, *ybc, *pD; int G, c;
    __device__ __forceinline__ bool next(int i, GUnit& u) const {
        const long L = (long)(i >> 3) * G + c; if (L >= 72 * 4) return false;
        int pm, pn; pg8::tile_map((int)L, 72, 4, pm, pn); const int sub = i & 7, br = sub >> 1;
        u.pm = pm; u.pn = pn; u.sub = sub; u.C = nullptr; u.ldc = 0; u.ldb = 1024;
        if ((sub & 1) == 0) { u.A = hb + (size_t)pm * 256 * 1024; u.lda = 1024; u.nt = 16; u.B = wg + (size_t)(br * 1024 + pn * 256) * 1024; }
        else { u.nt = 8; u.B = wout + (size_t)(br * 1024 + pn * 256) * 1024;
            if (br == 0) { u.A = pA + (size_t)pm * 256 * 1536; u.lda = 1536; }
            else if (br == 1) { u.A = ybc + (size_t)pm * 256 * 1024; u.lda = 1024; }
            else if (br == 2) { u.A = ybc + (size_t)pm * 256 * 1024 + 512; u.lda = 1024; }
            else { u.A = pD + (size_t)pm * 256 * 1536; u.lda = 1536; } }
        return true;
    }
};

template <class Map>
__device__ __forceinline__ void transpose_w(const Ctx& C, const float* W, int ldw, int K, int Nout, bf16_t* WT, int ldt, Map map) {
    LAS float* scr = (LAS float*)(C.lds + C.wave * 8704);
    const int lane = C.lane, nblk = Nout / 32, items = (K / 64) * nblk;
    for (int it = C.gw; it < items; it += C.NGW) {
        const int kb = it / nblk, nb = it % nblk, k0 = 64 * kb, n0 = 32 * nb;
        const int col = map(n0 + (lane & 31));
#pragma unroll 8
        for (int i = 0; i < 32; ++i) { const int kk = 2 * i + (lane >> 5); scr[kk * 33 + (lane & 31)] = (col >= 0) ? W[(size_t)(k0 + kk) * ldw + col] : 0.f; }
        LDS_WAIT();
        const int c = lane & 7;
#pragma unroll
        for (int j = 0; j < 4; ++j) { const int n = (lane >> 3) + 8 * j; const LAS float* s = scr + (8 * c) * 33 + n;
            u32x4 o; o.x = pk2(s[0 * 33], s[1 * 33]); o.y = pk2(s[2 * 33], s[3 * 33]); o.z = pk2(s[4 * 33], s[5 * 33]); o.w = pk2(s[6 * 33], s[7 * 33]);
            *(u32x4*)(WT + (size_t)(n0 + n) * ldt + k0 + 8 * c) = o; }
        LDS_WAIT();
    }
}
struct MapId { __device__ __forceinline__ int operator()(int n) const { return n; } };
struct MapOff { int off; __device__ __forceinline__ int operator()(int n) const { return n + off; } };
struct MapIn { __device__ __forceinline__ int operator()(int n) const { return n < 1536 ? n : (n < 2208 ? n + 8 : (n < 2216 ? n - 2208 + 1536 : (n < 2304 ? -1 : n - 88))); } };
struct MapKv { __device__ __forceinline__ int operator()(int n) const { return n < 512 ? ((n >> 6) * 128 + (n & 63)) : (((n - 512) >> 6) * 128 + 64 + (n & 63)); } };
struct MapUp { __device__ __forceinline__ int operator()(int n) const { const int t = n >> 8, w = n & 255; return w < 128 ? 128 * t + w : 2816 + 128 * t + (w - 128); } };

__device__ __forceinline__ void phase_wprep(const Ctx& C) {
    transpose_w(C, INL(10, 1024 * IN_COLS), IN_COLS, 1024, 5376, WSB(WS_WT_IN), 1024, MapIn());
    transpose_w(C, INL(10, 1024 * IN_COLS), IN_COLS, 1024, 4096, WSB(WS_WT_G), 1024, MapOff{5288});
    transpose_w(C, INL(20, 384 * 768), 768, 384, 768, WSB(WS_WT_QUP), 384, MapId());
    transpose_w(C, INL(22, 256 * 1024), 1024, 256, 1024, WSB(WS_WT_KVUP), 256, MapKv());
    transpose_w(C, INL(18, 512 * 1024), 1024, 512, 1024, WSB(WS_WT_OUT), 1024, MapId());
    transpose_w(C, INL(27, 512 * 1024), 1024, 512, 1024, WSB(WS_WT_OUT) + (size_t)1 * 1024 * 1024, 1024, MapId());
    transpose_w(C, INL(29, 512 * 1024), 1024, 512, 1024, WSB(WS_WT_OUT) + (size_t)2 * 1024 * 1024, 1024, MapId());
    transpose_w(C, INL(33, 512 * 1024), 1024, 512, 1024, WSB(WS_WT_OUT) + (size_t)3 * 1024 * 1024, 1024, MapId());
    transpose_w(C, INL(34, 1024 * 1024), 1024, 1024, 1024, WSB(WS_WT_O), 1024, MapId());
    transpose_w(C, INL(36, 1024 * 5632), 5632, 1024, 5632, WSB(WS_WT_UP), 1024, MapUp());
    transpose_w(C, INL(37, 2816 * 1024), 1024, 2816, 1024, WSB(WS_WT_DOWN), 2816, MapId());
}

__device__ __forceinline__ const float* xrow(const Ctx& C, int row, bool from_out) {
    if (from_out) return C.out + (size_t)row * DM;
    return row < NP ? IN0(0) + (size_t)row * DM : IN0(1) + (size_t)(row - NP) * DM;
}
__device__ __forceinline__ void phase_norm(const Ctx& C, const float* g, bool from_out) {
    const int lane = C.lane;
    f32x4 gv[4];
#pragma unroll
    for (int j = 0; j < 4; ++j) gv[j] = ((const f32x4*)g)[64 * j + lane];
    for (int row = C.gw; row < R; row += C.NGW) {
        const f32x4* xr = (const f32x4*)xrow(C, row, from_out) + lane;
        f32x4 v[4]; float s = 0.f;
#pragma unroll
        for (int j = 0; j < 4; ++j) { v[j] = xr[64 * j]; s += (v[j].x * v[j].x + v[j].y * v[j].y) + (v[j].z * v[j].z + v[j].w * v[j].w); }
        const float rstd = 1.f / sqrtf(wave_sum(s) * (1.f / DM) + EPS);
        u32x2* o = (u32x2*)(WSB(WS_HB) + (size_t)row * DM) + lane;
#pragma unroll
        for (int j = 0; j < 4; ++j) { u32x2 w; w.x = pk2(v[j].x * rstd * gv[j].x, v[j].y * rstd * gv[j].y); w.y = pk2(v[j].z * rstd * gv[j].z, v[j].w * rstd * gv[j].w); o[64 * j] = w; }
    }
}
__device__ __forceinline__ void rope_cs(int pos, int i, float& c, float& s) {
    const float chi = ((i & 8) ? ((i & 4) ? ((i & 2) ? ((i & 1) ? 2.831220627e-05f : 5.030632019e-05f) : ((i & 1) ? 8.952617645e-05f : 1.592636108e-04f)) : ((i & 2) ? ((i & 1) ? 2.832412720e-04f : 5.035400391e-04f) : ((i & 1) ? 8.945465088e-04f : 1.590728760e-03f))) : ((i & 4) ? ((i & 2) ? ((i & 1) ? 2.830505371e-03f : 5.035400391e-03f) : ((i & 1) ? 8.956909180e-03f : 1.593017578e-02f)) : ((i & 2) ? ((i & 1) ? 2.828979492e-02f : 5.035400391e-02f) : ((i & 1) ? 8.947753906e-02f : 1.591796875e-01f))));
    const float clo = ((i & 8) ? ((i & 4) ? ((i & 2) ? ((i & 1) ? -1.001043781e-08f : 2.289191414e-08f) : ((i & 1) ? -2.677484368e-08f : -1.086677486e-07f)) : ((i & 2) ? ((i & 1) ? -2.193136623e-07f : -2.479180239e-07f) : ((i & 1) ? 4.475072899e-07f : 8.206711755e-07f))) : ((i & 4) ? ((i & 2) ? ((i & 1) ? -2.857880190e-07f : -2.479180239e-06f) : ((i & 1) ? -6.969018614e-06f : -1.468147184e-05f)) : ((i & 2) ? ((i & 1) ? 1.240090842e-05f : -2.479180148e-05f) : ((i & 1) ? 2.186254642e-05f : -2.474440771e-05f))));
    const float pf = (float)pos, rh = pf * chi, f1 = rh - __builtin_rintf(rh), fr = f1 + pf * clo;
    c = __builtin_amdgcn_cosf(fr); s = __builtin_amdgcn_sinf(fr);
}
__device__ __forceinline__ int row_pos(int row) { return row < NP ? (row & (TP - 1)) : PAST + ((row - NP) & 63); }

__device__ __forceinline__ void phase_mla_prep(const Ctx& C) {
    const int lane = C.lane; const int l = C.l;
    const float* gq = INL(19, 384); const float* gkv = INL(21, 256); const float* gkr = INL(26, 32);
    for (int row = C.gw; row < R; row += C.NGW) {
        bf16_t* pb = WSB(WS_ZB) + (size_t)row * 768;
        unsigned q[3]; float ss = 0.f;
#pragma unroll
        for (int j = 0; j < 3; ++j) { q[j] = *(const unsigned*)(pb + 2 * lane + 128 * j); const float a = bflo(q[j]), b = bfhi(q[j]); ss += a * a + b * b; }
        float rstd = 1.f / sqrtf(wave_sum(ss) * (1.f / 384.f) + EPS);
#pragma unroll
        for (int j = 0; j < 3; ++j) { const int c = 2 * lane + 128 * j; *(unsigned*)(pb + c) = pk2(bflo(q[j]) * rstd * gq[c], bfhi(q[j]) * rstd * gq[c + 1]); }
        const u32x2 kv = *(const u32x2*)(pb + 384 + 4 * lane);
        float k0 = bflo(kv.x), k1 = bfhi(kv.x), k2 = bflo(kv.y), k3 = bfhi(kv.y);
        rstd = 1.f / sqrtf(wave_sum(k0 * k0 + k1 * k1 + k2 * k2 + k3 * k3) * (1.f / 256.f) + EPS);
        const f32x4 g4 = *(const f32x4*)(gkv + 4 * lane);
        f32x4 ck; ck.x = k0 * rstd * g4.x; ck.y = k1 * rstd * g4.y; ck.z = k2 * rstd * g4.z; ck.w = k3 * rstd * g4.w;
        u32x2 ckb; ckb.x = pk2(ck.x, ck.y); ckb.y = pk2(ck.z, ck.w);
        const int pos = row_pos(row);
        size_t srow = 0;
        if (row < NP) { *(f32x4*)(C.out + O_CKV_P + ((size_t)l * NP + row) * 256 + 4 * lane) = ck; *(u32x2*)(WSB(WS_CKVP) + (size_t)row * 256 + 4 * lane) = ckb; }
        else { const int rs = row - NP; srow = (size_t)(rs >> 6) * KS_ALL + PAST + (rs & 63);
            *(f32x4*)(C.out + O_CKV_S + ((size_t)l * NS + rs) * 256 + 4 * lane) = ck; *(u32x2*)(WSB(WS_CKVS) + srow * 256 + 4 * lane) = ckb; }
        const float x = (lane < 32) ? bf1(pb[640 + lane]) : 0.f;
        rstd = 1.f / sqrtf(wave_sum(x * x) * (1.f / 32.f) + EPS);
        const float y = x * rstd * gkr[lane & 31];
        const float part = __shfl_xor(y, 16);
        float cs, sn; rope_cs(pos, lane & 15, cs, sn);
        const float o = (lane < 16) ? (y * cs - part * sn) : (part * sn + y * cs);
        if (lane < 32) {
            if (row < NP) { C.out[O_KPE_P + ((size_t)l * NP + row) * 32 + lane] = o; WSB(WS_KPEP)[(size_t)row * 32 + lane] = (bf16_t)f2bf(o); }
            else { C.out[O_KPE_S + ((size_t)l * NS + (row - NP)) * 32 + lane] = o; WSB(WS_KPES)[srow * 32 + lane] = (bf16_t)f2bf(o); }
        }
    }
    const size_t gt = (size_t)C.bid * NTHREADS + C.tid, GT = (size_t)C.G * NTHREADS;
    { const float* src = INL(4, (size_t)BS * PAST * 256);
      for (size_t i = gt; i < (size_t)BS * PAST * 256 / 8; i += GT) { const size_t e = i * 8, b = e / ((size_t)PAST * 256), rem = e % ((size_t)PAST * 256);
          *(u32x4*)(WSB(WS_CKVS) + b * KS_ALL * 256 + rem) = load8(src, e, true); } }
    { const float* src = INL(5, (size_t)BS * PAST * 32);
      for (size_t i = gt; i < (size_t)BS * PAST * 32 / 8; i += GT) { const size_t e = i * 8, b = e / ((size_t)PAST * 32), rem = e % ((size_t)PAST * 32);
          *(u32x4*)(WSB(WS_KPES) + b * KS_ALL * 32 + rem) = load8(src, e, true); } }
}

__device__ __forceinline__ float red8(float v) { v += __shfl_xor(v, 1); v += __shfl_xor(v, 2); v += __shfl_xor(v, 4); return v; }

__device__ __forceinline__ void phase_band_prep(const Ctx& C) {
    const int lane = C.lane, l = C.l, d0 = (lane & 7) * 8;
    float gq[8], gk[8];
#pragma unroll
    for (int e = 0; e < 8; ++e) { gq[e] = INL(30, 64)[d0 + e] * (0.125f * LOG2E); gk[e] = INL(31, 64)[d0 + e]; }
    for (int row = C.gw; row < R; row += C.NGW) {
        bf16_t* pd = WSB(WS_PD) + (size_t)row * 1536 + 8 * lane;
        float f[8], kf[8], vf[8];
        unpack8(*(const u32x4*)pd, f); float ss = 0.f;
#pragma unroll
        for (int e = 0; e < 8; ++e) ss += f[e] * f[e];
        float rstd = 1.f / sqrtf(red8(ss) * (1.f / 64.f) + EPS);
#pragma unroll
        for (int e = 0; e < 8; ++e) f[e] *= rstd * gq[e];
        *(u32x4*)pd = pack8(f);
        unpack8(*(const u32x4*)(pd + 512), kf); ss = 0.f;
#pragma unroll
        for (int e = 0; e < 8; ++e) ss += kf[e] * kf[e];
        rstd = 1.f / sqrtf(red8(ss) * (1.f / 64.f) + EPS);
#pragma unroll
        for (int e = 0; e < 8; ++e) kf[e] *= rstd * gk[e];
        *(u32x4*)(pd + 512) = pack8(kf);
        unpack8(*(const u32x4*)(pd + 1024), vf);
        long dst = -1;
        if (row < NP) { const int t = row & (TP - 1), b = row >> 13; if (t >= TP - 512) dst = (long)(((size_t)(l * BP + b) * 512 + (t - (TP - 512))) * 512 + 8 * lane); }
        else { const int rs = row - NP, b = rs >> 6, t = rs & 63; dst = (long)(((size_t)(l * BS + b) * 512 + 448 + t) * 512 + 8 * lane); }
        if (dst >= 0) { float* ko = C.out + (row < NP ? O_BK_P : O_BK_S) + dst; float* vo = C.out + (row < NP ? O_BV_P : O_BV_S) + dst;
            *(f32x4*)ko = (f32x4){kf[0], kf[1], kf[2], kf[3]}; *(f32x4*)(ko + 4) = (f32x4){kf[4], kf[5], kf[6], kf[7]};
            *(f32x4*)vo = (f32x4){vf[0], vf[1], vf[2], vf[3]}; *(f32x4*)(vo + 4) = (f32x4){vf[4], vf[5], vf[6], vf[7]}; }
    }
    const size_t gt = (size_t)C.bid * NTHREADS + C.tid, GT = (size_t)C.G * NTHREADS;
    const f32x4* sk = (const f32x4*)INL(7, (size_t)BS * 512 * 512); const f32x4* sv = (const f32x4*)INL(8, (size_t)BS * 512 * 512);
    f32x4* dk = (f32x4*)(C.out + O_BK_S + (size_t)l * BS * 512 * 512); f32x4* dv = (f32x4*)(C.out + O_BV_S + (size_t)l * BS * 512 * 512);
    for (size_t i = gt; i < (size_t)BS * 448 * 128; i += GT) { const size_t b = i / (448 * 128), rem = i % (448 * 128);
        dk[b * 512 * 128 + rem] = sk[b * 512 * 128 + 64 * 128 + rem]; dv[b * 512 * 128 + rem] = sv[b * 512 * 128 + 64 * 128 + rem]; }
}

__device__ __forceinline__ void phase_sconv(const Ctx& C) {
    const int lane = C.lane, l = C.l, ch = 8 * lane;
    const float* w = INL(28, 3 * 512);
    float w0[8], w1[8], w2[8];
#pragma unroll
    for (int e = 0; e < 8; ++e) { w0[e] = w[ch + e]; w1[e] = w[512 + ch + e]; w2[e] = w[1024 + ch + e]; }
    for (int row = C.gw; row < R; row += C.NGW) {
        const bf16_t* pc = WSB(WS_XR) + (size_t)row * 1536 + ch;
        const bool pr = row < NP; const int t = pr ? (row & (TP - 1)) : ((row - NP) & 63); const int b = pr ? (row >> 13) : ((row - NP) >> 6);
        float cb[8], a[8], x[8], u0[8], u1[8], u2[8];
        unpack8(*(const u32x4*)pc, cb); unpack8(*(const u32x4*)(pc + 512), a); unpack8(*(const u32x4*)(pc + 1024), x);
#pragma unroll
        for (int e = 0; e < 8; ++e) u0[e] = a[e] * x[e];
        const float* st = INL(6, BS * 2 * 512) + (size_t)b * 2 * 512 + ch;
        if (t >= 1) { unpack8(*(const u32x4*)(pc - 1536 + 512), a); unpack8(*(const u32x4*)(pc - 1536 + 1024), x);
#pragma unroll
            for (int e = 0; e < 8; ++e) u1[e] = a[e] * x[e]; }
        else {
#pragma unroll
            for (int e = 0; e < 8; ++e) u1[e] = pr ? 0.f : st[512 + e]; }
        if (t >= 2) { unpack8(*(const u32x4*)(pc - 3072 + 512), a); unpack8(*(const u32x4*)(pc - 3072 + 1024), x);
#pragma unroll
            for (int e = 0; e < 8; ++e) u2[e] = a[e] * x[e]; }
        else {
#pragma unroll
            for (int e = 0; e < 8; ++e) u2[e] = pr ? 0.f : st[(t == 1 ? 512 : 0) + e]; }
        float y[8];
#pragma unroll
        for (int e = 0; e < 8; ++e) y[e] = cb[e] * (w0[e] * u2[e] + w1[e] * u1[e] + w2[e] * u0[e]);
        *(u32x4*)(WSB(WS_YBC) + (size_t)row * 1024 + 512 + ch) = pack8(y);
        const int T = pr ? TP : TS;
        if (t >= T - 2) { float* o = C.out + (pr ? O_SC_P + ((size_t)(l * BP + b) * 2 + (t - (T - 2))) * 512 : O_SC_S + ((size_t)(l * BS + b) * 2 + (t - (T - 2))) * 512) + ch;
            *(f32x4*)o = (f32x4){u0[0], u0[1], u0[2], u0[3]}; *(f32x4*)(o + 4) = (f32x4){u0[4], u0[5], u0[6], u0[7]}; }
    }
}

__device__ __forceinline__ void phase_qk_post(const Ctx& C) {
    const int lane = C.lane, head = lane >> 3, sub = lane & 7;
    const float SC = 0.10206207261596577f * LOG2E;
    float gn[8], gr[8], gk[8];
#pragma unroll
    for (int e = 0; e < 8; ++e) { gn[e] = INL(23, 64)[8 * sub + e] * SC; gr[e] = INL(25, 32)[8 * (sub & 3) + e]; gk[e] = INL(24, 64)[8 * sub + e]; }
    for (int row = C.gw; row < R; row += C.NGW) {
        bf16_t* qp = WSB(WS_Q) + (size_t)row * 768 + 96 * head;
        float f[8]; unpack8(*(const u32x4*)(qp + 8 * sub), f); float ss = 0.f;
#pragma unroll
        for (int e = 0; e < 8; ++e) ss += f[e] * f[e];
        float rstd = 1.f / sqrtf(red8(ss) * (1.f / 64.f) + EPS);
#pragma unroll
        for (int e = 0; e < 8; ++e) f[e] *= rstd * gn[e];
        *(u32x4*)(qp + 8 * sub) = pack8(f);
        float r[8];
        if (sub < 4) unpack8(*(const u32x4*)(qp + 64 + 8 * sub), r);
        else {
#pragma unroll
            for (int e = 0; e < 8; ++e) r[e] = 0.f; }
        ss = 0.f;
#pragma unroll
        for (int e = 0; e < 8; ++e) ss += r[e] * r[e];
        ss += __shfl_xor(ss, 1); ss += __shfl_xor(ss, 2);
        rstd = 1.f / sqrtf(ss * (1.f / 32.f) + EPS);
        const int pos = row_pos(row);
        float o[8];
#pragma unroll
        for (int e = 0; e < 8; ++e) { const float y = r[e] * rstd * gr[e]; const float part = __shfl_xor(y, 2);
            float cs, sn; rope_cs(pos, 8 * (sub & 1) + e, cs, sn);
            o[e] = ((sub < 2) ? (y * cs - part * sn) : (part * sn + y * cs)) * SC; }
        if (sub < 4) *(u32x4*)(qp + 64 + 8 * sub) = pack8(o);
    }
    for (int row = C.gw; row < NP + BS * KS_ALL; row += C.NGW) {
        bf16_t* kp = (row < NP ? WSB(WS_KVP) + (size_t)row * 1024 : WSB(WS_XR) + (size_t)(row - NP) * 1024) + 8 * lane;
        float f[8]; unpack8(*(const u32x4*)kp, f); float ss = 0.f;
#pragma unroll
        for (int e = 0; e < 8; ++e) ss += f[e] * f[e];
        const float rstd = 1.f / sqrtf(red8(ss) * (1.f / 64.f) + EPS);
#pragma unroll
        for (int e = 0; e < 8; ++e) f[e] *= rstd * gk[e];
        *(u32x4*)kp = pack8(f);
    }
}

__device__ __forceinline__ bf16x8 mk_frag(u32x2 lo, u32x2 hi) { u32x4 v; v.x = lo.x; v.y = lo.y; v.z = hi.x; v.w = hi.y; return __builtin_bit_cast(bf16x8, v); }
__device__ __forceinline__ bf16x8 as_frag(u32x4 v) { return __builtin_bit_cast(bf16x8, v); }
#define MFMA16(a, b, c) __builtin_amdgcn_mfma_f32_16x16x32_bf16((a), (b), (c), 0, 0, 0)

__device__ __forceinline__ int ssd_row0(int seq, int c) { return seq < 2 ? seq * TP + c * 64 : NP + (seq - 2) * 64; }
__device__ __forceinline__ void ssd_dt(const Ctx& C, int row0, LAS float* sDT, LAS float* sACS) {
    const int h = C.wave, lane = C.lane;
    const float adt = bf1(WSB(WS_ZB)[(size_t)(row0 + lane) * 768 + 672 + h]) + INL(14, 8)[h];
    float dt; { const float e_ = fexp(adt), u_ = 1.f + e_; dt = (adt > 20.f) ? adt : ((u_ == 1.f) ? e_ : (__builtin_amdgcn_logf(u_) * 0.6931471805599453f) * e_ * frcp(u_ - 1.f)); }
    const float A = -fexp(INL(15, 8)[h]);
    float cs = dt * A;
#pragma unroll
    for (int o = 1; o < 64; o <<= 1) { const float t = __shfl_up(cs, o); if (lane >= o) cs += t; }
    sDT[h * 64 + lane] = dt; sACS[h * 64 + lane] = cs;
}
template <class F>
__device__ __forceinline__ void ssd_load_chunk(const Ctx& C, int seq, int c, int row0, F store) {
    const int lane = C.lane, w = C.wave;
    const bf16_t* base = WSB(WS_PA) + (size_t)(row0 + lane) * 1536 + 512;
    const float* cw = INL(12, 4 * 1024); const float* cbias = INL(13, 1024);
    for (int j = 0; j < 16; ++j) {
        const int ch0 = 128 * w + 8 * j;
        const u32x4 v0 = *(const u32x4*)(base + ch0);
        u32x4 ex = (u32x4){0u, 0u, 0u, 0u};
        if (lane < 3) {
            if (seq < 2) { if (c > 0) ex = *(const u32x4*)(base - (size_t)3 * 1536 + ch0); }
            else ex = load8(INL(3, BS * 3 * 1024) + ((size_t)(seq - 2) * 3 + lane) * 1024 + ch0, 0, true);
        }
        float x0[8], xk[3][8];
        unpack8(v0, x0);
#pragma unroll
        for (int k = 1; k <= 3; ++k) {
            u32x4 a, b;
            a.x = __shfl(v0.x, (lane - k) & 63); a.y = __shfl(v0.y, (lane - k) & 63); a.z = __shfl(v0.z, (lane - k) & 63); a.w = __shfl(v0.w, (lane - k) & 63);
            b.x = __shfl(ex.x, (lane - k + 3) & 63); b.y = __shfl(ex.y, (lane - k + 3) & 63); b.z = __shfl(ex.z, (lane - k + 3) & 63); b.w = __shfl(ex.w, (lane - k + 3) & 63);
            unpack8(lane >= k ? a : b, xk[k - 1]);
        }
        float y[8];
#pragma unroll
        for (int e = 0; e < 8; ++e) {
            const float a = cbias[ch0 + e] + cw[3 * 1024 + ch0 + e] * x0[e] + cw[2 * 1024 + ch0 + e] * xk[0][e] + cw[1 * 1024 + ch0 + e] * xk[1][e] + cw[ch0 + e] * xk[2][e];
            y[e] = siluf_(a);
        }
        store(ch0, y, x0);
    }
}

constexpr int XT_ST = 72;
__device__ __forceinline__ void ssd_s1_item(const Ctx& C, int item) {
    const int seq = item < 256 ? (item >> 7) : 2 + (item - 256), c = item < 256 ? (item & 127) : 0, row0 = ssd_row0(seq, c);
    const int lane = C.lane, h = C.wave, fr = lane & 15, fq = lane >> 4, l = C.l;
    LAS bf16_t* XT = (LAS bf16_t*)C.lds; LAS bf16_t* BT = (LAS bf16_t*)(C.lds + 73728);
    LAS float* sDT = (LAS float*)(C.lds + 110592); LAS float* sACS = (LAS float*)(C.lds + 112640);
    ssd_dt(C, row0, sDT, sACS);
    __syncthreads();
    const bool lastc = (seq >= 2) || (c == 127);
    float* convo = C.out + (seq < 2 ? O_CONV_P + (size_t)(l * BP + seq) * 3 * 1024 : O_CONV_S + (size_t)(l * BS + seq - 2) * 3 * 1024);
    ssd_load_chunk(C, seq, c, row0, [&](int ch0, const float* y, const float* raw) {
        if (ch0 < 512) { const int hh = ch0 >> 6, p0 = ch0 & 63; const float wgt = sDT[hh * 64 + lane] * fexp(sACS[hh * 64 + 63] - sACS[hh * 64 + lane]);
#pragma unroll
            for (int e = 0; e < 8; ++e) XT[(hh * 64 + p0 + e) * XT_ST + lane] = (bf16_t)f2bf(y[e] * wgt); }
        else if (ch0 < 768) { const int g = (ch0 - 512) >> 7, n0 = (ch0 - 512) & 127;
#pragma unroll
            for (int e = 0; e < 8; ++e) BT[(g * 128 + n0 + e) * XT_ST + lane] = (bf16_t)f2bf(y[e]); }
        if (lastc && lane >= 61) {
#pragma unroll
            for (int e = 0; e < 8; ++e) convo[(size_t)(lane - 61) * 1024 + ch0 + e] = raw[e]; }
    });
    __syncthreads();
    const int g = h >> 2;
    bf16x8 bx[4][2];
#pragma unroll
    for (int pt = 0; pt < 4; ++pt)
#pragma unroll
        for (int ks = 0; ks < 2; ++ks) bx[pt][ks] = *(const LAS bf16x8*)(XT + (h * 64 + 16 * pt + fr) * XT_ST + 32 * ks + 8 * fq);
    const float dall = fexp(sACS[h * 64 + 63]);
    for (int nt = 0; nt < 8; ++nt) {
        bf16x8 a[2];
#pragma unroll
        for (int ks = 0; ks < 2; ++ks) a[ks] = *(const LAS bf16x8*)(BT + (g * 128 + 16 * nt + fr) * XT_ST + 32 * ks + 8 * fq);
#pragma unroll
        for (int pt = 0; pt < 4; ++pt) {
            f32x4 acc = (f32x4){0.f, 0.f, 0.f, 0.f};
#pragma unroll
            for (int ks = 0; ks < 2; ++ks) acc = MFMA16(a[ks], bx[pt][ks], acc);
            const int p = 16 * pt + fr, n = 16 * nt + 4 * fq;
            if (seq < 2) { u32x2 w; w.x = pk2(acc[0], acc[1]); w.y = pk2(acc[2], acc[3]);
                *(u32x2*)(WSB(WS_STATES) + ((size_t)((seq * 128 + c) * 8 + h) * 64 + p) * 128 + n) = w; }
            else { const size_t o = ((size_t)((l * BS + seq - 2) * 8 + h) * 64 + p) * 128 + n;
                const f32x4 h0 = *(const f32x4*)(IN0(2) + o);
                *(f32x4*)(C.out + O_SSM_S + o) = h0 * dall + acc; }
        }
    }
    if (seq < 2 && lane == 0) ((float*)(C.ws + WS_DECAY))[(seq * 128 + c) * 8 + h] = dall;
    __syncthreads();
}
__device__ __forceinline__ void ssd_scan(const Ctx& C) {
    const size_t gt = (size_t)C.bid * NTHREADS + C.tid;
    if (gt >= (size_t)2 * 8 * 64 * 128) return;
    const int b = (int)(gt >> 16), h = (int)(gt >> 13) & 7, pn = (int)(gt & 8191);
    bf16_t* st = WSB(WS_STATES) + ((size_t)(b * 128) * 8 + h) * 8192 + pn;
    const float* dec = (const float*)(C.ws + WS_DECAY) + (b * 128) * 8 + h;
    float hst = 0.f;
#pragma unroll 8
    for (int c = 0; c < 128; ++c) { const float s = bf1(st[(size_t)c * 8 * 8192]); st[(size_t)c * 8 * 8192] = (bf16_t)f2bf(hst); hst = dec[c * 8] * hst + s; }
    C.out[O_SSM_P + ((size_t)(C.l * BP + b) * 8 + h) * 8192 + pn] = hst;
}
constexpr int CN_ST = 136;
__device__ __forceinline__ void ssd_s3_item(const Ctx& C, int item) {
    const int seq = item < 256 ? (item >> 7) : 2 + (item - 256), c = item < 256 ? (item & 127) : 0, row0 = ssd_row0(seq, c);
    const int lane = C.lane, h = C.wave, fr = lane & 15, fq = lane >> 4, l = C.l, g = h >> 2;
    LAS bf16_t* Cn = (LAS bf16_t*)C.lds; LAS bf16_t* Bn = (LAS bf16_t*)(C.lds + 34816); LAS bf16_t* XT = (LAS bf16_t*)(C.lds + 69632);
    LAS float* sDT = (LAS float*)(C.lds + 143360); LAS float* sACS = (LAS float*)(C.lds + 145408); LAS float* sRed = (LAS float*)(C.lds + 147456);
    ssd_dt(C, row0, sDT, sACS);
    ssd_load_chunk(C, seq, c, row0, [&](int ch0, const float* y, const float*) {
        if (ch0 < 512) { const int hh = ch0 >> 6, p0 = ch0 & 63;
#pragma unroll
            for (int e = 0; e < 8; ++e) XT[(hh * 64 + p0 + e) * XT_ST + lane] = (bf16_t)f2bf(y[e]); }
        else if (ch0 < 768) { const int gg = (ch0 - 512) >> 7, n0 = (ch0 - 512) & 127; *(LAS u32x4*)(Bn + (gg * 64 + lane) * CN_ST + n0) = pack8(y); }
        else { const int gg = (ch0 - 768) >> 7, n0 = (ch0 - 768) & 127; *(LAS u32x4*)(Cn + (gg * 64 + lane) * CN_ST + n0) = pack8(y); }
    });
    __syncthreads();
#define CF(lt, ks) (*(const LAS bf16x8*)(Cn + (g * 64 + 16 * (lt) + fr) * CN_ST + 32 * (ks) + 8 * fq))
    f32x4 yacc[4][4];
    const void* hin; bool hin_f32;
    if (seq < 2) { hin = WSB(WS_STATES) + (size_t)((seq * 128 + c) * 8 + h) * 8192; hin_f32 = false; }
    else { hin = IN0(2) + (size_t)((l * BS + seq - 2) * 8 + h) * 8192; hin_f32 = true; }
#pragma unroll
    for (int pt = 0; pt < 4; ++pt) {
#pragma unroll
        for (int lt = 0; lt < 4; ++lt) yacc[pt][lt] = (f32x4){0.f, 0.f, 0.f, 0.f};
        bf16x8 af[4];
        if (hin_f32) {
#pragma unroll
            for (int ks = 0; ks < 4; ++ks) af[ks] = as_frag(load8(hin, (size_t)(16 * pt + fr) * 128 + 32 * ks + 8 * fq, true));
        } else {
#pragma unroll
            for (int ks = 0; ks < 4; ++ks) af[ks] = as_frag(load8(hin, (size_t)(16 * pt + fr) * 128 + 32 * ks + 8 * fq, false));
        }
#pragma unroll
        for (int ks = 0; ks < 4; ++ks)
#pragma unroll
            for (int lt = 0; lt < 4; ++lt) yacc[pt][lt] = MFMA16(af[ks], CF(lt, ks), yacc[pt][lt]);
        __builtin_amdgcn_sched_barrier(0);
    }
    float acl[4];
#pragma unroll
    for (int lt = 0; lt < 4; ++lt) { acl[lt] = sACS[h * 64 + 16 * lt + fr]; const float el = fexp(acl[lt]);
#pragma unroll
        for (int pt = 0; pt < 4; ++pt) yacc[pt][lt] = yacc[pt][lt] * el; }
    const float Dh = INL(16, 8)[h];
#pragma unroll
    for (int lt = 0; lt < 4; ++lt) {
        bf16x8 pf[2], cfl[4];
#pragma unroll
        for (int ks = 0; ks < 4; ++ks) cfl[ks] = CF(lt, ks);
        unsigned pw[4][2];
#pragma unroll
        for (int st = 0; st < 4; ++st) {
            f32x4 cb = (f32x4){0.f, 0.f, 0.f, 0.f};
#pragma unroll
            for (int ks = 0; ks < 4; ++ks) { const bf16x8 a = *(const LAS bf16x8*)(Bn + (g * 64 + 16 * st + fr) * CN_ST + 32 * ks + 8 * fq); cb = MFMA16(a, cfl[ks], cb); }
            const f32x4 as4 = *(const LAS f32x4*)(sACS + h * 64 + 16 * st + 4 * fq), dt4 = *(const LAS f32x4*)(sDT + h * 64 + 16 * st + 4 * fq);
            float m[4];
#pragma unroll
            for (int i = 0; i < 4; ++i) { const int s = 16 * st + 4 * fq + i, ll = 16 * lt + fr;
                float v = (s <= ll) ? cb[i] * fexp(acl[lt] - as4[i]) * dt4[i] : 0.f; if (s == ll) v += Dh; m[i] = v; }
            pw[st][0] = pk2(m[0], m[1]); pw[st][1] = pk2(m[2], m[3]);
        }
        { u32x4 v; v.x = pw[0][0]; v.y = pw[0][1]; v.z = pw[1][0]; v.w = pw[1][1]; pf[0] = as_frag(v); v.x = pw[2][0]; v.y = pw[2][1]; v.z = pw[3][0]; v.w = pw[3][1]; pf[1] = as_frag(v); }
#pragma unroll
        for (int pt = 0; pt < 4; ++pt)
#pragma unroll
            for (int kk = 0; kk < 2; ++kk) { const LAS bf16_t* xp = XT + (h * 64 + 16 * pt + fr) * XT_ST + 32 * kk + 4 * fq;
                const bf16x8 a = mk_frag(*(const LAS u32x2*)xp, *(const LAS u32x2*)(xp + 16)); yacc[pt][lt] = MFMA16(a, pf[kk], yacc[pt][lt]); }
        asm volatile("" ::: "memory");
    }
    float ss[4] = {0.f, 0.f, 0.f, 0.f};
#pragma unroll
    for (int lt = 0; lt < 4; ++lt)
#pragma unroll
        for (int pt = 0; pt < 4; ++pt) { const u32x2 z = *(const u32x2*)(WSB(WS_PA) + (size_t)(row0 + 16 * lt + fr) * 1536 + h * 64 + 16 * pt + 4 * fq);
            f32x4 v = yacc[pt][lt]; v[0] *= siluf_(bflo(z.x)); v[1] *= siluf_(bfhi(z.x)); v[2] *= siluf_(bflo(z.y)); v[3] *= siluf_(bfhi(z.y));
            yacc[pt][lt] = v; ss[lt] += v[0] * v[0] + v[1] * v[1] + v[2] * v[2] + v[3] * v[3]; }
#pragma unroll
    for (int lt = 0; lt < 4; ++lt) { ss[lt] += __shfl_xor(ss[lt], 16); ss[lt] += __shfl_xor(ss[lt], 32); if (fq == 0) sRed[h * 64 + 16 * lt + fr] = ss[lt]; }
    __syncthreads();
    const float* ng = INL(17, 512);
#pragma unroll
    for (int lt = 0; lt < 4; ++lt) { float tot = 0.f;
#pragma unroll
        for (int hh = 0; hh < 8; ++hh) tot += sRed[hh * 64 + 16 * lt + fr];
        const float rstd = 1.f / sqrtf(tot * (1.f / 512.f) + EPS);
#pragma unroll
        for (int pt = 0; pt < 4; ++pt) { const f32x4 gg = *(const f32x4*)(ng + h * 64 + 16 * pt + 4 * fq); const f32x4 v = yacc[pt][lt];
            u32x2 w; w.x = pk2(v[0] * rstd * gg[0], v[1] * rstd * gg[1]); w.y = pk2(v[2] * rstd * gg[2], v[3] * rstd * gg[3]);
            *(u32x2*)(WSB(WS_PA) + (size_t)(row0 + 16 * lt + fr) * 1536 + h * 64 + 16 * pt + 4 * fq) = w; } }
    __syncthreads();
}

struct AH {
    const bf16_t* q; int qld; bf16_t* o; int old_;
    const void* kn; size_t knld; bool kn_f32; const bf16_t* kn2; size_t kn2ld; int split;
    const bf16_t* kp; size_t kpld;
    const void* v; size_t vld; bool v_f32; const bf16_t* v2; size_t v2ld;
    int count, cdiff0;
};
template <int DK, bool BIAS, bool SHARED>
__device__ __forceinline__ void attn_core(const Ctx& C, const AH& H, int n_iter) {
    constexpr int KST = DK + 8, VST = 72, KBYTES = 64 * KST * 2, VBYTES = 64 * VST * 2, HBY = KBYTES + VBYTES;
    const int lane = C.lane, hf = C.wave >> 2, wq = C.wave & 3, tid_h = C.tid & 255, fr = lane & 15, fq = lane >> 4;
    LAS float* tab = (LAS float*)(C.lds + 4 * HBY) + hf * 260;
    bf16x8 qf[DK / 32];
#pragma unroll
    for (int ks = 0; ks < DK / 32; ++ks) qf[ks] = *(const bf16x8*)(H.q + (size_t)(16 * wq + fr) * H.qld + 32 * ks + 8 * fq);
    f32x4 oacc[4];
#pragma unroll
    for (int d = 0; d < 4; ++d) oacc[d] = (f32x4){0.f, 0.f, 0.f, 0.f};
    float m_run = -1e30f, l_run = 0.f;
    u32x4 rk[2], rp = (u32x4){0u, 0u, 0u, 0u}, rv[2];
    const int NPI = SHARED ? 1 : 2, PSTR = SHARED ? 0 : 256, ptid = SHARED ? C.tid : tid_h, lcount = SHARED ? n_iter : H.count, hsl = SHARED ? 0 : hf;
#define ATT_GLOAD(t) do { if ((t) < lcount) { const bool sec = (t) >= H.split; const int tk = sec ? (t) - H.split : (t); \
        _Pragma("unroll") for (int i = 0; i < NPI; ++i) { const int p = ptid + PSTR * i; \
            { const int key = p >> 3, ch = p & 7; rk[i] = sec ? load8(H.kn2, (size_t)(tk * 64 + key) * H.kn2ld + 8 * ch, false) : load8(H.kn, (size_t)(tk * 64 + key) * H.knld + 8 * ch, H.kn_f32); } \
            { const int key = p & 63, dc = p >> 6; rv[i] = sec ? load8(H.v2, (size_t)(tk * 64 + key) * H.v2ld + 8 * dc, false) : load8(H.v, (size_t)(tk * 64 + key) * H.vld + 8 * dc, H.v_f32); } } \
        if (DK == 96 && (!SHARED || ptid < 256)) { const int key = (ptid & 255) >> 2, ch = ptid & 3; rp = *(const u32x4*)(H.kp + (size_t)((t) * 64 + key) * H.kpld + 8 * ch); } } } while (0)
#define ATT_SSTORE(t, buf) do { if ((t) < lcount) { LAS unsigned char* base = C.lds + ((buf) * 2 + hsl) * HBY; \
        _Pragma("unroll") for (int i = 0; i < NPI; ++i) { const int p = ptid + PSTR * i; \
            { const int key = p >> 3, ch = p & 7; *(LAS u32x4*)(base + (key * KST + 8 * ch) * 2) = rk[i]; } \
            { const int key = p & 63, dc = p >> 6; LAS bf16_t* vt = (LAS bf16_t*)(base + KBYTES) + (8 * dc) * VST + key; const u32x4 vv = rv[i]; \
              vt[0] = (bf16_t)(vv.x & 0xffffu); vt[VST] = (bf16_t)(vv.x >> 16); vt[2 * VST] = (bf16_t)(vv.y & 0xffffu); vt[3 * VST] = (bf16_t)(vv.y >> 16); \
              vt[4 * VST] = (bf16_t)(vv.z & 0xffffu); vt[5 * VST] = (bf16_t)(vv.z >> 16); vt[6 * VST] = (bf16_t)(vv.w & 0xffffu); vt[7 * VST] = (bf16_t)(vv.w >> 16); } } \
        if (DK == 96 && (!SHARED || ptid < 256)) { const int key = (ptid & 255) >> 2, ch = ptid & 3; *(LAS u32x4*)(base + (key * KST + 64 + 8 * ch) * 2) = rp; } } } while (0)
    ATT_GLOAD(0); ATT_SSTORE(0, 0);
    __syncthreads();
    for (int t = 0; t < n_iter; ++t) {
        ATT_GLOAD(t + 1);
        if (t < H.count) {
            const LAS unsigned char* base = C.lds + ((t & 1) * 2 + hsl) * HBY;
            f32x4 s[4];
#pragma unroll
            for (int mt = 0; mt < 4; ++mt) { s[mt] = (f32x4){0.f, 0.f, 0.f, 0.f};
#pragma unroll
                for (int ks = 0; ks < DK / 32; ++ks) { const bf16x8 a = *(const LAS bf16x8*)(base + ((16 * mt + fr) * KST + 32 * ks + 8 * fq) * 2); s[mt] = MFMA16(a, qf[ks], s[mt]); } }
            if (BIAS) { const int cd = H.cdiff0 - t, ql = 16 * wq + fr;
                if (cd >= 3) { const float bb = tab[256];
#pragma unroll
                    for (int mt = 0; mt < 4; ++mt) s[mt] = s[mt] + bb; }
                else {
#pragma unroll
                    for (int mt = 0; mt < 4; ++mt)
#pragma unroll
                        for (int i = 0; i < 4; ++i) { int rel = cd * 64 + ql - (16 * mt + 4 * fq + i); rel = rel > 128 ? 128 : rel; s[mt][i] += tab[rel + 128]; } } }
            float mx = s[0][0];
#pragma unroll
            for (int mt = 0; mt < 4; ++mt)
#pragma unroll
                for (int i = 0; i < 4; ++i) mx = fmaxf(mx, s[mt][i]);
            mx = fmaxf(mx, __shfl_xor(mx, 16)); mx = fmaxf(mx, __shfl_xor(mx, 32));
            const float mnew = fmaxf(m_run, mx), alpha = fexp2(m_run - mnew); m_run = mnew;
            float psum = 0.f;
#pragma unroll
            for (int mt = 0; mt < 4; ++mt)
#pragma unroll
                for (int i = 0; i < 4; ++i) { const float p = fexp2(s[mt][i] - mnew); s[mt][i] = p; psum += p; }
            l_run = l_run * alpha + psum;
#pragma unroll
            for (int d = 0; d < 4; ++d) oacc[d] = oacc[d] * alpha;
            bf16x8 pf[2];
#pragma unroll
            for (int kk = 0; kk < 2; ++kk) { u32x4 v; v.x = pk2(s[2 * kk][0], s[2 * kk][1]); v.y = pk2(s[2 * kk][2], s[2 * kk][3]); v.z = pk2(s[2 * kk + 1][0], s[2 * kk + 1][1]); v.w = pk2(s[2 * kk + 1][2], s[2 * kk + 1][3]); pf[kk] = as_frag(v); }
            const LAS bf16_t* vt = (const LAS bf16_t*)(base + KBYTES);
#pragma unroll
            for (int d = 0; d < 4; ++d)
#pragma unroll
                for (int kk = 0; kk < 2; ++kk) { const LAS bf16_t* vp = vt + (16 * d + fr) * VST + 32 * kk + 4 * fq;
                    const bf16x8 a = mk_frag(*(const LAS u32x2*)vp, *(const LAS u32x2*)(vp + 16)); oacc[d] = MFMA16(a, pf[kk], oacc[d]); }
        }
        ATT_SSTORE(t + 1, (t + 1) & 1);
        __syncthreads();
    }
#undef ATT_GLOAD
#undef ATT_SSTORE
    l_run += __shfl_xor(l_run, 16); l_run += __shfl_xor(l_run, 32);
    const float inv = 1.f / l_run;
#pragma unroll
    for (int d = 0; d < 4; ++d) { u32x2 w; w.x = pk2(oacc[d][0] * inv, oacc[d][1] * inv); w.y = pk2(oacc[d][2] * inv, oacc[d][3] * inv);
        *(u32x2*)(H.o + (size_t)(16 * wq + fr) * H.old_ + 16 * d + 4 * fq) = w; }
}

__device__ __forceinline__ void attn_core2(const Ctx& C, const AH& H, int n_iter) {
    constexpr int DK = 96, KST = DK + 8, VST = 72, KBYTES = 64 * KST * 2, VBYTES = 64 * VST * 2, HBY = KBYTES + VBYTES;
    const int lane = C.lane, fr = lane & 15, fq = lane >> 4, p = C.tid;
    bf16x8 qf[2][3];
#pragma unroll
    for (int sb = 0; sb < 2; ++sb)
#pragma unroll
        for (int ks = 0; ks < 3; ++ks) qf[sb][ks] = *(const bf16x8*)(H.q + (size_t)(16 * sb + fr) * H.qld + 32 * ks + 8 * fq);
    f32x4 oacc[2][4];
#pragma unroll
    for (int sb = 0; sb < 2; ++sb)
#pragma unroll
        for (int d = 0; d < 4; ++d) oacc[sb][d] = (f32x4){0.f, 0.f, 0.f, 0.f};
    float m_run[2] = {-1e30f, -1e30f}, l_run[2] = {0.f, 0.f};
    u32x4 rk[2], rp[2], rv[2];
    rp[0] = (u32x4){0u, 0u, 0u, 0u}; rp[1] = rp[0];
#define A2_GLOAD(t, R) do { if ((t) < n_iter) { \
        { const int key = p >> 3, ch = p & 7; rk[R] = *(const u32x4*)((const bf16_t*)H.kn + (size_t)((t) * 64 + key) * H.knld + 8 * ch); } \
        { const int key = p & 63, dc = p >> 6; rv[R] = *(const u32x4*)((const bf16_t*)H.v + (size_t)((t) * 64 + key) * H.vld + 8 * dc); } \
        if (p < 256) { const int key = p >> 2, ch = p & 3; rp[R] = *(const u32x4*)(H.kp + (size_t)((t) * 64 + key) * H.kpld + 8 * ch); } } } while (0)
#define A2_SSTORE(t, buf, R) do { if ((t) < n_iter) { LAS unsigned char* base = C.lds + (buf) * HBY; \
        { const int key = p >> 3, ch = p & 7; *(LAS u32x4*)(base + (key * KST + 8 * ch) * 2) = rk[R]; } \
        { const int key = p & 63, dc = p >> 6; LAS bf16_t* vt = (LAS bf16_t*)(base + KBYTES) + (8 * dc) * VST + key; const u32x4 vv = rv[R]; \
          vt[0] = (bf16_t)(vv.x & 0xffffu); vt[VST] = (bf16_t)(vv.x >> 16); vt[2 * VST] = (bf16_t)(vv.y & 0xffffu); vt[3 * VST] = (bf16_t)(vv.y >> 16); \
          vt[4 * VST] = (bf16_t)(vv.z & 0xffffu); vt[5 * VST] = (bf16_t)(vv.z >> 16); vt[6 * VST] = (bf16_t)(vv.w & 0xffffu); vt[7 * VST] = (bf16_t)(vv.w >> 16); } \
        if (p < 256) { const int key = p >> 2, ch = p & 3; *(LAS u32x4*)(base + (key * KST + 64 + 8 * ch) * 2) = rp[R]; } } } while (0)
#define A2_COMPUTE(t, BUF) do { if ((t) < H.count) { \
            const LAS unsigned char* base = C.lds + (BUF) * HBY; \
            f32x4 s[2][4]; \
            _Pragma("unroll") for (int mt = 0; mt < 4; ++mt) { s[0][mt] = (f32x4){0.f, 0.f, 0.f, 0.f}; s[1][mt] = (f32x4){0.f, 0.f, 0.f, 0.f}; \
                _Pragma("unroll") for (int ks = 0; ks < 3; ++ks) { const bf16x8 a = *(const LAS bf16x8*)(base + ((16 * mt + fr) * KST + 32 * ks + 8 * fq) * 2); \
                    s[0][mt] = MFMA16(a, qf[0][ks], s[0][mt]); s[1][mt] = MFMA16(a, qf[1][ks], s[1][mt]); } } \
            bf16x8 pf[2][2]; \
            _Pragma("unroll") for (int sb = 0; sb < 2; ++sb) { \
                float mx = s[sb][0][0]; \
                _Pragma("unroll") for (int mt = 0; mt < 4; ++mt) _Pragma("unroll") for (int i = 0; i < 4; ++i) mx = fmaxf(mx, s[sb][mt][i]); \
                mx = fmaxf(mx, __shfl_xor(mx, 16)); mx = fmaxf(mx, __shfl_xor(mx, 32)); \
                const float mnew = fmaxf(m_run[sb], mx), alpha = fexp2(m_run[sb] - mnew); m_run[sb] = mnew; \
                float psum = 0.f; \
                _Pragma("unroll") for (int mt = 0; mt < 4; ++mt) _Pragma("unroll") for (int i = 0; i < 4; ++i) { const float pp = fexp2(s[sb][mt][i] - mnew); s[sb][mt][i] = pp; psum += pp; } \
                l_run[sb] = l_run[sb] * alpha + psum; \
                _Pragma("unroll") for (int d = 0; d < 4; ++d) oacc[sb][d] = oacc[sb][d] * alpha; \
                _Pragma("unroll") for (int kk = 0; kk < 2; ++kk) { u32x4 v; v.x = pk2(s[sb][2 * kk][0], s[sb][2 * kk][1]); v.y = pk2(s[sb][2 * kk][2], s[sb][2 * kk][3]); v.z = pk2(s[sb][2 * kk + 1][0], s[sb][2 * kk + 1][1]); v.w = pk2(s[sb][2 * kk + 1][2], s[sb][2 * kk + 1][3]); pf[sb][kk] = as_frag(v); } \
            } \
            const LAS bf16_t* vt = (const LAS bf16_t*)(base + KBYTES); \
            _Pragma("unroll") for (int d = 0; d < 4; ++d) _Pragma("unroll") for (int kk = 0; kk < 2; ++kk) { const LAS bf16_t* vp = vt + (16 * d + fr) * VST + 32 * kk + 4 * fq; \
                    const bf16x8 a = mk_frag(*(const LAS u32x2*)vp, *(const LAS u32x2*)(vp + 16)); \
                    oacc[0][d] = MFMA16(a, pf[0][kk], oacc[0][d]); oacc[1][d] = MFMA16(a, pf[1][kk], oacc[1][d]); } \
        } } while (0)
    A2_GLOAD(0, 0); A2_SSTORE(0, 0, 0); A2_GLOAD(1, 1);
    __syncthreads();
    for (int t = 0; t < n_iter; t += 2) {
        A2_GLOAD(t + 2, 0); A2_COMPUTE(t, 0); A2_SSTORE(t + 1, 1, 1); __syncthreads();
        A2_GLOAD(t + 3, 1); A2_COMPUTE(t + 1, 1); A2_SSTORE(t + 2, 0, 0); __syncthreads();
    }
#undef A2_COMPUTE
#undef A2_GLOAD
#undef A2_SSTORE
#pragma unroll
    for (int sb = 0; sb < 2; ++sb) { float l = l_run[sb]; l += __shfl_xor(l, 16); l += __shfl_xor(l, 32);
        const float inv = 1.f / l;
#pragma unroll
        for (int d = 0; d < 4; ++d) { u32x2 w; w.x = pk2(oacc[sb][d][0] * inv, oacc[sb][d][1] * inv); w.y = pk2(oacc[sb][d][2] * inv, oacc[sb][d][3] * inv);
            *(u32x2*)(H.o + (size_t)(16 * sb + fr) * H.old_ + 16 * d + 4 * fq) = w; } }
}

constexpr int N_MLAP = 512, N_S3 = 288, N_MLAS = 128, N_BANDP = 1024, N_BANDS = 128, N_P5 = N_MLAP + N_S3 + N_MLAS + N_BANDP + N_BANDS;
#ifndef P5SEL
#define P5SEL 7
#endif
__device__ __forceinline__ void p5_unit(const Ctx& C, int idx) {
    const int hf = C.wave >> 2, l = C.l;
    AH H; H.split = 1 << 30; H.kn2 = nullptr; H.kn2ld = 0; H.v2 = nullptr; H.v2ld = 0; H.kn_f32 = false; H.v_f32 = false; H.kp = nullptr; H.kpld = 0; H.cdiff0 = 0;
    if (idx < N_MLAP) {
        const int q4 = 31 - (idx >> 4), b = (idx >> 3) & 1, h = idx & 7, c = 4 * q4 + (C.wave >> 1); const size_t row0 = (size_t)b * TP + c * 64 + 32 * (C.wave & 1);
        H.q = WSB(WS_Q) + row0 * 768 + h * 96; H.qld = 768; H.o = WSB(WS_YBC) + row0 * 1024 + h * 64; H.old_ = 1024;
        H.kn = WSB(WS_KVP) + (size_t)b * TP * 1024 + h * 64; H.knld = 1024; H.kp = WSB(WS_KPEP) + (size_t)b * TP * 32; H.kpld = 32;
        H.v = WSB(WS_KVP) + (size_t)b * TP * 1024 + 512 + h * 64; H.vld = 1024; H.count = c + 1;
        if (P5SEL & 1) attn_core2(C, H, 4 * q4 + 4); return;
    }
    idx -= N_MLAP;
    if (idx < N_S3) { if (P5SEL & 2) ssd_s3_item(C, idx); return; }
    idx -= N_S3;
    if (idx < N_MLAS) {
        const int b = idx >> 2, h = (idx & 3) * 2 + hf; const size_t row0 = (size_t)NP + b * 64;
        H.q = WSB(WS_Q) + row0 * 768 + h * 96; H.qld = 768; H.o = WSB(WS_YBC) + row0 * 1024 + h * 64; H.old_ = 1024;
        H.kn = WSB(WS_XR) + (size_t)b * KS_ALL * 1024 + h * 64; H.knld = 1024; H.kp = WSB(WS_KPES) + (size_t)b * KS_ALL * 32; H.kpld = 32;
        H.v = WSB(WS_XR) + (size_t)b * KS_ALL * 1024 + 512 + h * 64; H.vld = 1024; H.count = 33;
        if (P5SEL & 1) attn_core<96, false, false>(C, H, 33); return;
    }
    idx -= N_MLAS;
    constexpr int HBY64 = 64 * 72 * 2 * 2;
    if (idx < N_BANDP) {
        const int cp = idx >> 4, b = (idx >> 3) & 1, h = idx & 7, c = 2 * cp + hf, kt0 = c > 8 ? c - 8 : 0; const size_t row0 = (size_t)b * TP + c * 64;
        LAS float* tab = (LAS float*)(C.lds + 4 * HBY64) + hf * 260; const float* rb = INL(32, 8 * 257) + h * 257;
        for (int i = C.tid & 255; i < 257; i += 256) tab[i] = rb[i] * LOG2E;
        H.q = WSB(WS_PD) + row0 * 1536 + h * 64; H.qld = 1536; H.o = WSB(WS_PD) + row0 * 1536 + h * 64; H.old_ = 1536;
        H.kn = WSB(WS_PD) + ((size_t)b * TP + kt0 * 64) * 1536 + 512 + h * 64; H.knld = 1536;
        H.v = WSB(WS_PD) + ((size_t)b * TP + kt0 * 64) * 1536 + 1024 + h * 64; H.vld = 1536; H.count = c - kt0 + 1; H.cdiff0 = c - kt0;
        const int c1 = 2 * cp + 1;
        if (P5SEL & 4) attn_core<64, true, false>(C, H, (c1 > 8 ? 8 : c1) + 1); return;
    }
    idx -= N_BANDP;
    {
        const int b = idx >> 2, h = (idx & 3) * 2 + hf; const size_t row0 = (size_t)NP + b * 64;
        LAS float* tab = (LAS float*)(C.lds + 4 * HBY64) + hf * 260; const float* rb = INL(32, 8 * 257) + h * 257;
        for (int i = C.tid & 255; i < 257; i += 256) tab[i] = rb[i] * LOG2E;
        H.q = WSB(WS_PD) + row0 * 1536 + h * 64; H.qld = 1536; H.o = WSB(WS_PD) + row0 * 1536 + h * 64; H.old_ = 1536;
        H.kn = INL(7, (size_t)BS * 512 * 512) + (size_t)b * 512 * 512 + h * 64; H.knld = 512; H.kn_f32 = true;
        H.v = INL(8, (size_t)BS * 512 * 512) + (size_t)b * 512 * 512 + h * 64; H.vld = 512; H.v_f32 = true;
        H.split = 8; H.kn2 = WSB(WS_PD) + row0 * 1536 + 512 + h * 64; H.kn2ld = 1536; H.v2 = WSB(WS_PD) + row0 * 1536 + 1024 + h * 64; H.v2ld = 1536;
        H.count = 9; H.cdiff0 = 8;
        if (P5SEL & 4) attn_core<64, true, false>(C, H, 9);
    }
}

__global__ void __launch_bounds__(NTHREADS) mk_fwd(Args args) {
    extern __shared__ __attribute__((aligned(16))) unsigned char lds_raw[];
    cg::grid_group grid = cg::this_grid();
    Ctx C;
    C.A = &args;
    C.out = args.out; C.ws = args.ws; C.lds = (LAS unsigned char*)lds_raw;
    C.tid = threadIdx.x; C.lane = C.tid & 63; C.wave = __builtin_amdgcn_readfirstlane(C.tid >> 6);
    C.G = gridDim.x; C.bid = blockIdx.x; C.gw = C.bid * NWAVES + C.wave; C.NGW = C.G * NWAVES;
    unsigned* ctl = (unsigned*)(C.ws + WS_CTL);
    LAS int* sIdx = (LAS int*)(C.lds + LDS_BYTES - 16);
#ifndef PMASK
#define PMASK 0xFFF
#endif
#define REFRESH() do { int t_ = threadIdx.x; asm volatile("" : "+v"(t_)); C.tid = t_; C.lane = t_ & 63; C.wave = __builtin_amdgcn_readfirstlane(t_ >> 6); C.gw = C.bid * NWAVES + C.wave; GAS unsigned char* w_ = (GAS unsigned char*)args.ws; asm volatile("" : "+s"(w_)); C.ws = (unsigned char*)w_; GAS float* o_ = (GAS float*)args.out; asm volatile("" : "+s"(o_)); C.out = (float*)o_; } while (0)
#define PH_BEGIN(n) if ((PMASK >> (n)) & 1) { REFRESH();
#define PH_END } grid.sync();
#pragma unroll 1
    for (int l = 0; l < 2; ++l) {
        C.l = l;
        PH_BEGIN(0)
            if (C.bid == 0 && C.tid == 0) { ctl[l] = 0u; ctl[2 + l] = 0u; }
            { const size_t gt = (size_t)C.bid * NTHREADS + C.tid, GT = (size_t)C.G * NTHREADS; for (size_t i = gt; i < (size_t)R; i += GT) ((float*)(C.ws + WS_SUMSQ))[i] = 0.f; }
            phase_wprep(C);
            phase_norm(C, INL(9, 1024), l > 0);
        PH_END
        PH_BEGIN(1)
            SchedInproj S{WSB(WS_HB), WSB(WS_WT_IN), WSB(WS_PA), WSB(WS_ZB), WSB(WS_XR), WSB(WS_PD), C.G, C.bid};
            pg8::EpiStore E; pg8::gemm_phase(C.lds, S, E, C.tid);
        PH_END
        PH_BEGIN(2)
            phase_mla_prep(C); phase_band_prep(C); phase_sconv(C);
            for (int it = C.G - 1 - C.bid; it < N_S3; it += C.G) { REFRESH(); ssd_s1_item(C, it); }
        PH_END
        PH_BEGIN(3)
            ssd_scan(C);
            SchedP3 S{WSB(WS_ZB), WSB(WS_WT_QUP), WSB(WS_CKVP), WSB(WS_CKVS), WSB(WS_WT_KVUP), WSB(WS_Q), WSB(WS_KVP), WSB(WS_XR), C.G, C.bid};
            pg8::EpiStore E; pg8::gemm_phase(C.lds, S, E, C.tid);
        PH_END
        PH_BEGIN(4)
            phase_qk_post(C);
        PH_END
        PH_BEGIN(5)
            for (;;) {
                if (C.tid == 0) *sIdx = (int)atomicAdd(&ctl[l], 1u);
                __syncthreads();
                const int idx = *sIdx;
                __syncthreads();
                if (idx >= N_P5) break;
                REFRESH();
                p5_unit(C, idx);
            }
        PH_END
        PH_BEGIN(7)
            SchedMerge S{WSB(WS_HB), WSB(WS_WT_G), WSB(WS_WT_OUT), WSB(WS_PA), WSB(WS_YBC), WSB(WS_PD), C.G, C.bid};
            pg8::EpiMerge E{INL(11, 4096), WSB(WS_ZB), WSB(WS_XR)}; pg8::gemm_phase(C.lds, S, E, C.tid);
        PH_END
        PH_BEGIN(8)
            SchedOne S{WSB(WS_ZB), WSB(WS_WT_O), nullptr, 1024, 1024, 0, 72, 4, 16, C.G, C.bid};
            pg8::EpiResidNorm E{l > 0 ? C.out : IN0(0), l > 0 ? C.out + (size_t)NP * DM : IN0(1), C.out, WSB(WS_HB), INL(35, 1024), (float*)(C.ws + WS_SUMSQ)}; pg8::gemm_phase(C.lds, S, E, C.tid);
        PH_END
        PH_BEGIN(10)
            SchedOne S{WSB(WS_HB), WSB(WS_WT_UP), nullptr, 1024, 1024, 0, 72, 22, 16, C.G, C.bid};
            pg8::EpiSwigluNorm E{WSB(WS_XR), (const float*)(C.ws + WS_SUMSQ)}; pg8::gemm_phase(C.lds, S, E, C.tid);
        PH_END
        PH_BEGIN(11)
            SchedOne S{WSB(WS_XR), WSB(WS_WT_DOWN), nullptr, 2816, 2816, 0, 72, 4, 44, C.G, C.bid};
            pg8::EpiResid E{C.out, C.out + (size_t)NP * DM, C.out}; pg8::gemm_phase(C.lds, S, E, C.tid);
        PH_END
    }
}

extern "C" void kernel_launch(void* const* d_in, const int* in_sizes, int n_in, void* d_out, int out_size, void* d_ws, size_t ws_size, hipStream_t stream) {
    static int grid = 0;
    if (grid == 0) {
        int dev = 0, cus = 0, per_cu = 0;
        (void)hipGetDevice(&dev);
        (void)hipDeviceGetAttribute(&cus, hipDeviceAttributeMultiprocessorCount, dev);
        (void)hipFuncSetAttribute((const void*)mk_fwd, hipFuncAttributeMaxDynamicSharedMemorySize, LDS_BYTES);
        (void)hipOccupancyMaxActiveBlocksPerMultiprocessor(&per_cu, (const void*)mk_fwd, NTHREADS, LDS_BYTES);
        if (per_cu < 1) per_cu = 1;
        grid = cus * per_cu;
        if (ws_size < WS_END || n_in != 38 || (size_t)out_size != O_END) { fprintf(stderr, "kernel_launch: bad sizes ws %zu n_in %d out %d\n", ws_size, n_in, out_size); grid = -1; }
    }
    if (grid < 0) return;
    Args a{};
    for (int i = 0; i < 38; ++i) a.in[i] = (const float*)d_in[i];
    a.out = (float*)d_out; a.ws = (unsigned char*)d_ws; a.ph_lo = 0; a.ph_hi = 1000;
    void* kargs[] = {&a};
    hipError_t e = hipLaunchCooperativeKernel((const void*)mk_fwd, dim3(grid), dim3(NTHREADS), kargs, LDS_BYTES, stream);
    if (e != hipSuccess) fprintf(stderr, "cooperative launch failed: %s (grid %d)\n", hipGetErrorString(e), grid);
}
```

```cpp
#include <hip/hip_runtime.h>
#include <hip/hip_cooperative_groups.h>
#include <cstdio>
#include <cstdint>
namespace cg = cooperative_groups;

#define LAS __attribute__((address_space(3)))
#define GAS __attribute__((address_space(1)))
typedef unsigned short bf16_t;
typedef short bf16x8 __attribute__((ext_vector_type(8)));
typedef float f32x4 __attribute__((ext_vector_type(4)));
typedef unsigned u32x4 __attribute__((ext_vector_type(4)));
typedef unsigned u32x2 __attribute__((ext_vector_type(2)));

constexpr int NTHREADS = 512, NWAVES = 8;
constexpr int LDS_BYTES = 155648;
constexpr int NP = 16384, NS = 2048, R = NP + NS;
constexpr int TP = 8192, TS = 64, BP = 2, BS = 32, PAST = 2048, KS_ALL = PAST + TS;
constexpr int DM = 1024, FF = 2816;
constexpr int IN_COLS = 9384;
constexpr float EPS = 1e-6f;
constexpr float LOG2E = 1.4426950408889634f;

constexpr size_t O_Y = 0;
constexpr size_t O_SSM_P = (size_t)R * DM;
constexpr size_t O_SSM_S = O_SSM_P + 262144;
constexpr size_t O_CONV_P = O_SSM_S + 4194304;
constexpr size_t O_CONV_S = O_CONV_P + 12288;
constexpr size_t O_CKV_P = O_CONV_S + 196608;
constexpr size_t O_CKV_S = O_CKV_P + 8388608;
constexpr size_t O_KPE_P = O_CKV_S + 1048576;
constexpr size_t O_KPE_S = O_KPE_P + 1048576;
constexpr size_t O_SC_P = O_KPE_S + 131072;
constexpr size_t O_SC_S = O_SC_P + 4096;
constexpr size_t O_BK_P = O_SC_S + 65536;
constexpr size_t O_BK_S = O_BK_P + 1048576;
constexpr size_t O_BV_P = O_BK_S + 16777216;
constexpr size_t O_BV_S = O_BV_P + 1048576;
constexpr size_t O_END = O_BV_S + 16777216;

constexpr size_t al256(size_t x) { return (x + 255) & ~(size_t)255; }
constexpr size_t WS_CTL = 0;
constexpr size_t WS_DECAY = 4096;
constexpr size_t WS_SUMSQ = 16384;
constexpr size_t WS_WT_IN = 131072;
constexpr size_t WS_WT_G = WS_WT_IN + (size_t)5376 * 1024 * 2;
constexpr size_t WS_WT_QUP = WS_WT_G + (size_t)4096 * 1024 * 2;
constexpr size_t WS_WT_KVUP = WS_WT_QUP + (size_t)768 * 384 * 2;
constexpr size_t WS_WT_OUT = WS_WT_KVUP + (size_t)1024 * 256 * 2;
constexpr size_t WS_WT_O = WS_WT_OUT + (size_t)4 * 1024 * 1024 * 2;
constexpr size_t WS_WT_UP = WS_WT_O + (size_t)1024 * 1024 * 2;
constexpr size_t WS_WT_DOWN = WS_WT_UP + (size_t)5632 * 1024 * 2;
constexpr size_t WS_HB = al256(WS_WT_DOWN + (size_t)1024 * 2816 * 2);
constexpr size_t WS_PA = WS_HB + (size_t)R * 1024 * 2;
constexpr size_t WS_PD = WS_PA + (size_t)R * 1536 * 2;
constexpr size_t WS_ZB = WS_PD + (size_t)R * 1536 * 2;
constexpr size_t WS_CKVP = WS_ZB + (size_t)R * 768 * 2;
constexpr size_t WS_XR = WS_ZB + (size_t)R * 1024 * 2;
constexpr size_t WS_Q = WS_XR + (size_t)67584 * 1024 * 2;
constexpr size_t WS_KPEP = WS_Q + (size_t)R * 768 * 2;
constexpr size_t WS_KPES = WS_KPEP + (size_t)16384 * 32 * 2;
constexpr size_t WS_KVP = WS_KPES + (size_t)67584 * 32 * 2;
constexpr size_t WS_STATES = WS_KVP + (size_t)16384 * 1024 * 2;
constexpr size_t WS_YBC = WS_STATES + (size_t)2048 * 64 * 128 * 2;
constexpr size_t WS_CKVS = WS_YBC + (size_t)R * 1024 * 2;
constexpr size_t WS_END = WS_CKVS + (size_t)67584 * 256 * 2;
static_assert(WS_END < (size_t)553000000, "ws map too large");
static_assert((size_t)R * 768 * 2 + (size_t)16384 * 256 * 2 <= (size_t)R * 1024 * 2, "ZB");
static_assert((size_t)67584 * 256 * 2 <= (size_t)R * 1024 * 2, "ckvS in HB");

typedef float f32x2_g __attribute__((ext_vector_type(2)));
typedef __bf16 bf16x2_g __attribute__((ext_vector_type(2)));
__device__ __forceinline__ unsigned pk2(float lo, float hi) { f32x2_g v = {lo, hi}; bf16x2_g b = __builtin_convertvector(v, bf16x2_g); return __builtin_bit_cast(unsigned, b); }
__device__ __forceinline__ unsigned f2bf(float f) { return pk2(f, 0.f) & 0xffffu; }
__device__ __forceinline__ float bflo(unsigned u) { return __builtin_bit_cast(float, u << 16); }
__device__ __forceinline__ float bfhi(unsigned u) { return __builtin_bit_cast(float, u & 0xffff0000u); }
__device__ __forceinline__ float bf1(bf16_t h) { return __builtin_bit_cast(float, (unsigned)h << 16); }
__device__ __forceinline__ float fexp2(float x) { return __builtin_amdgcn_exp2f(x); }
__device__ __forceinline__ float fexp(float x) { return __builtin_amdgcn_exp2f(x * LOG2E); }
__device__ __forceinline__ float frcp(float x) { return __builtin_amdgcn_rcpf(x); }
__device__ __forceinline__ float sigmoidf_(float x) { return frcp(1.f + fexp(-x)); }
__device__ __forceinline__ float siluf_(float x) { return x * sigmoidf_(x); }
__device__ __forceinline__ float wave_sum(float v) {
#pragma unroll
    for (int o = 1; o < 64; o <<= 1) v += __shfl_xor(v, o);
    return v;
}
#define LDS_WAIT() asm volatile("s_waitcnt lgkmcnt(0)" ::: "memory")
__device__ __forceinline__ void unpack8(u32x4 v, float* f) {
    f[0] = bflo(v.x); f[1] = bfhi(v.x); f[2] = bflo(v.y); f[3] = bfhi(v.y); f[4] = bflo(v.z); f[5] = bfhi(v.z); f[6] = bflo(v.w); f[7] = bfhi(v.w);
}
__device__ __forceinline__ u32x4 pack8(const float* f) { u32x4 o; o.x = pk2(f[0], f[1]); o.y = pk2(f[2], f[3]); o.z = pk2(f[4], f[5]); o.w = pk2(f[6], f[7]); return o; }
__device__ __forceinline__ u32x4 load8(const void* base, size_t idx, bool is_f32) {
    if (is_f32) { const f32x4* p = (const f32x4*)((const float*)base + idx); f32x4 a = p[0], b = p[1];
        u32x4 o; o.x = pk2(a.x, a.y); o.y = pk2(a.z, a.w); o.z = pk2(b.x, b.y); o.w = pk2(b.z, b.w); return o; }
    return *(const u32x4*)((const bf16_t*)base + idx);
}

namespace pg8 {
constexpr int BM = 256, BK = 64, HALF = 128, HTB = HALF * BK * 2, STAGE_BYTES = 8 * HTB, NXCD = 8, WGM = 8;
__device__ __forceinline__ int lds_byte(int r, int c) { const int st = (r >> 4) * 2 + (c >> 5), rr = r & 15, cc = c & 31, ob = rr * 64 + cc * 2; return st * 1024 + (ob ^ (((ob >> 9) & 1) << 5)); }
__device__ __forceinline__ void stage_rc(int b, int& Rr, int& C) { const int st = b / 1024, sb = b % 1024, swz = sb ^ (((sb >> 9) & 1) << 5); Rr = (st >> 1) * 16 + swz / 64; C = (st & 1) * 32 + (swz % 64) / 2; }
__device__ __forceinline__ int perm32(int rho) { const int n = rho >> 4, i = rho & 15; return 8 * (i >> 2) + 4 * n + (i & 3); }

struct GUnit { const bf16_t* A; const bf16_t* B; int lda, ldb, nt; int pm, pn, sub; bf16_t* C; int ldc; };

__device__ __forceinline__ void tile_map(int L, int nM, int nN, int& pm, int& pn) {
    const int nwg = nM * nN; int wgid = L;
    { const int q = nwg / NXCD, r = nwg % NXCD, xcd = wgid % NXCD, off = wgid / NXCD; wgid = (xcd < r ? xcd * (q + 1) : r * (q + 1) + (xcd - r) * q) + off; }
    const int nig = WGM * nN, gid = wgid / nig, fm = gid * WGM, gsz = (nM - fm) < WGM ? (nM - fm) : WGM;
    pm = fm + ((wgid % nig) % gsz); pn = (wgid % nig) / gsz;
}
typedef float f32x2_t __attribute__((ext_vector_type(2)));
typedef __bf16 bf16x2_t __attribute__((ext_vector_type(2)));
__device__ __forceinline__ unsigned cvt_pk_bf16(float lo, float hi) { f32x2_t v = {lo, hi}; bf16x2_t b = __builtin_convertvector(v, bf16x2_t); return __builtin_bit_cast(unsigned, b); }

template <class Epi, class Sched>
__device__ __forceinline__ void gemm_phase(LAS unsigned char* lds, const Sched& S, Epi& E, int tid) {
    const int wid = __builtin_amdgcn_readfirstlane(tid >> 6), lane = tid & 63, wr = wid >> 2, wc = wid & 3, fr = lane & 15, fq = lane >> 4;
    int RA[2], RB[2], CC[2];
#pragma unroll
    for (int i = 0; i < 2; ++i) { int Rr, C; stage_rc(tid * 16 + i * 8192, Rr, C); RA[i] = Rr; RB[i] = (Rr & ~31) + perm32(Rr & 31); CC[i] = C; }
    const size_t kstep = (size_t)(BK * 2);
    const unsigned ldsw = (unsigned)wid * 1024u;
    const int aoff = lds_byte(wr * 64 + fr, fq * 8), boff = lds_byte(wc * 32 + fr, fq * 8);
#define PG8_SA(b, h) (((b) * 2 + (h)) * HTB)
#define PG8_SB(b, h) ((4 + (b) * 2 + (h)) * HTB)
#define PG8_STAGE(bufoff, gbase, v0, v1) do { \
        __builtin_amdgcn_global_load_lds((const unsigned*)((const char*)(gbase) + (v0)), (LAS unsigned*)(lds + (bufoff) + ldsw), 16, 0, 0); \
        __builtin_amdgcn_global_load_lds((const unsigned*)((const char*)(gbase) + (v1)), (LAS unsigned*)(lds + (bufoff) + ldsw + 8192), 16, 0, 0); } while (0)
#define PG8_LDA(dst, b, h) do { _Pragma("unroll") for (int m = 0; m < 4; ++m) _Pragma("unroll") for (int k = 0; k < 2; ++k) dst[m][k] = *(const LAS bf16x8*)(lds + PG8_SA(b, h) + aoff + m * 2048 + k * 1024); } while (0)
#define PG8_LDB(dst, b, h) do { _Pragma("unroll") for (int n = 0; n < 2; ++n) _Pragma("unroll") for (int k = 0; k < 2; ++k) dst[n][k] = *(const LAS bf16x8*)(lds + PG8_SB(b, h) + boff + n * 2048 + k * 1024); } while (0)
#define PG8_MMA(ai, bj, At, Bt) do { __builtin_amdgcn_s_setprio(1); _Pragma("unroll") for (int m = 0; m < 4; ++m) _Pragma("unroll") for (int n = 0; n < 2; ++n) _Pragma("unroll") for (int k = 0; k < 2; ++k) \
        acc[ai][bj][m][n] = __builtin_amdgcn_mfma_f32_16x16x32_bf16(Bt[n][k], At[m][k], acc[ai][bj][m][n], 0, 0, 0); __builtin_amdgcn_s_setprio(0); } while (0)
#define PG8_WAIT_V(n) asm volatile("s_waitcnt vmcnt(" #n ")" ::: "memory")
#define PG8_WAIT_L(n) asm volatile("s_waitcnt lgkmcnt(" #n ")" ::: "memory")
#define PG8_BAR __builtin_amdgcn_s_barrier()
#define PG8_SCHED __builtin_amdgcn_sched_barrier(0)
    GUnit cur, nxt; int ui = 0;
    if (!S.next(0, cur)) return;
    f32x4 acc[2][2][4][2];
#pragma unroll
    for (int a = 0; a < 2; ++a)
#pragma unroll
        for (int b = 0; b < 2; ++b)
#pragma unroll
            for (int m = 0; m < 4; ++m)
#pragma unroll
                for (int n = 0; n < 2; ++n) acc[a][b][m][n] = (f32x4){0.f, 0.f, 0.f, 0.f};
    bf16x8 At[4][2], B0[2][2], B1[2][2];
    const char* cA = (const char*)cur.A; const char* cB = (const char*)cur.B;
    int clda = cur.lda, cldb = cur.ldb;
#define VA0(ld) ((unsigned)(RA[0] * (ld) + CC[0]) * 2u)
#define VA1(ld) ((unsigned)(RA[1] * (ld) + CC[1]) * 2u)
#define VB0(ld) ((unsigned)(RB[0] * (ld) + CC[0]) * 2u)
#define VB1(ld) ((unsigned)(RB[1] * (ld) + CC[1]) * 2u)
    unsigned vAc0 = VA0(clda), vAc1 = VA1(clda), vBc0 = VB0(cldb), vBc1 = VB1(cldb);
    size_t hsAc = (size_t)HALF * clda * 2, hsBc = (size_t)HALF * cldb * 2;
    PG8_STAGE(PG8_SB(0, 0), cB, vBc0, vBc1); PG8_STAGE(PG8_SB(0, 1), cB + hsBc, vBc0, vBc1); PG8_STAGE(PG8_SA(0, 0), cA, vAc0, vAc1); PG8_STAGE(PG8_SA(0, 1), cA + hsAc, vAc0, vAc1);
    if (wr == 1) PG8_BAR;
    PG8_WAIT_V(2); PG8_BAR;
    PG8_STAGE(PG8_SB(1, 0), cB + kstep, vBc0, vBc1); PG8_STAGE(PG8_SA(1, 0), cA + kstep, vAc0, vAc1); PG8_STAGE(PG8_SB(1, 1), cB + hsBc + kstep, vBc0, vBc1);
    PG8_WAIT_V(6); PG8_BAR;
    for (;;) {
        const bool has_next = S.next(ui + 1, nxt);
        const char* nA = has_next ? (const char*)nxt.A : cA; const char* nB = has_next ? (const char*)nxt.B : cB;
        const int nlda = has_next ? nxt.lda : cur.lda, nldb = has_next ? nxt.ldb : cur.ldb;
        const size_t hsAn = (size_t)HALF * nlda * 2, hsBn = (size_t)HALF * nldb * 2;
        const int nt = cur.nt;
        for (int t = 0; t < nt; t += 2) {
            const bool last = (t == nt - 2);
            const char* a1 = cA + (size_t)(t + 1) * kstep;
            const char* a2 = last ? nA : cA + (size_t)(t + 2) * kstep; const char* b2 = last ? nB : cB + (size_t)(t + 2) * kstep;
            const char* a3 = a2 + kstep; const char* b3 = b2 + kstep;
            const int lda2 = last ? nlda : clda, ldb2 = last ? nldb : cldb;
            const unsigned vA0 = VA0(lda2), vA1 = VA1(lda2), vB0 = VB0(ldb2), vB1 = VB1(ldb2);
            vAc0 = VA0(clda); vAc1 = VA1(clda);
            const size_t hsA2 = last ? hsAn : hsAc, hsB2 = last ? hsBn : hsBc;
            PG8_LDB(B0, 0, 0); PG8_LDB(B1, 0, 1); PG8_SCHED; PG8_LDA(At, 0, 0); PG8_STAGE(PG8_SA(1, 1), a1 + hsAc, vAc0, vAc1);
            PG8_WAIT_V(8); PG8_WAIT_L(0); PG8_BAR; PG8_MMA(0, 0, At, B0); PG8_MMA(0, 1, At, B1); PG8_BAR; PG8_SCHED;
            PG8_LDA(At, 0, 1); PG8_STAGE(PG8_SB(0, 0), b2, vB0, vB1); PG8_STAGE(PG8_SB(0, 1), b2 + hsB2, vB0, vB1); PG8_STAGE(PG8_SA(0, 0), a2, vA0, vA1);
            PG8_WAIT_V(8); PG8_WAIT_L(0); PG8_BAR; PG8_MMA(1, 0, At, B0); PG8_MMA(1, 1, At, B1); PG8_BAR; PG8_SCHED;
            PG8_LDB(B0, 1, 0); PG8_LDB(B1, 1, 1); PG8_SCHED; PG8_LDA(At, 1, 0); PG8_STAGE(PG8_SA(0, 1), a2 + hsA2, vA0, vA1);
            PG8_WAIT_V(8); PG8_WAIT_L(0); PG8_BAR; PG8_MMA(0, 0, At, B0); PG8_MMA(0, 1, At, B1); PG8_BAR; PG8_SCHED;
            PG8_LDA(At, 1, 1); PG8_STAGE(PG8_SB(1, 0), b3, vB0, vB1); PG8_STAGE(PG8_SB(1, 1), b3 + hsB2, vB0, vB1); PG8_STAGE(PG8_SA(1, 0), a3, vA0, vA1);
            PG8_WAIT_V(8); PG8_WAIT_L(0); PG8_BAR; PG8_MMA(1, 0, At, B0); PG8_MMA(1, 1, At, B1); PG8_BAR; PG8_SCHED;
        }
        if (wr == 0) PG8_BAR;
        const bool clear = E(acc, cur, wr, wc, fr, fq);
        if (!has_next) break;
        if (clear) {
#pragma unroll
        for (int a = 0; a < 2; ++a)
#pragma unroll
            for (int b = 0; b < 2; ++b)
#pragma unroll
                for (int m = 0; m < 4; ++m)
#pragma unroll
                    for (int n = 0; n < 2; ++n) acc[a][b][m][n] = (f32x4){0.f, 0.f, 0.f, 0.f};
        }
        cur = nxt; cA = nA; cB = nB; ++ui;
        clda = nlda; cldb = nldb; vAc0 = VA0(clda); vAc1 = VA1(clda); hsAc = hsAn; hsBc = hsBn;
        if (wr == 1) PG8_BAR;
    }
    PG8_WAIT_V(0);
    PG8_BAR;
#undef VA0
#undef VA1
#undef VB0
#undef VB1
#undef PG8_SA
#undef PG8_SB
#undef PG8_STAGE
#undef PG8_LDA
#undef PG8_LDB
#undef PG8_MMA
#undef PG8_WAIT_V
#undef PG8_WAIT_L
#undef PG8_BAR
#undef PG8_SCHED
}

struct EpiStore {
    __device__ __forceinline__ bool operator()(const f32x4 (&acc)[2][2][4][2], const GUnit& u, int wr, int wc, int fr, int fq) {
#pragma unroll
        for (int ai = 0; ai < 2; ++ai)
#pragma unroll
            for (int m = 0; m < 4; ++m) { bf16_t* rowp = u.C + (size_t)(ai * HALF + wr * 64 + m * 16 + fr) * u.ldc + wc * 32 + 8 * fq;
#pragma unroll
                for (int bj = 0; bj < 2; ++bj) { const f32x4 v0 = acc[ai][bj][m][0], v1 = acc[ai][bj][m][1];
                    u32x4 w; w.x = cvt_pk_bf16(v0[0], v0[1]); w.y = cvt_pk_bf16(v0[2], v0[3]); w.z = cvt_pk_bf16(v1[0], v1[1]); w.w = cvt_pk_bf16(v1[2], v1[3]);
                    *(GAS u32x4*)(rowp + bj * HALF) = w; } }
        return true;
    }
};
struct EpiResid {
    const float* xp; const float* xs; float* out;
    __device__ __forceinline__ bool operator()(const f32x4 (&acc)[2][2][4][2], const GUnit& u, int wr, int wc, int fr, int fq) {
        const unsigned off0 = (unsigned)(wr * 64 + fr) * DM + u.pn * 256 + wc * 32 + 8 * fq;
        const float* xin = ((u.pm < 64) ? xp + (size_t)u.pm * 256 * DM : xs + (size_t)(u.pm - 64) * 256 * DM) + off0;
        float* o = out + (size_t)u.pm * 256 * DM + off0;
#pragma unroll
        for (int ai = 0; ai < 2; ++ai)
#pragma unroll
            for (int m = 0; m < 4; ++m)
#pragma unroll
                for (int bj = 0; bj < 2; ++bj) { const unsigned ro = (unsigned)(ai * HALF + m * 16) * DM + bj * HALF;
                    const f32x4 x0 = *(const GAS f32x4*)(xin + ro), x1 = *(const GAS f32x4*)(xin + ro + 4);
                    *(GAS f32x4*)(o + ro) = x0 + acc[ai][bj][m][0]; *(GAS f32x4*)(o + ro + 4) = x1 + acc[ai][bj][m][1]; }
        return true;
    }
};
struct EpiResidNorm {
    const float* xp; const float* xs; float* out; bf16_t* hbo; const float* g2; float* sumsq;
    __device__ __forceinline__ bool operator()(const f32x4 (&acc)[2][2][4][2], const GUnit& u, int wr, int wc, int fr, int fq) {
        const unsigned col0 = u.pn * 256 + wc * 32 + 8 * fq;
        const unsigned off0 = (unsigned)(wr * 64 + fr) * DM + col0;
        const float* xin = ((u.pm < 64) ? xp + (size_t)u.pm * 256 * DM : xs + (size_t)(u.pm - 64) * 256 * DM) + off0;
        float* o = out + (size_t)u.pm * 256 * DM + off0;
        bf16_t* ho = hbo + (size_t)u.pm * 256 * DM + off0;
        f32x4 gg[2][2];
#pragma unroll
        for (int bj = 0; bj < 2; ++bj) { gg[bj][0] = *(const GAS f32x4*)(g2 + col0 + bj * HALF); gg[bj][1] = *(const GAS f32x4*)(g2 + col0 + bj * HALF + 4); }
#pragma unroll
        for (int ai = 0; ai < 2; ++ai)
#pragma unroll
            for (int m = 0; m < 4; ++m) { float ss = 0.f;
#pragma unroll
                for (int bj = 0; bj < 2; ++bj) { const unsigned ro = (unsigned)(ai * HALF + m * 16) * DM + bj * HALF;
                    const f32x4 x0 = *(const GAS f32x4*)(xin + ro) + acc[ai][bj][m][0], x1 = *(const GAS f32x4*)(xin + ro + 4) + acc[ai][bj][m][1];
                    *(GAS f32x4*)(o + ro) = x0; *(GAS f32x4*)(o + ro + 4) = x1;
                    ss += (x0[0] * x0[0] + x0[1] * x0[1]) + (x0[2] * x0[2] + x0[3] * x0[3]) + (x1[0] * x1[0] + x1[1] * x1[1]) + (x1[2] * x1[2] + x1[3] * x1[3]);
                    const f32x4 h0 = x0 * gg[bj][0], h1 = x1 * gg[bj][1]; u32x4 w;
                    w.x = cvt_pk_bf16(h0[0], h0[1]); w.y = cvt_pk_bf16(h0[2], h0[3]); w.z = cvt_pk_bf16(h1[0], h1[1]); w.w = cvt_pk_bf16(h1[2], h1[3]);
                    *(GAS u32x4*)(ho + ro) = w; }
                ss += __shfl_xor(ss, 16); ss += __shfl_xor(ss, 32);
                if (fq == 0) atomicAdd(sumsq + u.pm * 256 + ai * HALF + wr * 64 + m * 16 + fr, ss); }
        return true;
    }
};
struct EpiSwigluNorm {
    bf16_t* act; const float* sumsq;
    __device__ __forceinline__ bool operator()(const f32x4 (&acc)[2][2][4][2], const GUnit& u, int wr, int wc, int fr, int fq) {
#pragma unroll
        for (int ai = 0; ai < 2; ++ai)
#pragma unroll
            for (int m = 0; m < 4; ++m) { const int row = u.pm * 256 + ai * HALF + wr * 64 + m * 16 + fr;
                const float rs = 1.f / sqrtf(*(const GAS float*)(sumsq + row) * (1.f / DM) + EPS);
                bf16_t* rowp = act + (size_t)row * FF + u.pn * 128 + wc * 32 + 8 * fq;
                float o[8];
#pragma unroll
                for (int n = 0; n < 2; ++n)
#pragma unroll
                    for (int i = 0; i < 4; ++i) o[4 * n + i] = siluf_(rs * acc[ai][0][m][n][i]) * (rs * acc[ai][1][m][n][i]);
                u32x4 w; w.x = cvt_pk_bf16(o[0], o[1]); w.y = cvt_pk_bf16(o[2], o[3]); w.z = cvt_pk_bf16(o[4], o[5]); w.w = cvt_pk_bf16(o[6], o[7]);
                *(GAS u32x4*)rowp = w; }
        return true;
    }
};
struct EpiSwiglu {
    bf16_t* act;
    __device__ __forceinline__ bool operator()(const f32x4 (&acc)[2][2][4][2], const GUnit& u, int wr, int wc, int fr, int fq) {
#pragma unroll
        for (int ai = 0; ai < 2; ++ai)
#pragma unroll
            for (int m = 0; m < 4; ++m) { bf16_t* rowp = act + (size_t)(u.pm * 256 + ai * HALF + wr * 64 + m * 16 + fr) * FF + u.pn * 128 + wc * 32 + 8 * fq;
                float o[8];
#pragma unroll
                for (int n = 0; n < 2; ++n)
#pragma unroll
                    for (int i = 0; i < 4; ++i) o[4 * n + i] = siluf_(acc[ai][0][m][n][i]) * acc[ai][1][m][n][i];
                u32x4 w; w.x = cvt_pk_bf16(o[0], o[1]); w.y = cvt_pk_bf16(o[2], o[3]); w.z = cvt_pk_bf16(o[4], o[5]); w.w = cvt_pk_bf16(o[6], o[7]);
                *(GAS u32x4*)rowp = w; }
        return true;
    }
};
struct EpiMerge {
    const float* bgate; bf16_t* merged; bf16_t* gtmp;
    __device__ __forceinline__ bool operator()(const f32x4 (&acc)[2][2][4][2], const GUnit& u, int wr, int wc, int fr, int fq) {
        const int br = u.sub >> 1;
        const unsigned off0 = (unsigned)(u.pm * 256 + wr * 64 + fr) * DM + u.pn * 256 + wc * 32 + 8 * fq;
        if ((u.sub & 1) == 0) {
#pragma unroll
            for (int bj = 0; bj < 2; ++bj) { const float* bp = bgate + br * 1024 + u.pn * 256 + bj * HALF + wc * 32 + 8 * fq;
                const f32x4 b0 = *(const GAS f32x4*)bp, b1 = *(const GAS f32x4*)(bp + 4);
#pragma unroll
                for (int ai = 0; ai < 2; ++ai)
#pragma unroll
                    for (int m = 0; m < 4; ++m) { const f32x4 v0 = acc[ai][bj][m][0] + b0, v1 = acc[ai][bj][m][1] + b1; u32x4 w;
                        w.x = cvt_pk_bf16(sigmoidf_(v0[0]), sigmoidf_(v0[1])); w.y = cvt_pk_bf16(sigmoidf_(v0[2]), sigmoidf_(v0[3]));
                        w.z = cvt_pk_bf16(sigmoidf_(v1[0]), sigmoidf_(v1[1])); w.w = cvt_pk_bf16(sigmoidf_(v1[2]), sigmoidf_(v1[3]));
                        *(GAS u32x4*)(gtmp + off0 + (unsigned)(ai * HALF + m * 16) * DM + bj * HALF) = w; } }
        } else {
#pragma unroll
            for (int ai = 0; ai < 2; ++ai)
#pragma unroll
                for (int m = 0; m < 4; ++m)
#pragma unroll
                    for (int bj = 0; bj < 2; ++bj) { const unsigned off = off0 + (unsigned)(ai * HALF + m * 16) * DM + bj * HALF;
                        const u32x4 gg = *(const GAS u32x4*)(gtmp + off); u32x4 mm = (u32x4){0u, 0u, 0u, 0u}; if (br > 0) mm = *(const GAS u32x4*)(merged + off);
                        const f32x4 a0 = acc[ai][bj][m][0], a1 = acc[ai][bj][m][1]; u32x4 w;
                        w.x = cvt_pk_bf16(bflo(mm.x) + bflo(gg.x) * a0[0], bfhi(mm.x) + bfhi(gg.x) * a0[1]); w.y = cvt_pk_bf16(bflo(mm.y) + bflo(gg.y) * a0[2], bfhi(mm.y) + bfhi(gg.y) * a0[3]);
                        w.z = cvt_pk_bf16(bflo(mm.z) + bflo(gg.z) * a1[0], bfhi(mm.z) + bfhi(gg.z) * a1[1]); w.w = cvt_pk_bf16(bflo(mm.w) + bflo(gg.w) * a1[2], bfhi(mm.w) + bfhi(gg.w) * a1[3]);
                        *(GAS u32x4*)(merged + off) = w; }
        }
        return true;
    }
};
}

struct Args { const float* in[38]; float* out; unsigned char* ws; int ph_lo, ph_hi; };
struct Ctx {
    const Args* A; float* out; unsigned char* ws; LAS unsigned char* lds;
    int tid, lane, wave, gw, NGW, l, G, bid;
};
#define WSB(off) ((bf16_t*)(C.ws + (off)))
#define INL(i, sz) (C.A->in[i] + (size_t)C.l * (size_t)(sz))
#define IN0(i) (C.A->in[i])

using pg8::GUnit;
struct SchedOne {
    const bf16_t* A; const bf16_t* B; bf16_t* Cp; int lda, ldb, ldc, nM, nN, nt, G, c;
    __device__ __forceinline__ bool next(int i, GUnit& u) const {
        const long L = (long)i * G + c; if (L >= (long)nM * nN) return false;
        int pm, pn; pg8::tile_map((int)L, nM, nN, pm, pn);
        u.A = A + (size_t)pm * 256 * lda; u.B = B + (size_t)pn * 256 * ldb; u.lda = lda; u.ldb = ldb; u.nt = nt; u.pm = pm; u.pn = pn; u.sub = 0;
        u.C = Cp ? Cp + (size_t)pm * 256 * ldc + (size_t)pn * 256 : nullptr; u.ldc = ldc; return true;
    }
};
struct SchedInproj {
    const bf16_t* A; const bf16_t* B; bf16_t *pA, *pB, *pC, *pD; int G, c;
    __device__ __forceinline__ bool next(int i, GUnit& u) const {
        const long L = (long)i * G + c; if (L >= 72 * 21) return false;
        int pm, pn; pg8::tile_map((int)L, 72, 21, pm, pn);
        u.A = A + (size_t)pm * 256 * 1024; u.B = B + (size_t)pn * 256 * 1024; u.lda = 1024; u.ldb = 1024; u.nt = 16; u.pm = pm; u.pn = pn; u.sub = 0;
        if (pn < 6) { u.C = pA + (size_t)pm * 256 * 1536 + pn * 256; u.ldc = 1536; }
        else if (pn < 9) { u.C = pB + (size_t)pm * 256 * 768 + (pn - 6) * 256; u.ldc = 768; }
        else if (pn < 15) { u.C = pC + (size_t)pm * 256 * 1536 + (pn - 9) * 256; u.ldc = 1536; }
        else { u.C = pD + (size_t)pm * 256 * 1536 + (pn - 15) * 256; u.ldc = 1536; }
        return true;
    }
};
struct SchedP3 {
    const bf16_t *pB, *wq, *ckvP, *ckvS, *wkv; bf16_t *Q, *KVP, *KVS; int G, c;
    __device__ __forceinline__ bool next(int i, GUnit& u) const {
        long L = (long)i * G + c; int pm, pn; u.sub = 0;
        if (L < 264 * 4) { pg8::tile_map((int)L, 264, 4, pm, pn); u.A = ckvS + (size_t)pm * 256 * 256; u.B = wkv + (size_t)pn * 256 * 256; u.lda = 256; u.ldb = 256; u.nt = 4;
            u.C = KVS + (size_t)pm * 256 * 1024 + pn * 256; u.ldc = 1024; u.pm = pm; u.pn = pn; return true; }
        L -= 264 * 4;
        if (L < 64 * 4) { pg8::tile_map((int)L, 64, 4, pm, pn); u.A = ckvP + (size_t)pm * 256 * 256; u.B = wkv + (size_t)pn * 256 * 256; u.lda = 256; u.ldb = 256; u.nt = 4;
            u.C = KVP + (size_t)pm * 256 * 1024 + pn * 256; u.ldc = 1024; u.pm = pm; u.pn = pn; return true; }
        L -= 64 * 4;
        if (L < 72 * 3) { pg8::tile_map((int)L, 72, 3, pm, pn); u.A = pB + (size_t)pm * 256 * 768; u.B = wq + (size_t)pn * 256 * 384; u.lda = 768; u.ldb = 384; u.nt = 6;
            u.C = Q + (size_t)pm * 256 * 768 + pn * 256; u.ldc = 768; u.pm = pm; u.pn = pn; return true; }
        return false;
    }
};
struct SchedMerge {
    const bf16_t *hb, *wg, *wout, *pA, *ybc, *pD; int G, c;
    __device__ __forceinline__ bool next(int i, GUnit& u) const {
        const long L = (long)(i >> 3) * G + c; if (L >= 72 * 4) return false;
        int pm, pn; pg8::tile_map((int)L, 72, 4, pm, pn); const int sub = i & 7, br = sub >> 1;
        u.pm = pm; u.pn = pn; u.sub = sub; u.C = nullptr; u.ldc = 0; u.ldb = 1024;
        if ((sub & 1) == 0) { u.A = hb + (size_t)pm * 256 * 1024; u.lda = 1024; u.nt = 16; u.B = wg + (size_t)(br * 1024 + pn * 256) * 1024; }
        else { u.nt = 8; u.B = wout + (size_t)(br * 1024 + pn * 256) * 1024;
            if (br == 0) { u.A = pA + (size_t)pm * 256 * 1536; u.lda = 1536; }
            else if (br == 1) { u.A = ybc + (size_t)pm * 256 * 1024; u.lda = 1024; }
            else if (br == 2) { u.A = ybc + (size_t)pm * 256 * 1024 + 512; u.lda = 1024; }
            else { u.A = pD + (size_t)pm * 256 * 1536; u.lda = 1536; } }
        return true;
    }
};

template <class Map>
__device__ __forceinline__ void transpose_w(const Ctx& C, const float* W, int ldw, int K, int Nout, bf16_t* WT, int ldt, Map map) {
    LAS float* scr = (LAS float*)(C.lds + C.wave * 8704);
    const int lane = C.lane, nblk = Nout / 32, items = (K / 64) * nblk;
    for (int it = C.gw; it < items; it += C.NGW) {
        const int kb = it / nblk, nb = it % nblk, k0 = 64 * kb, n0 = 32 * nb;
        const int col = map(n0 + (lane & 31));
#pragma unroll 8
        for (int i = 0; i < 32; ++i) { const int kk = 2 * i + (lane >> 5); scr[kk * 33 + (lane & 31)] = (col >= 0) ? W[(size_t)(k0 + kk) * ldw + col] : 0.f; }
        LDS_WAIT();
        const int c = lane & 7;
#pragma unroll
        for (int j = 0; j < 4; ++j) { const int n = (lane >> 3) + 8 * j; const LAS float* s = scr + (8 * c) * 33 + n;
            u32x4 o; o.x = pk2(s[0 * 33], s[1 * 33]); o.y = pk2(s[2 * 33], s[3 * 33]); o.z = pk2(s[4 * 33], s[5 * 33]); o.w = pk2(s[6 * 33], s[7 * 33]);
            *(u32x4*)(WT + (size_t)(n0 + n) * ldt + k0 + 8 * c) = o; }
        LDS_WAIT();
    }
}
struct MapId { __device__ __forceinline__ int operator()(int n) const { return n; } };
struct MapOff { int off; __device__ __forceinline__ int operator()(int n) const { return n + off; } };
struct MapIn { __device__ __forceinline__ int operator()(int n) const { return n < 1536 ? n : (n < 2208 ? n + 8 : (n < 2216 ? n - 2208 + 1536 : (n < 2304 ? -1 : n - 88))); } };
struct MapKv { __device__ __forceinline__ int operator()(int n) const { return n < 512 ? ((n >> 6) * 128 + (n & 63)) : (((n - 512) >> 6) * 128 + 64 + (n & 63)); } };
struct MapUp { __device__ __forceinline__ int operator()(int n) const { const int t = n >> 8, w = n & 255; return w < 128 ? 128 * t + w : 2816 + 128 * t + (w - 128); } };

__device__ __forceinline__ void phase_wprep(const Ctx& C) {
    transpose_w(C, INL(10, 1024 * IN_COLS), IN_COLS, 1024, 5376, WSB(WS_WT_IN), 1024, MapIn());
    transpose_w(C, INL(10, 1024 * IN_COLS), IN_COLS, 1024, 4096, WSB(WS_WT_G), 1024, MapOff{5288});
    transpose_w(C, INL(20, 384 * 768), 768, 384, 768, WSB(WS_WT_QUP), 384, MapId());
    transpose_w(C, INL(22, 256 * 1024), 1024, 256, 1024, WSB(WS_WT_KVUP), 256, MapKv());
    transpose_w(C, INL(18, 512 * 1024), 1024, 512, 1024, WSB(WS_WT_OUT), 1024, MapId());
    transpose_w(C, INL(27, 512 * 1024), 1024, 512, 1024, WSB(WS_WT_OUT) + (size_t)1 * 1024 * 1024, 1024, MapId());
    transpose_w(C, INL(29, 512 * 1024), 1024, 512, 1024, WSB(WS_WT_OUT) + (size_t)2 * 1024 * 1024, 1024, MapId());
    transpose_w(C, INL(33, 512 * 1024), 1024, 512, 1024, WSB(WS_WT_OUT) + (size_t)3 * 1024 * 1024, 1024, MapId());
    transpose_w(C, INL(34, 1024 * 1024), 1024, 1024, 1024, WSB(WS_WT_O), 1024, MapId());
    transpose_w(C, INL(36, 1024 * 5632), 5632, 1024, 5632, WSB(WS_WT_UP), 1024, MapUp());
    transpose_w(C, INL(37, 2816 * 1024), 1024, 2816, 1024, WSB(WS_WT_DOWN), 2816, MapId());
}

__device__ __forceinline__ const float* xrow(const Ctx& C, int row, bool from_out) {
    if (from_out) return C.out + (size_t)row * DM;
    return row < NP ? IN0(0) + (size_t)row * DM : IN0(1) + (size_t)(row - NP) * DM;
}
__device__ __forceinline__ void phase_norm(const Ctx& C, const float* g, bool from_out) {
    const int lane = C.lane;
    f32x4 gv[4];
#pragma unroll
    for (int j = 0; j < 4; ++j) gv[j] = ((const f32x4*)g)[64 * j + lane];
    for (int row = C.gw; row < R; row += C.NGW) {
        const f32x4* xr = (const f32x4*)xrow(C, row, from_out) + lane;
        f32x4 v[4]; float s = 0.f;
#pragma unroll
        for (int j = 0; j < 4; ++j) { v[j] = xr[64 * j]; s += (v[j].x * v[j].x + v[j].y * v[j].y) + (v[j].z * v[j].z + v[j].w * v[j].w); }
        const float rstd = 1.f / sqrtf(wave_sum(s) * (1.f / DM) + EPS);
        u32x2* o = (u32x2*)(WSB(WS_HB) + (size_t)row * DM) + lane;
#pragma unroll
        for (int j = 0; j < 4; ++j) { u32x2 w; w.x = pk2(v[j].x * rstd * gv[j].x, v[j].y * rstd * gv[j].y); w.y = pk2(v[j].z * rstd * gv[j].z, v[j].w * rstd * gv[j].w); o[64 * j] = w; }
    }
}
__device__ __forceinline__ void rope_cs(int pos, int i, float& c, float& s) {
    const float chi = ((i & 8) ? ((i & 4) ? ((i & 2) ? ((i & 1) ? 2.831220627e-05f : 5.030632019e-05f) : ((i & 1) ? 8.952617645e-05f : 1.592636108e-04f)) : ((i & 2) ? ((i & 1) ? 2.832412720e-04f : 5.035400391e-04f) : ((i & 1) ? 8.945465088e-04f : 1.590728760e-03f))) : ((i & 4) ? ((i & 2) ? ((i & 1) ? 2.830505371e-03f : 5.035400391e-03f) : ((i & 1) ? 8.956909180e-03f : 1.593017578e-02f)) : ((i & 2) ? ((i & 1) ? 2.828979492e-02f : 5.035400391e-02f) : ((i & 1) ? 8.947753906e-02f : 1.591796875e-01f))));
    const float clo = ((i & 8) ? ((i & 4) ? ((i & 2) ? ((i & 1) ? -1.001043781e-08f : 2.289191414e-08f) : ((i & 1) ? -2.677484368e-08f : -1.086677486e-07f)) : ((i & 2) ? ((i & 1) ? -2.193136623e-07f : -2.479180239e-07f) : ((i & 1) ? 4.475072899e-07f : 8.206711755e-07f))) : ((i & 4) ? ((i & 2) ? ((i & 1) ? -2.857880190e-07f : -2.479180239e-06f) : ((i & 1) ? -6.969018614e-06f : -1.468147184e-05f)) : ((i & 2) ? ((i & 1) ? 1.240090842e-05f : -2.479180148e-05f) : ((i & 1) ? 2.186254642e-05f : -2.474440771e-05f))));
    const float pf = (float)pos, rh = pf * chi, f1 = rh - __builtin_rintf(rh), fr = f1 + pf * clo;
    c = __builtin_amdgcn_cosf(fr); s = __builtin_amdgcn_sinf(fr);
}
__device__ __forceinline__ int row_pos(int row) { return row < NP ? (row & (TP - 1)) : PAST + ((row - NP) & 63); }

__device__ __forceinline__ void phase_mla_prep(const Ctx& C) {
    const int lane = C.lane; const int l = C.l;
    const float* gq = INL(19, 384); const float* gkv = INL(21, 256); const float* gkr = INL(26, 32);
    for (int row = C.gw; row < R; row += C.NGW) {
        bf16_t* pb = WSB(WS_ZB) + (size_t)row * 768;
        unsigned q[3]; float ss = 0.f;
#pragma unroll
        for (int j = 0; j < 3; ++j) { q[j] = *(const unsigned*)(pb + 2 * lane + 128 * j); const float a = bflo(q[j]), b = bfhi(q[j]); ss += a * a + b * b; }
        float rstd = 1.f / sqrtf(wave_sum(ss) * (1.f / 384.f) + EPS);
#pragma unroll
        for (int j = 0; j < 3; ++j) { const int c = 2 * lane + 128 * j; *(unsigned*)(pb + c) = pk2(bflo(q[j]) * rstd * gq[c], bfhi(q[j]) * rstd * gq[c + 1]); }
        const u32x2 kv = *(const u32x2*)(pb + 384 + 4 * lane);
        float k0 = bflo(kv.x), k1 = bfhi(kv.x), k2 = bflo(kv.y), k3 = bfhi(kv.y);
        rstd = 1.f / sqrtf(wave_sum(k0 * k0 + k1 * k1 + k2 * k2 + k3 * k3) * (1.f / 256.f) + EPS);
        const f32x4 g4 = *(const f32x4*)(gkv + 4 * lane);
        f32x4 ck; ck.x = k0 * rstd * g4.x; ck.y = k1 * rstd * g4.y; ck.z = k2 * rstd * g4.z; ck.w = k3 * rstd * g4.w;
        u32x2 ckb; ckb.x = pk2(ck.x, ck.y); ckb.y = pk2(ck.z, ck.w);
        const int pos = row_pos(row);
        size_t srow = 0;
        if (row < NP) { *(f32x4*)(C.out + O_CKV_P + ((size_t)l * NP + row) * 256 + 4 * lane) = ck; *(u32x2*)(WSB(WS_CKVP) + (size_t)row * 256 + 4 * lane) = ckb; }
        else { const int rs = row - NP; srow = (size_t)(rs >> 6) * KS_ALL + PAST + (rs & 63);
            *(f32x4*)(C.out + O_CKV_S + ((size_t)l * NS + rs) * 256 + 4 * lane) = ck; *(u32x2*)(WSB(WS_CKVS) + srow * 256 + 4 * lane) = ckb; }
        const float x = (lane < 32) ? bf1(pb[640 + lane]) : 0.f;
        rstd = 1.f / sqrtf(wave_sum(x * x) * (1.f / 32.f) + EPS);
        const float y = x * rstd * gkr[lane & 31];
        const float part = __shfl_xor(y, 16);
        float cs, sn; rope_cs(pos, lane & 15, cs, sn);
        const float o = (lane < 16) ? (y * cs - part * sn) : (part * sn + y * cs);
        if (lane < 32) {
            if (row < NP) { C.out[O_KPE_P + ((size_t)l * NP + row) * 32 + lane] = o; WSB(WS_KPEP)[(size_t)row * 32 + lane] = (bf16_t)f2bf(o); }
            else { C.out[O_KPE_S + ((size_t)l * NS + (row - NP)) * 32 + lane] = o; WSB(WS_KPES)[srow * 32 + lane] = (bf16_t)f2bf(o); }
        }
    }
    const size_t gt = (size_t)C.bid * NTHREADS + C.tid, GT = (size_t)C.G * NTHREADS;
    { const float* src = INL(4, (size_t)BS * PAST * 256);
      for (size_t i = gt; i < (size_t)BS * PAST * 256 / 8; i += GT) { const size_t e = i * 8, b = e / ((size_t)PAST * 256), rem = e % ((size_t)PAST * 256);
          *(u32x4*)(WSB(WS_CKVS) + b * KS_ALL * 256 + rem) = load8(src, e, true); } }
    { const float* src = INL(5, (size_t)BS * PAST * 32);
      for (size_t i = gt; i < (size_t)BS * PAST * 32 / 8; i += GT) { const size_t e = i * 8, b = e / ((size_t)PAST * 32), rem = e % ((size_t)PAST * 32);
          *(u32x4*)(WSB(WS_KPES) + b * KS_ALL * 32 + rem) = load8(src, e, true); } }
}

__device__ __forceinline__ float red8(float v) { v += __shfl_xor(v, 1); v += __shfl_xor(v, 2); v += __shfl_xor(v, 4); return v; }

__device__ __forceinline__ void phase_band_prep(const Ctx& C) {
    const int lane = C.lane, l = C.l, d0 = (lane & 7) * 8;
    float gq[8], gk[8];
#pragma unroll
    for (int e = 0; e < 8; ++e) { gq[e] = INL(30, 64)[d0 + e] * (0.125f * LOG2E); gk[e] = INL(31, 64)[d0 + e]; }
    for (int row = C.gw; row < R; row += C.NGW) {
        bf16_t* pd = WSB(WS_PD) + (size_t)row * 1536 + 8 * lane;
        float f[8], kf[8], vf[8];
        unpack8(*(const u32x4*)pd, f); float ss = 0.f;
#pragma unroll
        for (int e = 0; e < 8; ++e) ss += f[e] * f[e];
        float rstd = 1.f / sqrtf(red8(ss) * (1.f / 64.f) + EPS);
#pragma unroll
        for (int e = 0; e < 8; ++e) f[e] *= rstd * gq[e];
        *(u32x4*)pd = pack8(f);
        unpack8(*(const u32x4*)(pd + 512), kf); ss = 0.f;
#pragma unroll
        for (int e = 0; e < 8; ++e) ss += kf[e] * kf[e];
        rstd = 1.f / sqrtf(red8(ss) * (1.f / 64.f) + EPS);
#pragma unroll
        for (int e = 0; e < 8; ++e) kf[e] *= rstd * gk[e];
        *(u32x4*)(pd + 512) = pack8(kf);
        unpack8(*(const u32x4*)(pd + 1024), vf);
        long dst = -1;
        if (row < NP) { const int t = row & (TP - 1), b = row >> 13; if (t >= TP - 512) dst = (long)(((size_t)(l * BP + b) * 512 + (t - (TP - 512))) * 512 + 8 * lane); }
        else { const int rs = row - NP, b = rs >> 6, t = rs & 63; dst = (long)(((size_t)(l * BS + b) * 512 + 448 + t) * 512 + 8 * lane); }
        if (dst >= 0) { float* ko = C.out + (row < NP ? O_BK_P : O_BK_S) + dst; float* vo = C.out + (row < NP ? O_BV_P : O_BV_S) + dst;
            *(f32x4*)ko = (f32x4){kf[0], kf[1], kf[2], kf[3]}; *(f32x4*)(ko + 4) = (f32x4){kf[4], kf[5], kf[6], kf[7]};
            *(f32x4*)vo = (f32x4){vf[0], vf[1], vf[2], vf[3]}; *(f32x4*)(vo + 4) = (f32x4){vf[4], vf[5], vf[6], vf[7]}; }
    }
    const size_t gt = (size_t)C.bid * NTHREADS + C.tid, GT = (size_t)C.G * NTHREADS;
    const f32x4* sk = (const f32x4*)INL(7, (size_t)BS * 512 * 512); const f32x4* sv = (const f32x4*)INL(8, (size_t)BS * 512 * 512);
    f32x4* dk = (f32x4*)(C.out + O_BK_S + (size_t)l * BS * 512 * 512); f32x4* dv = (f32x4*)(C.out + O_BV_S + (size_t)l * BS * 512 * 512);
    for (size_t i = gt; i < (size_t)BS * 448 * 128; i += GT) { const size_t b = i / (448 * 128), rem = i % (448 * 128);
        dk[b * 512 * 128 + rem] = sk[b * 512 * 128 + 64 * 128 + rem]; dv[b * 512 * 128 + rem] = sv[b * 512 * 128 + 64 * 128 + rem]; }
}

__device__ __forceinline__ void phase_sconv(const Ctx& C) {
    const int lane = C.lane, l = C.l, ch = 8 * lane;
    const float* w = INL(28, 3 * 512);
    float w0[8], w1[8], w2[8];
#pragma unroll
    for (int e = 0; e < 8; ++e) { w0[e] = w[ch + e]; w1[e] = w[512 + ch + e]; w2[e] = w[1024 + ch + e]; }
    for (int row = C.gw; row < R; row += C.NGW) {
        const bf16_t* pc = WSB(WS_XR) + (size_t)row * 1536 + ch;
        const bool pr = row < NP; const int t = pr ? (row & (TP - 1)) : ((row - NP) & 63); const int b = pr ? (row >> 13) : ((row - NP) >> 6);
        float cb[8], a[8], x[8], u0[8], u1[8], u2[8];
        unpack8(*(const u32x4*)pc, cb); unpack8(*(const u32x4*)(pc + 512), a); unpack8(*(const u32x4*)(pc + 1024), x);
#pragma unroll
        for (int e = 0; e < 8; ++e) u0[e] = a[e] * x[e];
        const float* st = INL(6, BS * 2 * 512) + (size_t)b * 2 * 512 + ch;
        if (t >= 1) { unpack8(*(const u32x4*)(pc - 1536 + 512), a); unpack8(*(const u32x4*)(pc - 1536 + 1024), x);
#pragma unroll
            for (int e = 0; e < 8; ++e) u1[e] = a[e] * x[e]; }
        else {
#pragma unroll
            for (int e = 0; e < 8; ++e) u1[e] = pr ? 0.f : st[512 + e]; }
        if (t >= 2) { unpack8(*(const u32x4*)(pc - 3072 + 512), a); unpack8(*(const u32x4*)(pc - 3072 + 1024), x);
#pragma unroll
            for (int e = 0; e < 8; ++e) u2[e] = a[e] * x[e]; }
        else {
#pragma unroll
            for (int e = 0; e < 8; ++e) u2[e] = pr ? 0.f : st[(t == 1 ? 512 : 0) + e]; }
        float y[8];
#pragma unroll
        for (int e = 0; e < 8; ++e) y[e] = cb[e] * (w0[e] * u2[e] + w1[e] * u1[e] + w2[e] * u0[e]);
        *(u32x4*)(WSB(WS_YBC) + (size_t)row * 1024 + 512 + ch) = pack8(y);
        const int T = pr ? TP : TS;
        if (t >= T - 2) { float* o = C.out + (pr ? O_SC_P + ((size_t)(l * BP + b) * 2 + (t - (T - 2))) * 512 : O_SC_S + ((size_t)(l * BS + b) * 2 + (t - (T - 2))) * 512) + ch;
            *(f32x4*)o = (f32x4){u0[0], u0[1], u0[2], u0[3]}; *(f32x4*)(o + 4) = (f32x4){u0[4], u0[5], u0[6], u0[7]}; }
    }
}

__device__ __forceinline__ void phase_qk_post(const Ctx& C) {
    const int lane = C.lane, head = lane >> 3, sub = lane & 7;
    const float SC = 0.10206207261596577f * LOG2E;
    float gn[8], gr[8], gk[8];
#pragma unroll
    for (int e = 0; e < 8; ++e) { gn[e] = INL(23, 64)[8 * sub + e] * SC; gr[e] = INL(25, 32)[8 * (sub & 3) + e]; gk[e] = INL(24, 64)[8 * sub + e]; }
    for (int row = C.gw; row < R; row += C.NGW) {
        bf16_t* qp = WSB(WS_Q) + (size_t)row * 768 + 96 * head;
        float f[8]; unpack8(*(const u32x4*)(qp + 8 * sub), f); float ss = 0.f;
#pragma unroll
        for (int e = 0; e < 8; ++e) ss += f[e] * f[e];
        float rstd = 1.f / sqrtf(red8(ss) * (1.f / 64.f) + EPS);
#pragma unroll
        for (int e = 0; e < 8; ++e) f[e] *= rstd * gn[e];
        *(u32x4*)(qp + 8 * sub) = pack8(f);
        float r[8];
        if (sub < 4) unpack8(*(const u32x4*)(qp + 64 + 8 * sub), r);
        else {
#pragma unroll
            for (int e = 0; e < 8; ++e) r[e] = 0.f; }
        ss = 0.f;
#pragma unroll
        for (int e = 0; e < 8; ++e) ss += r[e] * r[e];
        ss += __shfl_xor(ss, 1); ss += __shfl_xor(ss, 2);
        rstd = 1.f / sqrtf(ss * (1.f / 32.f) + EPS);
        const int pos = row_pos(row);
        float o[8];
#pragma unroll
        for (int e = 0; e < 8; ++e) { const float y = r[e] * rstd * gr[e]; const float part = __shfl_xor(y, 2);
            float cs, sn; rope_cs(pos, 8 * (sub & 1) + e, cs, sn);
            o[e] = ((sub < 2) ? (y * cs - part * sn) : (part * sn + y * cs)) * SC; }
        if (sub < 4) *(u32x4*)(qp + 64 + 8 * sub) = pack8(o);
    }
    for (int row = C.gw; row < NP + BS * KS_ALL; row += C.NGW) {
        bf16_t* kp = (row < NP ? WSB(WS_KVP) + (size_t)row * 1024 : WSB(WS_XR) + (size_t)(row - NP) * 1024) + 8 * lane;
        float f[8]; unpack8(*(const u32x4*)kp, f); float ss = 0.f;
#pragma unroll
        for (int e = 0; e < 8; ++e) ss += f[e] * f[e];
        const float rstd = 1.f / sqrtf(red8(ss) * (1.f / 64.f) + EPS);
#pragma unroll
        for (int e = 0; e < 8; ++e) f[e] *= rstd * gk[e];
        *(u32x4*)kp = pack8(f);
    }
}

__device__ __forceinline__ bf16x8 mk_frag(u32x2 lo, u32x2 hi) { u32x4 v; v.x = lo.x; v.y = lo.y; v.z = hi.x; v.w = hi.y; return __builtin_bit_cast(bf16x8, v); }
__device__ __forceinline__ bf16x8 as_frag(u32x4 v) { return __builtin_bit_cast(bf16x8, v); }
#define MFMA16(a, b, c) __builtin_amdgcn_mfma_f32_16x16x32_bf16((a), (b), (c), 0, 0, 0)

__device__ __forceinline__ int ssd_row0(int seq, int c) { return seq < 2 ? seq * TP + c * 64 : NP + (seq - 2) * 64; }
__device__ __forceinline__ void ssd_dt(const Ctx& C, int row0, LAS float* sDT, LAS float* sACS) {
    const int h = C.wave, lane = C.lane;
    const float adt = bf1(WSB(WS_ZB)[(size_t)(row0 + lane) * 768 + 672 + h]) + INL(14, 8)[h];
    float dt; { const float e_ = fexp(adt), u_ = 1.f + e_; dt = (adt > 20.f) ? adt : ((u_ == 1.f) ? e_ : (__builtin_amdgcn_logf(u_) * 0.6931471805599453f) * e_ * frcp(u_ - 1.f)); }
    const float A = -fexp(INL(15, 8)[h]);
    float cs = dt * A;
#pragma unroll
    for (int o = 1; o < 64; o <<= 1) { const float t = __shfl_up(cs, o); if (lane >= o) cs += t; }
    sDT[h * 64 + lane] = dt; sACS[h * 64 + lane] = cs;
}
template <class F>
__device__ __forceinline__ void ssd_load_chunk(const Ctx& C, int seq, int c, int row0, F store) {
    const int lane = C.lane, w = C.wave;
    const bf16_t* base = WSB(WS_PA) + (size_t)(row0 + lane) * 1536 + 512;
    const float* cw = INL(12, 4 * 1024); const float* cbias = INL(13, 1024);
    for (int j = 0; j < 16; ++j) {
        const int ch0 = 128 * w + 8 * j;
        const u32x4 v0 = *(const u32x4*)(base + ch0);
        u32x4 ex = (u32x4){0u, 0u, 0u, 0u};
        if (lane < 3) {
            if (seq < 2) { if (c > 0) ex = *(const u32x4*)(base - (size_t)3 * 1536 + ch0); }
            else ex = load8(INL(3, BS * 3 * 1024) + ((size_t)(seq - 2) * 3 + lane) * 1024 + ch0, 0, true);
        }
        float x0[8], xk[3][8];
        unpack8(v0, x0);
#pragma unroll
        for (int k = 1; k <= 3; ++k) {
            u32x4 a, b;
            a.x = __shfl(v0.x, (lane - k) & 63); a.y = __shfl(v0.y, (lane - k) & 63); a.z = __shfl(v0.z, (lane - k) & 63); a.w = __shfl(v0.w, (lane - k) & 63);
            b.x = __shfl(ex.x, (lane - k + 3) & 63); b.y = __shfl(ex.y, (lane - k + 3) & 63); b.z = __shfl(ex.z, (lane - k + 3) & 63); b.w = __shfl(ex.w, (lane - k + 3) & 63);
            unpack8(lane >= k ? a : b, xk[k - 1]);
        }
        float y[8];
#pragma unroll
        for (int e = 0; e < 8; ++e) {
            const float a = cbias[ch0 + e] + cw[3 * 1024 + ch0 + e] * x0[e] + cw[2 * 1024 + ch0 + e] * xk[0][e] + cw[1 * 1024 + ch0 + e] * xk[1][e] + cw[ch0 + e] * xk[2][e];
            y[e] = siluf_(a);
        }
        store(ch0, y, x0);
    }
}

constexpr int XT_ST = 72;
__device__ __forceinline__ void ssd_s1_item(const Ctx& C, int item) {
    const int seq = item < 256 ? (item >> 7) : 2 + (item - 256), c = item < 256 ? (item & 127) : 0, row0 = ssd_row0(seq, c);
    const int lane = C.lane, h = C.wave, fr = lane & 15, fq = lane >> 4, l = C.l;
    LAS bf16_t* XT = (LAS bf16_t*)C.lds; LAS bf16_t* BT = (LAS bf16_t*)(C.lds + 73728);
    LAS float* sDT = (LAS float*)(C.lds + 110592); LAS float* sACS = (LAS float*)(C.lds + 112640);
    ssd_dt(C, row0, sDT, sACS);
    __syncthreads();
    const bool lastc = (seq >= 2) || (c == 127);
    float* convo = C.out + (seq < 2 ? O_CONV_P + (size_t)(l * BP + seq) * 3 * 1024 : O_CONV_S + (size_t)(l * BS + seq - 2) * 3 * 1024);
    ssd_load_chunk(C, seq, c, row0, [&](int ch0, const float* y, const float* raw) {
        if (ch0 < 512) { const int hh = ch0 >> 6, p0 = ch0 & 63; const float wgt = sDT[hh * 64 + lane] * fexp(sACS[hh * 64 + 63] - sACS[hh * 64 + lane]);
#pragma unroll
            for (int e = 0; e < 8; ++e) XT[(hh * 64 + p0 + e) * XT_ST + lane] = (bf16_t)f2bf(y[e] * wgt); }
        else if (ch0 < 768) { const int g = (ch0 - 512) >> 7, n0 = (ch0 - 512) & 127;
#pragma unroll
            for (int e = 0; e < 8; ++e) BT[(g * 128 + n0 + e) * XT_ST + lane] = (bf16_t)f2bf(y[e]); }
        if (lastc && lane >= 61) {
#pragma unroll
            for (int e = 0; e < 8; ++e) convo[(size_t)(lane - 61) * 1024 + ch0 + e] = raw[e]; }
    });
    __syncthreads();
    const int g = h >> 2;
    bf16x8 bx[4][2];
#pragma unroll
    for (int pt = 0; pt < 4; ++pt)
#pragma unroll
        for (int ks = 0; ks < 2; ++ks) bx[pt][ks] = *(const LAS bf16x8*)(XT + (h * 64 + 16 * pt + fr) * XT_ST + 32 * ks + 8 * fq);
    const float dall = fexp(sACS[h * 64 + 63]);
    for (int nt = 0; nt < 8; ++nt) {
        bf16x8 a[2];
#pragma unroll
        for (int ks = 0; ks < 2; ++ks) a[ks] = *(const LAS bf16x8*)(BT + (g * 128 + 16 * nt + fr) * XT_ST + 32 * ks + 8 * fq);
#pragma unroll
        for (int pt = 0; pt < 4; ++pt) {
            f32x4 acc = (f32x4){0.f, 0.f, 0.f, 0.f};
#pragma unroll
            for (int ks = 0; ks < 2; ++ks) acc = MFMA16(a[ks], bx[pt][ks], acc);
            const int p = 16 * pt + fr, n = 16 * nt + 4 * fq;
            if (seq < 2) { u32x2 w; w.x = pk2(acc[0], acc[1]); w.y = pk2(acc[2], acc[3]);
                *(u32x2*)(WSB(WS_STATES) + ((size_t)((seq * 128 + c) * 8 + h) * 64 + p) * 128 + n) = w; }
            else { const size_t o = ((size_t)((l * BS + seq - 2) * 8 + h) * 64 + p) * 128 + n;
                const f32x4 h0 = *(const f32x4*)(IN0(2) + o);
                *(f32x4*)(C.out + O_SSM_S + o) = h0 * dall + acc; }
        }
    }
    if (seq < 2 && lane == 0) ((float*)(C.ws + WS_DECAY))[(seq * 128 + c) * 8 + h] = dall;
    __syncthreads();
}
__device__ __forceinline__ void ssd_scan(const Ctx& C) {
    const size_t gt = (size_t)C.bid * NTHREADS + C.tid;
    if (gt >= (size_t)2 * 8 * 64 * 128) return;
    const int b = (int)(gt >> 16), h = (int)(gt >> 13) & 7, pn = (int)(gt & 8191);
    bf16_t* st = WSB(WS_STATES) + ((size_t)(b * 128) * 8 + h) * 8192 + pn;
    const float* dec = (const float*)(C.ws + WS_DECAY) + (b * 128) * 8 + h;
    float hst = 0.f;
#pragma unroll 1
    for (int c0 = 0; c0 < 128; c0 += 32) {
        bf16_t sv[32]; float dv[32];
#pragma unroll
        for (int i = 0; i < 32; ++i) { sv[i] = st[(size_t)(c0 + i) * 8 * 8192]; dv[i] = dec[(c0 + i) * 8]; }
#pragma unroll
        for (int i = 0; i < 32; ++i) { st[(size_t)(c0 + i) * 8 * 8192] = (bf16_t)f2bf(hst); hst = dv[i] * hst + bf1(sv[i]); }
    }
    C.out[O_SSM_P + ((size_t)(C.l * BP + b) * 8 + h) * 8192 + pn] = hst;
}
constexpr int CN_ST = 136;
__device__ __forceinline__ void ssd_s3_item(const Ctx& C, int item) {
    const int seq = item < 256 ? (item >> 7) : 2 + (item - 256), c = item < 256 ? (item & 127) : 0, row0 = ssd_row0(seq, c);
    const int lane = C.lane, h = C.wave, fr = lane & 15, fq = lane >> 4, l = C.l, g = h >> 2;
    LAS bf16_t* Cn = (LAS bf16_t*)C.lds; LAS bf16_t* Bn = (LAS bf16_t*)(C.lds + 34816); LAS bf16_t* XT = (LAS bf16_t*)(C.lds + 69632);
    LAS float* sDT = (LAS float*)(C.lds + 143360); LAS float* sACS = (LAS float*)(C.lds + 145408); LAS float* sRed = (LAS float*)(C.lds + 147456);
    ssd_dt(C, row0, sDT, sACS);
    ssd_load_chunk(C, seq, c, row0, [&](int ch0, const float* y, const float*) {
        if (ch0 < 512) { const int hh = ch0 >> 6, p0 = ch0 & 63;
#pragma unroll
            for (int e = 0; e < 8; ++e) XT[(hh * 64 + p0 + e) * XT_ST + lane] = (bf16_t)f2bf(y[e]); }
        else if (ch0 < 768) { const int gg = (ch0 - 512) >> 7, n0 = (ch0 - 512) & 127; *(LAS u32x4*)(Bn + (gg * 64 + lane) * CN_ST + n0) = pack8(y); }
        else { const int gg = (ch0 - 768) >> 7, n0 = (ch0 - 768) & 127; *(LAS u32x4*)(Cn + (gg * 64 + lane) * CN_ST + n0) = pack8(y); }
    });
    __syncthreads();
#define CF(lt, ks) (*(const LAS bf16x8*)(Cn + (g * 64 + 16 * (lt) + fr) * CN_ST + 32 * (ks) + 8 * fq))
    f32x4 yacc[4][4];
    const void* hin; bool hin_f32;
    if (seq < 2) { hin = WSB(WS_STATES) + (size_t)((seq * 128 + c) * 8 + h) * 8192; hin_f32 = false; }
    else { hin = IN0(2) + (size_t)((l * BS + seq - 2) * 8 + h) * 8192; hin_f32 = true; }
#pragma unroll
    for (int pt = 0; pt < 4; ++pt) {
#pragma unroll
        for (int lt = 0; lt < 4; ++lt) yacc[pt][lt] = (f32x4){0.f, 0.f, 0.f, 0.f};
        bf16x8 af[4];
        if (hin_f32) {
#pragma unroll
            for (int ks = 0; ks < 4; ++ks) af[ks] = as_frag(load8(hin, (size_t)(16 * pt + fr) * 128 + 32 * ks + 8 * fq, true));
        } else {
#pragma unroll
            for (int ks = 0; ks < 4; ++ks) af[ks] = as_frag(load8(hin, (size_t)(16 * pt + fr) * 128 + 32 * ks + 8 * fq, false));
        }
#pragma unroll
        for (int ks = 0; ks < 4; ++ks)
#pragma unroll
            for (int lt = 0; lt < 4; ++lt) yacc[pt][lt] = MFMA16(af[ks], CF(lt, ks), yacc[pt][lt]);
        __builtin_amdgcn_sched_barrier(0);
    }
    float acl[4];
#pragma unroll
    for (int lt = 0; lt < 4; ++lt) { acl[lt] = sACS[h * 64 + 16 * lt + fr]; const float el = fexp(acl[lt]);
#pragma unroll
        for (int pt = 0; pt < 4; ++pt) yacc[pt][lt] = yacc[pt][lt] * el; }
    const float Dh = INL(16, 8)[h];
#pragma unroll
    for (int lt = 0; lt < 4; ++lt) {
        bf16x8 pf[2], cfl[4];
#pragma unroll
        for (int ks = 0; ks < 4; ++ks) cfl[ks] = CF(lt, ks);
        unsigned pw[4][2];
#pragma unroll
        for (int st = 0; st < 4; ++st) {
            f32x4 cb = (f32x4){0.f, 0.f, 0.f, 0.f};
#pragma unroll
            for (int ks = 0; ks < 4; ++ks) { const bf16x8 a = *(const LAS bf16x8*)(Bn + (g * 64 + 16 * st + fr) * CN_ST + 32 * ks + 8 * fq); cb = MFMA16(a, cfl[ks], cb); }
            const f32x4 as4 = *(const LAS f32x4*)(sACS + h * 64 + 16 * st + 4 * fq), dt4 = *(const LAS f32x4*)(sDT + h * 64 + 16 * st + 4 * fq);
            float m[4];
#pragma unroll
            for (int i = 0; i < 4; ++i) { const int s = 16 * st + 4 * fq + i, ll = 16 * lt + fr;
                float v = (s <= ll) ? cb[i] * fexp(acl[lt] - as4[i]) * dt4[i] : 0.f; if (s == ll) v += Dh; m[i] = v; }
            pw[st][0] = pk2(m[0], m[1]); pw[st][1] = pk2(m[2], m[3]);
        }
        { u32x4 v; v.x = pw[0][0]; v.y = pw[0][1]; v.z = pw[1][0]; v.w = pw[1][1]; pf[0] = as_frag(v); v.x = pw[2][0]; v.y = pw[2][1]; v.z = pw[3][0]; v.w = pw[3][1]; pf[1] = as_frag(v); }
#pragma unroll
        for (int pt = 0; pt < 4; ++pt)
#pragma unroll
            for (int kk = 0; kk < 2; ++kk) { const LAS bf16_t* xp = XT + (h * 64 + 16 * pt + fr) * XT_ST + 32 * kk + 4 * fq;
                const bf16x8 a = mk_frag(*(const LAS u32x2*)xp, *(const LAS u32x2*)(xp + 16)); yacc[pt][lt] = MFMA16(a, pf[kk], yacc[pt][lt]); }
        asm volatile("" ::: "memory");
    }
    float ss[4] = {0.f, 0.f, 0.f, 0.f};
#pragma unroll
    for (int lt = 0; lt < 4; ++lt)
#pragma unroll
        for (int pt = 0; pt < 4; ++pt) { const u32x2 z = *(const u32x2*)(WSB(WS_PA) + (size_t)(row0 + 16 * lt + fr) * 1536 + h * 64 + 16 * pt + 4 * fq);
            f32x4 v = yacc[pt][lt]; v[0] *= siluf_(bflo(z.x)); v[1] *= siluf_(bfhi(z.x)); v[2] *= siluf_(bflo(z.y)); v[3] *= siluf_(bfhi(z.y));
            yacc[pt][lt] = v; ss[lt] += v[0] * v[0] + v[1] * v[1] + v[2] * v[2] + v[3] * v[3]; }
#pragma unroll
    for (int lt = 0; lt < 4; ++lt) { ss[lt] += __shfl_xor(ss[lt], 16); ss[lt] += __shfl_xor(ss[lt], 32); if (fq == 0) sRed[h * 64 + 16 * lt + fr] = ss[lt]; }
    __syncthreads();
    const float* ng = INL(17, 512);
#pragma unroll
    for (int lt = 0; lt < 4; ++lt) { float tot = 0.f;
#pragma unroll
        for (int hh = 0; hh < 8; ++hh) tot += sRed[hh * 64 + 16 * lt + fr];
        const float rstd = 1.f / sqrtf(tot * (1.f / 512.f) + EPS);
#pragma unroll
        for (int pt = 0; pt < 4; ++pt) { const f32x4 gg = *(const f32x4*)(ng + h * 64 + 16 * pt + 4 * fq); const f32x4 v = yacc[pt][lt];
            u32x2 w; w.x = pk2(v[0] * rstd * gg[0], v[1] * rstd * gg[1]); w.y = pk2(v[2] * rstd * gg[2], v[3] * rstd * gg[3]);
            *(u32x2*)(WSB(WS_PA) + (size_t)(row0 + 16 * lt + fr) * 1536 + h * 64 + 16 * pt + 4 * fq) = w; } }
    __syncthreads();
}

struct AH {
    const bf16_t* q; int qld; bf16_t* o; int old_;
    const void* kn; size_t knld; bool kn_f32; const bf16_t* kn2; size_t kn2ld; int split;
    const bf16_t* kp; size_t kpld;
    const void* v; size_t vld; bool v_f32; const bf16_t* v2; size_t v2ld;
    int count, cdiff0;
};
template <int DK, bool BIAS, bool SHARED>
__device__ __forceinline__ void attn_core(const Ctx& C, const AH& H, int n_iter) {
    constexpr int KST = DK + 8, VST = 72, KBYTES = 64 * KST * 2, VBYTES = 64 * VST * 2, HBY = KBYTES + VBYTES;
    const int lane = C.lane, hf = C.wave >> 2, wq = C.wave & 3, tid_h = C.tid & 255, fr = lane & 15, fq = lane >> 4;
    LAS float* tab = (LAS float*)(C.lds + 4 * HBY) + hf * 260;
    bf16x8 qf[DK / 32];
#pragma unroll
    for (int ks = 0; ks < DK / 32; ++ks) qf[ks] = *(const bf16x8*)(H.q + (size_t)(16 * wq + fr) * H.qld + 32 * ks + 8 * fq);
    f32x4 oacc[4];
#pragma unroll
    for (int d = 0; d < 4; ++d) oacc[d] = (f32x4){0.f, 0.f, 0.f, 0.f};
    float m_run = -1e30f, l_run = 0.f;
    u32x4 rk[2], rp = (u32x4){0u, 0u, 0u, 0u}, rv[2];
    const int NPI = SHARED ? 1 : 2, PSTR = SHARED ? 0 : 256, ptid = SHARED ? C.tid : tid_h, lcount = SHARED ? n_iter : H.count, hsl = SHARED ? 0 : hf;
#define ATT_GLOAD(t) do { if ((t) < lcount) { const bool sec = (t) >= H.split; const int tk = sec ? (t) - H.split : (t); \
        _Pragma("unroll") for (int i = 0; i < NPI; ++i) { const int p = ptid + PSTR * i; \
            { const int key = p >> 3, ch = p & 7; rk[i] = sec ? load8(H.kn2, (size_t)(tk * 64 + key) * H.kn2ld + 8 * ch, false) : load8(H.kn, (size_t)(tk * 64 + key) * H.knld + 8 * ch, H.kn_f32); } \
            { const int key = p & 63, dc = p >> 6; rv[i] = sec ? load8(H.v2, (size_t)(tk * 64 + key) * H.v2ld + 8 * dc, false) : load8(H.v, (size_t)(tk * 64 + key) * H.vld + 8 * dc, H.v_f32); } } \
        if (DK == 96 && (!SHARED || ptid < 256)) { const int key = (ptid & 255) >> 2, ch = ptid & 3; rp = *(const u32x4*)(H.kp + (size_t)((t) * 64 + key) * H.kpld + 8 * ch); } } } while (0)
#define ATT_SSTORE(t, buf) do { if ((t) < lcount) { LAS unsigned char* base = C.lds + ((buf) * 2 + hsl) * HBY; \
        _Pragma("unroll") for (int i = 0; i < NPI; ++i) { const int p = ptid + PSTR * i; \
            { const int key = p >> 3, ch = p & 7; *(LAS u32x4*)(base + (key * KST + 8 * ch) * 2) = rk[i]; } \
            { const int key = p & 63, dc = p >> 6; LAS bf16_t* vt = (LAS bf16_t*)(base + KBYTES) + (8 * dc) * VST + key; const u32x4 vv = rv[i]; \
              vt[0] = (bf16_t)(vv.x & 0xffffu); vt[VST] = (bf16_t)(vv.x >> 16); vt[2 * VST] = (bf16_t)(vv.y & 0xffffu); vt[3 * VST] = (bf16_t)(vv.y >> 16); \
              vt[4 * VST] = (bf16_t)(vv.z & 0xffffu); vt[5 * VST] = (bf16_t)(vv.z >> 16); vt[6 * VST] = (bf16_t)(vv.w & 0xffffu); vt[7 * VST] = (bf16_t)(vv.w >> 16); } } \
        if (DK == 96 && (!SHARED || ptid < 256)) { const int key = (ptid & 255) >> 2, ch = ptid & 3; *(LAS u32x4*)(base + (key * KST + 64 + 8 * ch) * 2) = rp; } } } while (0)
    ATT_GLOAD(0); ATT_SSTORE(0, 0);
    __syncthreads();
    for (int t = 0; t < n_iter; ++t) {
        ATT_GLOAD(t + 1);
        if (t < H.count) {
            const LAS unsigned char* base = C.lds + ((t & 1) * 2 + hsl) * HBY;
            f32x4 s[4];
#pragma unroll
            for (int mt = 0; mt < 4; ++mt) { s[mt] = (f32x4){0.f, 0.f, 0.f, 0.f};
#pragma unroll
                for (int ks = 0; ks < DK / 32; ++ks) { const bf16x8 a = *(const LAS bf16x8*)(base + ((16 * mt + fr) * KST + 32 * ks + 8 * fq) * 2); s[mt] = MFMA16(a, qf[ks], s[mt]); } }
            if (BIAS) { const int cd = H.cdiff0 - t, ql = 16 * wq + fr;
                if (cd >= 3) { const float bb = tab[256];
#pragma unroll
                    for (int mt = 0; mt < 4; ++mt) s[mt] = s[mt] + bb; }
                else {
#pragma unroll
                    for (int mt = 0; mt < 4; ++mt)
#pragma unroll
                        for (int i = 0; i < 4; ++i) { int rel = cd * 64 + ql - (16 * mt + 4 * fq + i); rel = rel > 128 ? 128 : rel; s[mt][i] += tab[rel + 128]; } } }
            float mx = s[0][0];
#pragma unroll
            for (int mt = 0; mt < 4; ++mt)
#pragma unroll
                for (int i = 0; i < 4; ++i) mx = fmaxf(mx, s[mt][i]);
            mx = fmaxf(mx, __shfl_xor(mx, 16)); mx = fmaxf(mx, __shfl_xor(mx, 32));
            const float mnew = fmaxf(m_run, mx), alpha = fexp2(m_run - mnew); m_run = mnew;
            float psum = 0.f;
#pragma unroll
            for (int mt = 0; mt < 4; ++mt)
#pragma unroll
                for (int i = 0; i < 4; ++i) { const float p = fexp2(s[mt][i] - mnew); s[mt][i] = p; psum += p; }
            l_run = l_run * alpha + psum;
#pragma unroll
            for (int d = 0; d < 4; ++d) oacc[d] = oacc[d] * alpha;
            bf16x8 pf[2];
#pragma unroll
            for (int kk = 0; kk < 2; ++kk) { u32x4 v; v.x = pk2(s[2 * kk][0], s[2 * kk][1]); v.y = pk2(s[2 * kk][2], s[2 * kk][3]); v.z = pk2(s[2 * kk + 1][0], s[2 * kk + 1][1]); v.w = pk2(s[2 * kk + 1][2], s[2 * kk + 1][3]); pf[kk] = as_frag(v); }
            const LAS bf16_t* vt = (const LAS bf16_t*)(base + KBYTES);
#pragma unroll
            for (int d = 0; d < 4; ++d)
#pragma unroll
                for (int kk = 0; kk < 2; ++kk) { const LAS bf16_t* vp = vt + (16 * d + fr) * VST + 32 * kk + 4 * fq;
                    const bf16x8 a = mk_frag(*(const LAS u32x2*)vp, *(const LAS u32x2*)(vp + 16)); oacc[d] = MFMA16(a, pf[kk], oacc[d]); }
        }
        ATT_SSTORE(t + 1, (t + 1) & 1);
        __syncthreads();
    }
#undef ATT_GLOAD
#undef ATT_SSTORE
    l_run += __shfl_xor(l_run, 16); l_run += __shfl_xor(l_run, 32);
    const float inv = 1.f / l_run;
#pragma unroll
    for (int d = 0; d < 4; ++d) { u32x2 w; w.x = pk2(oacc[d][0] * inv, oacc[d][1] * inv); w.y = pk2(oacc[d][2] * inv, oacc[d][3] * inv);
        *(u32x2*)(H.o + (size_t)(16 * wq + fr) * H.old_ + 16 * d + 4 * fq) = w; }
}

__device__ __forceinline__ void attn_core2(const Ctx& C, const AH& H, int n_iter) {
    constexpr int DK = 96, KST = DK + 8, VST = 72, KBYTES = 64 * KST * 2, VBYTES = 64 * VST * 2, HBY = KBYTES + VBYTES;
    const int lane = C.lane, fr = lane & 15, fq = lane >> 4, p = C.tid;
    bf16x8 qf[2][3];
#pragma unroll
    for (int sb = 0; sb < 2; ++sb)
#pragma unroll
        for (int ks = 0; ks < 3; ++ks) qf[sb][ks] = *(const bf16x8*)(H.q + (size_t)(16 * sb + fr) * H.qld + 32 * ks + 8 * fq);
    f32x4 oacc[2][4];
#pragma unroll
    for (int sb = 0; sb < 2; ++sb)
#pragma unroll
        for (int d = 0; d < 4; ++d) oacc[sb][d] = (f32x4){0.f, 0.f, 0.f, 0.f};
    float m_run[2] = {-1e30f, -1e30f}, l_run[2] = {0.f, 0.f};
    u32x4 rk[2], rp[2], rv[2];
    rp[0] = (u32x4){0u, 0u, 0u, 0u}; rp[1] = rp[0];
#define A2_GLOAD(t, R) do { if ((t) < n_iter) { \
        { const int key = p >> 3, ch = p & 7; rk[R] = *(const u32x4*)((const bf16_t*)H.kn + (size_t)((t) * 64 + key) * H.knld + 8 * ch); } \
        { const int key = p & 63, dc = p >> 6; rv[R] = *(const u32x4*)((const bf16_t*)H.v + (size_t)((t) * 64 + key) * H.vld + 8 * dc); } \
        if (p < 256) { const int key = p >> 2, ch = p & 3; rp[R] = *(const u32x4*)(H.kp + (size_t)((t) * 64 + key) * H.kpld + 8 * ch); } } } while (0)
#define A2_SSTORE(t, buf, R) do { if ((t) < n_iter) { LAS unsigned char* base = C.lds + (buf) * HBY; \
        { const int key = p >> 3, ch = p & 7; *(LAS u32x4*)(base + (key * KST + 8 * ch) * 2) = rk[R]; } \
        { const int key = p & 63, dc = p >> 6; LAS bf16_t* vt = (LAS bf16_t*)(base + KBYTES) + (8 * dc) * VST + key; const u32x4 vv = rv[R]; \
          vt[0] = (bf16_t)(vv.x & 0xffffu); vt[VST] = (bf16_t)(vv.x >> 16); vt[2 * VST] = (bf16_t)(vv.y & 0xffffu); vt[3 * VST] = (bf16_t)(vv.y >> 16); \
          vt[4 * VST] = (bf16_t)(vv.z & 0xffffu); vt[5 * VST] = (bf16_t)(vv.z >> 16); vt[6 * VST] = (bf16_t)(vv.w & 0xffffu); vt[7 * VST] = (bf16_t)(vv.w >> 16); } \
        if (p < 256) { const int key = p >> 2, ch = p & 3; *(LAS u32x4*)(base + (key * KST + 64 + 8 * ch) * 2) = rp[R]; } } } while (0)
#define A2_COMPUTE(t, BUF) do { if ((t) < H.count) { \
            const LAS unsigned char* base = C.lds + (BUF) * HBY; \
            f32x4 s[2][4]; \
            _Pragma("unroll") for (int mt = 0; mt < 4; ++mt) { s[0][mt] = (f32x4){0.f, 0.f, 0.f, 0.f}; s[1][mt] = (f32x4){0.f, 0.f, 0.f, 0.f}; \
                _Pragma("unroll") for (int ks = 0; ks < 3; ++ks) { const bf16x8 a = *(const LAS bf16x8*)(base + ((16 * mt + fr) * KST + 32 * ks + 8 * fq) * 2); \
                    s[0][mt] = MFMA16(a, qf[0][ks], s[0][mt]); s[1][mt] = MFMA16(a, qf[1][ks], s[1][mt]); } } \
            bf16x8 pf[2][2]; \
            _Pragma("unroll") for (int sb = 0; sb < 2; ++sb) { \
                float mx = s[sb][0][0]; \
                _Pragma("unroll") for (int mt = 0; mt < 4; ++mt) _Pragma("unroll") for (int i = 0; i < 4; ++i) mx = fmaxf(mx, s[sb][mt][i]); \
                mx = fmaxf(mx, __shfl_xor(mx, 16)); mx = fmaxf(mx, __shfl_xor(mx, 32)); \
                const float mnew = fmaxf(m_run[sb], mx), alpha = fexp2(m_run[sb] - mnew); m_run[sb] = mnew; \
                float psum = 0.f; \
                _Pragma("unroll") for (int mt = 0; mt < 4; ++mt) _Pragma("unroll") for (int i = 0; i < 4; ++i) { const float pp = fexp2(s[sb][mt][i] - mnew); s[sb][mt][i] = pp; psum += pp; } \
                l_run[sb] = l_run[sb] * alpha + psum; \
                _Pragma("unroll") for (int d = 0; d < 4; ++d) oacc[sb][d] = oacc[sb][d] * alpha; \
                _Pragma("unroll") for (int kk = 0; kk < 2; ++kk) { u32x4 v; v.x = pk2(s[sb][2 * kk][0], s[sb][2 * kk][1]); v.y = pk2(s[sb][2 * kk][2], s[sb][2 * kk][3]); v.z = pk2(s[sb][2 * kk + 1][0], s[sb][2 * kk + 1][1]); v.w = pk2(s[sb][2 * kk + 1][2], s[sb][2 * kk + 1][3]); pf[sb][kk] = as_frag(v); } \
            } \
            const LAS bf16_t* vt = (const LAS bf16_t*)(base + KBYTES); \
            _Pragma("unroll") for (int d = 0; d < 4; ++d) _Pragma("unroll") for (int kk = 0; kk < 2; ++kk) { const LAS bf16_t* vp = vt + (16 * d + fr) * VST + 32 * kk + 4 * fq; \
                    const bf16x8 a = mk_frag(*(const LAS u32x2*)vp, *(const LAS u32x2*)(vp + 16)); \
                    oacc[0][d] = MFMA16(a, pf[0][kk], oacc[0][d]); oacc[1][d] = MFMA16(a, pf[1][kk], oacc[1][d]); } \
        } } while (0)
    A2_GLOAD(0, 0); A2_SSTORE(0, 0, 0); A2_GLOAD(1, 1);
    __syncthreads();
    for (int t = 0; t < n_iter; t += 2) {
        A2_GLOAD(t + 2, 0); A2_COMPUTE(t, 0); A2_SSTORE(t + 1, 1, 1); __syncthreads();
        A2_GLOAD(t + 3, 1); A2_COMPUTE(t + 1, 1); A2_SSTORE(t + 2, 0, 0); __syncthreads();
    }
#undef A2_COMPUTE
#undef A2_GLOAD
#undef A2_SSTORE
#pragma unroll
    for (int sb = 0; sb < 2; ++sb) { float l = l_run[sb]; l += __shfl_xor(l, 16); l += __shfl_xor(l, 32);
        const float inv = 1.f / l;
#pragma unroll
        for (int d = 0; d < 4; ++d) { u32x2 w; w.x = pk2(oacc[sb][d][0] * inv, oacc[sb][d][1] * inv); w.y = pk2(oacc[sb][d][2] * inv, oacc[sb][d][3] * inv);
            *(u32x2*)(H.o + (size_t)(16 * sb + fr) * H.old_ + 16 * d + 4 * fq) = w; } }
}

constexpr int N_MLAP = 512, N_S3 = 288, N_MLAS = 128, N_BANDP = 1024, N_BANDS = 128, N_P5 = N_MLAP + N_S3 + N_MLAS + N_BANDP + N_BANDS;
#ifndef P5SEL
#define P5SEL 7
#endif
__device__ __forceinline__ void p5_unit(const Ctx& C, int idx) {
    const int hf = C.wave >> 2, l = C.l;
    AH H; H.split = 1 << 30; H.kn2 = nullptr; H.kn2ld = 0; H.v2 = nullptr; H.v2ld = 0; H.kn_f32 = false; H.v_f32 = false; H.kp = nullptr; H.kpld = 0; H.cdiff0 = 0;
    if (idx < N_MLAP) {
        const int q4 = 31 - (idx >> 4), b = (idx >> 3) & 1, h = idx & 7, c = 4 * q4 + (C.wave >> 1); const size_t row0 = (size_t)b * TP + c * 64 + 32 * (C.wave & 1);
        H.q = WSB(WS_Q) + row0 * 768 + h * 96; H.qld = 768; H.o = WSB(WS_YBC) + row0 * 1024 + h * 64; H.old_ = 1024;
        H.kn = WSB(WS_KVP) + (size_t)b * TP * 1024 + h * 64; H.knld = 1024; H.kp = WSB(WS_KPEP) + (size_t)b * TP * 32; H.kpld = 32;
        H.v = WSB(WS_KVP) + (size_t)b * TP * 1024 + 512 + h * 64; H.vld = 1024; H.count = c + 1;
        if (P5SEL & 1) attn_core2(C, H, 4 * q4 + 4); return;
    }
    idx -= N_MLAP;
    if (idx < N_S3) { if (P5SEL & 2) ssd_s3_item(C, idx); return; }
    idx -= N_S3;
    if (idx < N_MLAS) {
        const int b = idx >> 2, h = (idx & 3) * 2 + hf; const size_t row0 = (size_t)NP + b * 64;
        H.q = WSB(WS_Q) + row0 * 768 + h * 96; H.qld = 768; H.o = WSB(WS_YBC) + row0 * 1024 + h * 64; H.old_ = 1024;
        H.kn = WSB(WS_XR) + (size_t)b * KS_ALL * 1024 + h * 64; H.knld = 1024; H.kp = WSB(WS_KPES) + (size_t)b * KS_ALL * 32; H.kpld = 32;
        H.v = WSB(WS_XR) + (size_t)b * KS_ALL * 1024 + 512 + h * 64; H.vld = 1024; H.count = 33;
        if (P5SEL & 1) attn_core<96, false, false>(C, H, 33); return;
    }
    idx -= N_MLAS;
    constexpr int HBY64 = 64 * 72 * 2 * 2;
    if (idx < N_BANDP) {
        const int cp = idx >> 4, b = (idx >> 3) & 1, h = idx & 7, c = 2 * cp + hf, kt0 = c > 8 ? c - 8 : 0; const size_t row0 = (size_t)b * TP + c * 64;
        LAS float* tab = (LAS float*)(C.lds + 4 * HBY64) + hf * 260; const float* rb = INL(32, 8 * 257) + h * 257;
        for (int i = C.tid & 255; i < 257; i += 256) tab[i] = rb[i] * LOG2E;
        H.q = WSB(WS_PD) + row0 * 1536 + h * 64; H.qld = 1536; H.o = WSB(WS_PD) + row0 * 1536 + h * 64; H.old_ = 1536;
        H.kn = WSB(WS_PD) + ((size_t)b * TP + kt0 * 64) * 1536 + 512 + h * 64; H.knld = 1536;
        H.v = WSB(WS_PD) + ((size_t)b * TP + kt0 * 64) * 1536 + 1024 + h * 64; H.vld = 1536; H.count = c - kt0 + 1; H.cdiff0 = c - kt0;
        const int c1 = 2 * cp + 1;
        if (P5SEL & 4) attn_core<64, true, false>(C, H, (c1 > 8 ? 8 : c1) + 1); return;
    }
    idx -= N_BANDP;
    {
        const int b = idx >> 2, h = (idx & 3) * 2 + hf; const size_t row0 = (size_t)NP + b * 64;
        LAS float* tab = (LAS float*)(C.lds + 4 * HBY64) + hf * 260; const float* rb = INL(32, 8 * 257) + h * 257;
        for (int i = C.tid & 255; i < 257; i += 256) tab[i] = rb[i] * LOG2E;
        H.q = WSB(WS_PD) + row0 * 1536 + h * 64; H.qld = 1536; H.o = WSB(WS_PD) + row0 * 1536 + h * 64; H.old_ = 1536;
        H.kn = INL(7, (size_t)BS * 512 * 512) + (size_t)b * 512 * 512 + h * 64; H.knld = 512; H.kn_f32 = true;
        H.v = INL(8, (size_t)BS * 512 * 512) + (size_t)b * 512 * 512 + h * 64; H.vld = 512; H.v_f32 = true;
        H.split = 8; H.kn2 = WSB(WS_PD) + row0 * 1536 + 512 + h * 64; H.kn2ld = 1536; H.v2 = WSB(WS_PD) + row0 * 1536 + 1024 + h * 64; H.v2ld = 1536;
        H.count = 9; H.cdiff0 = 8;
        if (P5SEL & 4) attn_core<64, true, false>(C, H, 9);
    }
}

__global__ void __launch_bounds__(NTHREADS) mk_fwd(Args args) {
    extern __shared__ __attribute__((aligned(16))) unsigned char lds_raw[];
    cg::grid_group grid = cg::this_grid();
    Ctx C;
    C.A = &args;
    C.out = args.out; C.ws = args.ws; C.lds = (LAS unsigned char*)lds_raw;
    C.tid = threadIdx.x; C.lane = C.tid & 63; C.wave = __builtin_amdgcn_readfirstlane(C.tid >> 6);
    C.G = gridDim.x; C.bid = blockIdx.x; C.gw = C.bid * NWAVES + C.wave; C.NGW = C.G * NWAVES;
    unsigned* ctl = (unsigned*)(C.ws + WS_CTL);
    LAS int* sIdx = (LAS int*)(C.lds + LDS_BYTES - 16);
#ifndef PMASK
#define PMASK 0xFFF
#endif
#define REFRESH() do { int t_ = threadIdx.x; asm volatile("" : "+v"(t_)); C.tid = t_; C.lane = t_ & 63; C.wave = __builtin_amdgcn_readfirstlane(t_ >> 6); C.gw = C.bid * NWAVES + C.wave; GAS unsigned char* w_ = (GAS unsigned char*)args.ws; asm volatile("" : "+s"(w_)); C.ws = (unsigned char*)w_; GAS float* o_ = (GAS float*)args.out; asm volatile("" : "+s"(o_)); C.out = (float*)o_; } while (0)
#define PH_BEGIN(n) if ((PMASK >> (n)) & 1) { REFRESH();
#define PH_END } grid.sync();
#pragma unroll 1
    for (int l = 0; l < 2; ++l) {
        C.l = l;
        PH_BEGIN(0)
            if (C.bid == 0 && C.tid == 0) { ctl[l] = 0u; ctl[2 + l] = 0u; }
            { const size_t gt = (size_t)C.bid * NTHREADS + C.tid, GT = (size_t)C.G * NTHREADS; for (size_t i = gt; i < (size_t)R; i += GT) ((float*)(C.ws + WS_SUMSQ))[i] = 0.f; }
            phase_wprep(C);
            phase_norm(C, INL(9, 1024), l > 0);
        PH_END
        PH_BEGIN(1)
            SchedInproj S{WSB(WS_HB), WSB(WS_WT_IN), WSB(WS_PA), WSB(WS_ZB), WSB(WS_XR), WSB(WS_PD), C.G, C.bid};
            pg8::EpiStore E; pg8::gemm_phase(C.lds, S, E, C.tid);
        PH_END
        PH_BEGIN(2)
            phase_mla_prep(C); phase_band_prep(C); phase_sconv(C);
            for (int it = C.G - 1 - C.bid; it < N_S3; it += C.G) { REFRESH(); ssd_s1_item(C, it); }
        PH_END
        PH_BEGIN(3)
            ssd_scan(C);
            SchedP3 S{WSB(WS_ZB), WSB(WS_WT_QUP), WSB(WS_CKVP), WSB(WS_CKVS), WSB(WS_WT_KVUP), WSB(WS_Q), WSB(WS_KVP), WSB(WS_XR), C.G, C.bid};
            pg8::EpiStore E; pg8::gemm_phase(C.lds, S, E, C.tid);
        PH_END
        PH_BEGIN(4)
            phase_qk_post(C);
        PH_END
        PH_BEGIN(5)
            for (;;) {
                if (C.tid == 0) *sIdx = (int)atomicAdd(&ctl[l], 1u);
                __syncthreads();
                const int idx = *sIdx;
                __syncthreads();
                if (idx >= N_P5) break;
                REFRESH();
                p5_unit(C, idx);
            }
        PH_END
        PH_BEGIN(7)
            SchedMerge S{WSB(WS_HB), WSB(WS_WT_G), WSB(WS_WT_OUT), WSB(WS_PA), WSB(WS_YBC), WSB(WS_PD), C.G, C.bid};
            pg8::EpiMerge E{INL(11, 4096), WSB(WS_ZB), WSB(WS_XR)}; pg8::gemm_phase(C.lds, S, E, C.tid);
        PH_END
        PH_BEGIN(8)
            SchedOne S{WSB(WS_ZB), WSB(WS_WT_O), nullptr, 1024, 1024, 0, 72, 4, 16, C.G, C.bid};
            pg8::EpiResidNorm E{l > 0 ? C.out : IN0(0), l > 0 ? C.out + (size_t)NP * DM : IN0(1), C.out, WSB(WS_HB), INL(35, 1024), (float*)(C.ws + WS_SUMSQ)}; pg8::gemm_phase(C.lds, S, E, C.tid);
        PH_END
        PH_BEGIN(10)
            SchedOne S{WSB(WS_HB), WSB(WS_WT_UP), nullptr, 1024, 1024, 0, 72, 22, 16, C.G, C.bid};
            pg8::EpiSwigluNorm E{WSB(WS_XR), (const float*)(C.ws + WS_SUMSQ)}; pg8::gemm_phase(C.lds, S, E, C.tid);
        PH_END
        PH_BEGIN(11)
            SchedOne S{WSB(WS_XR), WSB(WS_WT_DOWN), nullptr, 2816, 2816, 0, 72, 4, 44, C.G, C.bid};
            pg8::EpiResid E{C.out, C.out + (size_t)NP * DM, C.out}; pg8::gemm_phase(C.lds, S, E, C.tid);
        PH_END
    }
}

extern "C" void kernel_launch(void* const* d_in, const int* in_sizes, int n_in, void* d_out, int out_size, void* d_ws, size_t ws_size, hipStream_t stream) {
    static int grid = 0;
    if (grid == 0) {
        int dev = 0, cus = 0, per_cu = 0;
        (void)hipGetDevice(&dev);
        (void)hipDeviceGetAttribute(&cus, hipDeviceAttributeMultiprocessorCount, dev);
        (void)hipFuncSetAttribute((const void*)mk_fwd, hipFuncAttributeMaxDynamicSharedMemorySize, LDS_BYTES);
        (void)hipOccupancyMaxActiveBlocksPerMultiprocessor(&per_cu, (const void*)mk_fwd, NTHREADS, LDS_BYTES);
        if (per_cu < 1) per_cu = 1;
        grid = cus * per_cu;
        if (ws_size < WS_END || n_in != 38 || (size_t)out_size != O_END) { fprintf(stderr, "kernel_launch: bad sizes ws %zu n_in %d out %d\n", ws_size, n_in, out_size); grid = -1; }
    }
    if (grid < 0) return;
    Args a{};
    for (int i = 0; i < 38; ++i) a.in[i] = (const float*)d_in[i];
    a.out = (float*)d_out; a.ws = (unsigned char*)d_ws; a.ph_lo = 0; a.ph_hi = 1000;
    void* kargs[] = {&a};
    hipError_t e = hipLaunchCooperativeKernel((const void*)mk_fwd, dim3(grid), dim3(NTHREADS), kargs, LDS_BYTES, stream);
    if (e != hipSuccess) fprintf(stderr, "cooperative launch failed: %s (grid %d)\n", hipGetErrorString(e), grid);
}
```

```cpp
#include <hip/hip_runtime.h>
#include <hip/hip_cooperative_groups.h>
#include <cstdio>
#include <cstdint>
namespace cg = cooperative_groups;

#define LAS __attribute__((address_space(3)))
#define GAS __attribute__((address_space(1)))
typedef unsigned short bf16_t;
typedef short bf16x8 __attribute__((ext_vector_type(8)));
typedef float f32x4 __attribute__((ext_vector_type(4)));
typedef unsigned u32x4 __attribute__((ext_vector_type(4)));
typedef unsigned u32x2 __attribute__((ext_vector_type(2)));

constexpr int NTHREADS = 512, NWAVES = 8;
constexpr int LDS_BYTES = 155648;
constexpr int NP = 16384, NS = 2048, R = NP + NS;
constexpr int TP = 8192, TS = 64, BP = 2, BS = 32, PAST = 2048, KS_ALL = PAST + TS;
constexpr int DM = 1024, FF = 2816;
constexpr int IN_COLS = 9384;
constexpr float EPS = 1e-6f;
constexpr float LOG2E = 1.4426950408889634f;

constexpr size_t O_Y = 0;
constexpr size_t O_SSM_P = (size_t)R * DM;
constexpr size_t O_SSM_S = O_SSM_P + 262144;
constexpr size_t O_CONV_P = O_SSM_S + 4194304;
constexpr size_t O_CONV_S = O_CONV_P + 12288;
constexpr size_t O_CKV_P = O_CONV_S + 196608;
constexpr size_t O_CKV_S = O_CKV_P + 8388608;
constexpr size_t O_KPE_P = O_CKV_S + 1048576;
constexpr size_t O_KPE_S = O_KPE_P + 1048576;
constexpr size_t O_SC_P = O_KPE_S + 131072;
constexpr size_t O_SC_S = O_SC_P + 4096;
constexpr size_t O_BK_P = O_SC_S + 65536;
constexpr size_t O_BK_S = O_BK_P + 1048576;
constexpr size_t O_BV_P = O_BK_S + 16777216;
constexpr size_t O_BV_S = O_BV_P + 1048576;
constexpr size_t O_END = O_BV_S + 16777216;

constexpr size_t al256(size_t x) { return (x + 255) & ~(size_t)255; }
constexpr size_t WS_CTL = 0;
constexpr size_t WS_DECAY = 4096;
constexpr size_t WS_SUMSQ = 16384;
constexpr size_t WS_WT_IN = 131072;
constexpr size_t WS_WT_G = WS_WT_IN + (size_t)5376 * 1024 * 2;
constexpr size_t WS_WT_QUP = WS_WT_G + (size_t)4096 * 1024 * 2;
constexpr size_t WS_WT_KVUP = WS_WT_QUP + (size_t)768 * 384 * 2;
constexpr size_t WS_WT_OUT = WS_WT_KVUP + (size_t)1024 * 256 * 2;
constexpr size_t WS_WT_O = WS_WT_OUT + (size_t)4 * 1024 * 1024 * 2;
constexpr size_t WS_WT_UP = WS_WT_O + (size_t)1024 * 1024 * 2;
constexpr size_t WS_WT_DOWN = WS_WT_UP + (size_t)5632 * 1024 * 2;
constexpr size_t WS_HB = al256(WS_WT_DOWN + (size_t)1024 * 2816 * 2);
constexpr size_t WS_PA = WS_HB + (size_t)R * 1024 * 2;
constexpr size_t WS_PD = WS_PA + (size_t)R * 1536 * 2;
constexpr size_t WS_ZB = WS_PD + (size_t)R * 1536 * 2;
constexpr size_t WS_CKVP = WS_ZB + (size_t)R * 768 * 2;
constexpr size_t WS_XR = WS_ZB + (size_t)R * 1024 * 2;
constexpr size_t WS_Q = WS_XR + (size_t)67584 * 1024 * 2;
constexpr size_t WS_KPEP = WS_Q + (size_t)R * 768 * 2;
constexpr size_t WS_KPES = WS_KPEP + (size_t)16384 * 32 * 2;
constexpr size_t WS_KVP = WS_KPES + (size_t)67584 * 32 * 2;
constexpr size_t WS_STATES = WS_KVP + (size_t)16384 * 1024 * 2;
constexpr size_t WS_YBC = WS_STATES + (size_t)2048 * 64 * 128 * 2;
constexpr size_t WS_CKVS = WS_YBC + (size_t)R * 1024 * 2;
constexpr size_t WS_END = WS_CKVS + (size_t)67584 * 256 * 2;
static_assert(WS_END < (size_t)553000000, "ws map too large");
static_assert((size_t)R * 768 * 2 + (size_t)16384 * 256 * 2 <= (size_t)R * 1024 * 2, "ZB");
static_assert((size_t)67584 * 256 * 2 <= (size_t)R * 1024 * 2, "ckvS in HB");

typedef float f32x2_g __attribute__((ext_vector_type(2)));
typedef __bf16 bf16x2_g __attribute__((ext_vector_type(2)));
__device__ __forceinline__ unsigned pk2(float lo, float hi) { f32x2_g v = {lo, hi}; bf16x2_g b = __builtin_convertvector(v, bf16x2_g); return __builtin_bit_cast(unsigned, b); }
__device__ __forceinline__ unsigned f2bf(float f) { return pk2(f, 0.f) & 0xffffu; }
__device__ __forceinline__ float bflo(unsigned u) { return __builtin_bit_cast(float, u << 16); }
__device__ __forceinline__ float bfhi(unsigned u) { return __builtin_bit_cast(float, u & 0xffff0000u); }
__device__ __forceinline__ float bf1(bf16_t h) { return __builtin_bit_cast(float, (unsigned)h << 16); }
__device__ __forceinline__ float fexp2(float x) { return __builtin_amdgcn_exp2f(x); }
__device__ __forceinline__ float fexp(float x) { return __builtin_amdgcn_exp2f(x * LOG2E); }
__device__ __forceinline__ float frcp(float x) { return __builtin_amdgcn_rcpf(x); }
__device__ __forceinline__ float sigmoidf_(float x) { return frcp(1.f + fexp(-x)); }
__device__ __forceinline__ float siluf_(float x) { return x * sigmoidf_(x); }
__device__ __forceinline__ float wave_sum(float v) {
#pragma unroll
    for (int o = 1; o < 64; o <<= 1) v += __shfl_xor(v, o);
    return v;
}
#define LDS_WAIT() asm volatile("s_waitcnt lgkmcnt(0)" ::: "memory")
__device__ __forceinline__ void unpack8(u32x4 v, float* f) {
    f[0] = bflo(v.x); f[1] = bfhi(v.x); f[2] = bflo(v.y); f[3] = bfhi(v.y); f[4] = bflo(v.z); f[5] = bfhi(v.z); f[6] = bflo(v.w); f[7] = bfhi(v.w);
}
__device__ __forceinline__ u32x4 pack8(const float* f) { u32x4 o; o.x = pk2(f[0], f[1]); o.y = pk2(f[2], f[3]); o.z = pk2(f[4], f[5]); o.w = pk2(f[6], f[7]); return o; }
__device__ __forceinline__ u32x4 load8(const void* base, size_t idx, bool is_f32) {
    if (is_f32) { const f32x4* p = (const f32x4*)((const float*)base + idx); f32x4 a = p[0], b = p[1];
        u32x4 o; o.x = pk2(a.x, a.y); o.y = pk2(a.z, a.w); o.z = pk2(b.x, b.y); o.w = pk2(b.z, b.w); return o; }
    return *(const u32x4*)((const bf16_t*)base + idx);
}

namespace pg8 {
constexpr int BM = 256, BK = 64, HALF = 128, HTB = HALF * BK * 2, STAGE_BYTES = 8 * HTB, NXCD = 8, WGM = 8;
__device__ __forceinline__ int lds_byte(int r, int c) { const int st = (r >> 4) * 2 + (c >> 5), rr = r & 15, cc = c & 31, ob = rr * 64 + cc * 2; return st * 1024 + (ob ^ (((ob >> 9) & 1) << 5)); }
__device__ __forceinline__ void stage_rc(int b, int& Rr, int& C) { const int st = b / 1024, sb = b % 1024, swz = sb ^ (((sb >> 9) & 1) << 5); Rr = (st >> 1) * 16 + swz / 64; C = (st & 1) * 32 + (swz % 64) / 2; }
__device__ __forceinline__ int perm32(int rho) { const int n = rho >> 4, i = rho & 15; return 8 * (i >> 2) + 4 * n + (i & 3); }

struct GUnit { const bf16_t* A; const bf16_t* B; int lda, ldb, nt; int pm, pn, sub; bf16_t* C; int ldc; };

__device__ __forceinline__ void tile_map(int L, int nM, int nN, int& pm, int& pn) {
    const int nwg = nM * nN; int wgid = L;
    { const int q = nwg / NXCD, r = nwg % NXCD, xcd = wgid % NXCD, off = wgid / NXCD; wgid = (xcd < r ? xcd * (q + 1) : r * (q + 1) + (xcd - r) * q) + off; }
    const int nig = WGM * nN, gid = wgid / nig, fm = gid * WGM, gsz = (nM - fm) < WGM ? (nM - fm) : WGM;
    pm = fm + ((wgid % nig) % gsz); pn = (wgid % nig) / gsz;
}
typedef float f32x2_t __attribute__((ext_vector_type(2)));
typedef __bf16 bf16x2_t __attribute__((ext_vector_type(2)));
__device__ __forceinline__ unsigned cvt_pk_bf16(float lo, float hi) { f32x2_t v = {lo, hi}; bf16x2_t b = __builtin_convertvector(v, bf16x2_t); return __builtin_bit_cast(unsigned, b); }

template <class Epi, class Sched>
__device__ __forceinline__ void gemm_phase(LAS unsigned char* lds, const Sched& S, Epi& E, int tid) {
    const int wid = __builtin_amdgcn_readfirstlane(tid >> 6), lane = tid & 63, wr = wid >> 2, wc = wid & 3, fr = lane & 15, fq = lane >> 4;
    int RA[2], RB[2], CC[2];
#pragma unroll
    for (int i = 0; i < 2; ++i) { int Rr, C; stage_rc(tid * 16 + i * 8192, Rr, C); RA[i] = Rr; RB[i] = (Rr & ~31) + perm32(Rr & 31); CC[i] = C; }
    const size_t kstep = (size_t)(BK * 2);
    const unsigned ldsw = (unsigned)wid * 1024u;
    const int aoff = lds_byte(wr * 64 + fr, fq * 8), boff = lds_byte(wc * 32 + fr, fq * 8);
#define PG8_SA(b, h) (((b) * 2 + (h)) * HTB)
#define PG8_SB(b, h) ((4 + (b) * 2 + (h)) * HTB)
#define PG8_STAGE(bufoff, gbase, v0, v1) do { \
        __builtin_amdgcn_global_load_lds((const unsigned*)((const char*)(gbase) + (v0)), (LAS unsigned*)(lds + (bufoff) + ldsw), 16, 0, 0); \
        __builtin_amdgcn_global_load_lds((const unsigned*)((const char*)(gbase) + (v1)), (LAS unsigned*)(lds + (bufoff) + ldsw + 8192), 16, 0, 0); } while (0)
#define PG8_LDA(dst, b, h) do { _Pragma("unroll") for (int m = 0; m < 4; ++m) _Pragma("unroll") for (int k = 0; k < 2; ++k) dst[m][k] = *(const LAS bf16x8*)(lds + PG8_SA(b, h) + aoff + m * 2048 + k * 1024); } while (0)
#define PG8_LDB(dst, b, h) do { _Pragma("unroll") for (int n = 0; n < 2; ++n) _Pragma("unroll") for (int k = 0; k < 2; ++k) dst[n][k] = *(const LAS bf16x8*)(lds + PG8_SB(b, h) + boff + n * 2048 + k * 1024); } while (0)
#define PG8_MMA(ai, bj, At, Bt) do { __builtin_amdgcn_s_setprio(1); _Pragma("unroll") for (int m = 0; m < 4; ++m) _Pragma("unroll") for (int n = 0; n < 2; ++n) _Pragma("unroll") for (int k = 0; k < 2; ++k) \
        acc[ai][bj][m][n] = __builtin_amdgcn_mfma_f32_16x16x32_bf16(Bt[n][k], At[m][k], acc[ai][bj][m][n], 0, 0, 0); __builtin_amdgcn_s_setprio(0); } while (0)
#define PG8_WAIT_V(n) asm volatile("s_waitcnt vmcnt(" #n ")" ::: "memory")
#define PG8_WAIT_L(n) asm volatile("s_waitcnt lgkmcnt(" #n ")" ::: "memory")
#define PG8_BAR __builtin_amdgcn_s_barrier()
#define PG8_SCHED __builtin_amdgcn_sched_barrier(0)
    GUnit cur, nxt; int ui = 0;
    if (!S.next(0, cur)) return;
    f32x4 acc[2][2][4][2];
#pragma unroll
    for (int a = 0; a < 2; ++a)
#pragma unroll
        for (int b = 0; b < 2; ++b)
#pragma unroll
            for (int m = 0; m < 4; ++m)
#pragma unroll
                for (int n = 0; n < 2; ++n) acc[a][b][m][n] = (f32x4){0.f, 0.f, 0.f, 0.f};
    bf16x8 At[4][2], B0[2][2], B1[2][2];
    const char* cA = (const char*)cur.A; const char* cB = (const char*)cur.B;
    int clda = cur.lda, cldb = cur.ldb;
#define VA0(ld) ((unsigned)(RA[0] * (ld) + CC[0]) * 2u)
#define VA1(ld) ((unsigned)(RA[1] * (ld) + CC[1]) * 2u)
#define VB0(ld) ((unsigned)(RB[0] * (ld) + CC[0]) * 2u)
#define VB1(ld) ((unsigned)(RB[1] * (ld) + CC[1]) * 2u)
    unsigned vAc0 = VA0(clda), vAc1 = VA1(clda), vBc0 = VB0(cldb), vBc1 = VB1(cldb);
    size_t hsAc = (size_t)HALF * clda * 2, hsBc = (size_t)HALF * cldb * 2;
    PG8_STAGE(PG8_SB(0, 0), cB, vBc0, vBc1); PG8_STAGE(PG8_SB(0, 1), cB + hsBc, vBc0, vBc1); PG8_STAGE(PG8_SA(0, 0), cA, vAc0, vAc1); PG8_STAGE(PG8_SA(0, 1), cA + hsAc, vAc0, vAc1);
    if (wr == 1) PG8_BAR;
    PG8_WAIT_V(2); PG8_BAR;
    PG8_STAGE(PG8_SB(1, 0), cB + kstep, vBc0, vBc1); PG8_STAGE(PG8_SA(1, 0), cA + kstep, vAc0, vAc1); PG8_STAGE(PG8_SB(1, 1), cB + hsBc + kstep, vBc0, vBc1);
    PG8_WAIT_V(6); PG8_BAR;
    for (;;) {
        const bool has_next = S.next(ui + 1, nxt);
        const char* nA = has_next ? (const char*)nxt.A : cA; const char* nB = has_next ? (const char*)nxt.B : cB;
        const int nlda = has_next ? nxt.lda : cur.lda, nldb = has_next ? nxt.ldb : cur.ldb;
        const size_t hsAn = (size_t)HALF * nlda * 2, hsBn = (size_t)HALF * nldb * 2;
        const int nt = cur.nt;
        for (int t = 0; t < nt; t += 2) {
            const bool last = (t == nt - 2);
            const char* a1 = cA + (size_t)(t + 1) * kstep;
            const char* a2 = last ? nA : cA + (size_t)(t + 2) * kstep; const char* b2 = last ? nB : cB + (size_t)(t + 2) * kstep;
            const char* a3 = a2 + kstep; const char* b3 = b2 + kstep;
            const int lda2 = last ? nlda : clda, ldb2 = last ? nldb : cldb;
            const unsigned vA0 = VA0(lda2), vA1 = VA1(lda2), vB0 = VB0(ldb2), vB1 = VB1(ldb2);
            vAc0 = VA0(clda); vAc1 = VA1(clda);
            const size_t hsA2 = last ? hsAn : hsAc, hsB2 = last ? hsBn : hsBc;
            PG8_LDB(B0, 0, 0); PG8_LDB(B1, 0, 1); PG8_SCHED; PG8_LDA(At, 0, 0); PG8_STAGE(PG8_SA(1, 1), a1 + hsAc, vAc0, vAc1);
            PG8_WAIT_V(8); PG8_WAIT_L(0); PG8_BAR; PG8_MMA(0, 0, At, B0); PG8_MMA(0, 1, At, B1); PG8_BAR; PG8_SCHED;
            PG8_LDA(At, 0, 1); PG8_STAGE(PG8_SB(0, 0), b2, vB0, vB1); PG8_STAGE(PG8_SB(0, 1), b2 + hsB2, vB0, vB1); PG8_STAGE(PG8_SA(0, 0), a2, vA0, vA1);
            PG8_WAIT_V(8); PG8_WAIT_L(0); PG8_BAR; PG8_MMA(1, 0, At, B0); PG8_MMA(1, 1, At, B1); PG8_BAR; PG8_SCHED;
            PG8_LDB(B0, 1, 0); PG8_LDB(B1, 1, 1); PG8_SCHED; PG8_LDA(At, 1, 0); PG8_STAGE(PG8_SA(0, 1), a2 + hsA2, vA0, vA1);
            PG8_WAIT_V(8); PG8_WAIT_L(0); PG8_BAR; PG8_MMA(0, 0, At, B0); PG8_MMA(0, 1, At, B1); PG8_BAR; PG8_SCHED;
            PG8_LDA(At, 1, 1); PG8_STAGE(PG8_SB(1, 0), b3, vB0, vB1); PG8_STAGE(PG8_SB(1, 1), b3 + hsB2, vB0, vB1); PG8_STAGE(PG8_SA(1, 0), a3, vA0, vA1);
            PG8_WAIT_V(8); PG8_WAIT_L(0); PG8_BAR; PG8_MMA(1, 0, At, B0); PG8_MMA(1, 1, At, B1); PG8_BAR; PG8_SCHED;
        }
        if (wr == 0) PG8_BAR;
        const bool clear = E(acc, cur, wr, wc, fr, fq);
        if (!has_next) break;
        if (clear) {
#pragma unroll
        for (int a = 0; a < 2; ++a)
#pragma unroll
            for (int b = 0; b < 2; ++b)
#pragma unroll
                for (int m = 0; m < 4; ++m)
#pragma unroll
                    for (int n = 0; n < 2; ++n) acc[a][b][m][n] = (f32x4){0.f, 0.f, 0.f, 0.f};
        }
        cur = nxt; cA = nA; cB = nB; ++ui;
        clda = nlda; cldb = nldb; vAc0 = VA0(clda); vAc1 = VA1(clda); hsAc = hsAn; hsBc = hsBn;
        if (wr == 1) PG8_BAR;
    }
    PG8_WAIT_V(0);
    PG8_BAR;
#undef VA0
#undef VA1
#undef VB0
#undef VB1
#undef PG8_SA
#undef PG8_SB
#undef PG8_STAGE
#undef PG8_LDA
#undef PG8_LDB
#undef PG8_MMA
#undef PG8_WAIT_V
#undef PG8_WAIT_L
#undef PG8_BAR
#undef PG8_SCHED
}

struct EpiStore {
    __device__ __forceinline__ bool operator()(const f32x4 (&acc)[2][2][4][2], const GUnit& u, int wr, int wc, int fr, int fq) {
#pragma unroll
        for (int ai = 0; ai < 2; ++ai)
#pragma unroll
            for (int m = 0; m < 4; ++m) { bf16_t* rowp = u.C + (size_t)(ai * HALF + wr * 64 + m * 16 + fr) * u.ldc + wc * 32 + 8 * fq;
#pragma unroll
                for (int bj = 0; bj < 2; ++bj) { const f32x4 v0 = acc[ai][bj][m][0], v1 = acc[ai][bj][m][1];
                    u32x4 w; w.x = cvt_pk_bf16(v0[0], v0[1]); w.y = cvt_pk_bf16(v0[2], v0[3]); w.z = cvt_pk_bf16(v1[0], v1[1]); w.w = cvt_pk_bf16(v1[2], v1[3]);
                    *(GAS u32x4*)(rowp + bj * HALF) = w; } }
        return true;
    }
};
struct EpiResid {
    const float* xp; const float* xs; float* out;
    __device__ __forceinline__ bool operator()(const f32x4 (&acc)[2][2][4][2], const GUnit& u, int wr, int wc, int fr, int fq) {
        const unsigned off0 = (unsigned)(wr * 64 + fr) * DM + u.pn * 256 + wc * 32 + 8 * fq;
        const float* xin = ((u.pm < 64) ? xp + (size_t)u.pm * 256 * DM : xs + (size_t)(u.pm - 64) * 256 * DM) + off0;
        float* o = out + (size_t)u.pm * 256 * DM + off0;
#pragma unroll
        for (int ai = 0; ai < 2; ++ai)
#pragma unroll
            for (int m = 0; m < 4; ++m)
#pragma unroll
                for (int bj = 0; bj < 2; ++bj) { const unsigned ro = (unsigned)(ai * HALF + m * 16) * DM + bj * HALF;
                    const f32x4 x0 = *(const GAS f32x4*)(xin + ro), x1 = *(const GAS f32x4*)(xin + ro + 4);
                    *(GAS f32x4*)(o + ro) = x0 + acc[ai][bj][m][0]; *(GAS f32x4*)(o + ro + 4) = x1 + acc[ai][bj][m][1]; }
        return true;
    }
};
struct EpiResidNorm {
    const float* xp; const float* xs; float* out; bf16_t* hbo; const float* g2; float* sumsq;
    __device__ __forceinline__ bool operator()(const f32x4 (&acc)[2][2][4][2], const GUnit& u, int wr, int wc, int fr, int fq) {
        const unsigned col0 = u.pn * 256 + wc * 32 + 8 * fq;
        const unsigned off0 = (unsigned)(wr * 64 + fr) * DM + col0;
        const float* xin = ((u.pm < 64) ? xp + (size_t)u.pm * 256 * DM : xs + (size_t)(u.pm - 64) * 256 * DM) + off0;
        float* o = out + (size_t)u.pm * 256 * DM + off0;
        bf16_t* ho = hbo + (size_t)u.pm * 256 * DM + off0;
        f32x4 gg[2][2];
#pragma unroll
        for (int bj = 0; bj < 2; ++bj) { gg[bj][0] = *(const GAS f32x4*)(g2 + col0 + bj * HALF); gg[bj][1] = *(const GAS f32x4*)(g2 + col0 + bj * HALF + 4); }
#pragma unroll
        for (int ai = 0; ai < 2; ++ai)
#pragma unroll
            for (int m = 0; m < 4; ++m) { float ss = 0.f;
#pragma unroll
                for (int bj = 0; bj < 2; ++bj) { const unsigned ro = (unsigned)(ai * HALF + m * 16) * DM + bj * HALF;
                    const f32x4 x0 = *(const GAS f32x4*)(xin + ro) + acc[ai][bj][m][0], x1 = *(const GAS f32x4*)(xin + ro + 4) + acc[ai][bj][m][1];
                    *(GAS f32x4*)(o + ro) = x0; *(GAS f32x4*)(o + ro + 4) = x1;
                    ss += (x0[0] * x0[0] + x0[1] * x0[1]) + (x0[2] * x0[2] + x0[3] * x0[3]) + (x1[0] * x1[0] + x1[1] * x1[1]) + (x1[2] * x1[2] + x1[3] * x1[3]);
                    const f32x4 h0 = x0 * gg[bj][0], h1 = x1 * gg[bj][1]; u32x4 w;
                    w.x = cvt_pk_bf16(h0[0], h0[1]); w.y = cvt_pk_bf16(h0[2], h0[3]); w.z = cvt_pk_bf16(h1[0], h1[1]); w.w = cvt_pk_bf16(h1[2], h1[3]);
                    *(GAS u32x4*)(ho + ro) = w; }
                ss += __shfl_xor(ss, 16); ss += __shfl_xor(ss, 32);
                if (fq == 0) atomicAdd(sumsq + u.pm * 256 + ai * HALF + wr * 64 + m * 16 + fr, ss); }
        return true;
    }
};
struct EpiSwigluNorm {
    bf16_t* act; const float* sumsq;
    __device__ __forceinline__ bool operator()(const f32x4 (&acc)[2][2][4][2], const GUnit& u, int wr, int wc, int fr, int fq) {
#pragma unroll
        for (int ai = 0; ai < 2; ++ai)
#pragma unroll
            for (int m = 0; m < 4; ++m) { const int row = u.pm * 256 + ai * HALF + wr * 64 + m * 16 + fr;
                const float rs = 1.f / sqrtf(*(const GAS float*)(sumsq + row) * (1.f / DM) + EPS);
                bf16_t* rowp = act + (size_t)row * FF + u.pn * 128 + wc * 32 + 8 * fq;
                float o[8];
#pragma unroll
                for (int n = 0; n < 2; ++n)
#pragma unroll
                    for (int i = 0; i < 4; ++i) o[4 * n + i] = siluf_(rs * acc[ai][0][m][n][i]) * (rs * acc[ai][1][m][n][i]);
                u32x4 w; w.x = cvt_pk_bf16(o[0], o[1]); w.y = cvt_pk_bf16(o[2], o[3]); w.z = cvt_pk_bf16(o[4], o[5]); w.w = cvt_pk_bf16(o[6], o[7]);
                *(GAS u32x4*)rowp = w; }
        return true;
    }
};
struct EpiSwiglu {
    bf16_t* act;
    __device__ __forceinline__ bool operator()(const f32x4 (&acc)[2][2][4][2], const GUnit& u, int wr, int wc, int fr, int fq) {
#pragma unroll
        for (int ai = 0; ai < 2; ++ai)
#pragma unroll
            for (int m = 0; m < 4; ++m) { bf16_t* rowp = act + (size_t)(u.pm * 256 + ai * HALF + wr * 64 + m * 16 + fr) * FF + u.pn * 128 + wc * 32 + 8 * fq;
                float o[8];
#pragma unroll
                for (int n = 0; n < 2; ++n)
#pragma unroll
                    for (int i = 0; i < 4; ++i) o[4 * n + i] = siluf_(acc[ai][0][m][n][i]) * acc[ai][1][m][n][i];
                u32x4 w; w.x = cvt_pk_bf16(o[0], o[1]); w.y = cvt_pk_bf16(o[2], o[3]); w.z = cvt_pk_bf16(o[4], o[5]); w.w = cvt_pk_bf16(o[6], o[7]);
                *(GAS u32x4*)rowp = w; }
        return true;
    }
};
struct EpiMerge {
    const float* bgate; bf16_t* merged; bf16_t* gtmp;
    __device__ __forceinline__ bool operator()(const f32x4 (&acc)[2][2][4][2], const GUnit& u, int wr, int wc, int fr, int fq) {
        const int br = u.sub >> 1;
        const unsigned off0 = (unsigned)(u.pm * 256 + wr * 64 + fr) * DM + u.pn * 256 + wc * 32 + 8 * fq;
        if ((u.sub & 1) == 0) {
#pragma unroll
            for (int bj = 0; bj < 2; ++bj) { const float* bp = bgate + br * 1024 + u.pn * 256 + bj * HALF + wc * 32 + 8 * fq;
                const f32x4 b0 = *(const GAS f32x4*)bp, b1 = *(const GAS f32x4*)(bp + 4);
#pragma unroll
                for (int ai = 0; ai < 2; ++ai)
#pragma unroll
                    for (int m = 0; m < 4; ++m) { const f32x4 v0 = acc[ai][bj][m][0] + b0, v1 = acc[ai][bj][m][1] + b1; u32x4 w;
                        w.x = cvt_pk_bf16(sigmoidf_(v0[0]), sigmoidf_(v0[1])); w.y = cvt_pk_bf16(sigmoidf_(v0[2]), sigmoidf_(v0[3]));
                        w.z = cvt_pk_bf16(sigmoidf_(v1[0]), sigmoidf_(v1[1])); w.w = cvt_pk_bf16(sigmoidf_(v1[2]), sigmoidf_(v1[3]));
                        *(GAS u32x4*)(gtmp + off0 + (unsigned)(ai * HALF + m * 16) * DM + bj * HALF) = w; } }
        } else {
#pragma unroll
            for (int ai = 0; ai < 2; ++ai)
#pragma unroll
                for (int m = 0; m < 4; ++m)
#pragma unroll
                    for (int bj = 0; bj < 2; ++bj) { const unsigned off = off0 + (unsigned)(ai * HALF + m * 16) * DM + bj * HALF;
                        const u32x4 gg = *(const GAS u32x4*)(gtmp + off); u32x4 mm = (u32x4){0u, 0u, 0u, 0u}; if (br > 0) mm = *(const GAS u32x4*)(merged + off);
                        const f32x4 a0 = acc[ai][bj][m][0], a1 = acc[ai][bj][m][1]; u32x4 w;
                        w.x = cvt_pk_bf16(bflo(mm.x) + bflo(gg.x) * a0[0], bfhi(mm.x) + bfhi(gg.x) * a0[1]); w.y = cvt_pk_bf16(bflo(mm.y) + bflo(gg.y) * a0[2], bfhi(mm.y) + bfhi(gg.y) * a0[3]);
                        w.z = cvt_pk_bf16(bflo(mm.z) + bflo(gg.z) * a1[0], bfhi(mm.z) + bfhi(gg.z) * a1[1]); w.w = cvt_pk_bf16(bflo(mm.w) + bflo(gg.w) * a1[2], bfhi(mm.w) + bfhi(gg.w) * a1[3]);
                        *(GAS u32x4*)(merged + off) = w; }
        }
        return true;
    }
};
}

struct Args { const float* in[38]; float* out; unsigned char* ws; int ph_lo, ph_hi; };
struct Ctx {
    const Args* A; float* out; unsigned char* ws; LAS unsigned char* lds;
    int tid, lane, wave, gw, NGW, l, G, bid;
};
#define WSB(off) ((bf16_t*)(C.ws + (off)))
#define INL(i, sz) (C.A->in[i] + (size_t)C.l * (size_t)(sz))
#define IN0(i) (C.A->in[i])

using pg8::GUnit;
struct SchedOne {
    const bf16_t* A; const bf16_t* B; bf16_t* Cp; int lda, ldb, ldc, nM, nN, nt, G, c;
    __device__ __forceinline__ bool next(int i, GUnit& u) const {
        const long L = (long)i * G + c; if (L >= (long)nM * nN) return false;
        int pm, pn; pg8::tile_map((int)L, nM, nN, pm, pn);
        u.A = A + (size_t)pm * 256 * lda; u.B = B + (size_t)pn * 256 * ldb; u.lda = lda; u.ldb = ldb; u.nt = nt; u.pm = pm; u.pn = pn; u.sub = 0;
        u.C = Cp ? Cp + (size_t)pm * 256 * ldc + (size_t)pn * 256 : nullptr; u.ldc = ldc; return true;
    }
};
struct SchedInproj {
    const bf16_t* A; const bf16_t* B; bf16_t *pA, *pB, *pC, *pD; int G, c;
    __device__ __forceinline__ bool next(int i, GUnit& u) const {
        const long L = (long)i * G + c; if (L >= 72 * 21) return false;
        int pm, pn; pg8::tile_map((int)L, 72, 21, pm, pn);
        u.A = A + (size_t)pm * 256 * 1024; u.B = B + (size_t)pn * 256 * 1024; u.lda = 1024; u.ldb = 1024; u.nt = 16; u.pm = pm; u.pn = pn; u.sub = 0;
        if (pn < 6) { u.C = pA + (size_t)pm * 256 * 1536 + pn * 256; u.ldc = 1536; }
        else if (pn < 9) { u.C = pB + (size_t)pm * 256 * 768 + (pn - 6) * 256; u.ldc = 768; }
        else if (pn < 15) { u.C = pC + (size_t)pm * 256 * 1536 + (pn - 9) * 256; u.ldc = 1536; }
        else { u.C = pD + (size_t)pm * 256 * 1536 + (pn - 15) * 256; u.ldc = 1536; }
        return true;
    }
};
struct SchedP3 {
    const bf16_t *pB, *wq, *ckvP, *ckvS, *wkv; bf16_t *Q, *KVP, *KVS; int G, c;
    __device__ __forceinline__ bool next(int i, GUnit& u) const {
        long L = (long)i * G + c; int pm, pn; u.sub = 0;
        if (L < 264 * 4) { pg8::tile_map((int)L, 264, 4, pm, pn); u.A = ckvS + (size_t)pm * 256 * 256; u.B = wkv + (size_t)pn * 256 * 256; u.lda = 256; u.ldb = 256; u.nt = 4;
            u.C = KVS + (size_t)pm * 256 * 1024 + pn * 256; u.ldc = 1024; u.pm = pm; u.pn = pn; return true; }
        L -= 264 * 4;
        if (L < 64 * 4) { pg8::tile_map((int)L, 64, 4, pm, pn); u.A = ckvP + (size_t)pm * 256 * 256; u.B = wkv + (size_t)pn * 256 * 256; u.lda = 256; u.ldb = 256; u.nt = 4;
            u.C = KVP + (size_t)pm * 256 * 1024 + pn * 256; u.ldc = 1024; u.pm = pm; u.pn = pn; return true; }
        L -= 64 * 4;
        if (L < 72 * 3) { pg8::tile_map((int)L, 72, 3, pm, pn); u.A = pB + (size_t)pm * 256 * 768; u.B = wq + (size_t)pn * 256 * 384; u.lda = 768; u.ldb = 384; u.nt = 6;
            u.C = Q + (size_t)pm * 256 * 768 + pn * 256; u.ldc = 768; u.pm = pm; u.pn = pn; return true; }
        return false;
    }
};
struct SchedMerge {
    const bf16_t *hb, *wg, *wout, *pA, *ybc, *pD; int G, c;
    __device__ __forceinline__ bool next(int i, GUnit& u) const {
        const long L = (long)(i >> 3) * G + c; if (L >= 72 * 4) return false;
        int pm, pn; pg8::tile_map((int)L, 72, 4, pm, pn); const int sub = i & 7, br = sub >> 1;
        u.pm = pm; u.pn = pn; u.sub = sub; u.C = nullptr; u.ldc = 0; u.ldb = 1024;
        if ((sub & 1) == 0) { u.A = hb + (size_t)pm * 256 * 1024; u.lda = 1024; u.nt = 16; u.B = wg + (size_t)(br * 1024 + pn * 256) * 1024; }
        else { u.nt = 8; u.B = wout + (size_t)(br * 1024 + pn * 256) * 1024;
            if (br == 0) { u.A = pA + (size_t)pm * 256 * 1536; u.lda = 1536; }
            else if (br == 1) { u.A = ybc + (size_t)pm * 256 * 1024; u.lda = 1024; }
            else if (br == 2) { u.A = ybc + (size_t)pm * 256 * 1024 + 512; u.lda = 1024; }
            else { u.A = pD + (size_t)pm * 256 * 1536; u.lda = 1536; } }
        return true;
    }
};

template <class Map>
__device__ __forceinline__ void transpose_w(const Ctx& C, const float* W, int ldw, int K, int Nout, bf16_t* WT, int ldt, Map map) {
    LAS float* scr = (LAS float*)(C.lds + C.wave * 8704);
    const int lane = C.lane, nblk = Nout / 32, items = (K / 64) * nblk;
    for (int it = C.gw; it < items; it += C.NGW) {
        const int kb = it / nblk, nb = it % nblk, k0 = 64 * kb, n0 = 32 * nb;
        const int col = map(n0 + (lane & 31));
        float wv[32];
#pragma unroll
        for (int i = 0; i < 32; ++i) { const int kk = 2 * i + (lane >> 5); wv[i] = (col >= 0) ? W[(size_t)(k0 + kk) * ldw + col] : 0.f; }
#pragma unroll
        for (int i = 0; i < 32; ++i) { const int kk = 2 * i + (lane >> 5); scr[kk * 33 + (lane & 31)] = wv[i]; }
        LDS_WAIT();
        const int c = lane & 7;
#pragma unroll
        for (int j = 0; j < 4; ++j) { const int n = (lane >> 3) + 8 * j; const LAS float* s = scr + (8 * c) * 33 + n;
            u32x4 o; o.x = pk2(s[0 * 33], s[1 * 33]); o.y = pk2(s[2 * 33], s[3 * 33]); o.z = pk2(s[4 * 33], s[5 * 33]); o.w = pk2(s[6 * 33], s[7 * 33]);
            *(u32x4*)(WT + (size_t)(n0 + n) * ldt + k0 + 8 * c) = o; }
        LDS_WAIT();
    }
}
struct MapId { __device__ __forceinline__ int operator()(int n) const { return n; } };
struct MapOff { int off; __device__ __forceinline__ int operator()(int n) const { return n + off; } };
struct MapIn { __device__ __forceinline__ int operator()(int n) const { return n < 1536 ? n : (n < 2208 ? n + 8 : (n < 2216 ? n - 2208 + 1536 : (n < 2304 ? -1 : n - 88))); } };
struct MapKv { __device__ __forceinline__ int operator()(int n) const { return n < 512 ? ((n >> 6) * 128 + (n & 63)) : (((n - 512) >> 6) * 128 + 64 + (n & 63)); } };
struct MapUp { __device__ __forceinline__ int operator()(int n) const { const int t = n >> 8, w = n & 255; return w < 128 ? 128 * t + w : 2816 + 128 * t + (w - 128); } };

__device__ __forceinline__ void phase_wprep(const Ctx& C) {
    transpose_w(C, INL(10, 1024 * IN_COLS), IN_COLS, 1024, 5376, WSB(WS_WT_IN), 1024, MapIn());
    transpose_w(C, INL(10, 1024 * IN_COLS), IN_COLS, 1024, 4096, WSB(WS_WT_G), 1024, MapOff{5288});
    transpose_w(C, INL(20, 384 * 768), 768, 384, 768, WSB(WS_WT_QUP), 384, MapId());
    transpose_w(C, INL(22, 256 * 1024), 1024, 256, 1024, WSB(WS_WT_KVUP), 256, MapKv());
    transpose_w(C, INL(18, 512 * 1024), 1024, 512, 1024, WSB(WS_WT_OUT), 1024, MapId());
    transpose_w(C, INL(27, 512 * 1024), 1024, 512, 1024, WSB(WS_WT_OUT) + (size_t)1 * 1024 * 1024, 1024, MapId());
    transpose_w(C, INL(29, 512 * 1024), 1024, 512, 1024, WSB(WS_WT_OUT) + (size_t)2 * 1024 * 1024, 1024, MapId());
    transpose_w(C, INL(33, 512 * 1024), 1024, 512, 1024, WSB(WS_WT_OUT) + (size_t)3 * 1024 * 1024, 1024, MapId());
    transpose_w(C, INL(34, 1024 * 1024), 1024, 1024, 1024, WSB(WS_WT_O), 1024, MapId());
    transpose_w(C, INL(36, 1024 * 5632), 5632, 1024, 5632, WSB(WS_WT_UP), 1024, MapUp());
    transpose_w(C, INL(37, 2816 * 1024), 1024, 2816, 1024, WSB(WS_WT_DOWN), 2816, MapId());
}

__device__ __forceinline__ const float* xrow(const Ctx& C, int row, bool from_out) {
    if (from_out) return C.out + (size_t)row * DM;
    return row < NP ? IN0(0) + (size_t)row * DM : IN0(1) + (size_t)(row - NP) * DM;
}
__device__ __forceinline__ void phase_norm(const Ctx& C, const float* g, bool from_out) {
    const int lane = C.lane;
    f32x4 gv[4];
#pragma unroll
    for (int j = 0; j < 4; ++j) gv[j] = ((const f32x4*)g)[64 * j + lane];
    for (int row = C.gw; row < R; row += C.NGW) {
        const f32x4* xr = (const f32x4*)xrow(C, row, from_out) + lane;
        f32x4 v[4]; float s = 0.f;
#pragma unroll
        for (int j = 0; j < 4; ++j) { v[j] = xr[64 * j]; s += (v[j].x * v[j].x + v[j].y * v[j].y) + (v[j].z * v[j].z + v[j].w * v[j].w); }
        const float rstd = 1.f / sqrtf(wave_sum(s) * (1.f / DM) + EPS);
        u32x2* o = (u32x2*)(WSB(WS_HB) + (size_t)row * DM) + lane;
#pragma unroll
        for (int j = 0; j < 4; ++j) { u32x2 w; w.x = pk2(v[j].x * rstd * gv[j].x, v[j].y * rstd * gv[j].y); w.y = pk2(v[j].z * rstd * gv[j].z, v[j].w * rstd * gv[j].w); o[64 * j] = w; }
    }
}
__device__ __forceinline__ void rope_cs(int pos, int i, float& c, float& s) {
    const float chi = ((i & 8) ? ((i & 4) ? ((i & 2) ? ((i & 1) ? 2.831220627e-05f : 5.030632019e-05f) : ((i & 1) ? 8.952617645e-05f : 1.592636108e-04f)) : ((i & 2) ? ((i & 1) ? 2.832412720e-04f : 5.035400391e-04f) : ((i & 1) ? 8.945465088e-04f : 1.590728760e-03f))) : ((i & 4) ? ((i & 2) ? ((i & 1) ? 2.830505371e-03f : 5.035400391e-03f) : ((i & 1) ? 8.956909180e-03f : 1.593017578e-02f)) : ((i & 2) ? ((i & 1) ? 2.828979492e-02f : 5.035400391e-02f) : ((i & 1) ? 8.947753906e-02f : 1.591796875e-01f))));
    const float clo = ((i & 8) ? ((i & 4) ? ((i & 2) ? ((i & 1) ? -1.001043781e-08f : 2.289191414e-08f) : ((i & 1) ? -2.677484368e-08f : -1.086677486e-07f)) : ((i & 2) ? ((i & 1) ? -2.193136623e-07f : -2.479180239e-07f) : ((i & 1) ? 4.475072899e-07f : 8.206711755e-07f))) : ((i & 4) ? ((i & 2) ? ((i & 1) ? -2.857880190e-07f : -2.479180239e-06f) : ((i & 1) ? -6.969018614e-06f : -1.468147184e-05f)) : ((i & 2) ? ((i & 1) ? 1.240090842e-05f : -2.479180148e-05f) : ((i & 1) ? 2.186254642e-05f : -2.474440771e-05f))));
    const float pf = (float)pos, rh = pf * chi, f1 = rh - __builtin_rintf(rh), fr = f1 + pf * clo;
    c = __builtin_amdgcn_cosf(fr); s = __builtin_amdgcn_sinf(fr);
}
__device__ __forceinline__ int row_pos(int row) { return row < NP ? (row & (TP - 1)) : PAST + ((row - NP) & 63); }

__device__ __forceinline__ void phase_mla_prep(const Ctx& C) {
    const int lane = C.lane; const int l = C.l;
    const float* gq = INL(19, 384); const float* gkv = INL(21, 256); const float* gkr = INL(26, 32);
    for (int row = C.gw; row < R; row += C.NGW) {
        bf16_t* pb = WSB(WS_ZB) + (size_t)row * 768;
        unsigned q[3]; float ss = 0.f;
#pragma unroll
        for (int j = 0; j < 3; ++j) { q[j] = *(const unsigned*)(pb + 2 * lane + 128 * j); const float a = bflo(q[j]), b = bfhi(q[j]); ss += a * a + b * b; }
        float rstd = 1.f / sqrtf(wave_sum(ss) * (1.f / 384.f) + EPS);
#pragma unroll
        for (int j = 0; j < 3; ++j) { const int c = 2 * lane + 128 * j; *(unsigned*)(pb + c) = pk2(bflo(q[j]) * rstd * gq[c], bfhi(q[j]) * rstd * gq[c + 1]); }
        const u32x2 kv = *(const u32x2*)(pb + 384 + 4 * lane);
        float k0 = bflo(kv.x), k1 = bfhi(kv.x), k2 = bflo(kv.y), k3 = bfhi(kv.y);
        rstd = 1.f / sqrtf(wave_sum(k0 * k0 + k1 * k1 + k2 * k2 + k3 * k3) * (1.f / 256.f) + EPS);
        const f32x4 g4 = *(const f32x4*)(gkv + 4 * lane);
        f32x4 ck; ck.x = k0 * rstd * g4.x; ck.y = k1 * rstd * g4.y; ck.z = k2 * rstd * g4.z; ck.w = k3 * rstd * g4.w;
        u32x2 ckb; ckb.x = pk2(ck.x, ck.y); ckb.y = pk2(ck.z, ck.w);
        const int pos = row_pos(row);
        size_t srow = 0;
        if (row < NP) { *(f32x4*)(C.out + O_CKV_P + ((size_t)l * NP + row) * 256 + 4 * lane) = ck; *(u32x2*)(WSB(WS_CKVP) + (size_t)row * 256 + 4 * lane) = ckb; }
        else { const int rs = row - NP; srow = (size_t)(rs >> 6) * KS_ALL + PAST + (rs & 63);
            *(f32x4*)(C.out + O_CKV_S + ((size_t)l * NS + rs) * 256 + 4 * lane) = ck; *(u32x2*)(WSB(WS_CKVS) + srow * 256 + 4 * lane) = ckb; }
        const float x = (lane < 32) ? bf1(pb[640 + lane]) : 0.f;
        rstd = 1.f / sqrtf(wave_sum(x * x) * (1.f / 32.f) + EPS);
        const float y = x * rstd * gkr[lane & 31];
        const float part = __shfl_xor(y, 16);
        float cs, sn; rope_cs(pos, lane & 15, cs, sn);
        const float o = (lane < 16) ? (y * cs - part * sn) : (part * sn + y * cs);
        if (lane < 32) {
            if (row < NP) { C.out[O_KPE_P + ((size_t)l * NP + row) * 32 + lane] = o; WSB(WS_KPEP)[(size_t)row * 32 + lane] = (bf16_t)f2bf(o); }
            else { C.out[O_KPE_S + ((size_t)l * NS + (row - NP)) * 32 + lane] = o; WSB(WS_KPES)[srow * 32 + lane] = (bf16_t)f2bf(o); }
        }
    }
    const size_t gt = (size_t)C.bid * NTHREADS + C.tid, GT = (size_t)C.G * NTHREADS;
    { const float* src = INL(4, (size_t)BS * PAST * 256);
      for (size_t i = gt; i < (size_t)BS * PAST * 256 / 8; i += GT) { const size_t e = i * 8, b = e / ((size_t)PAST * 256), rem = e % ((size_t)PAST * 256);
          *(u32x4*)(WSB(WS_CKVS) + b * KS_ALL * 256 + rem) = load8(src, e, true); } }
    { const float* src = INL(5, (size_t)BS * PAST * 32);
      for (size_t i = gt; i < (size_t)BS * PAST * 32 / 8; i += GT) { const size_t e = i * 8, b = e / ((size_t)PAST * 32), rem = e % ((size_t)PAST * 32);
          *(u32x4*)(WSB(WS_KPES) + b * KS_ALL * 32 + rem) = load8(src, e, true); } }
}

__device__ __forceinline__ float red8(float v) { v += __shfl_xor(v, 1); v += __shfl_xor(v, 2); v += __shfl_xor(v, 4); return v; }

__device__ __forceinline__ void phase_band_prep(const Ctx& C) {
    const int lane = C.lane, l = C.l, d0 = (lane & 7) * 8;
    float gq[8], gk[8];
#pragma unroll
    for (int e = 0; e < 8; ++e) { gq[e] = INL(30, 64)[d0 + e] * (0.125f * LOG2E); gk[e] = INL(31, 64)[d0 + e]; }
    for (int row = C.gw; row < R; row += C.NGW) {
        bf16_t* pd = WSB(WS_PD) + (size_t)row * 1536 + 8 * lane;
        float f[8], kf[8], vf[8];
        unpack8(*(const u32x4*)pd, f); float ss = 0.f;
#pragma unroll
        for (int e = 0; e < 8; ++e) ss += f[e] * f[e];
        float rstd = 1.f / sqrtf(red8(ss) * (1.f / 64.f) + EPS);
#pragma unroll
        for (int e = 0; e < 8; ++e) f[e] *= rstd * gq[e];
        *(u32x4*)pd = pack8(f);
        unpack8(*(const u32x4*)(pd + 512), kf); ss = 0.f;
#pragma unroll
        for (int e = 0; e < 8; ++e) ss += kf[e] * kf[e];
        rstd = 1.f / sqrtf(red8(ss) * (1.f / 64.f) + EPS);
#pragma unroll
        for (int e = 0; e < 8; ++e) kf[e] *= rstd * gk[e];
        *(u32x4*)(pd + 512) = pack8(kf);
        unpack8(*(const u32x4*)(pd + 1024), vf);
        long dst = -1;
        if (row < NP) { const int t = row & (TP - 1), b = row >> 13; if (t >= TP - 512) dst = (long)(((size_t)(l * BP + b) * 512 + (t - (TP - 512))) * 512 + 8 * lane); }
        else { const int rs = row - NP, b = rs >> 6, t = rs & 63; dst = (long)(((size_t)(l * BS + b) * 512 + 448 + t) * 512 + 8 * lane); }
        if (dst >= 0) { float* ko = C.out + (row < NP ? O_BK_P : O_BK_S) + dst; float* vo = C.out + (row < NP ? O_BV_P : O_BV_S) + dst;
            *(f32x4*)ko = (f32x4){kf[0], kf[1], kf[2], kf[3]}; *(f32x4*)(ko + 4) = (f32x4){kf[4], kf[5], kf[6], kf[7]};
            *(f32x4*)vo = (f32x4){vf[0], vf[1], vf[2], vf[3]}; *(f32x4*)(vo + 4) = (f32x4){vf[4], vf[5], vf[6], vf[7]}; }
    }
    const size_t gt = (size_t)C.bid * NTHREADS + C.tid, GT = (size_t)C.G * NTHREADS;
    const f32x4* sk = (const f32x4*)INL(7, (size_t)BS * 512 * 512); const f32x4* sv = (const f32x4*)INL(8, (size_t)BS * 512 * 512);
    f32x4* dk = (f32x4*)(C.out + O_BK_S + (size_t)l * BS * 512 * 512); f32x4* dv = (f32x4*)(C.out + O_BV_S + (size_t)l * BS * 512 * 512);
    for (size_t i = gt; i < (size_t)BS * 448 * 128; i += GT) { const size_t b = i / (448 * 128), rem = i % (448 * 128);
        dk[b * 512 * 128 + rem] = sk[b * 512 * 128 + 64 * 128 + rem]; dv[b * 512 * 128 + rem] = sv[b * 512 * 128 + 64 * 128 + rem]; }
}

__device__ __forceinline__ void phase_sconv(const Ctx& C) {
    const int lane = C.lane, l = C.l, ch = 8 * lane;
    const float* w = INL(28, 3 * 512);
    float w0[8], w1[8], w2[8];
#pragma unroll
    for (int e = 0; e < 8; ++e) { w0[e] = w[ch + e]; w1[e] = w[512 + ch + e]; w2[e] = w[1024 + ch + e]; }
    for (int row = C.gw; row < R; row += C.NGW) {
        const bf16_t* pc = WSB(WS_XR) + (size_t)row * 1536 + ch;
        const bool pr = row < NP; const int t = pr ? (row & (TP - 1)) : ((row - NP) & 63); const int b = pr ? (row >> 13) : ((row - NP) >> 6);
        float cb[8], a[8], x[8], u0[8], u1[8], u2[8];
        unpack8(*(const u32x4*)pc, cb); unpack8(*(const u32x4*)(pc + 512), a); unpack8(*(const u32x4*)(pc + 1024), x);
#pragma unroll
        for (int e = 0; e < 8; ++e) u0[e] = a[e] * x[e];
        const float* st = INL(6, BS * 2 * 512) + (size_t)b * 2 * 512 + ch;
        if (t >= 1) { unpack8(*(const u32x4*)(pc - 1536 + 512), a); unpack8(*(const u32x4*)(pc - 1536 + 1024), x);
#pragma unroll
            for (int e = 0; e < 8; ++e) u1[e] = a[e] * x[e]; }
        else {
#pragma unroll
            for (int e = 0; e < 8; ++e) u1[e] = pr ? 0.f : st[512 + e]; }
        if (t >= 2) { unpack8(*(const u32x4*)(pc - 3072 + 512), a); unpack8(*(const u32x4*)(pc - 3072 + 1024), x);
#pragma unroll
            for (int e = 0; e < 8; ++e) u2[e] = a[e] * x[e]; }
        else {
#pragma unroll
            for (int e = 0; e < 8; ++e) u2[e] = pr ? 0.f : st[(t == 1 ? 512 : 0) + e]; }
        float y[8];
#pragma unroll
        for (int e = 0; e < 8; ++e) y[e] = cb[e] * (w0[e] * u2[e] + w1[e] * u1[e] + w2[e] * u0[e]);
        *(u32x4*)(WSB(WS_YBC) + (size_t)row * 1024 + 512 + ch) = pack8(y);
        const int T = pr ? TP : TS;
        if (t >= T - 2) { float* o = C.out + (pr ? O_SC_P + ((size_t)(l * BP + b) * 2 + (t - (T - 2))) * 512 : O_SC_S + ((size_t)(l * BS + b) * 2 + (t - (T - 2))) * 512) + ch;
            *(f32x4*)o = (f32x4){u0[0], u0[1], u0[2], u0[3]}; *(f32x4*)(o + 4) = (f32x4){u0[4], u0[5], u0[6], u0[7]}; }
    }
}

__device__ __forceinline__ void phase_qk_post(const Ctx& C) {
    const int lane = C.lane, head = lane >> 3, sub = lane & 7;
    const float SC = 0.10206207261596577f * LOG2E;
    float gn[8], gr[8], gk[8];
#pragma unroll
    for (int e = 0; e < 8; ++e) { gn[e] = INL(23, 64)[8 * sub + e] * SC; gr[e] = INL(25, 32)[8 * (sub & 3) + e]; gk[e] = INL(24, 64)[8 * sub + e]; }
    for (int row = C.gw; row < R; row += C.NGW) {
        bf16_t* qp = WSB(WS_Q) + (size_t)row * 768 + 96 * head;
        float f[8]; unpack8(*(const u32x4*)(qp + 8 * sub), f); float ss = 0.f;
#pragma unroll
        for (int e = 0; e < 8; ++e) ss += f[e] * f[e];
        float rstd = 1.f / sqrtf(red8(ss) * (1.f / 64.f) + EPS);
#pragma unroll
        for (int e = 0; e < 8; ++e) f[e] *= rstd * gn[e];
        *(u32x4*)(qp + 8 * sub) = pack8(f);
        float r[8];
        if (sub < 4) unpack8(*(const u32x4*)(qp + 64 + 8 * sub), r);
        else {
#pragma unroll
            for (int e = 0; e < 8; ++e) r[e] = 0.f; }
        ss = 0.f;
#pragma unroll
        for (int e = 0; e < 8; ++e) ss += r[e] * r[e];
        ss += __shfl_xor(ss, 1); ss += __shfl_xor(ss, 2);
        rstd = 1.f / sqrtf(ss * (1.f / 32.f) + EPS);
        const int pos = row_pos(row);
        float o[8];
#pragma unroll
        for (int e = 0; e < 8; ++e) { const float y = r[e] * rstd * gr[e]; const float part = __shfl_xor(y, 2);
            float cs, sn; rope_cs(pos, 8 * (sub & 1) + e, cs, sn);
            o[e] = ((sub < 2) ? (y * cs - part * sn) : (part * sn + y * cs)) * SC; }
        if (sub < 4) *(u32x4*)(qp + 64 + 8 * sub) = pack8(o);
    }
    for (int row = C.gw; row < NP + BS * KS_ALL; row += C.NGW) {
        bf16_t* kp = (row < NP ? WSB(WS_KVP) + (size_t)row * 1024 : WSB(WS_XR) + (size_t)(row - NP) * 1024) + 8 * lane;
        float f[8]; unpack8(*(const u32x4*)kp, f); float ss = 0.f;
#pragma unroll
        for (int e = 0; e < 8; ++e) ss += f[e] * f[e];
        const float rstd = 1.f / sqrtf(red8(ss) * (1.f / 64.f) + EPS);
#pragma unroll
        for (int e = 0; e < 8; ++e) f[e] *= rstd * gk[e];
        *(u32x4*)kp = pack8(f);
    }
}

__device__ __forceinline__ bf16x8 mk_frag(u32x2 lo, u32x2 hi) { u32x4 v; v.x = lo.x; v.y = lo.y; v.z = hi.x; v.w = hi.y; return __builtin_bit_cast(bf16x8, v); }
__device__ __forceinline__ bf16x8 as_frag(u32x4 v) { return __builtin_bit_cast(bf16x8, v); }
#define MFMA16(a, b, c) __builtin_amdgcn_mfma_f32_16x16x32_bf16((a), (b), (c), 0, 0, 0)

__device__ __forceinline__ int ssd_row0(int seq, int c) { return seq < 2 ? seq * TP + c * 64 : NP + (seq - 2) * 64; }
__device__ __forceinline__ void ssd_dt(const Ctx& C, int row0, LAS float* sDT, LAS float* sACS) {
    const int h = C.wave, lane = C.lane;
    const float adt = bf1(WSB(WS_ZB)[(size_t)(row0 + lane) * 768 + 672 + h]) + INL(14, 8)[h];
    float dt; { const float e_ = fexp(adt), u_ = 1.f + e_; dt = (adt > 20.f) ? adt : ((u_ == 1.f) ? e_ : (__builtin_amdgcn_logf(u_) * 0.6931471805599453f) * e_ * frcp(u_ - 1.f)); }
    const float A = -fexp(INL(15, 8)[h]);
    float cs = dt * A;
#pragma unroll
    for (int o = 1; o < 64; o <<= 1) { const float t = __shfl_up(cs, o); if (lane >= o) cs += t; }
    sDT[h * 64 + lane] = dt; sACS[h * 64 + lane] = cs;
}
template <class F>
__device__ __forceinline__ void ssd_load_chunk(const Ctx& C, int seq, int c, int row0, F store) {
    const int lane = C.lane, w = C.wave;
    const bf16_t* base = WSB(WS_PA) + (size_t)(row0 + lane) * 1536 + 512;
    const float* cw = INL(12, 4 * 1024); const float* cbias = INL(13, 1024);
    for (int j = 0; j < 16; ++j) {
        const int ch0 = 128 * w + 8 * j;
        const u32x4 v0 = *(const u32x4*)(base + ch0);
        u32x4 ex = (u32x4){0u, 0u, 0u, 0u};
        if (lane < 3) {
            if (seq < 2) { if (c > 0) ex = *(const u32x4*)(base - (size_t)3 * 1536 + ch0); }
            else ex = load8(INL(3, BS * 3 * 1024) + ((size_t)(seq - 2) * 3 + lane) * 1024 + ch0, 0, true);
        }
        float x0[8], xk[3][8];
        unpack8(v0, x0);
#pragma unroll
        for (int k = 1; k <= 3; ++k) {
            u32x4 a, b;
            a.x = __shfl(v0.x, (lane - k) & 63); a.y = __shfl(v0.y, (lane - k) & 63); a.z = __shfl(v0.z, (lane - k) & 63); a.w = __shfl(v0.w, (lane - k) & 63);
            b.x = __shfl(ex.x, (lane - k + 3) & 63); b.y = __shfl(ex.y, (lane - k + 3) & 63); b.z = __shfl(ex.z, (lane - k + 3) & 63); b.w = __shfl(ex.w, (lane - k + 3) & 63);
            unpack8(lane >= k ? a : b, xk[k - 1]);
        }
        float y[8];
#pragma unroll
        for (int e = 0; e < 8; ++e) {
            const float a = cbias[ch0 + e] + cw[3 * 1024 + ch0 + e] * x0[e] + cw[2 * 1024 + ch0 + e] * xk[0][e] + cw[1 * 1024 + ch0 + e] * xk[1][e] + cw[ch0 + e] * xk[2][e];
            y[e] = siluf_(a);
        }
        store(ch0, y, x0);
    }
}

constexpr int XT_ST = 72;
__device__ __forceinline__ void ssd_s1_item(const Ctx& C, int item) {
    const int seq = item < 256 ? (item >> 7) : 2 + (item - 256), c = item < 256 ? (item & 127) : 0, row0 = ssd_row0(seq, c);
    const int lane = C.lane, h = C.wave, fr = lane & 15, fq = lane >> 4, l = C.l;
    LAS bf16_t* XT = (LAS bf16_t*)C.lds; LAS bf16_t* BT = (LAS bf16_t*)(C.lds + 73728);
    LAS float* sDT = (LAS float*)(C.lds + 110592); LAS float* sACS = (LAS float*)(C.lds + 112640);
    ssd_dt(C, row0, sDT, sACS);
    __syncthreads();
    const bool lastc = (seq >= 2) || (c == 127);
    float* convo = C.out + (seq < 2 ? O_CONV_P + (size_t)(l * BP + seq) * 3 * 1024 : O_CONV_S + (size_t)(l * BS + seq - 2) * 3 * 1024);
    ssd_load_chunk(C, seq, c, row0, [&](int ch0, const float* y, const float* raw) {
        if (ch0 < 512) { const int hh = ch0 >> 6, p0 = ch0 & 63; const float wgt = sDT[hh * 64 + lane] * fexp(sACS[hh * 64 + 63] - sACS[hh * 64 + lane]);
#pragma unroll
            for (int e = 0; e < 8; ++e) XT[(hh * 64 + p0 + e) * XT_ST + lane] = (bf16_t)f2bf(y[e] * wgt); }
        else if (ch0 < 768) { const int g = (ch0 - 512) >> 7, n0 = (ch0 - 512) & 127;
#pragma unroll
            for (int e = 0; e < 8; ++e) BT[(g * 128 + n0 + e) * XT_ST + lane] = (bf16_t)f2bf(y[e]); }
        if (lastc && lane >= 61) {
#pragma unroll
            for (int e = 0; e < 8; ++e) convo[(size_t)(lane - 61) * 1024 + ch0 + e] = raw[e]; }
    });
    __syncthreads();
    const int g = h >> 2;
    bf16x8 bx[4][2];
#pragma unroll
    for (int pt = 0; pt < 4; ++pt)
#pragma unroll
        for (int ks = 0; ks < 2; ++ks) bx[pt][ks] = *(const LAS bf16x8*)(XT + (h * 64 + 16 * pt + fr) * XT_ST + 32 * ks + 8 * fq);
    const float dall = fexp(sACS[h * 64 + 63]);
    for (int nt = 0; nt < 8; ++nt) {
        bf16x8 a[2];
#pragma unroll
        for (int ks = 0; ks < 2; ++ks) a[ks] = *(const LAS bf16x8*)(BT + (g * 128 + 16 * nt + fr) * XT_ST + 32 * ks + 8 * fq);
#pragma unroll
        for (int pt = 0; pt < 4; ++pt) {
            f32x4 acc = (f32x4){0.f, 0.f, 0.f, 0.f};
#pragma unroll
            for (int ks = 0; ks < 2; ++ks) acc = MFMA16(a[ks], bx[pt][ks], acc);
            const int p = 16 * pt + fr, n = 16 * nt + 4 * fq;
            if (seq < 2) { u32x2 w; w.x = pk2(acc[0], acc[1]); w.y = pk2(acc[2], acc[3]);
                *(u32x2*)(WSB(WS_STATES) + ((size_t)((seq * 128 + c) * 8 + h) * 64 + p) * 128 + n) = w; }
            else { const size_t o = ((size_t)((l * BS + seq - 2) * 8 + h) * 64 + p) * 128 + n;
                const f32x4 h0 = *(const f32x4*)(IN0(2) + o);
                *(f32x4*)(C.out + O_SSM_S + o) = h0 * dall + acc; }
        }
    }
    if (seq < 2 && lane == 0) ((float*)(C.ws + WS_DECAY))[(seq * 128 + c) * 8 + h] = dall;
    __syncthreads();
}
__device__ __forceinline__ void ssd_scan(const Ctx& C) {
    const size_t gt = (size_t)C.bid * NTHREADS + C.tid;
    if (gt >= (size_t)2 * 8 * 64 * 128) return;
    const int b = (int)(gt >> 16), h = (int)(gt >> 13) & 7, pn = (int)(gt & 8191);
    bf16_t* st = WSB(WS_STATES) + ((size_t)(b * 128) * 8 + h) * 8192 + pn;
    const float* dec = (const float*)(C.ws + WS_DECAY) + (b * 128) * 8 + h;
    float hst = 0.f;
#pragma unroll 1
    for (int c0 = 0; c0 < 128; c0 += 32) {
        bf16_t sv[32]; float dv[32];
#pragma unroll
        for (int i = 0; i < 32; ++i) { sv[i] = st[(size_t)(c0 + i) * 8 * 8192]; dv[i] = dec[(c0 + i) * 8]; }
#pragma unroll
        for (int i = 0; i < 32; ++i) { st[(size_t)(c0 + i) * 8 * 8192] = (bf16_t)f2bf(hst); hst = dv[i] * hst + bf1(sv[i]); }
    }
    C.out[O_SSM_P + ((size_t)(C.l * BP + b) * 8 + h) * 8192 + pn] = hst;
}
constexpr int CN_ST = 136;
__device__ __forceinline__ void ssd_s3_item(const Ctx& C, int item) {
    const int seq = item < 256 ? (item >> 7) : 2 + (item - 256), c = item < 256 ? (item & 127) : 0, row0 = ssd_row0(seq, c);
    const int lane = C.lane, h = C.wave, fr = lane & 15, fq = lane >> 4, l = C.l, g = h >> 2;
    LAS bf16_t* Cn = (LAS bf16_t*)C.lds; LAS bf16_t* Bn = (LAS bf16_t*)(C.lds + 34816); LAS bf16_t* XT = (LAS bf16_t*)(C.lds + 69632);
    LAS float* sDT = (LAS float*)(C.lds + 143360); LAS float* sACS = (LAS float*)(C.lds + 145408); LAS float* sRed = (LAS float*)(C.lds + 147456);
    ssd_dt(C, row0, sDT, sACS);
    ssd_load_chunk(C, seq, c, row0, [&](int ch0, const float* y, const float*) {
        if (ch0 < 512) { const int hh = ch0 >> 6, p0 = ch0 & 63;
#pragma unroll
            for (int e = 0; e < 8; ++e) XT[(hh * 64 + p0 + e) * XT_ST + lane] = (bf16_t)f2bf(y[e]); }
        else if (ch0 < 768) { const int gg = (ch0 - 512) >> 7, n0 = (ch0 - 512) & 127; *(LAS u32x4*)(Bn + (gg * 64 + lane) * CN_ST + n0) = pack8(y); }
        else { const int gg = (ch0 - 768) >> 7, n0 = (ch0 - 768) & 127; *(LAS u32x4*)(Cn + (gg * 64 + lane) * CN_ST + n0) = pack8(y); }
    });
    __syncthreads();
#define CF(lt, ks) (*(const LAS bf16x8*)(Cn + (g * 64 + 16 * (lt) + fr) * CN_ST + 32 * (ks) + 8 * fq))
    f32x4 yacc[4][4];
    const void* hin; bool hin_f32;
    if (seq < 2) { hin = WSB(WS_STATES) + (size_t)((seq * 128 + c) * 8 + h) * 8192; hin_f32 = false; }
    else { hin = IN0(2) + (size_t)((l * BS + seq - 2) * 8 + h) * 8192; hin_f32 = true; }
#pragma unroll
    for (int pt = 0; pt < 4; ++pt) {
#pragma unroll
        for (int lt = 0; lt < 4; ++lt) yacc[pt][lt] = (f32x4){0.f, 0.f, 0.f, 0.f};
        bf16x8 af[4];
        if (hin_f32) {
#pragma unroll
            for (int ks = 0; ks < 4; ++ks) af[ks] = as_frag(load8(hin, (size_t)(16 * pt + fr) * 128 + 32 * ks + 8 * fq, true));
        } else {
#pragma unroll
            for (int ks = 0; ks < 4; ++ks) af[ks] = as_frag(load8(hin, (size_t)(16 * pt + fr) * 128 + 32 * ks + 8 * fq, false));
        }
#pragma unroll
        for (int ks = 0; ks < 4; ++ks)
#pragma unroll
            for (int lt = 0; lt < 4; ++lt) yacc[pt][lt] = MFMA16(af[ks], CF(lt, ks), yacc[pt][lt]);
        __builtin_amdgcn_sched_barrier(0);
    }
    float acl[4];
#pragma unroll
    for (int lt = 0; lt < 4; ++lt) { acl[lt] = sACS[h * 64 + 16 * lt + fr]; const float el = fexp(acl[lt]);
#pragma unroll
        for (int pt = 0; pt < 4; ++pt) yacc[pt][lt] = yacc[pt][lt] * el; }
    const float Dh = INL(16, 8)[h];
#pragma unroll
    for (int lt = 0; lt < 4; ++lt) {
        bf16x8 pf[2], cfl[4];
#pragma unroll
        for (int ks = 0; ks < 4; ++ks) cfl[ks] = CF(lt, ks);
        unsigned pw[4][2];
#pragma unroll
        for (int st = 0; st < 4; ++st) {
            f32x4 cb = (f32x4){0.f, 0.f, 0.f, 0.f};
#pragma unroll
            for (int ks = 0; ks < 4; ++ks) { const bf16x8 a = *(const LAS bf16x8*)(Bn + (g * 64 + 16 * st + fr) * CN_ST + 32 * ks + 8 * fq); cb = MFMA16(a, cfl[ks], cb); }
            const f32x4 as4 = *(const LAS f32x4*)(sACS + h * 64 + 16 * st + 4 * fq), dt4 = *(const LAS f32x4*)(sDT + h * 64 + 16 * st + 4 * fq);
            float m[4];
#pragma unroll
            for (int i = 0; i < 4; ++i) { const int s = 16 * st + 4 * fq + i, ll = 16 * lt + fr;
                float v = (s <= ll) ? cb[i] * fexp(acl[lt] - as4[i]) * dt4[i] : 0.f; if (s == ll) v += Dh; m[i] = v; }
            pw[st][0] = pk2(m[0], m[1]); pw[st][1] = pk2(m[2], m[3]);
        }
        { u32x4 v; v.x = pw[0][0]; v.y = pw[0][1]; v.z = pw[1][0]; v.w = pw[1][1]; pf[0] = as_frag(v); v.x = pw[2][0]; v.y = pw[2][1]; v.z = pw[3][0]; v.w = pw[3][1]; pf[1] = as_frag(v); }
#pragma unroll
        for (int pt = 0; pt < 4; ++pt)
#pragma unroll
            for (int kk = 0; kk < 2; ++kk) { const LAS bf16_t* xp = XT + (h * 64 + 16 * pt + fr) * XT_ST + 32 * kk + 4 * fq;
                const bf16x8 a = mk_frag(*(const LAS u32x2*)xp, *(const LAS u32x2*)(xp + 16)); yacc[pt][lt] = MFMA16(a, pf[kk], yacc[pt][lt]); }
        asm volatile("" ::: "memory");
    }
    float ss[4] = {0.f, 0.f, 0.f, 0.f};
#pragma unroll
    for (int lt = 0; lt < 4; ++lt)
#pragma unroll
        for (int pt = 0; pt < 4; ++pt) { const u32x2 z = *(const u32x2*)(WSB(WS_PA) + (size_t)(row0 + 16 * lt + fr) * 1536 + h * 64 + 16 * pt + 4 * fq);
            f32x4 v = yacc[pt][lt]; v[0] *= siluf_(bflo(z.x)); v[1] *= siluf_(bfhi(z.x)); v[2] *= siluf_(bflo(z.y)); v[3] *= siluf_(bfhi(z.y));
            yacc[pt][lt] = v; ss[lt] += v[0] * v[0] + v[1] * v[1] + v[2] * v[2] + v[3] * v[3]; }
#pragma unroll
    for (int lt = 0; lt < 4; ++lt) { ss[lt] += __shfl_xor(ss[lt], 16); ss[lt] += __shfl_xor(ss[lt], 32); if (fq == 0) sRed[h * 64 + 16 * lt + fr] = ss[lt]; }
    __syncthreads();
    const float* ng = INL(17, 512);
#pragma unroll
    for (int lt = 0; lt < 4; ++lt) { float tot = 0.f;
#pragma unroll
        for (int hh = 0; hh < 8; ++hh) tot += sRed[hh * 64 + 16 * lt + fr];
        const float rstd = 1.f / sqrtf(tot * (1.f / 512.f) + EPS);
#pragma unroll
        for (int pt = 0; pt < 4; ++pt) { const f32x4 gg = *(const f32x4*)(ng + h * 64 + 16 * pt + 4 * fq); const f32x4 v = yacc[pt][lt];
            u32x2 w; w.x = pk2(v[0] * rstd * gg[0], v[1] * rstd * gg[1]); w.y = pk2(v[2] * rstd * gg[2], v[3] * rstd * gg[3]);
            *(u32x2*)(WSB(WS_PA) + (size_t)(row0 + 16 * lt + fr) * 1536 + h * 64 + 16 * pt + 4 * fq) = w; } }
    __syncthreads();
}

struct AH {
    const bf16_t* q; int qld; bf16_t* o; int old_;
    const void* kn; size_t knld; bool kn_f32; const bf16_t* kn2; size_t kn2ld; int split;
    const bf16_t* kp; size_t kpld;
    const void* v; size_t vld; bool v_f32; const bf16_t* v2; size_t v2ld;
    int count, cdiff0;
};
template <int DK, bool BIAS, bool SHARED>
__device__ __forceinline__ void attn_core(const Ctx& C, const AH& H, int n_iter) {
    constexpr int KST = DK + 8, VST = 72, KBYTES = 64 * KST * 2, VBYTES = 64 * VST * 2, HBY = KBYTES + VBYTES;
    const int lane = C.lane, hf = C.wave >> 2, wq = C.wave & 3, tid_h = C.tid & 255, fr = lane & 15, fq = lane >> 4;
    LAS float* tab = (LAS float*)(C.lds + 4 * HBY) + hf * 260;
    bf16x8 qf[DK / 32];
#pragma unroll
    for (int ks = 0; ks < DK / 32; ++ks) qf[ks] = *(const bf16x8*)(H.q + (size_t)(16 * wq + fr) * H.qld + 32 * ks + 8 * fq);
    f32x4 oacc[4];
#pragma unroll
    for (int d = 0; d < 4; ++d) oacc[d] = (f32x4){0.f, 0.f, 0.f, 0.f};
    float m_run = -1e30f, l_run = 0.f;
    u32x4 rk[2], rp = (u32x4){0u, 0u, 0u, 0u}, rv[2];
    const int NPI = SHARED ? 1 : 2, PSTR = SHARED ? 0 : 256, ptid = SHARED ? C.tid : tid_h, lcount = SHARED ? n_iter : H.count, hsl = SHARED ? 0 : hf;
#define ATT_GLOAD(t) do { if ((t) < lcount) { const bool sec = (t) >= H.split; const int tk = sec ? (t) - H.split : (t); \
        _Pragma("unroll") for (int i = 0; i < NPI; ++i) { const int p = ptid + PSTR * i; \
            { const int key = p >> 3, ch = p & 7; rk[i] = sec ? load8(H.kn2, (size_t)(tk * 64 + key) * H.kn2ld + 8 * ch, false) : load8(H.kn, (size_t)(tk * 64 + key) * H.knld + 8 * ch, H.kn_f32); } \
            { const int key = p & 63, dc = p >> 6; rv[i] = sec ? load8(H.v2, (size_t)(tk * 64 + key) * H.v2ld + 8 * dc, false) : load8(H.v, (size_t)(tk * 64 + key) * H.vld + 8 * dc, H.v_f32); } } \
        if (DK == 96 && (!SHARED || ptid < 256)) { const int key = (ptid & 255) >> 2, ch = ptid & 3; rp = *(const u32x4*)(H.kp + (size_t)((t) * 64 + key) * H.kpld + 8 * ch); } } } while (0)
#define ATT_SSTORE(t, buf) do { if ((t) < lcount) { LAS unsigned char* base = C.lds + ((buf) * 2 + hsl) * HBY; \
        _Pragma("unroll") for (int i = 0; i < NPI; ++i) { const int p = ptid + PSTR * i; \
            { const int key = p >> 3, ch = p & 7; *(LAS u32x4*)(base + (key * KST + 8 * ch) * 2) = rk[i]; } \
            { const int key = p & 63, dc = p >> 6; LAS bf16_t* vt = (LAS bf16_t*)(base + KBYTES) + (8 * dc) * VST + key; const u32x4 vv = rv[i]; \
              vt[0] = (bf16_t)(vv.x & 0xffffu); vt[VST] = (bf16_t)(vv.x >> 16); vt[2 * VST] = (bf16_t)(vv.y & 0xffffu); vt[3 * VST] = (bf16_t)(vv.y >> 16); \
              vt[4 * VST] = (bf16_t)(vv.z & 0xffffu); vt[5 * VST] = (bf16_t)(vv.z >> 16); vt[6 * VST] = (bf16_t)(vv.w & 0xffffu); vt[7 * VST] = (bf16_t)(vv.w >> 16); } } \
        if (DK == 96 && (!SHARED || ptid < 256)) { const int key = (ptid & 255) >> 2, ch = ptid & 3; *(LAS u32x4*)(base + (key * KST + 64 + 8 * ch) * 2) = rp; } } } while (0)
    ATT_GLOAD(0); ATT_SSTORE(0, 0);
    __syncthreads();
    for (int t = 0; t < n_iter; ++t) {
        ATT_GLOAD(t + 1);
        if (t < H.count) {
            const LAS unsigned char* base = C.lds + ((t & 1) * 2 + hsl) * HBY;
            f32x4 s[4];
#pragma unroll
            for (int mt = 0; mt < 4; ++mt) { s[mt] = (f32x4){0.f, 0.f, 0.f, 0.f};
#pragma unroll
                for (int ks = 0; ks < DK / 32; ++ks) { const bf16x8 a = *(const LAS bf16x8*)(base + ((16 * mt + fr) * KST + 32 * ks + 8 * fq) * 2); s[mt] = MFMA16(a, qf[ks], s[mt]); } }
            if (BIAS) { const int cd = H.cdiff0 - t, ql = 16 * wq + fr;
                if (cd >= 3) { const float bb = tab[256];
#pragma unroll
                    for (int mt = 0; mt < 4; ++mt) s[mt] = s[mt] + bb; }
                else {
#pragma unroll
                    for (int mt = 0; mt < 4; ++mt)
#pragma unroll
                        for (int i = 0; i < 4; ++i) { int rel = cd * 64 + ql - (16 * mt + 4 * fq + i); rel = rel > 128 ? 128 : rel; s[mt][i] += tab[rel + 128]; } } }
            float mx = s[0][0];
#pragma unroll
            for (int mt = 0; mt < 4; ++mt)
#pragma unroll
                for (int i = 0; i < 4; ++i) mx = fmaxf(mx, s[mt][i]);
            mx = fmaxf(mx, __shfl_xor(mx, 16)); mx = fmaxf(mx, __shfl_xor(mx, 32));
            const float mnew = fmaxf(m_run, mx), alpha = fexp2(m_run - mnew); m_run = mnew;
            float psum = 0.f;
#pragma unroll
            for (int mt = 0; mt < 4; ++mt)
#pragma unroll
                for (int i = 0; i < 4; ++i) { const float p = fexp2(s[mt][i] - mnew); s[mt][i] = p; psum += p; }
            l_run = l_run * alpha + psum;
#pragma unroll
            for (int d = 0; d < 4; ++d) oacc[d] = oacc[d] * alpha;
            bf16x8 pf[2];
#pragma unroll
            for (int kk = 0; kk < 2; ++kk) { u32x4 v; v.x = pk2(s[2 * kk][0], s[2 * kk][1]); v.y = pk2(s[2 * kk][2], s[2 * kk][3]); v.z = pk2(s[2 * kk + 1][0], s[2 * kk + 1][1]); v.w = pk2(s[2 * kk + 1][2], s[2 * kk + 1][3]); pf[kk] = as_frag(v); }
            const LAS bf16_t* vt = (const LAS bf16_t*)(base + KBYTES);
#pragma unroll
            for (int d = 0; d < 4; ++d)
#pragma unroll
                for (int kk = 0; kk < 2; ++kk) { const LAS bf16_t* vp = vt + (16 * d + fr) * VST + 32 * kk + 4 * fq;
                    const bf16x8 a = mk_frag(*(const LAS u32x2*)vp, *(const LAS u32x2*)(vp + 16)); oacc[d] = MFMA16(a, pf[kk], oacc[d]); }
        }
        ATT_SSTORE(t + 1, (t + 1) & 1);
        __syncthreads();
    }
#undef ATT_GLOAD
#undef ATT_SSTORE
    l_run += __shfl_xor(l_run, 16); l_run += __shfl_xor(l_run, 32);
    const float inv = 1.f / l_run;
#pragma unroll
    for (int d = 0; d < 4; ++d) { u32x2 w; w.x = pk2(oacc[d][0] * inv, oacc[d][1] * inv); w.y = pk2(oacc[d][2] * inv, oacc[d][3] * inv);
        *(u32x2*)(H.o + (size_t)(16 * wq + fr) * H.old_ + 16 * d + 4 * fq) = w; }
}

__device__ __forceinline__ void attn_core2(const Ctx& C, const AH& H, int n_iter) {
    constexpr int DK = 96, KST = DK + 8, VST = 72, KBYTES = 64 * KST * 2, VBYTES = 64 * VST * 2, HBY = KBYTES + VBYTES;
    const int lane = C.lane, fr = lane & 15, fq = lane >> 4, p = C.tid;
    bf16x8 qf[2][3];
#pragma unroll
    for (int sb = 0; sb < 2; ++sb)
#pragma unroll
        for (int ks = 0; ks < 3; ++ks) qf[sb][ks] = *(const bf16x8*)(H.q + (size_t)(16 * sb + fr) * H.qld + 32 * ks + 8 * fq);
    f32x4 oacc[2][4];
#pragma unroll
    for (int sb = 0; sb < 2; ++sb)
#pragma unroll
        for (int d = 0; d < 4; ++d) oacc[sb][d] = (f32x4){0.f, 0.f, 0.f, 0.f};
    float m_run[2] = {-1e30f, -1e30f}, l_run[2] = {0.f, 0.f};
    u32x4 rk[2], rp[2], rv[2];
    rp[0] = (u32x4){0u, 0u, 0u, 0u}; rp[1] = rp[0];
#define A2_GLOAD(t, R) do { if ((t) < n_iter) { \
        { const int key = p >> 3, ch = p & 7; rk[R] = *(const u32x4*)((const bf16_t*)H.kn + (size_t)((t) * 64 + key) * H.knld + 8 * ch); } \
        { const int key = p & 63, dc = p >> 6; rv[R] = *(const u32x4*)((const bf16_t*)H.v + (size_t)((t) * 64 + key) * H.vld + 8 * dc); } \
        if (p < 256) { const int key = p >> 2, ch = p & 3; rp[R] = *(const u32x4*)(H.kp + (size_t)((t) * 64 + key) * H.kpld + 8 * ch); } } } while (0)
#define A2_SSTORE(t, buf, R) do { if ((t) < n_iter) { LAS unsigned char* base = C.lds + (buf) * HBY; \
        { const int key = p >> 3, ch = p & 7; *(LAS u32x4*)(base + (key * KST + 8 * ch) * 2) = rk[R]; } \
        { const int key = p & 63, dc = p >> 6; LAS bf16_t* vt = (LAS bf16_t*)(base + KBYTES) + (8 * dc) * VST + key; const u32x4 vv = rv[R]; \
          vt[0] = (bf16_t)(vv.x & 0xffffu); vt[VST] = (bf16_t)(vv.x >> 16); vt[2 * VST] = (bf16_t)(vv.y & 0xffffu); vt[3 * VST] = (bf16_t)(vv.y >> 16); \
          vt[4 * VST] = (bf16_t)(vv.z & 0xffffu); vt[5 * VST] = (bf16_t)(vv.z >> 16); vt[6 * VST] = (bf16_t)(vv.w & 0xffffu); vt[7 * VST] = (bf16_t)(vv.w >> 16); } \
        if (p < 256) { const int key = p >> 2, ch = p & 3; *(LAS u32x4*)(base + (key * KST + 64 + 8 * ch) * 2) = rp[R]; } } } while (0)
#define A2_COMPUTE(t, BUF) do { if ((t) < H.count) { \
            const LAS unsigned char* base = C.lds + (BUF) * HBY; \
            f32x4 s[2][4]; \
            _Pragma("unroll") for (int mt = 0; mt < 4; ++mt) { s[0][mt] = (f32x4){0.f, 0.f, 0.f, 0.f}; s[1][mt] = (f32x4){0.f, 0.f, 0.f, 0.f}; \
                _Pragma("unroll") for (int ks = 0; ks < 3; ++ks) { const bf16x8 a = *(const LAS bf16x8*)(base + ((16 * mt + fr) * KST + 32 * ks + 8 * fq) * 2); \
                    s[0][mt] = MFMA16(a, qf[0][ks], s[0][mt]); s[1][mt] = MFMA16(a, qf[1][ks], s[1][mt]); } } \
            bf16x8 pf[2][2]; \
            _Pragma("unroll") for (int sb = 0; sb < 2; ++sb) { \
                float mx = s[sb][0][0]; \
                _Pragma("unroll") for (int mt = 0; mt < 4; ++mt) _Pragma("unroll") for (int i = 0; i < 4; ++i) mx = fmaxf(mx, s[sb][mt][i]); \
                mx = fmaxf(mx, __shfl_xor(mx, 16)); mx = fmaxf(mx, __shfl_xor(mx, 32)); \
                const float mnew = fmaxf(m_run[sb], mx), alpha = fexp2(m_run[sb] - mnew); m_run[sb] = mnew; \
                float psum = 0.f; \
                _Pragma("unroll") for (int mt = 0; mt < 4; ++mt) _Pragma("unroll") for (int i = 0; i < 4; ++i) { const float pp = fexp2(s[sb][mt][i] - mnew); s[sb][mt][i] = pp; psum += pp; } \
                l_run[sb] = l_run[sb] * alpha + psum; \
                _Pragma("unroll") for (int d = 0; d < 4; ++d) oacc[sb][d] = oacc[sb][d] * alpha; \
                _Pragma("unroll") for (int kk = 0; kk < 2; ++kk) { u32x4 v; v.x = pk2(s[sb][2 * kk][0], s[sb][2 * kk][1]); v.y = pk2(s[sb][2 * kk][2], s[sb][2 * kk][3]); v.z = pk2(s[sb][2 * kk + 1][0], s[sb][2 * kk + 1][1]); v.w = pk2(s[sb][2 * kk + 1][2], s[sb][2 * kk + 1][3]); pf[sb][kk] = as_frag(v); } \
            } \
            const LAS bf16_t* vt = (const LAS bf16_t*)(base + KBYTES); \
            _Pragma("unroll") for (int d = 0; d < 4; ++d) _Pragma("unroll") for (int kk = 0; kk < 2; ++kk) { const LAS bf16_t* vp = vt + (16 * d + fr) * VST + 32 * kk + 4 * fq; \
                    const bf16x8 a = mk_frag(*(const LAS u32x2*)vp, *(const LAS u32x2*)(vp + 16)); \
                    oacc[0][d] = MFMA16(a, pf[0][kk], oacc[0][d]); oacc[1][d] = MFMA16(a, pf[1][kk], oacc[1][d]); } \
        } } while (0)
    A2_GLOAD(0, 0); A2_SSTORE(0, 0, 0); A2_GLOAD(1, 1);
    __syncthreads();
    for (int t = 0; t < n_iter; t += 2) {
        A2_GLOAD(t + 2, 0); A2_COMPUTE(t, 0); A2_SSTORE(t + 1, 1, 1); __syncthreads();
        A2_GLOAD(t + 3, 1); A2_COMPUTE(t + 1, 1); A2_SSTORE(t + 2, 0, 0); __syncthreads();
    }
#undef A2_COMPUTE
#undef A2_GLOAD
#undef A2_SSTORE
#pragma unroll
    for (int sb = 0; sb < 2; ++sb) { float l = l_run[sb]; l += __shfl_xor(l, 16); l += __shfl_xor(l, 32);
        const float inv = 1.f / l;
#pragma unroll
        for (int d = 0; d < 4; ++d) { u32x2 w; w.x = pk2(oacc[sb][d][0] * inv, oacc[sb][d][1] * inv); w.y = pk2(oacc[sb][d][2] * inv, oacc[sb][d][3] * inv);
            *(u32x2*)(H.o + (size_t)(16 * sb + fr) * H.old_ + 16 * d + 4 * fq) = w; } }
}

constexpr int N_MLAP = 512, N_S3 = 288, N_MLAS = 128, N_BANDP = 1024, N_BANDS = 128, N_P5 = N_MLAP + N_S3 + N_MLAS + N_BANDP + N_BANDS;
#ifndef P5SEL
#define P5SEL 7
#endif
__device__ __forceinline__ void p5_unit(const Ctx& C, int idx) {
    const int hf = C.wave >> 2, l = C.l;
    AH H; H.split = 1 << 30; H.kn2 = nullptr; H.kn2ld = 0; H.v2 = nullptr; H.v2ld = 0; H.kn_f32 = false; H.v_f32 = false; H.kp = nullptr; H.kpld = 0; H.cdiff0 = 0;
    if (idx < N_MLAP) {
        const int q4 = 31 - (idx >> 4), b = (idx >> 3) & 1, h = idx & 7, c = 4 * q4 + (C.wave >> 1); const size_t row0 = (size_t)b * TP + c * 64 + 32 * (C.wave & 1);
        H.q = WSB(WS_Q) + row0 * 768 + h * 96; H.qld = 768; H.o = WSB(WS_YBC) + row0 * 1024 + h * 64; H.old_ = 1024;
        H.kn = WSB(WS_KVP) + (size_t)b * TP * 1024 + h * 64; H.knld = 1024; H.kp = WSB(WS_KPEP) + (size_t)b * TP * 32; H.kpld = 32;
        H.v = WSB(WS_KVP) + (size_t)b * TP * 1024 + 512 + h * 64; H.vld = 1024; H.count = c + 1;
        if (P5SEL & 1) attn_core2(C, H, 4 * q4 + 4); return;
    }
    idx -= N_MLAP;
    if (idx < N_S3) { if (P5SEL & 2) ssd_s3_item(C, idx); return; }
    idx -= N_S3;
    if (idx < N_MLAS) {
        const int b = idx >> 2, h = (idx & 3) * 2 + hf; const size_t row0 = (size_t)NP + b * 64;
        H.q = WSB(WS_Q) + row0 * 768 + h * 96; H.qld = 768; H.o = WSB(WS_YBC) + row0 * 1024 + h * 64; H.old_ = 1024;
        H.kn = WSB(WS_XR) + (size_t)b * KS_ALL * 1024 + h * 64; H.knld = 1024; H.kp = WSB(WS_KPES) + (size_t)b * KS_ALL * 32; H.kpld = 32;
        H.v = WSB(WS_XR) + (size_t)b * KS_ALL * 1024 + 512 + h * 64; H.vld = 1024; H.count = 33;
        if (P5SEL & 1) attn_core<96, false, false>(C, H, 33); return;
    }
    idx -= N_MLAS;
    constexpr int HBY64 = 64 * 72 * 2 * 2;
    if (idx < N_BANDP) {
        const int cp = idx >> 4, b = (idx >> 3) & 1, h = idx & 7, c = 2 * cp + hf, kt0 = c > 8 ? c - 8 : 0; const size_t row0 = (size_t)b * TP + c * 64;
        LAS float* tab = (LAS float*)(C.lds + 4 * HBY64) + hf * 260; const float* rb = INL(32, 8 * 257) + h * 257;
        for (int i = C.tid & 255; i < 257; i += 256) tab[i] = rb[i] * LOG2E;
        H.q = WSB(WS_PD) + row0 * 1536 + h * 64; H.qld = 1536; H.o = WSB(WS_PD) + row0 * 1536 + h * 64; H.old_ = 1536;
        H.kn = WSB(WS_PD) + ((size_t)b * TP + kt0 * 64) * 1536 + 512 + h * 64; H.knld = 1536;
        H.v = WSB(WS_PD) + ((size_t)b * TP + kt0 * 64) * 1536 + 1024 + h * 64; H.vld = 1536; H.count = c - kt0 + 1; H.cdiff0 = c - kt0;
        const int c1 = 2 * cp + 1;
        if (P5SEL & 4) attn_core<64, true, false>(C, H, (c1 > 8 ? 8 : c1) + 1); return;
    }
    idx -= N_BANDP;
    {
        const int b = idx >> 2, h = (idx & 3) * 2 + hf; const size_t row0 = (size_t)NP + b * 64;
        LAS float* tab = (LAS float*)(C.lds + 4 * HBY64) + hf * 260; const float* rb = INL(32, 8 * 257) + h * 257;
        for (int i = C.tid & 255; i < 257; i += 256) tab[i] = rb[i] * LOG2E;
        H.q = WSB(WS_PD) + row0 * 1536 + h * 64; H.qld = 1536; H.o = WSB(WS_PD) + row0 * 1536 + h * 64; H.old_ = 1536;
        H.kn = INL(7, (size_t)BS * 512 * 512) + (size_t)b * 512 * 512 + h * 64; H.knld = 512; H.kn_f32 = true;
        H.v = INL(8, (size_t)BS * 512 * 512) + (size_t)b * 512 * 512 + h * 64; H.vld = 512; H.v_f32 = true;
        H.split = 8; H.kn2 = WSB(WS_PD) + row0 * 1536 + 512 + h * 64; H.kn2ld = 1536; H.v2 = WSB(WS_PD) + row0 * 1536 + 1024 + h * 64; H.v2ld = 1536;
        H.count = 9; H.cdiff0 = 8;
        if (P5SEL & 4) attn_core<64, true, false>(C, H, 9);
    }
}

__global__ void __launch_bounds__(NTHREADS) mk_fwd(Args args) {
    extern __shared__ __attribute__((aligned(16))) unsigned char lds_raw[];
    cg::grid_group grid = cg::this_grid();
    Ctx C;
    C.A = &args;
    C.out = args.out; C.ws = args.ws; C.lds = (LAS unsigned char*)lds_raw;
    C.tid = threadIdx.x; C.lane = C.tid & 63; C.wave = __builtin_amdgcn_readfirstlane(C.tid >> 6);
    C.G = gridDim.x; C.bid = blockIdx.x; C.gw = C.bid * NWAVES + C.wave; C.NGW = C.G * NWAVES;
    unsigned* ctl = (unsigned*)(C.ws + WS_CTL);
    LAS int* sIdx = (LAS int*)(C.lds + LDS_BYTES - 16);
#ifndef PMASK
#define PMASK 0xFFF
#endif
#define REFRESH() do { int t_ = threadIdx.x; asm volatile("" : "+v"(t_)); C.tid = t_; C.lane = t_ & 63; C.wave = __builtin_amdgcn_readfirstlane(t_ >> 6); C.gw = C.bid * NWAVES + C.wave; GAS unsigned char* w_ = (GAS unsigned char*)args.ws; asm volatile("" : "+s"(w_)); C.ws = (unsigned char*)w_; GAS float* o_ = (GAS float*)args.out; asm volatile("" : "+s"(o_)); C.out = (float*)o_; } while (0)
#define PH_BEGIN(n) if ((PMASK >> (n)) & 1) { REFRESH();
#define PH_END } grid.sync();
#pragma unroll 1
    for (int l = 0; l < 2; ++l) {
        C.l = l;
        PH_BEGIN(0)
            if (C.bid == 0 && C.tid == 0) { ctl[l] = 0u; ctl[2 + l] = 0u; }
            { const size_t gt = (size_t)C.bid * NTHREADS + C.tid, GT = (size_t)C.G * NTHREADS; for (size_t i = gt; i < (size_t)R; i += GT) ((float*)(C.ws + WS_SUMSQ))[i] = 0.f; }
            phase_wprep(C);
            phase_norm(C, INL(9, 1024), l > 0);
        PH_END
        PH_BEGIN(1)
            SchedInproj S{WSB(WS_HB), WSB(WS_WT_IN), WSB(WS_PA), WSB(WS_ZB), WSB(WS_XR), WSB(WS_PD), C.G, C.bid};
            pg8::EpiStore E; pg8::gemm_phase(C.lds, S, E, C.tid);
        PH_END
        PH_BEGIN(2)
            phase_mla_prep(C); phase_band_prep(C); phase_sconv(C);
            for (int it = C.G - 1 - C.bid; it < N_S3; it += C.G) { REFRESH(); ssd_s1_item(C, it); }
        PH_END
        PH_BEGIN(3)
            ssd_scan(C);
            SchedP3 S{WSB(WS_ZB), WSB(WS_WT_QUP), WSB(WS_CKVP), WSB(WS_CKVS), WSB(WS_WT_KVUP), WSB(WS_Q), WSB(WS_KVP), WSB(WS_XR), C.G, C.bid};
            pg8::EpiStore E; pg8::gemm_phase(C.lds, S, E, C.tid);
        PH_END
        PH_BEGIN(4)
            phase_qk_post(C);
        PH_END
        PH_BEGIN(5)
            for (;;) {
                if (C.tid == 0) *sIdx = (int)atomicAdd(&ctl[l], 1u);
                __syncthreads();
                const int idx = *sIdx;
                __syncthreads();
                if (idx >= N_P5) break;
                REFRESH();
                p5_unit(C, idx);
            }
        PH_END
        PH_BEGIN(7)
            SchedMerge S{WSB(WS_HB), WSB(WS_WT_G), WSB(WS_WT_OUT), WSB(WS_PA), WSB(WS_YBC), WSB(WS_PD), C.G, C.bid};
            pg8::EpiMerge E{INL(11, 4096), WSB(WS_ZB), WSB(WS_XR)}; pg8::gemm_phase(C.lds, S, E, C.tid);
        PH_END
        PH_BEGIN(8)
            SchedOne S{WSB(WS_ZB), WSB(WS_WT_O), nullptr, 1024, 1024, 0, 72, 4, 16, C.G, C.bid};
            pg8::EpiResidNorm E{l > 0 ? C.out : IN0(0), l > 0 ? C.out + (size_t)NP * DM : IN0(1), C.out, WSB(WS_HB), INL(35, 1024), (float*)(C.ws + WS_SUMSQ)}; pg8::gemm_phase(C.lds, S, E, C.tid);
        PH_END
        PH_BEGIN(10)
            SchedOne S{WSB(WS_HB), WSB(WS_WT_UP), nullptr, 1024, 1024, 0, 72, 22, 16, C.G, C.bid};
            pg8::EpiSwigluNorm E{WSB(WS_XR), (const float*)(C.ws + WS_SUMSQ)}; pg8::gemm_phase(C.lds, S, E, C.tid);
        PH_END
        PH_BEGIN(11)
            SchedOne S{WSB(WS_XR), WSB(WS_WT_DOWN), nullptr, 2816, 2816, 0, 72, 4, 44, C.G, C.bid};
            pg8::EpiResid E{C.out, C.out + (size_t)NP * DM, C.out}; pg8::gemm_phase(C.lds, S, E, C.tid);
        PH_END
    }
}

extern "C" void kernel_launch(void* const* d_in, const int* in_sizes, int n_in, void* d_out, int out_size, void* d_ws, size_t ws_size, hipStream_t stream) {
    static int grid = 0;
    if (grid == 0) {
        int dev = 0, cus = 0, per_cu = 0;
        (void)hipGetDevice(&dev);
        (void)hipDeviceGetAttribute(&cus, hipDeviceAttributeMultiprocessorCount, dev);
        (void)hipFuncSetAttribute((const void*)mk_fwd, hipFuncAttributeMaxDynamicSharedMemorySize, LDS_BYTES);
        (void)hipOccupancyMaxActiveBlocksPerMultiprocessor(&per_cu, (const void*)mk_fwd, NTHREADS, LDS_BYTES);
        if (per_cu < 1) per_cu = 1;
        grid = cus * per_cu;
        if (ws_size < WS_END || n_in != 38 || (size_t)out_size != O_END) { fprintf(stderr, "kernel_launch: bad sizes ws %zu n_in %d out %d\n", ws_size, n_in, out_size); grid = -1; }
    }
    if (grid < 0) return;
    Args a{};
    for (int i = 0; i < 38; ++i) a.in[i] = (const float*)d_in[i];
    a.out = (float*)d_out; a.ws = (unsigned char*)d_ws; a.ph_lo = 0; a.ph_hi = 1000;
    void* kargs[] = {&a};
    hipError_t e = hipLaunchCooperativeKernel((const void*)mk_fwd, dim3(grid), dim3(NTHREADS), kargs, LDS_BYTES, stream);
    if (e != hipSuccess) fprintf(stderr, "cooperative launch failed: %s (grid %d)\n", hipGetErrorString(e), grid);
}
```

```cpp
#include <hip/hip_runtime.h>
#include <hip/hip_cooperative_groups.h>
#include <cstdio>
#include <cstdint>
namespace cg = cooperative_groups;

#define LAS __attribute__((address_space(3)))
#define GAS __attribute__((address_space(1)))
typedef unsigned short bf16_t;
typedef short bf16x8 __attribute__((ext_vector_type(8)));
typedef float f32x4 __attribute__((ext_vector_type(4)));
typedef unsigned u32x4 __attribute__((ext_vector_type(4)));
typedef unsigned u32x2 __attribute__((ext_vector_type(2)));

constexpr int NTHREADS = 512, NWAVES = 8;
constexpr int LDS_BYTES = 155648;
constexpr int NP = 16384, NS = 2048, R = NP + NS;
constexpr int TP = 8192, TS = 64, BP = 2, BS = 32, PAST = 2048, KS_ALL = PAST + TS;
constexpr int DM = 1024, FF = 2816;
constexpr int IN_COLS = 9384;
constexpr float EPS = 1e-6f;
constexpr float LOG2E = 1.4426950408889634f;

constexpr size_t O_Y = 0;
constexpr size_t O_SSM_P = (size_t)R * DM;
constexpr size_t O_SSM_S = O_SSM_P + 262144;
constexpr size_t O_CONV_P = O_SSM_S + 4194304;
constexpr size_t O_CONV_S = O_CONV_P + 12288;
constexpr size_t O_CKV_P = O_CONV_S + 196608;
constexpr size_t O_CKV_S = O_CKV_P + 8388608;
constexpr size_t O_KPE_P = O_CKV_S + 1048576;
constexpr size_t O_KPE_S = O_KPE_P + 1048576;
constexpr size_t O_SC_P = O_KPE_S + 131072;
constexpr size_t O_SC_S = O_SC_P + 4096;
constexpr size_t O_BK_P = O_SC_S + 65536;
constexpr size_t O_BK_S = O_BK_P + 1048576;
constexpr size_t O_BV_P = O_BK_S + 16777216;
constexpr size_t O_BV_S = O_BV_P + 1048576;
constexpr size_t O_END = O_BV_S + 16777216;

constexpr size_t al256(size_t x) { return (x + 255) & ~(size_t)255; }
constexpr size_t WS_CTL = 0;
constexpr size_t WS_DECAY = 4096;
constexpr size_t WS_SUMSQ = 16384;
constexpr size_t WS_WT_IN = 131072;
constexpr size_t WS_WT_G = WS_WT_IN + (size_t)5376 * 1024 * 2;
constexpr size_t WS_WT_QUP = WS_WT_G + (size_t)4096 * 1024 * 2;
constexpr size_t WS_WT_KVUP = WS_WT_QUP + (size_t)768 * 384 * 2;
constexpr size_t WS_WT_OUT = WS_WT_KVUP + (size_t)1024 * 256 * 2;
constexpr size_t WS_WT_O = WS_WT_OUT + (size_t)4 * 1024 * 1024 * 2;
constexpr size_t WS_WT_UP = WS_WT_O + (size_t)1024 * 1024 * 2;
constexpr size_t WS_WT_DOWN = WS_WT_UP + (size_t)5632 * 1024 * 2;
constexpr size_t WS_HB = al256(WS_WT_DOWN + (size_t)1024 * 2816 * 2);
constexpr size_t WS_PA = WS_HB + (size_t)R * 1024 * 2;
constexpr size_t WS_PD = WS_PA + (size_t)R * 1536 * 2;
constexpr size_t WS_ZB = WS_PD + (size_t)R * 1536 * 2;
constexpr size_t WS_CKVP = WS_ZB + (size_t)R * 768 * 2;
constexpr size_t WS_XR = WS_ZB + (size_t)R * 1024 * 2;
constexpr size_t WS_Q = WS_XR + (size_t)67584 * 1024 * 2;
constexpr size_t WS_KPEP = WS_Q + (size_t)R * 768 * 2;
constexpr size_t WS_KPES = WS_KPEP + (size_t)16384 * 32 * 2;
constexpr size_t WS_KVP = WS_KPES + (size_t)67584 * 32 * 2;
constexpr size_t WS_STATES = WS_KVP + (size_t)16384 * 1024 * 2;
constexpr size_t WS_YBC = WS_STATES + (size_t)2048 * 64 * 128 * 2;
constexpr size_t WS_CKVS = WS_YBC + (size_t)R * 1024 * 2;
constexpr size_t WS_END = WS_CKVS + (size_t)67584 * 256 * 2;
static_assert(WS_END < (size_t)553000000, "ws map too large");
static_assert((size_t)R * 768 * 2 + (size_t)16384 * 256 * 2 <= (size_t)R * 1024 * 2, "ZB");
static_assert((size_t)67584 * 256 * 2 <= (size_t)R * 1024 * 2, "ckvS in HB");

typedef float f32x2_g __attribute__((ext_vector_type(2)));
typedef __bf16 bf16x2_g __attribute__((ext_vector_type(2)));
__device__ __forceinline__ unsigned pk2(float lo, float hi) { f32x2_g v = {lo, hi}; bf16x2_g b = __builtin_convertvector(v, bf16x2_g); return __builtin_bit_cast(unsigned, b); }
__device__ __forceinline__ unsigned f2bf(float f) { return pk2(f, 0.f) & 0xffffu; }
__device__ __forceinline__ float bflo(unsigned u) { return __builtin_bit_cast(float, u << 16); }
__device__ __forceinline__ float bfhi(unsigned u) { return __builtin_bit_cast(float, u & 0xffff0000u); }
__device__ __forceinline__ float bf1(bf16_t h) { return __builtin_bit_cast(float, (unsigned)h << 16); }
__device__ __forceinline__ float fexp2(float x) { return __builtin_amdgcn_exp2f(x); }
__device__ __forceinline__ float fexp(float x) { return __builtin_amdgcn_exp2f(x * LOG2E); }
__device__ __forceinline__ float frcp(float x) { return __builtin_amdgcn_rcpf(x); }
__device__ __forceinline__ float sigmoidf_(float x) { return frcp(1.f + fexp(-x)); }
__device__ __forceinline__ float siluf_(float x) { return x * sigmoidf_(x); }
__device__ __forceinline__ float wave_sum(float v) {
#pragma unroll
    for (int o = 1; o < 64; o <<= 1) v += __shfl_xor(v, o);
    return v;
}
#define LDS_WAIT() asm volatile("s_waitcnt lgkmcnt(0)" ::: "memory")
__device__ __forceinline__ void unpack8(u32x4 v, float* f) {
    f[0] = bflo(v.x); f[1] = bfhi(v.x); f[2] = bflo(v.y); f[3] = bfhi(v.y); f[4] = bflo(v.z); f[5] = bfhi(v.z); f[6] = bflo(v.w); f[7] = bfhi(v.w);
}
__device__ __forceinline__ u32x4 pack8(const float* f) { u32x4 o; o.x = pk2(f[0], f[1]); o.y = pk2(f[2], f[3]); o.z = pk2(f[4], f[5]); o.w = pk2(f[6], f[7]); return o; }
__device__ __forceinline__ u32x4 load8(const void* base, size_t idx, bool is_f32) {
    if (is_f32) { const f32x4* p = (const f32x4*)((const float*)base + idx); f32x4 a = p[0], b = p[1];
        u32x4 o; o.x = pk2(a.x, a.y); o.y = pk2(a.z, a.w); o.z = pk2(b.x, b.y); o.w = pk2(b.z, b.w); return o; }
    return *(const u32x4*)((const bf16_t*)base + idx);
}

namespace pg8 {
constexpr int BM = 256, BK = 64, HALF = 128, HTB = HALF * BK * 2, STAGE_BYTES = 8 * HTB, NXCD = 8, WGM = 8;
__device__ __forceinline__ int lds_byte(int r, int c) { const int st = (r >> 4) * 2 + (c >> 5), rr = r & 15, cc = c & 31, ob = rr * 64 + cc * 2; return st * 1024 + (ob ^ (((ob >> 9) & 1) << 5)); }
__device__ __forceinline__ void stage_rc(int b, int& Rr, int& C) { const int st = b / 1024, sb = b % 1024, swz = sb ^ (((sb >> 9) & 1) << 5); Rr = (st >> 1) * 16 + swz / 64; C = (st & 1) * 32 + (swz % 64) / 2; }
__device__ __forceinline__ int perm32(int rho) { const int n = rho >> 4, i = rho & 15; return 8 * (i >> 2) + 4 * n + (i & 3); }

struct GUnit { const bf16_t* A; const bf16_t* B; int lda, ldb, nt; int pm, pn, sub; bf16_t* C; int ldc; };

__device__ __forceinline__ void tile_map(int L, int nM, int nN, int& pm, int& pn) {
    const int nwg = nM * nN; int wgid = L;
    { const int q = nwg / NXCD, r = nwg % NXCD, xcd = wgid % NXCD, off = wgid / NXCD; wgid = (xcd < r ? xcd * (q + 1) : r * (q + 1) + (xcd - r) * q) + off; }
    const int nig = WGM * nN, gid = wgid / nig, fm = gid * WGM, gsz = (nM - fm) < WGM ? (nM - fm) : WGM;
    pm = fm + ((wgid % nig) % gsz); pn = (wgid % nig) / gsz;
}
typedef float f32x2_t __attribute__((ext_vector_type(2)));
typedef __bf16 bf16x2_t __attribute__((ext_vector_type(2)));
__device__ __forceinline__ unsigned cvt_pk_bf16(float lo, float hi) { f32x2_t v = {lo, hi}; bf16x2_t b = __builtin_convertvector(v, bf16x2_t); return __builtin_bit_cast(unsigned, b); }

template <class Epi, class Sched>
__device__ __forceinline__ void gemm_phase(LAS unsigned char* lds, const Sched& S, Epi& E, int tid) {
    const int wid = __builtin_amdgcn_readfirstlane(tid >> 6), lane = tid & 63, wr = wid >> 2, wc = wid & 3, fr = lane & 15, fq = lane >> 4;
    int RA[2], RB[2], CC[2];
#pragma unroll
    for (int i = 0; i < 2; ++i) { int Rr, C; stage_rc(tid * 16 + i * 8192, Rr, C); RA[i] = Rr; RB[i] = (Rr & ~31) + perm32(Rr & 31); CC[i] = C; }
    const size_t kstep = (size_t)(BK * 2);
    const unsigned ldsw = (unsigned)wid * 1024u;
    const int aoff = lds_byte(wr * 64 + fr, fq * 8), boff = lds_byte(wc * 32 + fr, fq * 8);
#define PG8_SA(b, h) (((b) * 2 + (h)) * HTB)
#define PG8_SB(b, h) ((4 + (b) * 2 + (h)) * HTB)
#define PG8_STAGE(bufoff, gbase, v0, v1) do { \
        __builtin_amdgcn_global_load_lds((const unsigned*)((const char*)(gbase) + (v0)), (LAS unsigned*)(lds + (bufoff) + ldsw), 16, 0, 0); \
        __builtin_amdgcn_global_load_lds((const unsigned*)((const char*)(gbase) + (v1)), (LAS unsigned*)(lds + (bufoff) + ldsw + 8192), 16, 0, 0); } while (0)
#define PG8_LDA(dst, b, h) do { _Pragma("unroll") for (int m = 0; m < 4; ++m) _Pragma("unroll") for (int k = 0; k < 2; ++k) dst[m][k] = *(const LAS bf16x8*)(lds + PG8_SA(b, h) + aoff + m * 2048 + k * 1024); } while (0)
#define PG8_LDB(dst, b, h) do { _Pragma("unroll") for (int n = 0; n < 2; ++n) _Pragma("unroll") for (int k = 0; k < 2; ++k) dst[n][k] = *(const LAS bf16x8*)(lds + PG8_SB(b, h) + boff + n * 2048 + k * 1024); } while (0)
#define PG8_MMA(ai, bj, At, Bt) do { __builtin_amdgcn_s_setprio(1); _Pragma("unroll") for (int m = 0; m < 4; ++m) _Pragma("unroll") for (int n = 0; n < 2; ++n) _Pragma("unroll") for (int k = 0; k < 2; ++k) \
        acc[ai][bj][m][n] = __builtin_amdgcn_mfma_f32_16x16x32_bf16(Bt[n][k], At[m][k], acc[ai][bj][m][n], 0, 0, 0); __builtin_amdgcn_s_setprio(0); } while (0)
#define PG8_WAIT_V(n) asm volatile("s_waitcnt vmcnt(" #n ")" ::: "memory")
#define PG8_WAIT_L(n) asm volatile("s_waitcnt lgkmcnt(" #n ")" ::: "memory")
#define PG8_BAR __builtin_amdgcn_s_barrier()
#define PG8_SCHED __builtin_amdgcn_sched_barrier(0)
    GUnit cur, nxt; int ui = 0;
    if (!S.next(0, cur)) return;
    f32x4 acc[2][2][4][2];
#pragma unroll
    for (int a = 0; a < 2; ++a)
#pragma unroll
        for (int b = 0; b < 2; ++b)
#pragma unroll
            for (int m = 0; m < 4; ++m)
#pragma unroll
                for (int n = 0; n < 2; ++n) acc[a][b][m][n] = (f32x4){0.f, 0.f, 0.f, 0.f};
    bf16x8 At[4][2], B0[2][2], B1[2][2];
    const char* cA = (const char*)cur.A; const char* cB = (const char*)cur.B;
    int clda = cur.lda, cldb = cur.ldb;
#define VA0(ld) ((unsigned)(RA[0] * (ld) + CC[0]) * 2u)
#define VA1(ld) ((unsigned)(RA[1] * (ld) + CC[1]) * 2u)
#define VB0(ld) ((unsigned)(RB[0] * (ld) + CC[0]) * 2u)
#define VB1(ld) ((unsigned)(RB[1] * (ld) + CC[1]) * 2u)
    unsigned vAc0 = VA0(clda), vAc1 = VA1(clda), vBc0 = VB0(cldb), vBc1 = VB1(cldb);
    size_t hsAc = (size_t)HALF * clda * 2, hsBc = (size_t)HALF * cldb * 2;
    PG8_STAGE(PG8_SB(0, 0), cB, vBc0, vBc1); PG8_STAGE(PG8_SB(0, 1), cB + hsBc, vBc0, vBc1); PG8_STAGE(PG8_SA(0, 0), cA, vAc0, vAc1); PG8_STAGE(PG8_SA(0, 1), cA + hsAc, vAc0, vAc1);
    if (wr == 1) PG8_BAR;
    PG8_WAIT_V(2); PG8_BAR;
    PG8_STAGE(PG8_SB(1, 0), cB + kstep, vBc0, vBc1); PG8_STAGE(PG8_SA(1, 0), cA + kstep, vAc0, vAc1); PG8_STAGE(PG8_SB(1, 1), cB + hsBc + kstep, vBc0, vBc1);
    PG8_WAIT_V(6); PG8_BAR;
    for (;;) {
        const bool has_next = S.next(ui + 1, nxt);
        const char* nA = has_next ? (const char*)nxt.A : cA; const char* nB = has_next ? (const char*)nxt.B : cB;
        const int nlda = has_next ? nxt.lda : cur.lda, nldb = has_next ? nxt.ldb : cur.ldb;
        const size_t hsAn = (size_t)HALF * nlda * 2, hsBn = (size_t)HALF * nldb * 2;
        const int nt = cur.nt;
        for (int t = 0; t < nt; t += 2) {
            const bool last = (t == nt - 2);
            const char* a1 = cA + (size_t)(t + 1) * kstep;
            const char* a2 = last ? nA : cA + (size_t)(t + 2) * kstep; const char* b2 = last ? nB : cB + (size_t)(t + 2) * kstep;
            const char* a3 = a2 + kstep; const char* b3 = b2 + kstep;
            const int lda2 = last ? nlda : clda, ldb2 = last ? nldb : cldb;
            const unsigned vA0 = VA0(lda2), vA1 = VA1(lda2), vB0 = VB0(ldb2), vB1 = VB1(ldb2);
            vAc0 = VA0(clda); vAc1 = VA1(clda);
            const size_t hsA2 = last ? hsAn : hsAc, hsB2 = last ? hsBn : hsBc;
            PG8_LDB(B0, 0, 0); PG8_LDB(B1, 0, 1); PG8_SCHED; PG8_LDA(At, 0, 0); PG8_STAGE(PG8_SA(1, 1), a1 + hsAc, vAc0, vAc1);
            PG8_WAIT_V(8); PG8_WAIT_L(0); PG8_BAR; PG8_MMA(0, 0, At, B0); PG8_MMA(0, 1, At, B1); PG8_BAR; PG8_SCHED;
            PG8_LDA(At, 0, 1); PG8_STAGE(PG8_SB(0, 0), b2, vB0, vB1); PG8_STAGE(PG8_SB(0, 1), b2 + hsB2, vB0, vB1); PG8_STAGE(PG8_SA(0, 0), a2, vA0, vA1);
            PG8_WAIT_V(8); PG8_WAIT_L(0); PG8_BAR; PG8_MMA(1, 0, At, B0); PG8_MMA(1, 1, At, B1); PG8_BAR; PG8_SCHED;
            PG8_LDB(B0, 1, 0); PG8_LDB(B1, 1, 1); PG8_SCHED; PG8_LDA(At, 1, 0); PG8_STAGE(PG8_SA(0, 1), a2 + hsA2, vA0, vA1);
            PG8_WAIT_V(8); PG8_WAIT_L(0); PG8_BAR; PG8_MMA(0, 0, At, B0); PG8_MMA(0, 1, At, B1); PG8_BAR; PG8_SCHED;
            PG8_LDA(At, 1, 1); PG8_STAGE(PG8_SB(1, 0), b3, vB0, vB1); PG8_STAGE(PG8_SB(1, 1), b3 + hsB2, vB0, vB1); PG8_STAGE(PG8_SA(1, 0), a3, vA0, vA1);
            PG8_WAIT_V(8); PG8_WAIT_L(0); PG8_BAR; PG8_MMA(1, 0, At, B0); PG8_MMA(1, 1, At, B1); PG8_BAR; PG8_SCHED;
        }
        if (wr == 0) PG8_BAR;
        const bool clear = E(acc, cur, wr, wc, fr, fq);
        if (!has_next) break;
        if (clear) {
#pragma unroll
        for (int a = 0; a < 2; ++a)
#pragma unroll
            for (int b = 0; b < 2; ++b)
#pragma unroll
                for (int m = 0; m < 4; ++m)
#pragma unroll
                    for (int n = 0; n < 2; ++n) acc[a][b][m][n] = (f32x4){0.f, 0.f, 0.f, 0.f};
        }
        cur = nxt; cA = nA; cB = nB; ++ui;
        clda = nlda; cldb = nldb; vAc0 = VA0(clda); vAc1 = VA1(clda); hsAc = hsAn; hsBc = hsBn;
        if (wr == 1) PG8_BAR;
    }
    PG8_WAIT_V(0);
    PG8_BAR;
#undef VA0
#undef VA1
#undef VB0
#undef VB1
#undef PG8_SA
#undef PG8_SB
#undef PG8_STAGE
#undef PG8_LDA
#undef PG8_LDB
#undef PG8_MMA
#undef PG8_WAIT_V
#undef PG8_WAIT_L
#undef PG8_BAR
#undef PG8_SCHED
}

struct EpiStore {
    __device__ __forceinline__ bool operator()(const f32x4 (&acc)[2][2][4][2], const GUnit& u, int wr, int wc, int fr, int fq) {
#pragma unroll
        for (int ai = 0; ai < 2; ++ai)
#pragma unroll
            for (int m = 0; m < 4; ++m) { bf16_t* rowp = u.C + (size_t)(ai * HALF + wr * 64 + m * 16 + fr) * u.ldc + wc * 32 + 8 * fq;
#pragma unroll
                for (int bj = 0; bj < 2; ++bj) { const f32x4 v0 = acc[ai][bj][m][0], v1 = acc[ai][bj][m][1];
                    u32x4 w; w.x = cvt_pk_bf16(v0[0], v0[1]); w.y = cvt_pk_bf16(v0[2], v0[3]); w.z = cvt_pk_bf16(v1[0], v1[1]); w.w = cvt_pk_bf16(v1[2], v1[3]);
                    *(GAS u32x4*)(rowp + bj * HALF) = w; } }
        return true;
    }
};
struct EpiResid {
    const float* xp; const float* xs; float* out;
    __device__ __forceinline__ bool operator()(const f32x4 (&acc)[2][2][4][2], const GUnit& u, int wr, int wc, int fr, int fq) {
        const unsigned off0 = (unsigned)(wr * 64 + fr) * DM + u.pn * 256 + wc * 32 + 8 * fq;
        const float* xin = ((u.pm < 64) ? xp + (size_t)u.pm * 256 * DM : xs + (size_t)(u.pm - 64) * 256 * DM) + off0;
        float* o = out + (size_t)u.pm * 256 * DM + off0;
#pragma unroll
        for (int ai = 0; ai < 2; ++ai)
#pragma unroll
            for (int m = 0; m < 4; ++m)
#pragma unroll
                for (int bj = 0; bj < 2; ++bj) { const unsigned ro = (unsigned)(ai * HALF + m * 16) * DM + bj * HALF;
                    const f32x4 x0 = *(const GAS f32x4*)(xin + ro), x1 = *(const GAS f32x4*)(xin + ro + 4);
                    *(GAS f32x4*)(o + ro) = x0 + acc[ai][bj][m][0]; *(GAS f32x4*)(o + ro + 4) = x1 + acc[ai][bj][m][1]; }
        return true;
    }
};
struct EpiResidNorm {
    const float* xp; const float* xs; float* out; bf16_t* hbo; const float* g2; float* sumsq;
    __device__ __forceinline__ bool operator()(const f32x4 (&acc)[2][2][4][2], const GUnit& u, int wr, int wc, int fr, int fq) {
        const unsigned col0 = u.pn * 256 + wc * 32 + 8 * fq;
        const unsigned off0 = (unsigned)(wr * 64 + fr) * DM + col0;
        const float* xin = ((u.pm < 64) ? xp + (size_t)u.pm * 256 * DM : xs + (size_t)(u.pm - 64) * 256 * DM) + off0;
        float* o = out + (size_t)u.pm * 256 * DM + off0;
        bf16_t* ho = hbo + (size_t)u.pm * 256 * DM + off0;
        f32x4 gg[2][2];
#pragma unroll
        for (int bj = 0; bj < 2; ++bj) { gg[bj][0] = *(const GAS f32x4*)(g2 + col0 + bj * HALF); gg[bj][1] = *(const GAS f32x4*)(g2 + col0 + bj * HALF + 4); }
#pragma unroll
        for (int ai = 0; ai < 2; ++ai)
#pragma unroll
            for (int m = 0; m < 4; ++m) { float ss = 0.f;
#pragma unroll
                for (int bj = 0; bj < 2; ++bj) { const unsigned ro = (unsigned)(ai * HALF + m * 16) * DM + bj * HALF;
                    const f32x4 x0 = *(const GAS f32x4*)(xin + ro) + acc[ai][bj][m][0], x1 = *(const GAS f32x4*)(xin + ro + 4) + acc[ai][bj][m][1];
                    *(GAS f32x4*)(o + ro) = x0; *(GAS f32x4*)(o + ro + 4) = x1;
                    ss += (x0[0] * x0[0] + x0[1] * x0[1]) + (x0[2] * x0[2] + x0[3] * x0[3]) + (x1[0] * x1[0] + x1[1] * x1[1]) + (x1[2] * x1[2] + x1[3] * x1[3]);
                    const f32x4 h0 = x0 * gg[bj][0], h1 = x1 * gg[bj][1]; u32x4 w;
                    w.x = cvt_pk_bf16(h0[0], h0[1]); w.y = cvt_pk_bf16(h0[2], h0[3]); w.z = cvt_pk_bf16(h1[0], h1[1]); w.w = cvt_pk_bf16(h1[2], h1[3]);
                    *(GAS u32x4*)(ho + ro) = w; }
                ss += __shfl_xor(ss, 16); ss += __shfl_xor(ss, 32);
                if (fq == 0) atomicAdd(sumsq + u.pm * 256 + ai * HALF + wr * 64 + m * 16 + fr, ss); }
        return true;
    }
};
struct EpiSwigluNorm {
    bf16_t* act; const float* sumsq;
    __device__ __forceinline__ bool operator()(const f32x4 (&acc)[2][2][4][2], const GUnit& u, int wr, int wc, int fr, int fq) {
#pragma unroll
        for (int ai = 0; ai < 2; ++ai)
#pragma unroll
            for (int m = 0; m < 4; ++m) { const int row = u.pm * 256 + ai * HALF + wr * 64 + m * 16 + fr;
                const float rs = 1.f / sqrtf(*(const GAS float*)(sumsq + row) * (1.f / DM) + EPS);
                bf16_t* rowp = act + (size_t)row * FF + u.pn * 128 + wc * 32 + 8 * fq;
                float o[8];
#pragma unroll
                for (int n = 0; n < 2; ++n)
#pragma unroll
                    for (int i = 0; i < 4; ++i) o[4 * n + i] = siluf_(rs * acc[ai][0][m][n][i]) * (rs * acc[ai][1][m][n][i]);
                u32x4 w; w.x = cvt_pk_bf16(o[0], o[1]); w.y = cvt_pk_bf16(o[2], o[3]); w.z = cvt_pk_bf16(o[4], o[5]); w.w = cvt_pk_bf16(o[6], o[7]);
                *(GAS u32x4*)rowp = w; }
        return true;
    }
};
struct EpiSwiglu {
    bf16_t* act;
    __device__ __forceinline__ bool operator()(const f32x4 (&acc)[2][2][4][2], const GUnit& u, int wr, int wc, int fr, int fq) {
#pragma unroll
        for (int ai = 0; ai < 2; ++ai)
#pragma unroll
            for (int m = 0; m < 4; ++m) { bf16_t* rowp = act + (size_t)(u.pm * 256 + ai * HALF + wr * 64 + m * 16 + fr) * FF + u.pn * 128 + wc * 32 + 8 * fq;
                float o[8];
#pragma unroll
                for (int n = 0; n < 2; ++n)
#pragma unroll
                    for (int i = 0; i < 4; ++i) o[4 * n + i] = siluf_(acc[ai][0][m][n][i]) * acc[ai][1][m][n][i];
                u32x4 w; w.x = cvt_pk_bf16(o[0], o[1]); w.y = cvt_pk_bf16(o[2], o[3]); w.z = cvt_pk_bf16(o[4], o[5]); w.w = cvt_pk_bf16(o[6], o[7]);
                *(GAS u32x4*)rowp = w; }
        return true;
    }
};
struct EpiMerge {
    const float* bgate; bf16_t* merged; bf16_t* gtmp;
    __device__ __forceinline__ bool operator()(const f32x4 (&acc)[2][2][4][2], const GUnit& u, int wr, int wc, int fr, int fq) {
        const int br = u.sub >> 1;
        const unsigned off0 = (unsigned)(u.pm * 256 + wr * 64 + fr) * DM + u.pn * 256 + wc * 32 + 8 * fq;
        if ((u.sub & 1) == 0) {
#pragma unroll
            for (int bj = 0; bj < 2; ++bj) { const float* bp = bgate + br * 1024 + u.pn * 256 + bj * HALF + wc * 32 + 8 * fq;
                const f32x4 b0 = *(const GAS f32x4*)bp, b1 = *(const GAS f32x4*)(bp + 4);
#pragma unroll
                for (int ai = 0; ai < 2; ++ai)
#pragma unroll
                    for (int m = 0; m < 4; ++m) { const f32x4 v0 = acc[ai][bj][m][0] + b0, v1 = acc[ai][bj][m][1] + b1; u32x4 w;
                        w.x = cvt_pk_bf16(sigmoidf_(v0[0]), sigmoidf_(v0[1])); w.y = cvt_pk_bf16(sigmoidf_(v0[2]), sigmoidf_(v0[3]));
                        w.z = cvt_pk_bf16(sigmoidf_(v1[0]), sigmoidf_(v1[1])); w.w = cvt_pk_bf16(sigmoidf_(v1[2]), sigmoidf_(v1[3]));
                        *(GAS u32x4*)(gtmp + off0 + (unsigned)(ai * HALF + m * 16) * DM + bj * HALF) = w; } }
        } else {
#pragma unroll
            for (int ai = 0; ai < 2; ++ai)
#pragma unroll
                for (int m = 0; m < 4; ++m)
#pragma unroll
                    for (int bj = 0; bj < 2; ++bj) { const unsigned off = off0 + (unsigned)(ai * HALF + m * 16) * DM + bj * HALF;
                        const u32x4 gg = *(const GAS u32x4*)(gtmp + off); u32x4 mm = (u32x4){0u, 0u, 0u, 0u}; if (br > 0) mm = *(const GAS u32x4*)(merged + off);
                        const f32x4 a0 = acc[ai][bj][m][0], a1 = acc[ai][bj][m][1]; u32x4 w;
                        w.x = cvt_pk_bf16(bflo(mm.x) + bflo(gg.x) * a0[0], bfhi(mm.x) + bfhi(gg.x) * a0[1]); w.y = cvt_pk_bf16(bflo(mm.y) + bflo(gg.y) * a0[2], bfhi(mm.y) + bfhi(gg.y) * a0[3]);
                        w.z = cvt_pk_bf16(bflo(mm.z) + bflo(gg.z) * a1[0], bfhi(mm.z) + bfhi(gg.z) * a1[1]); w.w = cvt_pk_bf16(bflo(mm.w) + bflo(gg.w) * a1[2], bfhi(mm.w) + bfhi(gg.w) * a1[3]);
                        *(GAS u32x4*)(merged + off) = w; }
        }
        return true;
    }
};
}

struct Args { const float* in[38]; float* out; unsigned char* ws; int ph_lo, ph_hi; };
struct Ctx {
    const Args* A; float* out; unsigned char* ws; LAS unsigned char* lds;
    int tid, lane, wave, gw, NGW, l, G, bid;
};
#define WSB(off) ((bf16_t*)(C.ws + (off)))
#define INL(i, sz) (C.A->in[i] + (size_t)C.l * (size_t)(sz))
#define IN0(i) (C.A->in[i])

using pg8::GUnit;
struct SchedOne {
    const bf16_t* A; const bf16_t* B; bf16_t* Cp; int lda, ldb, ldc, nM, nN, nt, G, c;
    __device__ __forceinline__ bool next(int i, GUnit& u) const {
        const long L = (long)i * G + c; if (L >= (long)nM * nN) return false;
        int pm, pn; pg8::tile_map((int)L, nM, nN, pm, pn);
        u.A = A + (size_t)pm * 256 * lda; u.B = B + (size_t)pn * 256 * ldb; u.lda = lda; u.ldb = ldb; u.nt = nt; u.pm = pm; u.pn = pn; u.sub = 0;
        u.C = Cp ? Cp + (size_t)pm * 256 * ldc + (size_t)pn * 256 : nullptr; u.ldc = ldc; return true;
    }
};
struct SchedInproj {
    const bf16_t* A; const bf16_t* B; bf16_t *pA, *pB, *pC, *pD; int G, c;
    __device__ __forceinline__ bool next(int i, GUnit& u) const {
        const long L = (long)i * G + c; if (L >= 72 * 21) return false;
        int pm, pn; pg8::tile_map((int)L, 72, 21, pm, pn);
        u.A = A + (size_t)pm * 256 * 1024; u.B = B + (size_t)pn * 256 * 1024; u.lda = 1024; u.ldb = 1024; u.nt = 16; u.pm = pm; u.pn = pn; u.sub = 0;
        if (pn < 6) { u.C = pA + (size_t)pm * 256 * 1536 + pn * 256; u.ldc = 1536; }
        else if (pn < 9) { u.C = pB + (size_t)pm * 256 * 768 + (pn - 6) * 256; u.ldc = 768; }
        else if (pn < 15) { u.C = pC + (size_t)pm * 256 * 1536 + (pn - 9) * 256; u.ldc = 1536; }
        else { u.C = pD + (size_t)pm * 256 * 1536 + (pn - 15) * 256; u.ldc = 1536; }
        return true;
    }
};
struct SchedP3 {
    const bf16_t *pB, *wq, *ckvP, *ckvS, *wkv; bf16_t *Q, *KVP, *KVS; int G, c;
    __device__ __forceinline__ bool next(int i, GUnit& u) const {
        long L = (long)i * G + c; int pm, pn; u.sub = 0;
        if (L < 264 * 4) { pg8::tile_map((int)L, 264, 4, pm, pn); u.A = ckvS + (size_t)pm * 256 * 256; u.B = wkv + (size_t)pn * 256 * 256; u.lda = 256; u.ldb = 256; u.nt = 4;
            u.C = KVS + (size_t)pm * 256 * 1024 + pn * 256; u.ldc = 1024; u.pm = pm; u.pn = pn; return true; }
        L -= 264 * 4;
        if (L < 64 * 4) { pg8::tile_map((int)L, 64, 4, pm, pn); u.A = ckvP + (size_t)pm * 256 * 256; u.B = wkv + (size_t)pn * 256 * 256; u.lda = 256; u.ldb = 256; u.nt = 4;
            u.C = KVP + (size_t)pm * 256 * 1024 + pn * 256; u.ldc = 1024; u.pm = pm; u.pn = pn; return true; }
        L -= 64 * 4;
        if (L < 72 * 3) { pg8::tile_map((int)L, 72, 3, pm, pn); u.A = pB + (size_t)pm * 256 * 768; u.B = wq + (size_t)pn * 256 * 384; u.lda = 768; u.ldb = 384; u.nt = 6;
            u.C = Q + (size_t)pm * 256 * 768 + pn * 256; u.ldc = 768; u.pm = pm; u.pn = pn; return true; }
        return false;
    }
};
struct SchedMerge {
    const bf16_t *hb, *wg, *wout, *pA, *ybc, *pD; int G, c;
    __device__ __forceinline__ bool next(int i, GUnit& u) const {
        const long L = (long)(i >> 3) * G + c; if (L >= 72 * 4) return false;
        int pm, pn; pg8::tile_map((int)L, 72, 4, pm, pn); const int sub = i & 7, br = sub >> 1;
        u.pm = pm; u.pn = pn; u.sub = sub; u.C = nullptr; u.ldc = 0; u.ldb = 1024;
        if ((sub & 1) == 0) { u.A = hb + (size_t)pm * 256 * 1024; u.lda = 1024; u.nt = 16; u.B = wg + (size_t)(br * 1024 + pn * 256) * 1024; }
        else { u.nt = 8; u.B = wout + (size_t)(br * 1024 + pn * 256) * 1024;
            if (br == 0) { u.A = pA + (size_t)pm * 256 * 1536; u.lda = 1536; }
            else if (br == 1) { u.A = ybc + (size_t)pm * 256 * 1024; u.lda = 1024; }
            else if (br == 2) { u.A = ybc + (size_t)pm * 256 * 1024 + 512; u.lda = 1024; }
            else { u.A = pD + (size_t)pm * 256 * 1536; u.lda = 1536; } }
        return true;
    }
};

template <class Map>
__device__ __forceinline__ void transpose_w(const Ctx& C, const float* W, int ldw, int K, int Nout, bf16_t* WT, int ldt, Map map) {
    LAS float* scr = (LAS float*)(C.lds + C.wave * 8704);
    const int lane = C.lane, nblk = Nout / 32, items = (K / 64) * nblk;
    for (int it = C.gw; it < items; it += C.NGW) {
        const int kb = it / nblk, nb = it % nblk, k0 = 64 * kb, n0 = 32 * nb;
        const int col = map(n0 + (lane & 31));
        float wv[32];
#pragma unroll
        for (int i = 0; i < 32; ++i) { const int kk = 2 * i + (lane >> 5); wv[i] = (col >= 0) ? W[(size_t)(k0 + kk) * ldw + col] : 0.f; }
#pragma unroll
        for (int i = 0; i < 32; ++i) { const int kk = 2 * i + (lane >> 5); scr[kk * 33 + (lane & 31)] = wv[i]; }
        LDS_WAIT();
        const int c = lane & 7;
#pragma unroll
        for (int j = 0; j < 4; ++j) { const int n = (lane >> 3) + 8 * j; const LAS float* s = scr + (8 * c) * 33 + n;
            u32x4 o; o.x = pk2(s[0 * 33], s[1 * 33]); o.y = pk2(s[2 * 33], s[3 * 33]); o.z = pk2(s[4 * 33], s[5 * 33]); o.w = pk2(s[6 * 33], s[7 * 33]);
            *(u32x4*)(WT + (size_t)(n0 + n) * ldt + k0 + 8 * c) = o; }
        LDS_WAIT();
    }
}
struct MapId { __device__ __forceinline__ int operator()(int n) const { return n; } };
struct MapOff { int off; __device__ __forceinline__ int operator()(int n) const { return n + off; } };
struct MapIn { __device__ __forceinline__ int operator()(int n) const { return n < 1536 ? n : (n < 2208 ? n + 8 : (n < 2216 ? n - 2208 + 1536 : (n < 2304 ? -1 : n - 88))); } };
struct MapKv { __device__ __forceinline__ int operator()(int n) const { return n < 512 ? ((n >> 6) * 128 + (n & 63)) : (((n - 512) >> 6) * 128 + 64 + (n & 63)); } };
struct MapUp { __device__ __forceinline__ int operator()(int n) const { const int t = n >> 8, w = n & 255; return w < 128 ? 128 * t + w : 2816 + 128 * t + (w - 128); } };

__device__ __forceinline__ void phase_wprep(const Ctx& C) {
    transpose_w(C, INL(10, 1024 * IN_COLS), IN_COLS, 1024, 5376, WSB(WS_WT_IN), 1024, MapIn());
    transpose_w(C, INL(10, 1024 * IN_COLS), IN_COLS, 1024, 4096, WSB(WS_WT_G), 1024, MapOff{5288});
    transpose_w(C, INL(20, 384 * 768), 768, 384, 768, WSB(WS_WT_QUP), 384, MapId());
    transpose_w(C, INL(22, 256 * 1024), 1024, 256, 1024, WSB(WS_WT_KVUP), 256, MapKv());
    transpose_w(C, INL(18, 512 * 1024), 1024, 512, 1024, WSB(WS_WT_OUT), 1024, MapId());
    transpose_w(C, INL(27, 512 * 1024), 1024, 512, 1024, WSB(WS_WT_OUT) + (size_t)1 * 1024 * 1024, 1024, MapId());
    transpose_w(C, INL(29, 512 * 1024), 1024, 512, 1024, WSB(WS_WT_OUT) + (size_t)2 * 1024 * 1024, 1024, MapId());
    transpose_w(C, INL(33, 512 * 1024), 1024, 512, 1024, WSB(WS_WT_OUT) + (size_t)3 * 1024 * 1024, 1024, MapId());
    transpose_w(C, INL(34, 1024 * 1024), 1024, 1024, 1024, WSB(WS_WT_O), 1024, MapId());
    transpose_w(C, INL(36, 1024 * 5632), 5632, 1024, 5632, WSB(WS_WT_UP), 1024, MapUp());
    transpose_w(C, INL(37, 2816 * 1024), 1024, 2816, 1024, WSB(WS_WT_DOWN), 2816, MapId());
}

__device__ __forceinline__ const float* xrow(const Ctx& C, int row, bool from_out) {
    if (from_out) return C.out + (size_t)row * DM;
    return row < NP ? IN0(0) + (size_t)row * DM : IN0(1) + (size_t)(row - NP) * DM;
}
__device__ __forceinline__ void phase_norm(const Ctx& C, const float* g, bool from_out) {
    const int lane = C.lane;
    f32x4 gv[4];
#pragma unroll
    for (int j = 0; j < 4; ++j) gv[j] = ((const f32x4*)g)[64 * j + lane];
    f32x4 nv[4];
    if (C.gw < R) { const f32x4* xr0 = (const f32x4*)xrow(C, C.gw, from_out) + lane;
#pragma unroll
        for (int j = 0; j < 4; ++j) nv[j] = xr0[64 * j]; }
    for (int row = C.gw; row < R; row += C.NGW) {
        f32x4 v[4]; float s = 0.f;
#pragma unroll
        for (int j = 0; j < 4; ++j) v[j] = nv[j];
        if (row + C.NGW < R) { const f32x4* xrn = (const f32x4*)xrow(C, row + C.NGW, from_out) + lane;
#pragma unroll
            for (int j = 0; j < 4; ++j) nv[j] = xrn[64 * j]; }
#pragma unroll
        for (int j = 0; j < 4; ++j) s += (v[j].x * v[j].x + v[j].y * v[j].y) + (v[j].z * v[j].z + v[j].w * v[j].w);
        const float rstd = 1.f / sqrtf(wave_sum(s) * (1.f / DM) + EPS);
        u32x2* o = (u32x2*)(WSB(WS_HB) + (size_t)row * DM) + lane;
#pragma unroll
        for (int j = 0; j < 4; ++j) { u32x2 w; w.x = pk2(v[j].x * rstd * gv[j].x, v[j].y * rstd * gv[j].y); w.y = pk2(v[j].z * rstd * gv[j].z, v[j].w * rstd * gv[j].w); o[64 * j] = w; }
    }
}
__device__ __forceinline__ void rope_cs(int pos, int i, float& c, float& s) {
    const float chi = ((i & 8) ? ((i & 4) ? ((i & 2) ? ((i & 1) ? 2.831220627e-05f : 5.030632019e-05f) : ((i & 1) ? 8.952617645e-05f : 1.592636108e-04f)) : ((i & 2) ? ((i & 1) ? 2.832412720e-04f : 5.035400391e-04f) : ((i & 1) ? 8.945465088e-04f : 1.590728760e-03f))) : ((i & 4) ? ((i & 2) ? ((i & 1) ? 2.830505371e-03f : 5.035400391e-03f) : ((i & 1) ? 8.956909180e-03f : 1.593017578e-02f)) : ((i & 2) ? ((i & 1) ? 2.828979492e-02f : 5.035400391e-02f) : ((i & 1) ? 8.947753906e-02f : 1.591796875e-01f))));
    const float clo = ((i & 8) ? ((i & 4) ? ((i & 2) ? ((i & 1) ? -1.001043781e-08f : 2.289191414e-08f) : ((i & 1) ? -2.677484368e-08f : -1.086677486e-07f)) : ((i & 2) ? ((i & 1) ? -2.193136623e-07f : -2.479180239e-07f) : ((i & 1) ? 4.475072899e-07f : 8.206711755e-07f))) : ((i & 4) ? ((i & 2) ? ((i & 1) ? -2.857880190e-07f : -2.479180239e-06f) : ((i & 1) ? -6.969018614e-06f : -1.468147184e-05f)) : ((i & 2) ? ((i & 1) ? 1.240090842e-05f : -2.479180148e-05f) : ((i & 1) ? 2.186254642e-05f : -2.474440771e-05f))));
    const float pf = (float)pos, rh = pf * chi, f1 = rh - __builtin_rintf(rh), fr = f1 + pf * clo;
    c = __builtin_amdgcn_cosf(fr); s = __builtin_amdgcn_sinf(fr);
}
__device__ __forceinline__ int row_pos(int row) { return row < NP ? (row & (TP - 1)) : PAST + ((row - NP) & 63); }

__device__ __forceinline__ void phase_mla_prep(const Ctx& C) {
    const int lane = C.lane; const int l = C.l;
    const float* gq = INL(19, 384); const float* gkv = INL(21, 256); const float* gkr = INL(26, 32);
    for (int row = C.gw; row < R; row += C.NGW) {
        bf16_t* pb = WSB(WS_ZB) + (size_t)row * 768;
        unsigned q[3]; float ss = 0.f;
#pragma unroll
        for (int j = 0; j < 3; ++j) { q[j] = *(const unsigned*)(pb + 2 * lane + 128 * j); const float a = bflo(q[j]), b = bfhi(q[j]); ss += a * a + b * b; }
        float rstd = 1.f / sqrtf(wave_sum(ss) * (1.f / 384.f) + EPS);
#pragma unroll
        for (int j = 0; j < 3; ++j) { const int c = 2 * lane + 128 * j; *(unsigned*)(pb + c) = pk2(bflo(q[j]) * rstd * gq[c], bfhi(q[j]) * rstd * gq[c + 1]); }
        const u32x2 kv = *(const u32x2*)(pb + 384 + 4 * lane);
        float k0 = bflo(kv.x), k1 = bfhi(kv.x), k2 = bflo(kv.y), k3 = bfhi(kv.y);
        rstd = 1.f / sqrtf(wave_sum(k0 * k0 + k1 * k1 + k2 * k2 + k3 * k3) * (1.f / 256.f) + EPS);
        const f32x4 g4 = *(const f32x4*)(gkv + 4 * lane);
        f32x4 ck; ck.x = k0 * rstd * g4.x; ck.y = k1 * rstd * g4.y; ck.z = k2 * rstd * g4.z; ck.w = k3 * rstd * g4.w;
        u32x2 ckb; ckb.x = pk2(ck.x, ck.y); ckb.y = pk2(ck.z, ck.w);
        const int pos = row_pos(row);
        size_t srow = 0;
        if (row < NP) { *(f32x4*)(C.out + O_CKV_P + ((size_t)l * NP + row) * 256 + 4 * lane) = ck; *(u32x2*)(WSB(WS_CKVP) + (size_t)row * 256 + 4 * lane) = ckb; }
        else { const int rs = row - NP; srow = (size_t)(rs >> 6) * KS_ALL + PAST + (rs & 63);
            *(f32x4*)(C.out + O_CKV_S + ((size_t)l * NS + rs) * 256 + 4 * lane) = ck; *(u32x2*)(WSB(WS_CKVS) + srow * 256 + 4 * lane) = ckb; }
        const float x = (lane < 32) ? bf1(pb[640 + lane]) : 0.f;
        rstd = 1.f / sqrtf(wave_sum(x * x) * (1.f / 32.f) + EPS);
        const float y = x * rstd * gkr[lane & 31];
        const float part = __shfl_xor(y, 16);
        float cs, sn; rope_cs(pos, lane & 15, cs, sn);
        const float o = (lane < 16) ? (y * cs - part * sn) : (part * sn + y * cs);
        if (lane < 32) {
            if (row < NP) { C.out[O_KPE_P + ((size_t)l * NP + row) * 32 + lane] = o; WSB(WS_KPEP)[(size_t)row * 32 + lane] = (bf16_t)f2bf(o); }
            else { C.out[O_KPE_S + ((size_t)l * NS + (row - NP)) * 32 + lane] = o; WSB(WS_KPES)[srow * 32 + lane] = (bf16_t)f2bf(o); }
        }
    }
    const size_t gt = (size_t)C.bid * NTHREADS + C.tid, GT = (size_t)C.G * NTHREADS;
    { const float* src = INL(4, (size_t)BS * PAST * 256);
      for (size_t i = gt; i < (size_t)BS * PAST * 256 / 8; i += GT) { const size_t e = i * 8, b = e / ((size_t)PAST * 256), rem = e % ((size_t)PAST * 256);
          *(u32x4*)(WSB(WS_CKVS) + b * KS_ALL * 256 + rem) = load8(src, e, true); } }
    { const float* src = INL(5, (size_t)BS * PAST * 32);
      for (size_t i = gt; i < (size_t)BS * PAST * 32 / 8; i += GT) { const size_t e = i * 8, b = e / ((size_t)PAST * 32), rem = e % ((size_t)PAST * 32);
          *(u32x4*)(WSB(WS_KPES) + b * KS_ALL * 32 + rem) = load8(src, e, true); } }
}

__device__ __forceinline__ float red8(float v) { v += __shfl_xor(v, 1); v += __shfl_xor(v, 2); v += __shfl_xor(v, 4); return v; }

__device__ __forceinline__ void phase_band_prep(const Ctx& C) {
    const int lane = C.lane, l = C.l, d0 = (lane & 7) * 8;
    float gq[8], gk[8];
#pragma unroll
    for (int e = 0; e < 8; ++e) { gq[e] = INL(30, 64)[d0 + e] * (0.125f * LOG2E); gk[e] = INL(31, 64)[d0 + e]; }
    for (int row = C.gw; row < R; row += C.NGW) {
        bf16_t* pd = WSB(WS_PD) + (size_t)row * 1536 + 8 * lane;
        float f[8], kf[8], vf[8];
        unpack8(*(const u32x4*)pd, f); float ss = 0.f;
#pragma unroll
        for (int e = 0; e < 8; ++e) ss += f[e] * f[e];
        float rstd = 1.f / sqrtf(red8(ss) * (1.f / 64.f) + EPS);
#pragma unroll
        for (int e = 0; e < 8; ++e) f[e] *= rstd * gq[e];
        *(u32x4*)pd = pack8(f);
        unpack8(*(const u32x4*)(pd + 512), kf); ss = 0.f;
#pragma unroll
        for (int e = 0; e < 8; ++e) ss += kf[e] * kf[e];
        rstd = 1.f / sqrtf(red8(ss) * (1.f / 64.f) + EPS);
#pragma unroll
        for (int e = 0; e < 8; ++e) kf[e] *= rstd * gk[e];
        *(u32x4*)(pd + 512) = pack8(kf);
        unpack8(*(const u32x4*)(pd + 1024), vf);
        long dst = -1;
        if (row < NP) { const int t = row & (TP - 1), b = row >> 13; if (t >= TP - 512) dst = (long)(((size_t)(l * BP + b) * 512 + (t - (TP - 512))) * 512 + 8 * lane); }
        else { const int rs = row - NP, b = rs >> 6, t = rs & 63; dst = (long)(((size_t)(l * BS + b) * 512 + 448 + t) * 512 + 8 * lane); }
        if (dst >= 0) { float* ko = C.out + (row < NP ? O_BK_P : O_BK_S) + dst; float* vo = C.out + (row < NP ? O_BV_P : O_BV_S) + dst;
            *(f32x4*)ko = (f32x4){kf[0], kf[1], kf[2], kf[3]}; *(f32x4*)(ko + 4) = (f32x4){kf[4], kf[5], kf[6], kf[7]};
            *(f32x4*)vo = (f32x4){vf[0], vf[1], vf[2], vf[3]}; *(f32x4*)(vo + 4) = (f32x4){vf[4], vf[5], vf[6], vf[7]}; }
    }
    const size_t gt = (size_t)C.bid * NTHREADS + C.tid, GT = (size_t)C.G * NTHREADS;
    const f32x4* sk = (const f32x4*)INL(7, (size_t)BS * 512 * 512); const f32x4* sv = (const f32x4*)INL(8, (size_t)BS * 512 * 512);
    f32x4* dk = (f32x4*)(C.out + O_BK_S + (size_t)l * BS * 512 * 512); f32x4* dv = (f32x4*)(C.out + O_BV_S + (size_t)l * BS * 512 * 512);
    for (size_t i = gt; i < (size_t)BS * 448 * 128; i += GT) { const size_t b = i / (448 * 128), rem = i % (448 * 128);
        dk[b * 512 * 128 + rem] = sk[b * 512 * 128 + 64 * 128 + rem]; dv[b * 512 * 128 + rem] = sv[b * 512 * 128 + 64 * 128 + rem]; }
}

__device__ __forceinline__ void phase_sconv(const Ctx& C) {
    const int lane = C.lane, l = C.l, ch = 8 * lane;
    const float* w = INL(28, 3 * 512);
    float w0[8], w1[8], w2[8];
#pragma unroll
    for (int e = 0; e < 8; ++e) { w0[e] = w[ch + e]; w1[e] = w[512 + ch + e]; w2[e] = w[1024 + ch + e]; }
    for (int row = C.gw; row < R; row += C.NGW) {
        const bf16_t* pc = WSB(WS_XR) + (size_t)row * 1536 + ch;
        const bool pr = row < NP; const int t = pr ? (row & (TP - 1)) : ((row - NP) & 63); const int b = pr ? (row >> 13) : ((row - NP) >> 6);
        float cb[8], a[8], x[8], u0[8], u1[8], u2[8];
        unpack8(*(const u32x4*)pc, cb); unpack8(*(const u32x4*)(pc + 512), a); unpack8(*(const u32x4*)(pc + 1024), x);
#pragma unroll
        for (int e = 0; e < 8; ++e) u0[e] = a[e] * x[e];
        const float* st = INL(6, BS * 2 * 512) + (size_t)b * 2 * 512 + ch;
        if (t >= 1) { unpack8(*(const u32x4*)(pc - 1536 + 512), a); unpack8(*(const u32x4*)(pc - 1536 + 1024), x);
#pragma unroll
            for (int e = 0; e < 8; ++e) u1[e] = a[e] * x[e]; }
        else {
#pragma unroll
            for (int e = 0; e < 8; ++e) u1[e] = pr ? 0.f : st[512 + e]; }
        if (t >= 2) { unpack8(*(const u32x4*)(pc - 3072 + 512), a); unpack8(*(const u32x4*)(pc - 3072 + 1024), x);
#pragma unroll
            for (int e = 0; e < 8; ++e) u2[e] = a[e] * x[e]; }
        else {
#pragma unroll
            for (int e = 0; e < 8; ++e) u2[e] = pr ? 0.f : st[(t == 1 ? 512 : 0) + e]; }
        float y[8];
#pragma unroll
        for (int e = 0; e < 8; ++e) y[e] = cb[e] * (w0[e] * u2[e] + w1[e] * u1[e] + w2[e] * u0[e]);
        *(u32x4*)(WSB(WS_YBC) + (size_t)row * 1024 + 512 + ch) = pack8(y);
        const int T = pr ? TP : TS;
        if (t >= T - 2) { float* o = C.out + (pr ? O_SC_P + ((size_t)(l * BP + b) * 2 + (t - (T - 2))) * 512 : O_SC_S + ((size_t)(l * BS + b) * 2 + (t - (T - 2))) * 512) + ch;
            *(f32x4*)o = (f32x4){u0[0], u0[1], u0[2], u0[3]}; *(f32x4*)(o + 4) = (f32x4){u0[4], u0[5], u0[6], u0[7]}; }
    }
}

__device__ __forceinline__ void phase_qk_post(const Ctx& C) {
    const int lane = C.lane, head = lane >> 3, sub = lane & 7;
    const float SC = 0.10206207261596577f * LOG2E;
    float gn[8], gr[8], gk[8];
#pragma unroll
    for (int e = 0; e < 8; ++e) { gn[e] = INL(23, 64)[8 * sub + e] * SC; gr[e] = INL(25, 32)[8 * (sub & 3) + e]; gk[e] = INL(24, 64)[8 * sub + e]; }
    for (int row = C.gw; row < R; row += C.NGW) {
        bf16_t* qp = WSB(WS_Q) + (size_t)row * 768 + 96 * head;
        float f[8]; unpack8(*(const u32x4*)(qp + 8 * sub), f); float ss = 0.f;
#pragma unroll
        for (int e = 0; e < 8; ++e) ss += f[e] * f[e];
        float rstd = 1.f / sqrtf(red8(ss) * (1.f / 64.f) + EPS);
#pragma unroll
        for (int e = 0; e < 8; ++e) f[e] *= rstd * gn[e];
        *(u32x4*)(qp + 8 * sub) = pack8(f);
        float r[8];
        if (sub < 4) unpack8(*(const u32x4*)(qp + 64 + 8 * sub), r);
        else {
#pragma unroll
            for (int e = 0; e < 8; ++e) r[e] = 0.f; }
        ss = 0.f;
#pragma unroll
        for (int e = 0; e < 8; ++e) ss += r[e] * r[e];
        ss += __shfl_xor(ss, 1); ss += __shfl_xor(ss, 2);
        rstd = 1.f / sqrtf(ss * (1.f / 32.f) + EPS);
        const int pos = row_pos(row);
        float o[8];
#pragma unroll
        for (int e = 0; e < 8; ++e) { const float y = r[e] * rstd * gr[e]; const float part = __shfl_xor(y, 2);
            float cs, sn; rope_cs(pos, 8 * (sub & 1) + e, cs, sn);
            o[e] = ((sub < 2) ? (y * cs - part * sn) : (part * sn + y * cs)) * SC; }
        if (sub < 4) *(u32x4*)(qp + 64 + 8 * sub) = pack8(o);
    }
    for (int row = C.gw; row < NP + BS * KS_ALL; row += C.NGW) {
        bf16_t* kp = (row < NP ? WSB(WS_KVP) + (size_t)row * 1024 : WSB(WS_XR) + (size_t)(row - NP) * 1024) + 8 * lane;
        float f[8]; unpack8(*(const u32x4*)kp, f); float ss = 0.f;
#pragma unroll
        for (int e = 0; e < 8; ++e) ss += f[e] * f[e];
        const float rstd = 1.f / sqrtf(red8(ss) * (1.f / 64.f) + EPS);
#pragma unroll
        for (int e = 0; e < 8; ++e) f[e] *= rstd * gk[e];
        *(u32x4*)kp = pack8(f);
    }
}

__device__ __forceinline__ bf16x8 mk_frag(u32x2 lo, u32x2 hi) { u32x4 v; v.x = lo.x; v.y = lo.y; v.z = hi.x; v.w = hi.y; return __builtin_bit_cast(bf16x8, v); }
__device__ __forceinline__ bf16x8 as_frag(u32x4 v) { return __builtin_bit_cast(bf16x8, v); }
#define MFMA16(a, b, c) __builtin_amdgcn_mfma_f32_16x16x32_bf16((a), (b), (c), 0, 0, 0)

__device__ __forceinline__ int ssd_row0(int seq, int c) { return seq < 2 ? seq * TP + c * 64 : NP + (seq - 2) * 64; }
__device__ __forceinline__ void ssd_dt(const Ctx& C, int row0, LAS float* sDT, LAS float* sACS) {
    const int h = C.wave, lane = C.lane;
    const float adt = bf1(WSB(WS_ZB)[(size_t)(row0 + lane) * 768 + 672 + h]) + INL(14, 8)[h];
    float dt; { const float e_ = fexp(adt), u_ = 1.f + e_; dt = (adt > 20.f) ? adt : ((u_ == 1.f) ? e_ : (__builtin_amdgcn_logf(u_) * 0.6931471805599453f) * e_ * frcp(u_ - 1.f)); }
    const float A = -fexp(INL(15, 8)[h]);
    float cs = dt * A;
#pragma unroll
    for (int o = 1; o < 64; o <<= 1) { const float t = __shfl_up(cs, o); if (lane >= o) cs += t; }
    sDT[h * 64 + lane] = dt; sACS[h * 64 + lane] = cs;
}
template <class F>
__device__ __forceinline__ void ssd_load_chunk(const Ctx& C, int seq, int c, int row0, F store) {
    const int lane = C.lane, w = C.wave;
    const bf16_t* base = WSB(WS_PA) + (size_t)(row0 + lane) * 1536 + 512;
    const float* cw = INL(12, 4 * 1024); const float* cbias = INL(13, 1024);
    for (int j = 0; j < 16; ++j) {
        const int ch0 = 128 * w + 8 * j;
        const u32x4 v0 = *(const u32x4*)(base + ch0);
        u32x4 ex = (u32x4){0u, 0u, 0u, 0u};
        if (lane < 3) {
            if (seq < 2) { if (c > 0) ex = *(const u32x4*)(base - (size_t)3 * 1536 + ch0); }
            else ex = load8(INL(3, BS * 3 * 1024) + ((size_t)(seq - 2) * 3 + lane) * 1024 + ch0, 0, true);
        }
        float x0[8], xk[3][8];
        unpack8(v0, x0);
#pragma unroll
        for (int k = 1; k <= 3; ++k) {
            u32x4 a, b;
            a.x = __shfl(v0.x, (lane - k) & 63); a.y = __shfl(v0.y, (lane - k) & 63); a.z = __shfl(v0.z, (lane - k) & 63); a.w = __shfl(v0.w, (lane - k) & 63);
            b.x = __shfl(ex.x, (lane - k + 3) & 63); b.y = __shfl(ex.y, (lane - k + 3) & 63); b.z = __shfl(ex.z, (lane - k + 3) & 63); b.w = __shfl(ex.w, (lane - k + 3) & 63);
            unpack8(lane >= k ? a : b, xk[k - 1]);
        }
        float y[8];
#pragma unroll
        for (int e = 0; e < 8; ++e) {
            const float a = cbias[ch0 + e] + cw[3 * 1024 + ch0 + e] * x0[e] + cw[2 * 1024 + ch0 + e] * xk[0][e] + cw[1 * 1024 + ch0 + e] * xk[1][e] + cw[ch0 + e] * xk[2][e];
            y[e] = siluf_(a);
        }
        store(ch0, y, x0);
    }
}

constexpr int XT_ST = 72;
__device__ __forceinline__ void ssd_s1_item(const Ctx& C, int item) {
    const int seq = item < 256 ? (item >> 7) : 2 + (item - 256), c = item < 256 ? (item & 127) : 0, row0 = ssd_row0(seq, c);
    const int lane = C.lane, h = C.wave, fr = lane & 15, fq = lane >> 4, l = C.l;
    LAS bf16_t* XT = (LAS bf16_t*)C.lds; LAS bf16_t* BT = (LAS bf16_t*)(C.lds + 73728);
    LAS float* sDT = (LAS float*)(C.lds + 110592); LAS float* sACS = (LAS float*)(C.lds + 112640);
    ssd_dt(C, row0, sDT, sACS);
    __syncthreads();
    const bool lastc = (seq >= 2) || (c == 127);
    float* convo = C.out + (seq < 2 ? O_CONV_P + (size_t)(l * BP + seq) * 3 * 1024 : O_CONV_S + (size_t)(l * BS + seq - 2) * 3 * 1024);
    ssd_load_chunk(C, seq, c, row0, [&](int ch0, const float* y, const float* raw) {
        if (ch0 < 512) { const int hh = ch0 >> 6, p0 = ch0 & 63; const float wgt = sDT[hh * 64 + lane] * fexp(sACS[hh * 64 + 63] - sACS[hh * 64 + lane]);
#pragma unroll
            for (int e = 0; e < 8; ++e) XT[(hh * 64 + p0 + e) * XT_ST + lane] = (bf16_t)f2bf(y[e] * wgt); }
        else if (ch0 < 768) { const int g = (ch0 - 512) >> 7, n0 = (ch0 - 512) & 127;
#pragma unroll
            for (int e = 0; e < 8; ++e) BT[(g * 128 + n0 + e) * XT_ST + lane] = (bf16_t)f2bf(y[e]); }
        if (lastc && lane >= 61) {
#pragma unroll
            for (int e = 0; e < 8; ++e) convo[(size_t)(lane - 61) * 1024 + ch0 + e] = raw[e]; }
    });
    __syncthreads();
    const int g = h >> 2;
    bf16x8 bx[4][2];
#pragma unroll
    for (int pt = 0; pt < 4; ++pt)
#pragma unroll
        for (int ks = 0; ks < 2; ++ks) bx[pt][ks] = *(const LAS bf16x8*)(XT + (h * 64 + 16 * pt + fr) * XT_ST + 32 * ks + 8 * fq);
    const float dall = fexp(sACS[h * 64 + 63]);
    for (int nt = 0; nt < 8; ++nt) {
        bf16x8 a[2];
#pragma unroll
        for (int ks = 0; ks < 2; ++ks) a[ks] = *(const LAS bf16x8*)(BT + (g * 128 + 16 * nt + fr) * XT_ST + 32 * ks + 8 * fq);
#pragma unroll
        for (int pt = 0; pt < 4; ++pt) {
            f32x4 acc = (f32x4){0.f, 0.f, 0.f, 0.f};
#pragma unroll
            for (int ks = 0; ks < 2; ++ks) acc = MFMA16(a[ks], bx[pt][ks], acc);
            const int p = 16 * pt + fr, n = 16 * nt + 4 * fq;
            if (seq < 2) { u32x2 w; w.x = pk2(acc[0], acc[1]); w.y = pk2(acc[2], acc[3]);
                *(u32x2*)(WSB(WS_STATES) + ((size_t)((seq * 128 + c) * 8 + h) * 64 + p) * 128 + n) = w; }
            else { const size_t o = ((size_t)((l * BS + seq - 2) * 8 + h) * 64 + p) * 128 + n;
                const f32x4 h0 = *(const f32x4*)(IN0(2) + o);
                *(f32x4*)(C.out + O_SSM_S + o) = h0 * dall + acc; }
        }
    }
    if (seq < 2 && lane == 0) ((float*)(C.ws + WS_DECAY))[(seq * 128 + c) * 8 + h] = dall;
    __syncthreads();
}
__device__ __forceinline__ void ssd_scan(const Ctx& C) {
    const size_t gt = (size_t)C.bid * NTHREADS + C.tid;
    if (gt >= (size_t)2 * 8 * 64 * 128) return;
    const int b = (int)(gt >> 16), h = (int)(gt >> 13) & 7, pn = (int)(gt & 8191);
    bf16_t* st = WSB(WS_STATES) + ((size_t)(b * 128) * 8 + h) * 8192 + pn;
    const float* dec = (const float*)(C.ws + WS_DECAY) + (b * 128) * 8 + h;
    float hst = 0.f;
#pragma unroll 1
    for (int c0 = 0; c0 < 128; c0 += 32) {
        bf16_t sv[32]; float dv[32];
#pragma unroll
        for (int i = 0; i < 32; ++i) { sv[i] = st[(size_t)(c0 + i) * 8 * 8192]; dv[i] = dec[(c0 + i) * 8]; }
#pragma unroll
        for (int i = 0; i < 32; ++i) { st[(size_t)(c0 + i) * 8 * 8192] = (bf16_t)f2bf(hst); hst = dv[i] * hst + bf1(sv[i]); }
    }
    C.out[O_SSM_P + ((size_t)(C.l * BP + b) * 8 + h) * 8192 + pn] = hst;
}
constexpr int CN_ST = 136;
__device__ __forceinline__ void ssd_s3_item(const Ctx& C, int item) {
    const int seq = item < 256 ? (item >> 7) : 2 + (item - 256), c = item < 256 ? (item & 127) : 0, row0 = ssd_row0(seq, c);
    const int lane = C.lane, h = C.wave, fr = lane & 15, fq = lane >> 4, l = C.l, g = h >> 2;
    LAS bf16_t* Cn = (LAS bf16_t*)C.lds; LAS bf16_t* Bn = (LAS bf16_t*)(C.lds + 34816); LAS bf16_t* XT = (LAS bf16_t*)(C.lds + 69632);
    LAS float* sDT = (LAS float*)(C.lds + 143360); LAS float* sACS = (LAS float*)(C.lds + 145408); LAS float* sRed = (LAS float*)(C.lds + 147456);
    ssd_dt(C, row0, sDT, sACS);
    ssd_load_chunk(C, seq, c, row0, [&](int ch0, const float* y, const float*) {
        if (ch0 < 512) { const int hh = ch0 >> 6, p0 = ch0 & 63;
#pragma unroll
            for (int e = 0; e < 8; ++e) XT[(hh * 64 + p0 + e) * XT_ST + lane] = (bf16_t)f2bf(y[e]); }
        else if (ch0 < 768) { const int gg = (ch0 - 512) >> 7, n0 = (ch0 - 512) & 127; *(LAS u32x4*)(Bn + (gg * 64 + lane) * CN_ST + n0) = pack8(y); }
        else { const int gg = (ch0 - 768) >> 7, n0 = (ch0 - 768) & 127; *(LAS u32x4*)(Cn + (gg * 64 + lane) * CN_ST + n0) = pack8(y); }
    });
    __syncthreads();
#define CF(lt, ks) (*(const LAS bf16x8*)(Cn + (g * 64 + 16 * (lt) + fr) * CN_ST + 32 * (ks) + 8 * fq))
    f32x4 yacc[4][4];
    const void* hin; bool hin_f32;
    if (seq < 2) { hin = WSB(WS_STATES) + (size_t)((seq * 128 + c) * 8 + h) * 8192; hin_f32 = false; }
    else { hin = IN0(2) + (size_t)((l * BS + seq - 2) * 8 + h) * 8192; hin_f32 = true; }
#pragma unroll
    for (int pt = 0; pt < 4; ++pt) {
#pragma unroll
        for (int lt = 0; lt < 4; ++lt) yacc[pt][lt] = (f32x4){0.f, 0.f, 0.f, 0.f};
        bf16x8 af[4];
        if (hin_f32) {
#pragma unroll
            for (int ks = 0; ks < 4; ++ks) af[ks] = as_frag(load8(hin, (size_t)(16 * pt + fr) * 128 + 32 * ks + 8 * fq, true));
        } else {
#pragma unroll
            for (int ks = 0; ks < 4; ++ks) af[ks] = as_frag(load8(hin, (size_t)(16 * pt + fr) * 128 + 32 * ks + 8 * fq, false));
        }
#pragma unroll
        for (int ks = 0; ks < 4; ++ks)
#pragma unroll
            for (int lt = 0; lt < 4; ++lt) yacc[pt][lt] = MFMA16(af[ks], CF(lt, ks), yacc[pt][lt]);
        __builtin_amdgcn_sched_barrier(0);
    }
    float acl[4];
#pragma unroll
    for (int lt = 0; lt < 4; ++lt) { acl[lt] = sACS[h * 64 + 16 * lt + fr]; const float el = fexp(acl[lt]);
#pragma unroll
        for (int pt = 0; pt < 4; ++pt) yacc[pt][lt] = yacc[pt][lt] * el; }
    const float Dh = INL(16, 8)[h];
#pragma unroll
    for (int lt = 0; lt < 4; ++lt) {
        bf16x8 pf[2], cfl[4];
#pragma unroll
        for (int ks = 0; ks < 4; ++ks) cfl[ks] = CF(lt, ks);
        unsigned pw[4][2];
#pragma unroll
        for (int st = 0; st < 4; ++st) {
            f32x4 cb = (f32x4){0.f, 0.f, 0.f, 0.f};
#pragma unroll
            for (int ks = 0; ks < 4; ++ks) { const bf16x8 a = *(const LAS bf16x8*)(Bn + (g * 64 + 16 * st + fr) * CN_ST + 32 * ks + 8 * fq); cb = MFMA16(a, cfl[ks], cb); }
            const f32x4 as4 = *(const LAS f32x4*)(sACS + h * 64 + 16 * st + 4 * fq), dt4 = *(const LAS f32x4*)(sDT + h * 64 + 16 * st + 4 * fq);
            float m[4];
#pragma unroll
            for (int i = 0; i < 4; ++i) { const int s = 16 * st + 4 * fq + i, ll = 16 * lt + fr;
                float v = (s <= ll) ? cb[i] * fexp(acl[lt] - as4[i]) * dt4[i] : 0.f; if (s == ll) v += Dh; m[i] = v; }
            pw[st][0] = pk2(m[0], m[1]); pw[st][1] = pk2(m[2], m[3]);
        }
        { u32x4 v; v.x = pw[0][0]; v.y = pw[0][1]; v.z = pw[1][0]; v.w = pw[1][1]; pf[0] = as_frag(v); v.x = pw[2][0]; v.y = pw[2][1]; v.z = pw[3][0]; v.w = pw[3][1]; pf[1] = as_frag(v); }
#pragma unroll
        for (int pt = 0; pt < 4; ++pt)
#pragma unroll
            for (int kk = 0; kk < 2; ++kk) { const LAS bf16_t* xp = XT + (h * 64 + 16 * pt + fr) * XT_ST + 32 * kk + 4 * fq;
                const bf16x8 a = mk_frag(*(const LAS u32x2*)xp, *(const LAS u32x2*)(xp + 16)); yacc[pt][lt] = MFMA16(a, pf[kk], yacc[pt][lt]); }
        asm volatile("" ::: "memory");
    }
    float ss[4] = {0.f, 0.f, 0.f, 0.f};
#pragma unroll
    for (int lt = 0; lt < 4; ++lt)
#pragma unroll
        for (int pt = 0; pt < 4; ++pt) { const u32x2 z = *(const u32x2*)(WSB(WS_PA) + (size_t)(row0 + 16 * lt + fr) * 1536 + h * 64 + 16 * pt + 4 * fq);
            f32x4 v = yacc[pt][lt]; v[0] *= siluf_(bflo(z.x)); v[1] *= siluf_(bfhi(z.x)); v[2] *= siluf_(bflo(z.y)); v[3] *= siluf_(bfhi(z.y));
            yacc[pt][lt] = v; ss[lt] += v[0] * v[0] + v[1] * v[1] + v[2] * v[2] + v[3] * v[3]; }
#pragma unroll
    for (int lt = 0; lt < 4; ++lt) { ss[lt] += __shfl_xor(ss[lt], 16); ss[lt] += __shfl_xor(ss[lt], 32); if (fq == 0) sRed[h * 64 + 16 * lt + fr] = ss[lt]; }
    __syncthreads();
    const float* ng = INL(17, 512);
#pragma unroll
    for (int lt = 0; lt < 4; ++lt) { float tot = 0.f;
#pragma unroll
        for (int hh = 0; hh < 8; ++hh) tot += sRed[hh * 64 + 16 * lt + fr];
        const float rstd = 1.f / sqrtf(tot * (1.f / 512.f) + EPS);
#pragma unroll
        for (int pt = 0; pt < 4; ++pt) { const f32x4 gg = *(const f32x4*)(ng + h * 64 + 16 * pt + 4 * fq); const f32x4 v = yacc[pt][lt];
            u32x2 w; w.x = pk2(v[0] * rstd * gg[0], v[1] * rstd * gg[1]); w.y = pk2(v[2] * rstd * gg[2], v[3] * rstd * gg[3]);
            *(u32x2*)(WSB(WS_PA) + (size_t)(row0 + 16 * lt + fr) * 1536 + h * 64 + 16 * pt + 4 * fq) = w; } }
    __syncthreads();
}

struct AH {
    const bf16_t* q; int qld; bf16_t* o; int old_;
    const void* kn; size_t knld; bool kn_f32; const bf16_t* kn2; size_t kn2ld; int split;
    const bf16_t* kp; size_t kpld;
    const void* v; size_t vld; bool v_f32; const bf16_t* v2; size_t v2ld;
    int count, cdiff0;
};
template <int DK, bool BIAS, bool SHARED>
__device__ __forceinline__ void attn_core(const Ctx& C, const AH& H, int n_iter) {
    constexpr int KST = DK + 8, VST = 72, KBYTES = 64 * KST * 2, VBYTES = 64 * VST * 2, HBY = KBYTES + VBYTES;
    const int lane = C.lane, hf = C.wave >> 2, wq = C.wave & 3, tid_h = C.tid & 255, fr = lane & 15, fq = lane >> 4;
    LAS float* tab = (LAS float*)(C.lds + 4 * HBY) + hf * 260;
    bf16x8 qf[DK / 32];
#pragma unroll
    for (int ks = 0; ks < DK / 32; ++ks) qf[ks] = *(const bf16x8*)(H.q + (size_t)(16 * wq + fr) * H.qld + 32 * ks + 8 * fq);
    f32x4 oacc[4];
#pragma unroll
    for (int d = 0; d < 4; ++d) oacc[d] = (f32x4){0.f, 0.f, 0.f, 0.f};
    float m_run = -1e30f, l_run = 0.f;
    u32x4 rk[2], rp = (u32x4){0u, 0u, 0u, 0u}, rv[2];
    const int NPI = SHARED ? 1 : 2, PSTR = SHARED ? 0 : 256, ptid = SHARED ? C.tid : tid_h, lcount = SHARED ? n_iter : H.count, hsl = SHARED ? 0 : hf;
#define ATT_GLOAD(t) do { if ((t) < lcount) { const bool sec = (t) >= H.split; const int tk = sec ? (t) - H.split : (t); \
        _Pragma("unroll") for (int i = 0; i < NPI; ++i) { const int p = ptid + PSTR * i; \
            { const int key = p >> 3, ch = p & 7; rk[i] = sec ? load8(H.kn2, (size_t)(tk * 64 + key) * H.kn2ld + 8 * ch, false) : load8(H.kn, (size_t)(tk * 64 + key) * H.knld + 8 * ch, H.kn_f32); } \
            { const int key = p & 63, dc = p >> 6; rv[i] = sec ? load8(H.v2, (size_t)(tk * 64 + key) * H.v2ld + 8 * dc, false) : load8(H.v, (size_t)(tk * 64 + key) * H.vld + 8 * dc, H.v_f32); } } \
        if (DK == 96 && (!SHARED || ptid < 256)) { const int key = (ptid & 255) >> 2, ch = ptid & 3; rp = *(const u32x4*)(H.kp + (size_t)((t) * 64 + key) * H.kpld + 8 * ch); } } } while (0)
#define ATT_SSTORE(t, buf) do { if ((t) < lcount) { LAS unsigned char* base = C.lds + ((buf) * 2 + hsl) * HBY; \
        _Pragma("unroll") for (int i = 0; i < NPI; ++i) { const int p = ptid + PSTR * i; \
            { const int key = p >> 3, ch = p & 7; *(LAS u32x4*)(base + (key * KST + 8 * ch) * 2) = rk[i]; } \
            { const int key = p & 63, dc = p >> 6; LAS bf16_t* vt = (LAS bf16_t*)(base + KBYTES) + (8 * dc) * VST + key; const u32x4 vv = rv[i]; \
              vt[0] = (bf16_t)(vv.x & 0xffffu); vt[VST] = (bf16_t)(vv.x >> 16); vt[2 * VST] = (bf16_t)(vv.y & 0xffffu); vt[3 * VST] = (bf16_t)(vv.y >> 16); \
              vt[4 * VST] = (bf16_t)(vv.z & 0xffffu); vt[5 * VST] = (bf16_t)(vv.z >> 16); vt[6 * VST] = (bf16_t)(vv.w & 0xffffu); vt[7 * VST] = (bf16_t)(vv.w >> 16); } } \
        if (DK == 96 && (!SHARED || ptid < 256)) { const int key = (ptid & 255) >> 2, ch = ptid & 3; *(LAS u32x4*)(base + (key * KST + 64 + 8 * ch) * 2) = rp; } } } while (0)
    ATT_GLOAD(0); ATT_SSTORE(0, 0);
    __syncthreads();
    for (int t = 0; t < n_iter; ++t) {
        ATT_GLOAD(t + 1);
        if (t < H.count) {
            const LAS unsigned char* base = C.lds + ((t & 1) * 2 + hsl) * HBY;
            f32x4 s[4];
#pragma unroll
            for (int mt = 0; mt < 4; ++mt) { s[mt] = (f32x4){0.f, 0.f, 0.f, 0.f};
#pragma unroll
                for (int ks = 0; ks < DK / 32; ++ks) { const bf16x8 a = *(const LAS bf16x8*)(base + ((16 * mt + fr) * KST + 32 * ks + 8 * fq) * 2); s[mt] = MFMA16(a, qf[ks], s[mt]); } }
            if (BIAS) { const int cd = H.cdiff0 - t, ql = 16 * wq + fr;
                if (cd >= 3) { const float bb = tab[256];
#pragma unroll
                    for (int mt = 0; mt < 4; ++mt) s[mt] = s[mt] + bb; }
                else {
#pragma unroll
                    for (int mt = 0; mt < 4; ++mt)
#pragma unroll
                        for (int i = 0; i < 4; ++i) { int rel = cd * 64 + ql - (16 * mt + 4 * fq + i); rel = rel > 128 ? 128 : rel; s[mt][i] += tab[rel + 128]; } } }
            float mx = s[0][0];
#pragma unroll
            for (int mt = 0; mt < 4; ++mt)
#pragma unroll
                for (int i = 0; i < 4; ++i) mx = fmaxf(mx, s[mt][i]);
            mx = fmaxf(mx, __shfl_xor(mx, 16)); mx = fmaxf(mx, __shfl_xor(mx, 32));
            const float mnew = fmaxf(m_run, mx), alpha = fexp2(m_run - mnew); m_run = mnew;
            float psum = 0.f;
#pragma unroll
            for (int mt = 0; mt < 4; ++mt)
#pragma unroll
                for (int i = 0; i < 4; ++i) { const float p = fexp2(s[mt][i] - mnew); s[mt][i] = p; psum += p; }
            l_run = l_run * alpha + psum;
#pragma unroll
            for (int d = 0; d < 4; ++d) oacc[d] = oacc[d] * alpha;
            bf16x8 pf[2];
#pragma unroll
            for (int kk = 0; kk < 2; ++kk) { u32x4 v; v.x = pk2(s[2 * kk][0], s[2 * kk][1]); v.y = pk2(s[2 * kk][2], s[2 * kk][3]); v.z = pk2(s[2 * kk + 1][0], s[2 * kk + 1][1]); v.w = pk2(s[2 * kk + 1][2], s[2 * kk + 1][3]); pf[kk] = as_frag(v); }
            const LAS bf16_t* vt = (const LAS bf16_t*)(base + KBYTES);
#pragma unroll
            for (int d = 0; d < 4; ++d)
#pragma unroll
                for (int kk = 0; kk < 2; ++kk) { const LAS bf16_t* vp = vt + (16 * d + fr) * VST + 32 * kk + 4 * fq;
                    const bf16x8 a = mk_frag(*(const LAS u32x2*)vp, *(const LAS u32x2*)(vp + 16)); oacc[d] = MFMA16(a, pf[kk], oacc[d]); }
        }
        ATT_SSTORE(t + 1, (t + 1) & 1);
        __syncthreads();
    }
#undef ATT_GLOAD
#undef ATT_SSTORE
    l_run += __shfl_xor(l_run, 16); l_run += __shfl_xor(l_run, 32);
    const float inv = 1.f / l_run;
#pragma unroll
    for (int d = 0; d < 4; ++d) { u32x2 w; w.x = pk2(oacc[d][0] * inv, oacc[d][1] * inv); w.y = pk2(oacc[d][2] * inv, oacc[d][3] * inv);
        *(u32x2*)(H.o + (size_t)(16 * wq + fr) * H.old_ + 16 * d + 4 * fq) = w; }
}

__device__ __forceinline__ void attn_core2(const Ctx& C, const AH& H, int n_iter) {
    constexpr int DK = 96, KST = DK + 8, VST = 72, KBYTES = 64 * KST * 2, VBYTES = 64 * VST * 2, HBY = KBYTES + VBYTES;
    const int lane = C.lane, fr = lane & 15, fq = lane >> 4, p = C.tid;
    bf16x8 qf[2][3];
#pragma unroll
    for (int sb = 0; sb < 2; ++sb)
#pragma unroll
        for (int ks = 0; ks < 3; ++ks) qf[sb][ks] = *(const bf16x8*)(H.q + (size_t)(16 * sb + fr) * H.qld + 32 * ks + 8 * fq);
    f32x4 oacc[2][4];
#pragma unroll
    for (int sb = 0; sb < 2; ++sb)
#pragma unroll
        for (int d = 0; d < 4; ++d) oacc[sb][d] = (f32x4){0.f, 0.f, 0.f, 0.f};
    float m_run[2] = {-1e30f, -1e30f}, l_run[2] = {0.f, 0.f};
    u32x4 rk[2], rp[2], rv[2];
    rp[0] = (u32x4){0u, 0u, 0u, 0u}; rp[1] = rp[0];
#define A2_GLOAD(t, R) do { if ((t) < n_iter) { \
        { const int key = p >> 3, ch = p & 7; rk[R] = *(const u32x4*)((const bf16_t*)H.kn + (size_t)((t) * 64 + key) * H.knld + 8 * ch); } \
        { const int key = p & 63, dc = p >> 6; rv[R] = *(const u32x4*)((const bf16_t*)H.v + (size_t)((t) * 64 + key) * H.vld + 8 * dc); } \
        if (p < 256) { const int key = p >> 2, ch = p & 3; rp[R] = *(const u32x4*)(H.kp + (size_t)((t) * 64 + key) * H.kpld + 8 * ch); } } } while (0)
#define A2_SSTORE(t, buf, R) do { if ((t) < n_iter) { LAS unsigned char* base = C.lds + (buf) * HBY; \
        { const int key = p >> 3, ch = p & 7; *(LAS u32x4*)(base + (key * KST + 8 * ch) * 2) = rk[R]; } \
        { const int key = p & 63, dc = p >> 6; LAS bf16_t* vt = (LAS bf16_t*)(base + KBYTES) + (8 * dc) * VST + key; const u32x4 vv = rv[R]; \
          vt[0] = (bf16_t)(vv.x & 0xffffu); vt[VST] = (bf16_t)(vv.x >> 16); vt[2 * VST] = (bf16_t)(vv.y & 0xffffu); vt[3 * VST] = (bf16_t)(vv.y >> 16); \
          vt[4 * VST] = (bf16_t)(vv.z & 0xffffu); vt[5 * VST] = (bf16_t)(vv.z >> 16); vt[6 * VST] = (bf16_t)(vv.w & 0xffffu); vt[7 * VST] = (bf16_t)(vv.w >> 16); } \
        if (p < 256) { const int key = p >> 2, ch = p & 3; *(LAS u32x4*)(base + (key * KST + 64 + 8 * ch) * 2) = rp[R]; } } } while (0)
#define A2_COMPUTE(t, BUF) do { if ((t) < H.count) { \
            const LAS unsigned char* base = C.lds + (BUF) * HBY; \
            f32x4 s[2][4]; \
            _Pragma("unroll") for (int mt = 0; mt < 4; ++mt) { s[0][mt] = (f32x4){0.f, 0.f, 0.f, 0.f}; s[1][mt] = (f32x4){0.f, 0.f, 0.f, 0.f}; \
                _Pragma("unroll") for (int ks = 0; ks < 3; ++ks) { const bf16x8 a = *(const LAS bf16x8*)(base + ((16 * mt + fr) * KST + 32 * ks + 8 * fq) * 2); \
                    s[0][mt] = MFMA16(a, qf[0][ks], s[0][mt]); s[1][mt] = MFMA16(a, qf[1][ks], s[1][mt]); } } \
            bf16x8 pf[2][2]; \
            _Pragma("unroll") for (int sb = 0; sb < 2; ++sb) { \
                float mx = s[sb][0][0]; \
                _Pragma("unroll") for (int mt = 0; mt < 4; ++mt) _Pragma("unroll") for (int i = 0; i < 4; ++i) mx = fmaxf(mx, s[sb][mt][i]); \
                mx = fmaxf(mx, __shfl_xor(mx, 16)); mx = fmaxf(mx, __shfl_xor(mx, 32)); \
                const float mnew = fmaxf(m_run[sb], mx), alpha = fexp2(m_run[sb] - mnew); m_run[sb] = mnew; \
                float psum = 0.f; \
                _Pragma("unroll") for (int mt = 0; mt < 4; ++mt) _Pragma("unroll") for (int i = 0; i < 4; ++i) { const float pp = fexp2(s[sb][mt][i] - mnew); s[sb][mt][i] = pp; psum += pp; } \
                l_run[sb] = l_run[sb] * alpha + psum; \
                _Pragma("unroll") for (int d = 0; d < 4; ++d) oacc[sb][d] = oacc[sb][d] * alpha; \
                _Pragma("unroll") for (int kk = 0; kk < 2; ++kk) { u32x4 v; v.x = pk2(s[sb][2 * kk][0], s[sb][2 * kk][1]); v.y = pk2(s[sb][2 * kk][2], s[sb][2 * kk][3]); v.z = pk2(s[sb][2 * kk + 1][0], s[sb][2 * kk + 1][1]); v.w = pk2(s[sb][2 * kk + 1][2], s[sb][2 * kk + 1][3]); pf[sb][kk] = as_frag(v); } \
            } \
            const LAS bf16_t* vt = (const LAS bf16_t*)(base + KBYTES); \
            _Pragma("unroll") for (int d = 0; d < 4; ++d) _Pragma("unroll") for (int kk = 0; kk < 2; ++kk) { const LAS bf16_t* vp = vt + (16 * d + fr) * VST + 32 * kk + 4 * fq; \
                    const bf16x8 a = mk_frag(*(const LAS u32x2*)vp, *(const LAS u32x2*)(vp + 16)); \
                    oacc[0][d] = MFMA16(a, pf[0][kk], oacc[0][d]); oacc[1][d] = MFMA16(a, pf[1][kk], oacc[1][d]); } \
        } } while (0)
    A2_GLOAD(0, 0); A2_SSTORE(0, 0, 0); A2_GLOAD(1, 1);
    __syncthreads();
    for (int t = 0; t < n_iter; t += 2) {
        A2_GLOAD(t + 2, 0); A2_COMPUTE(t, 0); A2_SSTORE(t + 1, 1, 1); __syncthreads();
        A2_GLOAD(t + 3, 1); A2_COMPUTE(t + 1, 1); A2_SSTORE(t + 2, 0, 0); __syncthreads();
    }
#undef A2_COMPUTE
#undef A2_GLOAD
#undef A2_SSTORE
#pragma unroll
    for (int sb = 0; sb < 2; ++sb) { float l = l_run[sb]; l += __shfl_xor(l, 16); l += __shfl_xor(l, 32);
        const float inv = 1.f / l;
#pragma unroll
        for (int d = 0; d < 4; ++d) { u32x2 w; w.x = pk2(oacc[sb][d][0] * inv, oacc[sb][d][1] * inv); w.y = pk2(oacc[sb][d][2] * inv, oacc[sb][d][3] * inv);
            *(u32x2*)(H.o + (size_t)(16 * sb + fr) * H.old_ + 16 * d + 4 * fq) = w; } }
}

constexpr int N_MLAP = 512, N_S3 = 288, N_MLAS = 128, N_BANDP = 1024, N_BANDS = 128, N_P5 = N_MLAP + N_S3 + N_MLAS + N_BANDP + N_BANDS;
#ifndef P5SEL
#define P5SEL 7
#endif
__device__ __forceinline__ void p5_unit(const Ctx& C, int idx) {
    const int hf = C.wave >> 2, l = C.l;
    AH H; H.split = 1 << 30; H.kn2 = nullptr; H.kn2ld = 0; H.v2 = nullptr; H.v2ld = 0; H.kn_f32 = false; H.v_f32 = false; H.kp = nullptr; H.kpld = 0; H.cdiff0 = 0;
    if (idx < N_MLAP) {
        const int q4 = 31 - (idx >> 4), b = (idx >> 3) & 1, h = idx & 7, c = 4 * q4 + (C.wave >> 1); const size_t row0 = (size_t)b * TP + c * 64 + 32 * (C.wave & 1);
        H.q = WSB(WS_Q) + row0 * 768 + h * 96; H.qld = 768; H.o = WSB(WS_YBC) + row0 * 1024 + h * 64; H.old_ = 1024;
        H.kn = WSB(WS_KVP) + (size_t)b * TP * 1024 + h * 64; H.knld = 1024; H.kp = WSB(WS_KPEP) + (size_t)b * TP * 32; H.kpld = 32;
        H.v = WSB(WS_KVP) + (size_t)b * TP * 1024 + 512 + h * 64; H.vld = 1024; H.count = c + 1;
        if (P5SEL & 1) attn_core2(C, H, 4 * q4 + 4); return;
    }
    idx -= N_MLAP;
    if (idx < N_S3) { if (P5SEL & 2) ssd_s3_item(C, idx); return; }
    idx -= N_S3;
    if (idx < N_MLAS) {
        const int b = idx >> 2, h = (idx & 3) * 2 + hf; const size_t row0 = (size_t)NP + b * 64;
        H.q = WSB(WS_Q) + row0 * 768 + h * 96; H.qld = 768; H.o = WSB(WS_YBC) + row0 * 1024 + h * 64; H.old_ = 1024;
        H.kn = WSB(WS_XR) + (size_t)b * KS_ALL * 1024 + h * 64; H.knld = 1024; H.kp = WSB(WS_KPES) + (size_t)b * KS_ALL * 32; H.kpld = 32;
        H.v = WSB(WS_XR) + (size_t)b * KS_ALL * 1024 + 512 + h * 64; H.vld = 1024; H.count = 33;
        if (P5SEL & 1) attn_core<96, false, false>(C, H, 33); return;
    }
    idx -= N_MLAS;
    constexpr int HBY64 = 64 * 72 * 2 * 2;
    if (idx < N_BANDP) {
        const int cp = idx >> 4, b = (idx >> 3) & 1, h = idx & 7, c = 2 * cp + hf, kt0 = c > 8 ? c - 8 : 0; const size_t row0 = (size_t)b * TP + c * 64;
        LAS float* tab = (LAS float*)(C.lds + 4 * HBY64) + hf * 260; const float* rb = INL(32, 8 * 257) + h * 257;
        for (int i = C.tid & 255; i < 257; i += 256) tab[i] = rb[i] * LOG2E;
        H.q = WSB(WS_PD) + row0 * 1536 + h * 64; H.qld = 1536; H.o = WSB(WS_PD) + row0 * 1536 + h * 64; H.old_ = 1536;
        H.kn = WSB(WS_PD) + ((size_t)b * TP + kt0 * 64) * 1536 + 512 + h * 64; H.knld = 1536;
        H.v = WSB(WS_PD) + ((size_t)b * TP + kt0 * 64) * 1536 + 1024 + h * 64; H.vld = 1536; H.count = c - kt0 + 1; H.cdiff0 = c - kt0;
        const int c1 = 2 * cp + 1;
        if (P5SEL & 4) attn_core<64, true, false>(C, H, (c1 > 8 ? 8 : c1) + 1); return;
    }
    idx -= N_BANDP;
    {
        const int b = idx >> 2, h = (idx & 3) * 2 + hf; const size_t row0 = (size_t)NP + b * 64;
        LAS float* tab = (LAS float*)(C.lds + 4 * HBY64) + hf * 260; const float* rb = INL(32, 8 * 257) + h * 257;
        for (int i = C.tid & 255; i < 257; i += 256) tab[i] = rb[i] * LOG2E;
        H.q = WSB(WS_PD) + row0 * 1536 + h * 64; H.qld = 1536; H.o = WSB(WS_PD) + row0 * 1536 + h * 64; H.old_ = 1536;
        H.kn = INL(7, (size_t)BS * 512 * 512) + (size_t)b * 512 * 512 + h * 64; H.knld = 512; H.kn_f32 = true;
        H.v = INL(8, (size_t)BS * 512 * 512) + (size_t)b * 512 * 512 + h * 64; H.vld = 512; H.v_f32 = true;
        H.split = 8; H.kn2 = WSB(WS_PD) + row0 * 1536 + 512 + h * 64; H.kn2ld = 1536; H.v2 = WSB(WS_PD) + row0 * 1536 + 1024 + h * 64; H.v2ld = 1536;
        H.count = 9; H.cdiff0 = 8;
        if (P5SEL & 4) attn_core<64, true, false>(C, H, 9);
    }
}

__global__ void __launch_bounds__(NTHREADS) mk_fwd(Args args) {
    extern __shared__ __attribute__((aligned(16))) unsigned char lds_raw[];
    cg::grid_group grid = cg::this_grid();
    Ctx C;
    C.A = &args;
    C.out = args.out; C.ws = args.ws; C.lds = (LAS unsigned char*)lds_raw;
    C.tid = threadIdx.x; C.lane = C.tid & 63; C.wave = __builtin_amdgcn_readfirstlane(C.tid >> 6);
    C.G = gridDim.x; C.bid = blockIdx.x; C.gw = C.bid * NWAVES + C.wave; C.NGW = C.G * NWAVES;
    unsigned* ctl = (unsigned*)(C.ws + WS_CTL);
    LAS int* sIdx = (LAS int*)(C.lds + LDS_BYTES - 16);
#ifndef PMASK
#define PMASK 0xFFF
#endif
#define REFRESH() do { int t_ = threadIdx.x; asm volatile("" : "+v"(t_)); C.tid = t_; C.lane = t_ & 63; C.wave = __builtin_amdgcn_readfirstlane(t_ >> 6); C.gw = C.bid * NWAVES + C.wave; GAS unsigned char* w_ = (GAS unsigned char*)args.ws; asm volatile("" : "+s"(w_)); C.ws = (unsigned char*)w_; GAS float* o_ = (GAS float*)args.out; asm volatile("" : "+s"(o_)); C.out = (float*)o_; } while (0)
#define PH_BEGIN(n) if ((PMASK >> (n)) & 1) { REFRESH();
#define PH_END } grid.sync();
#pragma unroll 1
    for (int l = 0; l < 2; ++l) {
        C.l = l;
        PH_BEGIN(0)
            if (C.bid == 0 && C.tid == 0) { ctl[l] = 0u; ctl[2 + l] = 0u; }
            { const size_t gt = (size_t)C.bid * NTHREADS + C.tid, GT = (size_t)C.G * NTHREADS; for (size_t i = gt; i < (size_t)R; i += GT) ((float*)(C.ws + WS_SUMSQ))[i] = 0.f; }
            phase_wprep(C);
            phase_norm(C, INL(9, 1024), l > 0);
        PH_END
        PH_BEGIN(1)
            SchedInproj S{WSB(WS_HB), WSB(WS_WT_IN), WSB(WS_PA), WSB(WS_ZB), WSB(WS_XR), WSB(WS_PD), C.G, C.bid};
            pg8::EpiStore E; pg8::gemm_phase(C.lds, S, E, C.tid);
        PH_END
        PH_BEGIN(2)
            phase_mla_prep(C); phase_band_prep(C); phase_sconv(C);
            for (int it = C.G - 1 - C.bid; it < N_S3; it += C.G) { REFRESH(); ssd_s1_item(C, it); }
        PH_END
        PH_BEGIN(3)
            ssd_scan(C);
            SchedP3 S{WSB(WS_ZB), WSB(WS_WT_QUP), WSB(WS_CKVP), WSB(WS_CKVS), WSB(WS_WT_KVUP), WSB(WS_Q), WSB(WS_KVP), WSB(WS_XR), C.G, C.bid};
            pg8::EpiStore E; pg8::gemm_phase(C.lds, S, E, C.tid);
        PH_END
        PH_BEGIN(4)
            phase_qk_post(C);
        PH_END
        PH_BEGIN(5)
            for (;;) {
                if (C.tid == 0) *sIdx = (int)atomicAdd(&ctl[l], 1u);
                __syncthreads();
                const int idx = *sIdx;
                __syncthreads();
                if (idx >= N_P5) break;
                REFRESH();
                p5_unit(C, idx);
            }
        PH_END
        PH_BEGIN(7)
            SchedMerge S{WSB(WS_HB), WSB(WS_WT_G), WSB(WS_WT_OUT), WSB(WS_PA), WSB(WS_YBC), WSB(WS_PD), C.G, C.bid};
            pg8::EpiMerge E{INL(11, 4096), WSB(WS_ZB), WSB(WS_XR)}; pg8::gemm_phase(C.lds, S, E, C.tid);
        PH_END
        PH_BEGIN(8)
            SchedOne S{WSB(WS_ZB), WSB(WS_WT_O), nullptr, 1024, 1024, 0, 72, 4, 16, C.G, C.bid};
            pg8::EpiResidNorm E{l > 0 ? C.out : IN0(0), l > 0 ? C.out + (size_t)NP * DM : IN0(1), C.out, WSB(WS_HB), INL(35, 1024), (float*)(C.ws + WS_SUMSQ)}; pg8::gemm_phase(C.lds, S, E, C.tid);
        PH_END
        PH_BEGIN(10)
            SchedOne S{WSB(WS_HB), WSB(WS_WT_UP), nullptr, 1024, 1024, 0, 72, 22, 16, C.G, C.bid};
            pg8::EpiSwigluNorm E{WSB(WS_XR), (const float*)(C.ws + WS_SUMSQ)}; pg8::gemm_phase(C.lds, S, E, C.tid);
        PH_END
        PH_BEGIN(11)
            SchedOne S{WSB(WS_XR), WSB(WS_WT_DOWN), nullptr, 2816, 2816, 0, 72, 4, 44, C.G, C.bid};
            pg8::EpiResid E{C.out, C.out + (size_t)NP * DM, C.out}; pg8::gemm_phase(C.lds, S, E, C.tid);
        PH_END
    }
}

extern "C" void kernel_launch(void* const* d_in, const int* in_sizes, int n_in, void* d_out, int out_size, void* d_ws, size_t ws_size, hipStream_t stream) {
    static int grid = 0;
    if (grid == 0) {
        int dev = 0, cus = 0, per_cu = 0;
        (void)hipGetDevice(&dev);
        (void)hipDeviceGetAttribute(&cus, hipDeviceAttributeMultiprocessorCount, dev);
        (void)hipFuncSetAttribute((const void*)mk_fwd, hipFuncAttributeMaxDynamicSharedMemorySize, LDS_BYTES);
        (void)hipOccupancyMaxActiveBlocksPerMultiprocessor(&per_cu, (const void*)mk_fwd, NTHREADS, LDS_BYTES);
        if (per_cu < 1) per_cu = 1;
        grid = cus * per_cu;
        if (ws_size < WS_END || n_in != 38 || (size_t)out_size != O_END) { fprintf(stderr, "kernel_launch: bad sizes ws %zu n_in %d out %d\n", ws_size, n_in, out_size); grid = -1; }
    }
    if (grid < 0) return;
    Args a{};
    for (int i = 0; i < 38; ++i) a.in[i] = (const float*)d_in[i];
    a.out = (float*)d_out; a.ws = (unsigned char*)d_ws; a.ph_lo = 0; a.ph_hi = 1000;
    void* kargs[] = {&a};
    hipError_t e = hipLaunchCooperativeKernel((const void*)mk_fwd, dim3(grid), dim3(NTHREADS), kargs, LDS_BYTES, stream);
    if (e != hipSuccess) fprintf(stderr, "cooperative launch failed: %s (grid %d)\n", hipGetErrorString(e), grid);
}
```
